# Optimizing an MI355X kernel written in HIP

```python
import numpy as np
import jax
import jax.numpy as jnp
from jax import lax


D_MODEL = 1024
BATCH = 4
SEQ = 4096
DEPTH = 2

HEAD_DIM = 64
N_HEADS = D_MODEL // HEAD_DIM
N_KV_HEADS = 4
GROUP = N_HEADS // N_KV_HEADS
ROPE_THETA = 10000.0
RMS_EPS = 1e-6
NEG_INF = -1e30
POS_INF = 1e30
IDX_HEADS = 8
IDX_DIM = HEAD_DIM
DSA_TOPK = 256
DSA_Q_BLOCK = 128
CMP_LEN = 32
CMP_STRIDE = 16
CMP_HIDDEN = 256
SLC_LEN = 64
SLC_TOPN = 16
WINDOW = 512
NSA_Q_BLOCK = 64
N_NSA_BRANCH = 3
D_FF = 256 * ((8 * D_MODEL // 3 + 255) // 256)
N_EXPERTS = 8
TOP_K_EXPERTS = 2
D_FF_EXPERT = 7 * D_MODEL // 2
N_A_LAYERS = max(1, DEPTH // 2)
N_B_LAYERS = DEPTH - N_A_LAYERS
N_DENSE_LAYERS = (DEPTH + 1) // 2
N_MOE_LAYERS = DEPTH // 2
A_WIDTHS = (N_HEADS * HEAD_DIM, N_KV_HEADS * HEAD_DIM, N_KV_HEADS * HEAD_DIM, IDX_HEADS * IDX_DIM, IDX_DIM, IDX_HEADS)
A_IN = sum(A_WIDTHS)
B_IN = N_HEADS * HEAD_DIM + N_NSA_BRANCH * N_HEADS
KV_WIDTH = 2 * N_NSA_BRANCH * N_KV_HEADS * HEAD_DIM

kernel_name = 'yoco_dsa_nsa_adaln_moe_trunk'

F32 = jnp.float32


def rmsnorm(x, g):
    xf = x.astype(F32)
    y = xf * lax.rsqrt(jnp.mean(xf * xf, axis=-1, keepdims=True) + RMS_EPS)
    return (y * g.astype(F32)).astype(x.dtype)


def modulate(u, shift, scale):
    return u * (1.0 + scale[:, None, :]) + shift[:, None, :]


def rope_tables(positions, dim):
    inv = 1.0 / (ROPE_THETA ** (jnp.arange(0, dim, 2, dtype=F32) / dim))
    ang = positions.astype(F32)[..., None] * inv
    return jnp.cos(ang), jnp.sin(ang)


def apply_rope(x, cos, sin):
    x1, x2 = jnp.split(x.astype(F32), 2, axis=-1)
    c = cos[:, :, None, :]
    s = sin[:, :, None, :]
    return jnp.concatenate([x1 * c - x2 * s, x2 * c + x1 * s], axis=-1).astype(x.dtype)


def masked_softmax(s, mask):
    p = jax.nn.softmax(jnp.where(mask, s, NEG_INF), axis=-1)
    return jnp.where(mask, p, 0.0)


def swiglu(u, wg, wu, wd):
    return (jax.nn.silu(u @ wg) * (u @ wu)) @ wd


def moe_swiglu(u, w_router, wg, wu, wd):
    bsz, seq, d = u.shape
    xf = u.reshape(bsz * seq, d)
    logits = (xf @ w_router).astype(F32)
    vals, idx = lax.top_k(logits, TOP_K_EXPERTS)
    w = jax.nn.softmax(vals, axis=-1)
    gate = jnp.sum(jax.nn.one_hot(idx, N_EXPERTS, dtype=F32) * w[..., None], axis=1)
    y = jnp.zeros_like(xf)
    for e in range(N_EXPERTS):
        y = y + gate[:, e:e + 1].astype(xf.dtype) * swiglu(xf, wg[e], wu[e], wd[e])
    return y.reshape(bsz, seq, d)


def dsa_mixer(u, cos, sin, w_in, w_out):
    bsz, seq, _ = u.shape
    splits = [int(i) for i in np.cumsum(A_WIDTHS[:-1])]
    q, k, v, iq, ik, iw = jnp.split(u @ w_in, splits, axis=-1)
    q = apply_rope(q.reshape(bsz, seq, N_HEADS, HEAD_DIM), cos, sin)
    k = apply_rope(k.reshape(bsz, seq, N_KV_HEADS, HEAD_DIM), cos, sin)
    v = v.reshape(bsz, seq, N_KV_HEADS, HEAD_DIM)
    iq = apply_rope(iq.reshape(bsz, seq, IDX_HEADS, IDX_DIM), cos, sin).astype(F32)
    ik = apply_rope(ik.reshape(bsz, seq, 1, IDX_DIM), cos, sin)[:, :, 0].astype(F32)
    iw = iw.astype(F32) * (IDX_HEADS ** -0.5 * IDX_DIM ** -0.5)
    n_keep = min(DSA_TOPK, seq // 4)
    key_pos = jnp.arange(seq)
    scale = HEAD_DIM ** -0.5

    def block(i):
        q0 = i * DSA_Q_BLOCK
        t = q0 + jnp.arange(DSA_Q_BLOCK)
        qb = lax.dynamic_slice_in_dim(q, q0, DSA_Q_BLOCK, axis=1)
        iqb = lax.dynamic_slice_in_dim(iq, q0, DSA_Q_BLOCK, axis=1)
        iwb = lax.dynamic_slice_in_dim(iw, q0, DSA_Q_BLOCK, axis=1)
        rel = jax.nn.relu(jnp.einsum('bqhd,bsd->bqhs', iqb, ik))
        score = jnp.einsum('bqh,bqhs->bqs', iwb, rel)
        score = jnp.where(key_pos[None, None, :] <= t[None, :, None], score, NEG_INF)
        _, idx = lax.top_k(score, n_keep)
        kg = jax.vmap(lambda kb, ib: kb[ib])(k, idx)
        vg = jax.vmap(lambda vb, ib: vb[ib])(v, idx)
        qg = qb.reshape(bsz, DSA_Q_BLOCK, N_KV_HEADS, GROUP, HEAD_DIM)
        s = jnp.einsum('bqgrd,bqkgd->bgrqk', qg, kg).astype(F32) * scale
        valid = (idx <= t[None, :, None])[:, None, None]
        p = masked_softmax(s, valid).astype(vg.dtype)
        o = jnp.einsum('bgrqk,bqkgd->bqgrd', p, vg)
        return o.reshape(bsz, DSA_Q_BLOCK, N_HEADS * HEAD_DIM)

    o = lax.map(block, jnp.arange(seq // DSA_Q_BLOCK))
    o = jnp.transpose(o, (1, 0, 2, 3)).reshape(bsz, seq, N_HEADS * HEAD_DIM)
    return o @ w_out


def compress_blocks(x, blk_idx, pe, w1, w2):
    bsz = x.shape[0]
    n_cmp = blk_idx.shape[0]
    xb = x[:, blk_idx] + pe[None, None, :, None, :]
    xb = jnp.transpose(xb, (0, 1, 3, 2, 4)).reshape(bsz, n_cmp, N_KV_HEADS, CMP_LEN * HEAD_DIM)
    return jax.nn.gelu(xb @ w1) @ w2


def nsa_shared_kv(h, c_act, kv_gain, w_kv_ada, b_kv_ada, w_kv, pe_k, w1_k, w2_k, pe_v, w1_v, w2_v, cos, sin):
    bsz, seq, _ = h.shape
    shift, scale = jnp.split(c_act @ w_kv_ada + b_kv_ada, 2, axis=-1)
    u = modulate(rmsnorm(h, kv_gain), shift, scale)
    kv = (u @ w_kv).reshape(bsz, seq, 2 * N_NSA_BRANCH, N_KV_HEADS, HEAD_DIM)
    k_cmp = apply_rope(kv[:, :, 0], cos, sin)
    v_cmp = kv[:, :, 1]
    k_slc = apply_rope(kv[:, :, 2], cos, sin)
    v_slc = kv[:, :, 3]
    k_win = apply_rope(kv[:, :, 4], cos, sin)
    v_win = kv[:, :, 5]
    n_cmp = (seq - CMP_LEN) // CMP_STRIDE + 1
    blk_idx = np.arange(n_cmp)[:, None] * CMP_STRIDE + np.arange(CMP_LEN)[None, :]
    kc = compress_blocks(k_cmp, blk_idx, pe_k, w1_k, w2_k)
    vc = compress_blocks(v_cmp, blk_idx, pe_v, w1_v, w2_v)
    return kc, vc, k_slc, v_slc, k_win, v_win


def nsa_mixer(u, cos, sin, kc, vc, k_slc, v_slc, k_win, v_win, w_q, w_out):
    bsz, seq, _ = u.shape
    proj = u @ w_q
    q = apply_rope(proj[..., :N_HEADS * HEAD_DIM].reshape(bsz, seq, N_HEADS, HEAD_DIM), cos, sin)
    gates = jax.nn.sigmoid(proj[..., N_HEADS * HEAD_DIM:].astype(F32)).reshape(bsz, seq, N_HEADS, N_NSA_BRANCH)
    n_cmp = kc.shape[1]
    n_slc = seq // SLC_LEN
    n_sel = min(SLC_TOPN, n_slc)
    cmp_start = np.arange(n_cmp) * CMP_STRIDE
    cmp_end = jnp.asarray(cmp_start + CMP_LEN - 1)
    slc_start = np.arange(n_slc) * SLC_LEN
    ov = np.minimum(cmp_start[:, None] + CMP_LEN, slc_start[None, :] + SLC_LEN) - np.maximum(cmp_start[:, None], slc_start[None, :])
    agg = jnp.asarray(np.clip(ov, 0, None) / CMP_LEN, dtype=F32)
    ks_blk = jnp.transpose(k_slc.reshape(bsz, n_slc, SLC_LEN, N_KV_HEADS, HEAD_DIM), (0, 3, 1, 2, 4))
    vs_blk = jnp.transpose(v_slc.reshape(bsz, n_slc, SLC_LEN, N_KV_HEADS, HEAD_DIM), (0, 3, 1, 2, 4))
    kw_pad = jnp.pad(k_win, ((0, 0), (WINDOW, 0), (0, 0), (0, 0)))
    vw_pad = jnp.pad(v_win, ((0, 0), (WINDOW, 0), (0, 0), (0, 0)))
    blk = jnp.arange(n_slc)
    in_blk = jnp.arange(SLC_LEN)
    scale = HEAD_DIM ** -0.5

    def block(i):
        q0 = i * NSA_Q_BLOCK
        t = q0 + jnp.arange(NSA_Q_BLOCK)
        qb = lax.dynamic_slice_in_dim(q, q0, NSA_Q_BLOCK, axis=1)
        qb = jnp.transpose(qb.reshape(bsz, NSA_Q_BLOCK, N_KV_HEADS, GROUP, HEAD_DIM), (0, 2, 3, 1, 4))
        gb = lax.dynamic_slice_in_dim(gates, q0, NSA_Q_BLOCK, axis=1)
        gb = jnp.transpose(gb.reshape(bsz, NSA_Q_BLOCK, N_KV_HEADS, GROUP, N_NSA_BRANCH), (0, 2, 3, 1, 4))
        sc = jnp.einsum('bgrqd,bngd->bgrqn', qb, kc).astype(F32) * scale
        pc = masked_softmax(sc, cmp_end[None, :] <= t[:, None])
        oc = jnp.einsum('bgrqn,bngd->bgrqd', pc.astype(vc.dtype), vc)
        imp = jnp.einsum('bgrqn,nj->bgqj', pc, agg)
        jt = t // SLC_LEN
        valid_b = blk[None, :] * SLC_LEN <= t[:, None]
        forced = (blk[None, :] == 0) | (blk[None, :] == jt[:, None]) | (blk[None, :] == jt[:, None] - 1)
        imp = jnp.where(valid_b, jnp.where(forced, POS_INF, imp), NEG_INF)
        _, sel = lax.top_k(imp, n_sel)
        kg = jax.vmap(jax.vmap(lambda kb, sb: kb[sb]))(ks_blk, sel)
        vg = jax.vmap(jax.vmap(lambda vb, sb: vb[sb]))(vs_blk, sel)
        tok = sel[..., None] * SLC_LEN + in_blk
        ss = jnp.einsum('bgrqd,bgqnld->bgrqnl', qb, kg).astype(F32) * scale
        ss = ss.reshape(bsz, N_KV_HEADS, GROUP, NSA_Q_BLOCK, n_sel * SLC_LEN)
        ms = (tok <= t[None, None, :, None, None]).reshape(bsz, N_KV_HEADS, 1, NSA_Q_BLOCK, n_sel * SLC_LEN)
        ps = masked_softmax(ss, ms)
        os_ = jnp.einsum('bgrqm,bgqmd->bgrqd', ps.astype(vg.dtype), vg.reshape(bsz, N_KV_HEADS, NSA_Q_BLOCK, n_sel * SLC_LEN, HEAD_DIM))
        kwb = lax.dynamic_slice_in_dim(kw_pad, q0, NSA_Q_BLOCK + WINDOW, axis=1)
        vwb = lax.dynamic_slice_in_dim(vw_pad, q0, NSA_Q_BLOCK + WINDOW, axis=1)
        s_pos = q0 - WINDOW + jnp.arange(NSA_Q_BLOCK + WINDOW)
        mw = (s_pos[None, :] >= 0) & (s_pos[None, :] <= t[:, None]) & (s_pos[None, :] > t[:, None] - WINDOW)
        sw = jnp.einsum('bgrqd,bkgd->bgrqk', qb, kwb).astype(F32) * scale
        pw = masked_softmax(sw, mw)
        ow = jnp.einsum('bgrqk,bkgd->bgrqd', pw.astype(vwb.dtype), vwb)
        o = gb[..., 0:1] * oc.astype(F32) + gb[..., 1:2] * os_.astype(F32) + gb[..., 2:3] * ow.astype(F32)
        return jnp.transpose(o, (0, 3, 1, 2, 4)).reshape(bsz, NSA_Q_BLOCK, N_HEADS * HEAD_DIM).astype(u.dtype)

    o = lax.map(block, jnp.arange(seq // NSA_Q_BLOCK))
    o = jnp.transpose(o, (1, 0, 2, 3)).reshape(bsz, seq, N_HEADS * HEAD_DIM)
    return o @ w_out


def setup_inputs(seed: int = 0) -> dict:
    key = jax.random.key(seed)
    ks = jax.random.split(key, 32)
    d = D_MODEL

    def nrm(k, shape, scale):
        return jax.random.normal(k, shape, F32) * scale

    offset = jax.random.randint(ks[2], (BATCH, 1), 0, 1024, dtype=jnp.int32)
    positions = (offset + jnp.arange(SEQ, dtype=jnp.int32)[None, :]).astype(jnp.int32)
    return {
        'x': nrm(ks[0], (BATCH, SEQ, d), 1.0),
        'c': nrm(ks[1], (BATCH, d), 1.0),
        'positions': positions,
        'attn_gain': 1.0 + nrm(ks[3], (DEPTH, d), 0.05),
        'ffn_gain': 1.0 + nrm(ks[4], (DEPTH, d), 0.05),
        'w_ada': nrm(ks[5], (DEPTH, d, 6 * d), 0.5 * d ** -0.5),
        'b_ada': nrm(ks[6], (DEPTH, 6 * d), 0.01),
        'a_w_in': nrm(ks[7], (N_A_LAYERS, d, A_IN), d ** -0.5),
        'a_w_out': nrm(ks[8], (N_A_LAYERS, N_HEADS * HEAD_DIM, d), (N_HEADS * HEAD_DIM) ** -0.5),
        'b_w_q': nrm(ks[9], (N_B_LAYERS, d, B_IN), d ** -0.5),
        'b_w_out': nrm(ks[10], (N_B_LAYERS, N_HEADS * HEAD_DIM, d), (N_HEADS * HEAD_DIM) ** -0.5),
        'kv_gain': 1.0 + nrm(ks[11], (d,), 0.05),
        'w_kv_ada': nrm(ks[12], (d, 2 * d), 0.5 * d ** -0.5),
        'b_kv_ada': nrm(ks[13], (2 * d,), 0.01),
        'w_kv': nrm(ks[14], (d, KV_WIDTH), d ** -0.5),
        'cmp_pe_k': nrm(ks[15], (CMP_LEN, HEAD_DIM), 0.5),
        'cmp_w1_k': nrm(ks[16], (CMP_LEN * HEAD_DIM, CMP_HIDDEN), (CMP_LEN * HEAD_DIM) ** -0.5),
        'cmp_w2_k': nrm(ks[17], (CMP_HIDDEN, HEAD_DIM), CMP_HIDDEN ** -0.5),
        'cmp_pe_v': nrm(ks[18], (CMP_LEN, HEAD_DIM), 0.5),
        'cmp_w1_v': nrm(ks[19], (CMP_LEN * HEAD_DIM, CMP_HIDDEN), (CMP_LEN * HEAD_DIM) ** -0.5),
        'cmp_w2_v': nrm(ks[20], (CMP_HIDDEN, HEAD_DIM), CMP_HIDDEN ** -0.5),
        'ffn_w_gate': nrm(ks[21], (N_DENSE_LAYERS, d, D_FF), d ** -0.5),
        'ffn_w_up': nrm(ks[22], (N_DENSE_LAYERS, d, D_FF), d ** -0.5),
        'ffn_w_down': nrm(ks[23], (N_DENSE_LAYERS, D_FF, d), D_FF ** -0.5),
        'moe_w_router': nrm(ks[24], (N_MOE_LAYERS, d, N_EXPERTS), d ** -0.5),
        'moe_w_gate': nrm(ks[25], (N_MOE_LAYERS, N_EXPERTS, d, D_FF_EXPERT), d ** -0.5),
        'moe_w_up': nrm(ks[26], (N_MOE_LAYERS, N_EXPERTS, d, D_FF_EXPERT), d ** -0.5),
        'moe_w_down': nrm(ks[27], (N_MOE_LAYERS, N_EXPERTS, D_FF_EXPERT, d), D_FF_EXPERT ** -0.5),
        'final_gain': 1.0 + nrm(ks[28], (d,), 0.05),
    }


def reference(x, c, positions, attn_gain, ffn_gain, w_ada, b_ada, a_w_in, a_w_out, b_w_q, b_w_out,
              kv_gain, w_kv_ada, b_kv_ada, w_kv, cmp_pe_k, cmp_w1_k, cmp_w2_k, cmp_pe_v, cmp_w1_v, cmp_w2_v,
              ffn_w_gate, ffn_w_up, ffn_w_down, moe_w_router, moe_w_gate, moe_w_up, moe_w_down, final_gain):
    cos, sin = rope_tables(positions, HEAD_DIM)
    c_act = jax.nn.silu(c)
    h = x
    kc = vc = k_slc = v_slc = k_win = v_win = None
    for layer in range(DEPTH):
        mod = c_act @ w_ada[layer] + b_ada[layer]
        a_shift, a_scale, a_gate, f_shift, f_scale, f_gate = jnp.split(mod, 6, axis=-1)
        if layer == N_A_LAYERS:
            kc, vc, k_slc, v_slc, k_win, v_win = nsa_shared_kv(
                h, c_act, kv_gain, w_kv_ada, b_kv_ada, w_kv,
                cmp_pe_k, cmp_w1_k, cmp_w2_k, cmp_pe_v, cmp_w1_v, cmp_w2_v, cos, sin)
        u = modulate(rmsnorm(h, attn_gain[layer]), a_shift, a_scale)
        if layer < N_A_LAYERS:
            mix = dsa_mixer(u, cos, sin, a_w_in[layer], a_w_out[layer])
        else:
            j = layer - N_A_LAYERS
            mix = nsa_mixer(u, cos, sin, kc, vc, k_slc, v_slc, k_win, v_win, b_w_q[j], b_w_out[j])
        h = h + a_gate[:, None, :] * mix
        u = modulate(rmsnorm(h, ffn_gain[layer]), f_shift, f_scale)
        if layer % 2 == 0:
            ff = swiglu(u, ffn_w_gate[layer // 2], ffn_w_up[layer // 2], ffn_w_down[layer // 2])
        else:
            m = layer // 2
            ff = moe_swiglu(u, moe_w_router[m], moe_w_gate[m], moe_w_up[m], moe_w_down[m])
        h = h + f_gate[:, None, :] * ff
    return rmsnorm(h, final_gain)
```

```cpp
#include <hip/hip_runtime.h>
#include <cstdio>
#include <cstdint>

#ifndef MK_PER_PHASE
#define MK_PER_PHASE 1
#endif

#define GAS __attribute__((address_space(1)))
#define LAS __attribute__((address_space(3)))
typedef unsigned short bf16;
typedef short bf16x8 __attribute__((ext_vector_type(8)));
typedef float f32x4 __attribute__((ext_vector_type(4)));
typedef float f32x16 __attribute__((ext_vector_type(16)));
typedef unsigned u32x4 __attribute__((ext_vector_type(4)));
typedef unsigned u32x2 __attribute__((ext_vector_type(2)));
typedef GAS unsigned gu32;

constexpr int NB = 4, SEQ = 4096, T = NB * SEQ, D = 1024, NH = 16, HD = 64, NG = 4;
constexpr int A_IN = 2120, A_INP = 2304, FF0 = 2816, FFE = 3584, NE = 8;
constexpr int KVW = 1536, BQ = 1072, BQP = 1280;
constexpr float C2 = 0.125f * 1.4426950408889634f;
constexpr float IWS = 0.04419417382415922f;
constexpr float RMS_EPS = 1e-6f;
constexpr int MPAD = 2 * T + NE * 256;

constexpr size_t MiB = 1u << 20;
constexpr size_t WS_CTL = 0, CTL_ZERO_BYTES = 1 * MiB;
constexpr size_t WS_SMALL = 1 * MiB;
constexpr size_t SM_MOD0 = WS_SMALL, SM_MOD1 = SM_MOD0 + 4 * 6144 * 4, SM_KVMOD = SM_MOD1 + 4 * 6144 * 4, SM_CBIAS = SM_KVMOD + 4 * 2048 * 4;
constexpr size_t SM_COS = 2 * MiB, SM_SIN = 4 * MiB, SM_IW = 6 * MiB, SM_GATES = 7 * MiB, SM_TOKE = 10 * MiB, SM_TOKW = SM_TOKE + 131072, SM_SLOT = SM_TOKW + 131072;
constexpr size_t SM_KC = 11 * MiB, SM_VC = SM_KC + 524288 + 4096;
static_assert(SM_CBIAS + 2048 <= SM_COS && SM_SLOT + 131072 <= SM_KC && SM_VC + 524288 + 4096 <= 16 * MiB, "small map");
constexpr size_t WB_IN = 16 * MiB;
constexpr size_t WB_O0 = WB_IN + (size_t)A_INP * D * 2;
constexpr size_t WB_GU0 = WB_O0 + (size_t)D * D * 2;
constexpr size_t WB_D0 = WB_GU0 + (size_t)2 * FF0 * D * 2;
constexpr size_t WB_KVQ = WB_D0 + (size_t)D * FF0 * 2;
constexpr size_t WB_O1 = WB_KVQ + (size_t)(KVW + BQP) * D * 2;
constexpr size_t WB_C1 = WB_O1 + (size_t)D * D * 2;
constexpr size_t WB_C2 = WB_C1 + (size_t)512 * 2048 * 2;
static_assert(WB_C2 + 128 * 256 * 2 <= 50 * MiB, "weight map");
constexpr size_t WS_U = 50 * MiB, WS_U2 = 82 * MiB;
constexpr size_t WS_Q0 = 114 * MiB, WS_K0 = 146 * MiB, WS_V0 = 154 * MiB, WS_IQ = 162 * MiB, WS_IK = 178 * MiB, WS_O0 = 180 * MiB, WS_MASK = 212 * MiB, WS_SCORES = 220 * MiB;
constexpr size_t WS_HID = 220 * MiB;
constexpr size_t WS_KCMP = 114 * MiB, WS_VCMP = 122 * MiB, WS_KSLC = 130 * MiB, WS_VSLC = 138 * MiB, WS_KWIN = 146 * MiB, WS_VWIN = 154 * MiB;
constexpr size_t WS_Q1 = 162 * MiB, WS_O1 = 194 * MiB, WS_CH = 226 * MiB;
constexpr size_t WS_UM = 300 * MiB;
constexpr size_t WS_AG = 16 * MiB;
constexpr size_t WS_Y = 16 * MiB;
constexpr size_t WS_HID2 = 84 * MiB;
constexpr size_t WS_WGU1 = 351 * MiB, WS_WD1 = 463 * MiB, WS_END = 519 * MiB;
static_assert(WS_AG + (size_t)MPAD * D * 2 <= WS_HID2 && WS_HID2 + (size_t)MPAD * FFE * 2 <= WS_WGU1 && WS_WGU1 + (size_t)NE * 2 * FFE * D * 2 == WS_WD1 && WS_WD1 + (size_t)NE * D * FFE * 2 == WS_END, "moe map");
static_assert(WS_HID + (size_t)T * FF0 * 2 <= WS_WGU1 && WS_UM + (size_t)T * D * 2 <= WS_WGU1 && WS_SCORES + (size_t)NB * SEQ * SEQ * 4 <= 476 * MiB, "map");
constexpr int CW_TMO = 0, CW_BAR = 4096, CW_CNT = 8192, CW_FILL = 8256;
#define XCD_BAR_WORDS 3456

constexpr int RING_BYTES = 131072, LDSCTL_OFF = RING_BYTES, MISC_OFF = LDSCTL_OFF + 320, LDS_BYTES = 147456;
constexpr int NWAVES = 8;

#define RLX_AGENT __ATOMIC_RELAXED, __HIP_MEMORY_SCOPE_AGENT
#define LDS_WAIT() asm volatile("s_waitcnt lgkmcnt(0)" ::: "memory")
#define VM_WAIT() asm volatile("s_waitcnt vmcnt(0)" ::: "memory")
__device__ __forceinline__ unsigned f2bf(float f) { unsigned u = __builtin_bit_cast(unsigned, f); return (u + 0x7fffu + ((u >> 16) & 1u)) >> 16; }
__device__ __forceinline__ unsigned pk2(float lo, float hi) { return f2bf(lo) | (f2bf(hi) << 16); }
__device__ __forceinline__ float bf2f(unsigned v) { return __builtin_bit_cast(float, v << 16); }
__device__ __forceinline__ float bflo(unsigned w) { return __builtin_bit_cast(float, w << 16); }
__device__ __forceinline__ float bfhi(unsigned w) { return __builtin_bit_cast(float, w & 0xffff0000u); }
__device__ __forceinline__ float bfround(float f) { return bf2f(f2bf(f)); }
__device__ __forceinline__ float wave_sum(float v) {
#pragma unroll
    for (int o = 1; o < 64; o <<= 1) v += __shfl_xor(v, o);
    return v;
}
__device__ __forceinline__ float wave_max(float v) {
#pragma unroll
    for (int o = 1; o < 64; o <<= 1) v = fmaxf(v, __shfl_xor(v, o));
    return v;
}
__device__ __forceinline__ int wave_sum_i(int v) {
#pragma unroll
    for (int o = 1; o < 64; o <<= 1) v += __shfl_xor(v, o);
    return v;
}
__device__ __forceinline__ int lds_add(LAS int* p, int v) { return __hip_atomic_fetch_add(p, v, __ATOMIC_RELAXED, __HIP_MEMORY_SCOPE_WORKGROUP); }
__device__ __forceinline__ unsigned ld_u32(const unsigned* p) { return __hip_atomic_load(p, RLX_AGENT); }
__device__ __forceinline__ float dot8(u32x4 a, u32x4 b, float acc) {
    acc += bflo(a.x) * bflo(b.x); acc += bfhi(a.x) * bfhi(b.x); acc += bflo(a.y) * bflo(b.y); acc += bfhi(a.y) * bfhi(b.y);
    acc += bflo(a.z) * bflo(b.z); acc += bfhi(a.z) * bfhi(b.z); acc += bflo(a.w) * bflo(b.w); acc += bfhi(a.w) * bfhi(b.w);
    return acc;
}

namespace pg8 {
constexpr int BM = 256, BK = 64, HALF = 128, HTB = HALF * BK * 2, STAGE_BYTES = 8 * HTB, NXCD = 8, WGM = 8;
__host__ __device__ __forceinline__ int lds_byte(int r, int c) { const int st = (r >> 4) * 2 + (c >> 5), rr = r & 15, cc = c & 31, ob = rr * 64 + cc * 2; return st * 1024 + (ob ^ (((ob >> 9) & 1) << 5)); }
__host__ __device__ __forceinline__ void stage_rc(int b, int& R, int& C) { const int st = b / 1024, sb = b % 1024, swz = sb ^ (((sb >> 9) & 1) << 5); R = (st >> 1) * 16 + swz / 64; C = (st & 1) * 32 + (swz % 64) / 2; }
__host__ __device__ __forceinline__ int perm32(int rho) { const int n = rho >> 4, i = rho & 15; return 8 * (i >> 2) + 4 * n + (i & 3); }
struct Unit { int pm, pn; };
struct Gemm { const bf16* A; const bf16* Bt; int K, lda, ldb; };

struct StaticOrder {
    int nM, nN, nwg, G, c;
    __device__ void init(int M, int N, int G_, int c_) { nM = M / BM; nN = N / BM; nwg = nM * nN; G = G_; c = c_; }
    __device__ bool next(int i, Unit& u) const {
        const long L = (long)i * G + c; if (L >= nwg) return false;
        int wgid = (int)L; { const int q = nwg / NXCD, r = nwg % NXCD, xcd = wgid % NXCD, off = wgid / NXCD; wgid = (xcd < r ? xcd * (q + 1) : r * (q + 1) + (xcd - r) * q) + off; }
        const int nig = WGM * nN, gid = wgid / nig, fm = gid * WGM, gsz = (nM - fm) < WGM ? (nM - fm) : WGM;
        u.pm = fm + ((wgid % nig) % gsz); u.pn = (wgid % nig) / gsz; return true;
    }
};

template <class Epi, class Sched>
__device__ __forceinline__ void gemm_phase(LAS unsigned char* lds, const Gemm g, const Sched& S, const Epi& E) {
    const int tid = threadIdx.x, wid = __builtin_amdgcn_readfirstlane(tid >> 6), lane = tid & 63, wr = wid >> 2, wc = wid & 3, fr = lane & 15, fq = lane >> 4;
    const int K = g.K, nt = K / BK;
    unsigned voffA[2], voffB[2];
#pragma unroll
    for (int i = 0; i < 2; ++i) { int R, C; stage_rc(tid * 16 + i * 8192, R, C); const int Rb = (R & ~31) + perm32(R & 31);
        voffA[i] = (unsigned)(R * g.lda + C) * 2u; voffB[i] = (unsigned)(Rb * g.ldb + C) * 2u; }
    const size_t kstep = (size_t)(BK * 2);
    const size_t hA = (size_t)HALF * g.lda * 2, hB = (size_t)HALF * g.ldb * 2;
    const size_t tA = 2 * hA, tB = 2 * hB;
    const unsigned ldsw = (unsigned)wid * 1024u;
    const int aoff = lds_byte(wr * 64 + fr, fq * 8), boff = lds_byte(wc * 32 + fr, fq * 8);
#define PG8_SA(b, h) (((b) * 2 + (h)) * HTB)
#define PG8_SB(b, h) ((4 + (b) * 2 + (h)) * HTB)
#define PG8_STAGE(bufoff, gbase, voff) do { _Pragma("unroll") for (int _i = 0; _i < 2; ++_i) \
        __builtin_amdgcn_global_load_lds((const unsigned*)((const char*)(gbase) + (voff)[_i]), (LAS unsigned*)(lds + (bufoff) + ldsw + _i * 8192), 16, 0, 0); } while (0)
#define PG8_LDA(dst, b, h) do { _Pragma("unroll") for (int m = 0; m < 4; ++m) _Pragma("unroll") for (int k = 0; k < 2; ++k) dst[m][k] = *(const LAS bf16x8*)(lds + PG8_SA(b, h) + aoff + m * 2048 + k * 1024); } while (0)
#define PG8_LDB(dst, b, h) do { _Pragma("unroll") for (int n = 0; n < 2; ++n) _Pragma("unroll") for (int k = 0; k < 2; ++k) dst[n][k] = *(const LAS bf16x8*)(lds + PG8_SB(b, h) + boff + n * 2048 + k * 1024); } while (0)
#define PG8_MMA(ai, bj, At, Bt) do { __builtin_amdgcn_s_setprio(1); _Pragma("unroll") for (int m = 0; m < 4; ++m) _Pragma("unroll") for (int n = 0; n < 2; ++n) _Pragma("unroll") for (int k = 0; k < 2; ++k) \
        acc[ai][bj][m][n] = __builtin_amdgcn_mfma_f32_16x16x32_bf16(Bt[n][k], At[m][k], acc[ai][bj][m][n], 0, 0, 0); __builtin_amdgcn_s_setprio(0); } while (0)
#define PG8_WAIT_V(n) asm volatile("s_waitcnt vmcnt(" #n ")" ::: "memory")
#define PG8_WAIT_L(n) asm volatile("s_waitcnt lgkmcnt(" #n ")" ::: "memory")
#define PG8_BAR __builtin_amdgcn_s_barrier()
#define PG8_SCHED __builtin_amdgcn_sched_barrier(0)
    Unit cur, nxt; int ui = 0;
    if (!S.next(0, cur)) return;
    f32x4 acc[2][2][4][2];
#pragma unroll
    for (int a = 0; a < 2; ++a)
#pragma unroll
        for (int b = 0; b < 2; ++b)
#pragma unroll
            for (int m = 0; m < 4; ++m)
#pragma unroll
                for (int n = 0; n < 2; ++n) acc[a][b][m][n] = (f32x4){0.f, 0.f, 0.f, 0.f};
    bf16x8 At[4][2], B0[2][2], B1[2][2];
    const char* cA = (const char*)g.A + (size_t)cur.pm * tA; const char* cB = (const char*)g.Bt + (size_t)cur.pn * tB;
    PG8_STAGE(PG8_SB(0, 0), cB, voffB); PG8_STAGE(PG8_SB(0, 1), cB + hB, voffB); PG8_STAGE(PG8_SA(0, 0), cA, voffA); PG8_STAGE(PG8_SA(0, 1), cA + hA, voffA);
    if (wr == 1) PG8_BAR;
    PG8_WAIT_V(2); PG8_BAR;
    PG8_STAGE(PG8_SB(1, 0), cB + kstep, voffB); PG8_STAGE(PG8_SA(1, 0), cA + kstep, voffA); PG8_STAGE(PG8_SB(1, 1), cB + hB + kstep, voffB);
    PG8_WAIT_V(6); PG8_BAR;
    for (;;) {
        const bool has_next = S.next(ui + 1, nxt);
        const char* nA = has_next ? (const char*)g.A + (size_t)nxt.pm * tA : cA; const char* nB = has_next ? (const char*)g.Bt + (size_t)nxt.pn * tB : cB;
        for (int t = 0; t < nt; t += 2) {
            const bool last = (t == nt - 2);
            const char* a1 = cA + (size_t)(t + 1) * kstep;
            const char* a2 = last ? nA : cA + (size_t)(t + 2) * kstep; const char* b2 = last ? nB : cB + (size_t)(t + 2) * kstep;
            const char* a3 = a2 + kstep; const char* b3 = b2 + kstep;
            PG8_LDB(B0, 0, 0); PG8_LDB(B1, 0, 1); PG8_SCHED; PG8_LDA(At, 0, 0); PG8_STAGE(PG8_SA(1, 1), a1 + hA, voffA);
            PG8_WAIT_V(8); PG8_WAIT_L(0); PG8_BAR; PG8_MMA(0, 0, At, B0); PG8_MMA(0, 1, At, B1); PG8_BAR; PG8_SCHED;
            PG8_LDA(At, 0, 1); PG8_STAGE(PG8_SB(0, 0), b2, voffB); PG8_STAGE(PG8_SB(0, 1), b2 + hB, voffB); PG8_STAGE(PG8_SA(0, 0), a2, voffA);
            PG8_WAIT_V(8); PG8_WAIT_L(0); PG8_BAR; PG8_MMA(1, 0, At, B0); PG8_MMA(1, 1, At, B1); PG8_BAR; PG8_SCHED;
            PG8_LDB(B0, 1, 0); PG8_LDB(B1, 1, 1); PG8_SCHED; PG8_LDA(At, 1, 0); PG8_STAGE(PG8_SA(0, 1), a2 + hA, voffA);
            PG8_WAIT_V(8); PG8_WAIT_L(0); PG8_BAR; PG8_MMA(0, 0, At, B0); PG8_MMA(0, 1, At, B1); PG8_BAR; PG8_SCHED;
            PG8_LDA(At, 1, 1); PG8_STAGE(PG8_SB(1, 0), b3, voffB); PG8_STAGE(PG8_SB(1, 1), b3 + hB, voffB); PG8_STAGE(PG8_SA(1, 0), a3, voffA);
            PG8_WAIT_V(8); PG8_WAIT_L(0); PG8_BAR; PG8_MMA(1, 0, At, B0); PG8_MMA(1, 1, At, B1); PG8_BAR; PG8_SCHED;
        }
        if (wr == 0) PG8_BAR;
        E(acc, cur, wr, wc, fr, fq);
        if (!has_next) break;
#pragma unroll
        for (int a = 0; a < 2; ++a)
#pragma unroll
            for (int b = 0; b < 2; ++b)
#pragma unroll
                for (int m = 0; m < 4; ++m)
#pragma unroll
                    for (int n = 0; n < 2; ++n) acc[a][b][m][n] = (f32x4){0.f, 0.f, 0.f, 0.f};
        cur = nxt; cA = nA; cB = nB; ++ui;
        if (wr == 1) PG8_BAR;
    }
    PG8_WAIT_V(0);
    PG8_BAR;
#undef PG8_SA
#undef PG8_SB
#undef PG8_STAGE
#undef PG8_LDA
#undef PG8_LDB
#undef PG8_MMA
#undef PG8_WAIT_V
#undef PG8_WAIT_L
#undef PG8_BAR
#undef PG8_SCHED
}
}

#define XB_TMO      128
#define XB_XCNT(j)  (256  + 64 * (j))
#define XB_XSUB(j)  (1280 + 64 * (j))
#define XB_XGEN(j)  (2304 + 64 * (j))
#define XB_TOP      3328
#define XB_TOPGEN   3392
#define XB_SPIN_CAP (1u << 18)
__device__ __forceinline__ unsigned xb_ld(unsigned* p)              { return __hip_atomic_load(p, __ATOMIC_RELAXED, __HIP_MEMORY_SCOPE_AGENT); }
__device__ __forceinline__ unsigned xb_add(unsigned* p, unsigned v) { return __hip_atomic_fetch_add(p, v, __ATOMIC_RELAXED, __HIP_MEMORY_SCOPE_AGENT); }
__device__ __forceinline__ unsigned xb_xcc_id() { return (unsigned)__builtin_amdgcn_s_getreg((3 << 11) | 20) & 0xFu; }
#define XB_SPIN(cond, bar) do { unsigned _sp = 0; while (cond) { __builtin_amdgcn_s_sleep(1); \
    if ((++_sp & 255u) == 0u) { if (xb_ld(&(bar)[XB_TMO])) break; if (_sp > XB_SPIN_CAP) { atomicAdd(&(bar)[XB_TMO], 1u); break; } } } } while (0)
struct XcdBarrier { unsigned* bar; unsigned x; volatile LAS unsigned* st; };
__device__ __forceinline__ XcdBarrier xcd_barrier_post(unsigned* bar, volatile LAS unsigned* st) {
    XcdBarrier b; b.bar = bar; b.x = xb_xcc_id(); b.st = st;
    if (threadIdx.x == 0) (void)xb_add(&bar[XB_XCNT(b.x)], 1u);
    return b;
}
__device__ __forceinline__ void xcd_barrier_complete(unsigned* bar, unsigned x, unsigned& nloc, unsigned& nx) {
    const unsigned G = gridDim.x * gridDim.y * gridDim.z;
    unsigned sum, cnt, mine, sp = 0u;
    for (;;) {
        sum = 0u; cnt = 0u; mine = 0u;
#pragma unroll
        for (unsigned j = 0; j < 16; ++j) { const unsigned c = xb_ld(&bar[XB_XCNT(j)]); sum += c; cnt += (c > 0u) ? 1u : 0u; mine = (j == x) ? c : mine; }
        if (sum == G) break;
        __builtin_amdgcn_s_sleep(1);
        if ((++sp & 255u) == 0u) { if (xb_ld(&bar[XB_TMO])) break; if (sp > XB_SPIN_CAP) { atomicAdd(&bar[XB_TMO], 1u); break; } }
    }
    nloc = mine > 0u ? mine : 1u; nx = cnt > 0u ? cnt : 1u;
}
__device__ __forceinline__ void xcd_barrier(const XcdBarrier& b) {
    asm volatile("s_waitcnt vmcnt(0)" ::: "memory");
    __syncthreads();
    if (threadIdx.x == 0) {
        unsigned* bar = b.bar;
        __builtin_amdgcn_s_waitcnt(0);
        unsigned nloc = b.st[0], nx = b.st[1];
        if (nloc == 0u) { xcd_barrier_complete(bar, b.x, nloc, nx); b.st[0] = nloc; b.st[1] = nx; }
        const unsigned old = xb_add(&bar[XB_XSUB(b.x)], 1u);
        const unsigned gen = old / nloc;
        if (old + 1u == (gen + 1u) * nloc) {
            __builtin_amdgcn_fence(__ATOMIC_RELEASE, "agent");
            asm volatile("s_waitcnt vmcnt(0)" ::: "memory");
            const unsigned og = xb_add(&bar[XB_TOP], 1u);
            const unsigned tg = og / nx;
            if (og + 1u == (tg + 1u) * nx) xb_add(&bar[XB_TOPGEN], 1u);
            else XB_SPIN(xb_ld(&bar[XB_TOPGEN]) == tg, bar);
            __builtin_amdgcn_fence(__ATOMIC_ACQUIRE, "agent");
            xb_add(&bar[XB_XGEN(b.x)], 1u);
            asm volatile("s_waitcnt vmcnt(0)" ::: "memory");
        } else {
            XB_SPIN(xb_ld(&bar[XB_XGEN(b.x)]) == gen, bar);
            __builtin_amdgcn_fence(__ATOMIC_ACQUIRE, "agent");
            asm volatile("s_waitcnt vmcnt(0)" ::: "memory");
        }
    }
    __syncthreads();
}

struct Frame {
    LAS unsigned char* lds;
    volatile LAS unsigned* MISC;
    unsigned* ctl;
    unsigned char* ws;
    int tid, lane, wave, G, gw, NGW;
    const float *x, *c; const int* pos;
    const float *attn_gain, *ffn_gain, *w_ada, *b_ada, *a_w_in, *a_w_out, *b_w_q, *b_w_out, *kv_gain, *w_kv_ada, *b_kv_ada, *w_kv;
    const float *pe_k, *w1_k, *w2_k, *pe_v, *w1_v, *w2_v, *ffn_wg, *ffn_wu, *ffn_wd, *w_router, *moe_wg, *moe_wu, *moe_wd, *final_gain;
    float* out;
};
#define WSP(T_, off) ((T_*)(F.ws + (off)))

__device__ __forceinline__ void tr_item(const float* W, int Nsrc, int ncol0, int K, int k0, bf16* WT, int drow0, LAS float* scr, int lane) {
    const int cc = ncol0 + (lane & 31); const bool ok = (ncol0 >= 0) && (cc < Nsrc);
#pragma unroll 8
    for (int i = 0; i < 32; ++i) { const int kk = 2 * i + (lane >> 5); scr[kk * 33 + (lane & 31)] = ok ? W[(size_t)(k0 + kk) * Nsrc + cc] : 0.f; }
    LDS_WAIT(); asm volatile("" ::: "memory");
    const int c = lane & 7;
#pragma unroll
    for (int j = 0; j < 4; ++j) { const int n = (lane >> 3) + 8 * j; const LAS float* s = scr + (8 * c) * 33 + n;
        u32x4 o; o.x = pk2(s[0 * 33], s[1 * 33]); o.y = pk2(s[2 * 33], s[3 * 33]); o.z = pk2(s[4 * 33], s[5 * 33]); o.w = pk2(s[6 * 33], s[7 * 33]);
        *(u32x4*)(WT + (size_t)(drow0 + n) * K + k0 + 8 * c) = o; }
    LDS_WAIT(); asm volatile("" ::: "memory");
}
__device__ __forceinline__ int rope_lb(int pb) { const int pn = pb >> 3, half = (pb >> 2) & 1, hl = pb & 3; return 8 * pn + 2 * hl + half; }

__device__ __forceinline__ void conv_item_a(Frame& F, int it, LAS float* scr) {
    const int lane = F.lane;
    int r = it;
    { constexpr int NBK = A_INP / 32, NI = 16 * NBK; if (r < NI) { const int kb = r / NBK, pb = r % NBK; tr_item(F.a_w_in, A_IN, 32 * rope_lb(pb), D, 64 * kb, WSP(bf16, WB_IN), 32 * pb, scr, lane); return; } r -= NI; }
    { constexpr int NBK = D / 32, NI = 16 * NBK; if (r < NI) { const int kb = r / NBK, pb = r % NBK; tr_item(F.a_w_out, D, 32 * pb, D, 64 * kb, WSP(bf16, WB_O0), 32 * pb, scr, lane); return; } r -= NI; }
    { constexpr int NBK = 2 * FF0 / 32, NI = 16 * NBK; if (r < NI) { const int kb = r / NBK, pb = r % NBK; const int pn = pb >> 3, half = (pb >> 2) & 1, q = pb & 3;
        tr_item(half ? F.ffn_wu : F.ffn_wg, FF0, 32 * (4 * pn + q), D, 64 * kb, WSP(bf16, WB_GU0), 32 * pb, scr, lane); return; } r -= NI; }
    { constexpr int NBK = D / 32, NI = (FF0 / 64) * NBK; if (r < NI) { const int kb = r / NBK, pb = r % NBK; tr_item(F.ffn_wd, D, 32 * pb, FF0, 64 * kb, WSP(bf16, WB_D0), 32 * pb, scr, lane); return; } r -= NI; }
    { constexpr int NBK = KVW / 32, NI = 16 * NBK; if (r < NI) { const int kb = r / NBK, pb = r % NBK; tr_item(F.w_kv, KVW, 32 * rope_lb(pb), D, 64 * kb, WSP(bf16, WB_KVQ), 32 * pb, scr, lane); return; } r -= NI; }
    { constexpr int NBK = BQP / 32, NI = 16 * NBK; if (r < NI) { const int kb = r / NBK, pb = r % NBK; tr_item(F.b_w_q, BQ, 32 * rope_lb(pb), D, 64 * kb, WSP(bf16, WB_KVQ) + (size_t)KVW * D, 32 * pb, scr, lane); return; } r -= NI; }
    { constexpr int NBK = D / 32, NI = 16 * NBK; if (r < NI) { const int kb = r / NBK, pb = r % NBK; tr_item(F.b_w_out, D, 32 * pb, D, 64 * kb, WSP(bf16, WB_O1), 32 * pb, scr, lane); return; } r -= NI; }
    { constexpr int NBK = 8, NI = 32 * NBK; if (r < NI) { const int kb = r / NBK, pb = r % NBK; tr_item(F.w1_k, 256, 32 * pb, 2048, 64 * kb, WSP(bf16, WB_C1), 32 * pb, scr, lane); return; } r -= NI;
                                       if (r < NI) { const int kb = r / NBK, pb = r % NBK; tr_item(F.w1_v, 256, 32 * pb, 2048, 64 * kb, WSP(bf16, WB_C1), 256 + 32 * pb, scr, lane); return; } r -= NI; }
    { constexpr int NBK = 2, NI = 4 * NBK; if (r < NI) { const int kb = r / NBK, pb = r % NBK; tr_item(F.w2_k, 64, 32 * pb, 256, 64 * kb, WSP(bf16, WB_C2), 32 * pb, scr, lane); return; } r -= NI;
                                       if (r < NI) { const int kb = r / NBK, pb = r % NBK; tr_item(F.w2_v, 64, 32 * pb, 256, 64 * kb, WSP(bf16, WB_C2), 64 + 32 * pb, scr, lane); return; } r -= NI; }
}
constexpr int NCONV_A = 16 * (A_INP / 32) + 16 * 32 + 16 * (2 * FF0 / 32) + (FF0 / 64) * 32 + 16 * (KVW / 32) + 16 * (BQP / 32) + 16 * 32 + 2 * 32 * 8 + 2 * 4 * 2;
__device__ __forceinline__ void conv_item_b(Frame& F, int it, LAS float* scr) {
    const int lane = F.lane;
    constexpr int NBK1 = 2 * FFE / 32, NI1 = 16 * NBK1;
    constexpr int NBK2 = D / 32, NI2 = (FFE / 64) * NBK2;
    int r = it;
    if (r < NE * NI1) { const int e = r / NI1; r -= e * NI1; const int kb = r / NBK1, pb = r % NBK1; const int pn = pb >> 3, half = (pb >> 2) & 1, q = pb & 3;
        tr_item((half ? F.moe_wu : F.moe_wg) + (size_t)e * D * FFE, FFE, 32 * (4 * pn + q), D, 64 * kb, WSP(bf16, WS_WGU1) + (size_t)e * 2 * FFE * D, 32 * pb, scr, lane); return; }
    r -= NE * NI1;
    { const int e = r / NI2; r -= e * NI2; const int kb = r / NBK2, pb = r % NBK2;
        tr_item(F.moe_wd + (size_t)e * FFE * D, D, 32 * pb, FFE, 64 * kb, WSP(bf16, WS_WD1) + (size_t)e * D * FFE, 32 * pb, scr, lane); }
}
constexpr int NCONV_B = NE * (16 * (2 * FFE / 32) + (FFE / 64) * 32);

template <int NBAT>
__device__ __forceinline__ void gemv_item(Frame& F, const LAS float* act, const float* W, int K, int N, int n0, const float* bias, float* out, int ldo, LAS float* red) {
    const int kper = K / 8, k0 = F.wave * kper;
    float a[NBAT];
#pragma unroll
    for (int b = 0; b < NBAT; ++b) a[b] = 0.f;
    const float* wp = W + (size_t)k0 * N + n0 + F.lane;
#pragma unroll 8
    for (int k = 0; k < kper; ++k) { const float w = wp[(size_t)k * N];
#pragma unroll
        for (int b = 0; b < NBAT; ++b) a[b] += act[b * K + k0 + k] * w; }
#pragma unroll
    for (int b = 0; b < NBAT; ++b) red[(F.wave * 4 + b) * 64 + F.lane] = a[b];
    __syncthreads();
    if (F.tid < 64 * NBAT) { const int b = F.tid >> 6, l = F.tid & 63; float s = 0.f;
#pragma unroll
        for (int w = 0; w < 8; ++w) s += red[(w * 4 + b) * 64 + l];
        out[(size_t)b * ldo + n0 + l] = s + (bias ? bias[n0 + l] : 0.f); }
    __syncthreads();
}

__device__ __forceinline__ void p0_prologue(Frame& F) {
    {
        LAS float* act = (LAS float*)(F.lds);
        LAS float* red = (LAS float*)(F.lds + 16384);
        constexpr int NI_MOD = 6144 / 64, NI_KV = 2048 / 64, NITEMS = 2 * NI_MOD + NI_KV + 8;
        for (int it = blockIdx.x; it < NITEMS; it += F.G) {
            if (it < 2 * NI_MOD + NI_KV) {
                for (int i = F.tid; i < 4096; i += 512) { const float v = F.c[i]; act[i] = v / (1.f + __expf(-v)); }
                __syncthreads();
                if (it < NI_MOD) gemv_item<4>(F, act, F.w_ada, D, 6144, 64 * it, F.b_ada, WSP(float, SM_MOD0), 6144, red);
                else if (it < 2 * NI_MOD) gemv_item<4>(F, act, F.w_ada + (size_t)D * 6144, D, 6144, 64 * (it - NI_MOD), F.b_ada + 6144, WSP(float, SM_MOD1), 6144, red);
                else gemv_item<4>(F, act, F.w_kv_ada, D, 2048, 64 * (it - 2 * NI_MOD), F.b_kv_ada, WSP(float, SM_KVMOD), 2048, red);
            } else {
                const int j = it - (2 * NI_MOD + NI_KV), kv = j >> 2;
                const float* pe = kv ? F.pe_v : F.pe_k;
                for (int i = F.tid; i < 2048; i += 512) act[i] = pe[i];
                __syncthreads();
                gemv_item<1>(F, act, kv ? F.w1_v : F.w1_k, 2048, 256, 64 * (j & 3), nullptr, WSP(float, SM_CBIAS) + 256 * kv, 256, red);
            }
        }
        __syncthreads();
    }
    {
        LAS float* scr = (LAS float*)(F.lds + F.wave * 16384);
        for (int it = F.gw; it < NCONV_A; it += F.NGW) conv_item_a(F, it, scr);
    }
    {
        float* cs = WSP(float, SM_COS); float* sn = WSP(float, SM_SIN);
        for (int i = F.gw * 64 + F.lane; i < T * 32; i += F.NGW * 64) {
            const int m = i >> 5, d = i & 31;
            const float inv = 1.0f / powf(10000.0f, (float)d * (1.0f / 32.0f));
            const float ang = (float)F.pos[m] * inv;
            cs[i] = cosf(ang); sn[i] = sinf(ang);
        }
    }
}

__device__ __forceinline__ void load_row(const float* row, int lane, f32x4 (&v)[4]) {
#pragma unroll
    for (int j = 0; j < 4; ++j) v[j] = ((const f32x4*)row)[lane + 64 * j];
}
__device__ __forceinline__ float row_rs(const f32x4 (&v)[4]) {
    float s = 0.f;
#pragma unroll
    for (int j = 0; j < 4; ++j) s += (v[j].x * v[j].x + v[j].y * v[j].y) + (v[j].z * v[j].z + v[j].w * v[j].w);
    return 1.0f / sqrtf(wave_sum(s) * (1.f / D) + RMS_EPS);
}
__device__ __forceinline__ void modulate_row(const f32x4 (&v)[4], float r, const float* gain, const float* shift, const float* scale, int lane, f32x4 (&u)[4]) {
#pragma unroll
    for (int j = 0; j < 4; ++j) { const f32x4 g = ((const f32x4*)gain)[lane + 64 * j], sh = ((const f32x4*)shift)[lane + 64 * j], sc = ((const f32x4*)scale)[lane + 64 * j];
        u[j] = v[j] * r * g * (sc + 1.0f) + sh; }
}
__device__ __forceinline__ void store_row_bf16(bf16* orow, int lane, const f32x4 (&u)[4]) {
#pragma unroll
    for (int j = 0; j < 4; ++j) { u32x2 o; o.x = pk2(u[j].x, u[j].y); o.y = pk2(u[j].z, u[j].w); ((u32x2*)orow)[lane + 64 * j] = o; }
}
__device__ __forceinline__ void norm_phase(Frame& F, const float* src, const float* gain, const float* mod  , int ldm, int shift_off, int scale_off, bf16* dst) {
    for (int m = F.gw; m < T; m += F.NGW) {
        f32x4 v[4], u[4]; load_row(src + (size_t)m * D, F.lane, v);
        const float r = row_rs(v); const int b = m >> 12;
        modulate_row(v, r, gain, mod + (size_t)b * ldm + shift_off, mod + (size_t)b * ldm + scale_off, F.lane, u);
        store_row_bf16(dst + (size_t)m * D, F.lane, u);
    }
}

__device__ __forceinline__ void store8(bf16* p, const float (&y)[8]) { u32x4 w; w.x = pk2(y[0], y[1]); w.y = pk2(y[2], y[3]); w.z = pk2(y[4], y[5]); w.w = pk2(y[6], y[7]); *(u32x4*)p = w; }
__device__ __forceinline__ void get8(const f32x4 (&a)[2], float (&x)[8]) { x[0] = a[0].x; x[1] = a[0].y; x[2] = a[0].z; x[3] = a[0].w; x[4] = a[1].x; x[5] = a[1].y; x[6] = a[1].z; x[7] = a[1].w; }
__device__ __forceinline__ void rope8(const float* cs, const float* sn, int row, int fq, const float (&x1)[8], const float (&x2)[8], float sc, float (&y1)[8], float (&y2)[8]) {
    const f32x4 c0 = *(const f32x4*)(cs + (size_t)row * 32 + 8 * fq), c1 = *(const f32x4*)(cs + (size_t)row * 32 + 8 * fq + 4);
    const f32x4 s0 = *(const f32x4*)(sn + (size_t)row * 32 + 8 * fq), s1 = *(const f32x4*)(sn + (size_t)row * 32 + 8 * fq + 4);
    const float c[8] = {c0.x, c0.y, c0.z, c0.w, c1.x, c1.y, c1.z, c1.w}, s[8] = {s0.x, s0.y, s0.z, s0.w, s1.x, s1.y, s1.z, s1.w};
#pragma unroll
    for (int j = 0; j < 8; ++j) { y1[j] = (x1[j] * c[j] - x2[j] * s[j]) * sc; y2[j] = (x2[j] * c[j] + x1[j] * s[j]) * sc; }
}
struct EpiIn {
    bf16 *Q, *K, *V, *IQ, *IK; float* IW; const float *cs, *sn;
    __device__ __forceinline__ void operator()(const f32x4 (&acc)[2][2][4][2], const pg8::Unit& u, int wr, int wc, int fr, int fq) const {
        const int pn = u.pn;
        if (pn == 8 && wc >= 2) return;
#pragma unroll
        for (int ai = 0; ai < 2; ++ai)
#pragma unroll
            for (int m = 0; m < 4; ++m) {
                const int row = u.pm * 256 + ai * 128 + wr * 64 + m * 16 + fr;
                float x1[8], x2[8]; get8(acc[ai][0][m], x1); get8(acc[ai][1][m], x2);
                if (pn == 5) { bf16* d = V + (size_t)row * 256 + wc * 64 + 8 * fq; store8(d, x1); store8(d + 32, x2); }
                else if (pn == 8 && wc == 1) { if (fq == 0) { f32x4 a = {x1[0] * IWS, x1[1] * IWS, x1[2] * IWS, x1[3] * IWS}, b = {x1[4] * IWS, x1[5] * IWS, x1[6] * IWS, x1[7] * IWS};
                        *(f32x4*)(IW + (size_t)row * 8) = a; *(f32x4*)(IW + (size_t)row * 8 + 4) = b; } }
                else {
                    float y1[8], y2[8]; rope8(cs, sn, row, fq, x1, x2, pn < 4 ? C2 : 1.0f, y1, y2);
                    bf16* d;
                    if (pn < 4) d = Q + (size_t)row * 1024 + (4 * pn + wc) * 64;
                    else if (pn == 4) d = K + (size_t)row * 256 + wc * 64;
                    else if (pn < 8) d = IQ + (size_t)row * 512 + (4 * (pn - 6) + wc) * 64;
                    else d = IK + (size_t)row * 64;
                    store8(d + 8 * fq, y1); store8(d + 32 + 8 * fq, y2);
                }
            }
    }
};
struct EpiRes {
    const float* base; float* out; const float* gate; int ldg;
    __device__ __forceinline__ void operator()(const f32x4 (&acc)[2][2][4][2], const pg8::Unit& u, int wr, int wc, int fr, int fq) const {
        const float* gv = gate + (size_t)((u.pm * 256) >> 12) * ldg;
#pragma unroll
        for (int bj = 0; bj < 2; ++bj) {
            const int col = u.pn * 256 + bj * 128 + wc * 32 + 8 * fq;
            const f32x4 g0 = *(const f32x4*)(gv + col), g1 = *(const f32x4*)(gv + col + 4);
#pragma unroll
            for (int ai = 0; ai < 2; ++ai)
#pragma unroll
                for (int m = 0; m < 4; ++m) {
                    const size_t o = (size_t)(u.pm * 256 + ai * 128 + wr * 64 + m * 16 + fr) * D + col;
                    const f32x4 b0 = *(const f32x4*)(base + o), b1 = *(const f32x4*)(base + o + 4);
                    *(f32x4*)(out + o) = b0 + g0 * acc[ai][bj][m][0]; *(f32x4*)(out + o + 4) = b1 + g1 * acc[ai][bj][m][1];
                }
        }
    }
};
__device__ __forceinline__ float silu_f(float g) { return g * __builtin_amdgcn_rcpf(1.0f + __builtin_amdgcn_exp2f(-1.4426950408889634f * g)); }
struct EpiSwiglu {
    bf16* H; int ldh, npn;
    __device__ __forceinline__ void operator()(const f32x4 (&acc)[2][2][4][2], const pg8::Unit& u, int wr, int wc, int fr, int fq) const {
        const int col = (u.pn % npn) * 128 + wc * 32 + 8 * fq;
#pragma unroll
        for (int ai = 0; ai < 2; ++ai)
#pragma unroll
            for (int m = 0; m < 4; ++m) {
                const int row = u.pm * 256 + ai * 128 + wr * 64 + m * 16 + fr;
                float g[8], up[8], h[8]; get8(acc[ai][0][m], g); get8(acc[ai][1][m], up);
#pragma unroll
                for (int j = 0; j < 8; ++j) h[j] = silu_f(g[j]) * up[j];
                store8(H + (size_t)row * ldh + col, h);
            }
    }
};
struct EpiKVQ {
    bf16 *KCMP, *VCMP, *KSLC, *VSLC, *KWIN, *VWIN, *Q; float* GATES; const float *cs, *sn;
    __device__ __forceinline__ void operator()(const f32x4 (&acc)[2][2][4][2], const pg8::Unit& u, int wr, int wc, int fr, int fq) const {
        const int pn = u.pn;
        if (pn == 10 && wc >= 1) return;
#pragma unroll
        for (int ai = 0; ai < 2; ++ai)
#pragma unroll
            for (int m = 0; m < 4; ++m) {
                const int row = (u.pm & 63) * 256 + ai * 128 + wr * 64 + m * 16 + fr;
                float x1[8], x2[8]; get8(acc[ai][0][m], x1); get8(acc[ai][1][m], x2);
                if (pn < 6) {
                    if ((pn & 1) == 0) { float y1[8], y2[8]; rope8(cs, sn, row, fq, x1, x2, 1.0f, y1, y2);
#pragma unroll
                        for (int j = 0; j < 8; ++j) { x1[j] = y1[j]; x2[j] = y2[j]; } }
                    bf16* d;
                    if (pn < 2) d = (pn == 0 ? KCMP : VCMP) + ((size_t)((row >> 12) * 4 + wc) * SEQ + (row & 4095)) * 64;
                    else d = (pn == 2 ? KSLC : pn == 3 ? VSLC : pn == 4 ? KWIN : VWIN) + (size_t)row * 256 + wc * 64;
                    store8(d + 8 * fq, x1); store8(d + 32 + 8 * fq, x2);
                } else if (pn < 10) {
                    float y1[8], y2[8]; rope8(cs, sn, row, fq, x1, x2, C2, y1, y2);
                    bf16* d = Q + (size_t)row * 1024 + (4 * (pn - 6) + wc) * 64;
                    store8(d + 8 * fq, y1); store8(d + 32 + 8 * fq, y2);
                } else {
                    float* gp = GATES + (size_t)row * 48;
#pragma unroll
                    for (int j = 0; j < 8; ++j) gp[8 * fq + j] = 1.0f / (1.0f + __expf(-x1[j]));
                    if (fq < 2) {
#pragma unroll
                        for (int j = 0; j < 8; ++j) gp[32 + 8 * fq + j] = 1.0f / (1.0f + __expf(-x2[j])); }
                }
            }
    }
};
struct EpiY {
    bf16* Y;
    __device__ __forceinline__ void operator()(const f32x4 (&acc)[2][2][4][2], const pg8::Unit& u, int wr, int wc, int fr, int fq) const {
#pragma unroll
        for (int ai = 0; ai < 2; ++ai)
#pragma unroll
            for (int m = 0; m < 4; ++m) {
                const int row = u.pm * 256 + ai * 128 + wr * 64 + m * 16 + fr;
#pragma unroll
                for (int bj = 0; bj < 2; ++bj) { float x[8]; get8(acc[ai][bj][m], x); store8(Y + (size_t)row * D + (u.pn & 3) * 256 + bj * 128 + wc * 32 + 8 * fq, x); }
            }
    }
};
struct KvqOrder {
    pg8::StaticOrder S;
    __device__ bool next(int i, pg8::Unit& u) const { if (!S.next(i, u)) return false; if (u.pn >= 6) u.pm += 64; return true; }
};
struct MoeOrder {
    int tend[NE]; int ntiles, npn, G, c;
    __device__ void init(const unsigned* cnt, int npn_, int G_, int c_) { int acc = 0; for (int e = 0; e < NE; ++e) { acc += (int)((ld_u32(cnt + e) + 255u) >> 8); tend[e] = acc; } ntiles = acc; npn = npn_; G = G_; c = c_; }
    __device__ bool next(int i, pg8::Unit& u) const {
        const long L = (long)i * G + c; if (L >= (long)ntiles * npn) return false;
        const int mt = (int)(L / npn), pn = (int)(L % npn); int e = 0;
#pragma unroll
        for (int k = 0; k < NE - 1; ++k) e += (mt >= tend[k]) ? 1 : 0;
        u.pm = mt; u.pn = e * npn + pn; return true;
    }
};

__device__ __forceinline__ f32x16 sgemm_tile(const bf16* A, int lda, const bf16* Bt, int ldb, int K, int row0, int col0, int lane) {
    f32x16 acc = {};
    const bf16* ap = A + (size_t)(row0 + (lane & 31)) * lda + 8 * (lane >> 5);
    const bf16* bp = Bt + (size_t)(col0 + (lane & 31)) * ldb + 8 * (lane >> 5);
#pragma unroll 4
    for (int k = 0; k < K; k += 16) { const bf16x8 a = *(const bf16x8*)(ap + k), b = *(const bf16x8*)(bp + k); acc = __builtin_amdgcn_mfma_f32_32x32x16_bf16(a, b, acc, 0, 0, 0); }
    return acc;
}
__device__ __forceinline__ float gelu_tanh(float x) { const float t = tanhf(0.7978845608028654f * (x + 0.044715f * x * x * x)); return 0.5f * x * (1.0f + t); }

__device__ __forceinline__ unsigned okey(float f) { const unsigned u = __builtin_bit_cast(unsigned, f); return (u & 0x80000000u) ? ~u : (u | 0x80000000u); }
__device__ __forceinline__ void dsa_naive_item(Frame& F, int m) {
    const int tid = F.tid, lane = F.lane, wave = F.wave;
    const int b = m >> 12, t = m & 4095, n = t + 1;
    LAS unsigned* KEY = (LAS unsigned*)(F.lds);
    LAS u32x4* IQL = (LAS u32x4*)(F.lds + 16384);
    LAS float* IWL = (LAS float*)(F.lds + 16384 + 1024);
    LAS int* LIST = (LAS int*)(F.lds + 20480);
    LAS int* CNT = (LAS int*)(F.lds + 20480 + 1024);
    LAS float* PL = (LAS float*)(F.lds + 24576);
    const bf16* IQ = WSP(bf16, WS_IQ); const bf16* IK = WSP(bf16, WS_IK); const float* IW = WSP(float, SM_IW);
    if (tid < 64) IQL[tid] = ((const u32x4*)(IQ + (size_t)m * 512))[tid];
    if (tid < 8) IWL[tid] = IW[(size_t)m * 8 + tid];
    __syncthreads();
    for (int s = tid; s < n; s += 512) {
        const u32x4* kp = (const u32x4*)(IK + (size_t)(b * SEQ + s) * 64);
        u32x4 kv[8];
#pragma unroll
        for (int c = 0; c < 8; ++c) kv[c] = kp[c];
        float sc = 0.f;
#pragma unroll
        for (int h = 0; h < 8; ++h) { float d = 0.f;
#pragma unroll
            for (int c = 0; c < 8; ++c) d = dot8(kv[c], IQL[h * 8 + c], d);
            sc += IWL[h] * fmaxf(d, 0.f); }
        KEY[s] = okey(sc);
    }
    __syncthreads();
    const bool all = (n <= 256);
    unsigned thr = 0u; int need_ties = 0;
    if (!all) {
        unsigned myk[8];
#pragma unroll
        for (int i = 0; i < 8; ++i) { const int s = tid + 512 * i; myk[i] = s < n ? KEY[s] : 0u; }
        unsigned prefix = 0u;
        for (int bit = 31; bit >= 0; --bit) {
            const unsigned cand = prefix | (1u << bit);
            int c = 0;
#pragma unroll
            for (int i = 0; i < 8; ++i) c += (myk[i] >= cand) ? 1 : 0;
            c = wave_sum_i(c);
            if (lane == 0) CNT[(bit & 1) * 8 + wave] = c;
            __syncthreads();
            int tot = 0;
#pragma unroll
            for (int w = 0; w < 8; ++w) tot += CNT[(bit & 1) * 8 + w];
            if (tot >= 256) prefix = cand;
        }
        thr = prefix;
        int c = 0;
#pragma unroll
        for (int i = 0; i < 8; ++i) c += (myk[i] > thr) ? 1 : 0;
        c = wave_sum_i(c);
        if (lane == 0) CNT[16 + wave] = c;
        __syncthreads();
        int tot = 0;
#pragma unroll
        for (int w = 0; w < 8; ++w) tot += CNT[16 + w];
        need_ties = 256 - tot;
    }
    if (wave == 0) {
        int pos = 0, ties = 0;
        const unsigned long long lt = (1ull << lane) - 1ull;
        for (int c0 = 0; c0 < n; c0 += 64) {
            const int s = c0 + lane; const bool valid = s < n; const unsigned k = valid ? KEY[s] : 0u;
            const bool gt = valid && (all || k > thr), eq = valid && !all && (k == thr);
            const unsigned long long beq = __ballot(eq); const int tr = ties + __popcll(beq & lt);
            const bool sel = gt || (eq && tr < need_ties);
            const unsigned long long bs = __ballot(sel); const int p = pos + __popcll(bs & lt);
            if (sel) LIST[p] = s;
            pos += __popcll(bs); ties += __popcll(beq);
        }
        if (lane == 0) CNT[32] = pos;
    }
    __syncthreads();
    const int nsel = CNT[32];
    const int g = wave >> 1, h0 = 4 * g + 2 * (wave & 1);
    const bf16* Q = WSP(bf16, WS_Q0); const bf16* Kp = WSP(bf16, WS_K0); const bf16* Vp = WSP(bf16, WS_V0);
    u32x4 q0[8], q1[8];
#pragma unroll
    for (int c = 0; c < 8; ++c) { q0[c] = ((const u32x4*)(Q + (size_t)m * 1024 + h0 * 64))[c]; q1[c] = ((const u32x4*)(Q + (size_t)m * 1024 + (h0 + 1) * 64))[c]; }
    float s0[4], s1[4]; float mx0 = -INFINITY, mx1 = -INFINITY;
#pragma unroll
    for (int i = 0; i < 4; ++i) { const int j = lane + 64 * i; s0[i] = -INFINITY; s1[i] = -INFINITY;
        if (j < nsel) { const int s = LIST[j]; const u32x4* kp = (const u32x4*)(Kp + (size_t)(b * SEQ + s) * 256 + g * 64); float d0 = 0.f, d1 = 0.f;
#pragma unroll
            for (int c = 0; c < 8; ++c) { const u32x4 kk = kp[c]; d0 = dot8(kk, q0[c], d0); d1 = dot8(kk, q1[c], d1); }
            s0[i] = d0; s1[i] = d1; }
        mx0 = fmaxf(mx0, s0[i]); mx1 = fmaxf(mx1, s1[i]); }
    mx0 = wave_max(mx0); mx1 = wave_max(mx1);
    float l0 = 0.f, l1 = 0.f;
    LAS float* P0 = PL + (wave * 2 + 0) * 256; LAS float* P1 = PL + (wave * 2 + 1) * 256;
#pragma unroll
    for (int i = 0; i < 4; ++i) { const int j = lane + 64 * i; const float p0 = (j < nsel) ? __builtin_amdgcn_exp2f(s0[i] - mx0) : 0.f, p1 = (j < nsel) ? __builtin_amdgcn_exp2f(s1[i] - mx1) : 0.f;
        l0 += p0; l1 += p1; P0[j] = bfround(p0); P1[j] = bfround(p1); }
    l0 = wave_sum(l0); l1 = wave_sum(l1);
    float a0 = 0.f, a1 = 0.f;
    for (int j = 0; j < nsel; ++j) { const int s = LIST[j]; const float v = bf2f(Vp[(size_t)(b * SEQ + s) * 256 + g * 64 + lane]); a0 += P0[j] * v; a1 += P1[j] * v; }
    bf16* O = WSP(bf16, WS_O0);
    O[(size_t)m * 1024 + h0 * 64 + lane] = (bf16)f2bf(a0 / l0); O[(size_t)m * 1024 + (h0 + 1) * 64 + lane] = (bf16)f2bf(a1 / l1);
    __syncthreads();
}

__device__ __forceinline__ void nsa_naive_item(Frame& F, int m) {
    const int lane = F.lane, wave = F.wave;
    const int b = m >> 12, t = m & 4095, jt = t >> 6;
    const int g = wave >> 1, h0 = 4 * g + 2 * (wave & 1);
    LAS float* PC = (LAS float*)(F.lds);
    LAS float* SC0 = (LAS float*)(F.lds + 16384) + (wave * 2 + 0) * 1024;
    LAS float* SC1 = SC0 + 1024;
    LAS unsigned long long* SEL = (LAS unsigned long long*)(F.lds + 16384 + 65536);
    const bf16* Q = WSP(bf16, WS_Q1);
    u32x4 q0[8], q1[8];
#pragma unroll
    for (int c = 0; c < 8; ++c) { q0[c] = ((const u32x4*)(Q + (size_t)m * 1024 + h0 * 64))[c]; q1[c] = ((const u32x4*)(Q + (size_t)m * 1024 + (h0 + 1) * 64))[c]; }
    const int nv = t >= 31 ? min(255, (t - 31) / 16 + 1) : 0;
    const bf16* KC = WSP(bf16, SM_KC) + (size_t)(b * 4 + g) * 256 * 64; const bf16* VC = WSP(bf16, SM_VC) + (size_t)(b * 4 + g) * 256 * 64;
    float oc0 = 0.f, oc1 = 0.f;
    {
        float s0[4], s1[4]; float mx0 = -INFINITY, mx1 = -INFINITY;
#pragma unroll
        for (int i = 0; i < 4; ++i) { const int n = lane + 64 * i; s0[i] = -INFINITY; s1[i] = -INFINITY;
            if (n < nv) { const u32x4* kp = (const u32x4*)(KC + (size_t)n * 64); float d0 = 0.f, d1 = 0.f;
#pragma unroll
                for (int c = 0; c < 8; ++c) { const u32x4 kk = kp[c]; d0 = dot8(kk, q0[c], d0); d1 = dot8(kk, q1[c], d1); }
                s0[i] = d0; s1[i] = d1; }
            mx0 = fmaxf(mx0, s0[i]); mx1 = fmaxf(mx1, s1[i]); }
        mx0 = wave_max(mx0); mx1 = wave_max(mx1);
        float p0[4], p1[4], l0 = 0.f, l1 = 0.f;
#pragma unroll
        for (int i = 0; i < 4; ++i) { const int n = lane + 64 * i; p0[i] = (n < nv) ? __builtin_amdgcn_exp2f(s0[i] - mx0) : 0.f; p1[i] = (n < nv) ? __builtin_amdgcn_exp2f(s1[i] - mx1) : 0.f; l0 += p0[i]; l1 += p1[i]; }
        l0 = wave_sum(l0); l1 = wave_sum(l1);
        const float r0 = nv > 0 ? 1.0f / l0 : 0.f, r1 = nv > 0 ? 1.0f / l1 : 0.f;
#pragma unroll
        for (int i = 0; i < 4; ++i) { const int n = lane + 64 * i; PC[h0 * 256 + n] = p0[i] * r0; PC[(h0 + 1) * 256 + n] = p1[i] * r1; SC0[n] = bfround(p0[i]); SC1[n] = bfround(p1[i]); }
        for (int n = 0; n < nv; ++n) { const float v = bf2f(VC[(size_t)n * 64 + lane]); oc0 += SC0[n] * v; oc1 += SC1[n] * v; }
        oc0 *= r0; oc1 *= r1;
    }
    __syncthreads();
    if ((wave & 1) == 0) {
        const int j = lane;
        auto P4 = [&](int n) -> float { return (PC[(4 * g) * 256 + n] + PC[(4 * g + 1) * 256 + n]) + (PC[(4 * g + 2) * 256 + n] + PC[(4 * g + 3) * 256 + n]); };
        float imp = P4(4 * j) + P4(4 * j + 1) + P4(4 * j + 2) + 0.5f * P4(4 * j + 3);
        if (j > 0) imp += 0.5f * P4(4 * j - 1);
        const bool valid = j <= jt, forced = (j == 0) || (j == jt) || (j + 1 == jt);
        const float val = valid ? (forced ? 1e30f : imp) : -1e30f;
        int rank = 0;
        for (int jj = 0; jj < 64; ++jj) { const float vj = __shfl(val, jj); rank += ((vj > val) || (vj == val && jj < j)) ? 1 : 0; }
        const unsigned long long mk = __ballot(rank < 16);
        if (lane == 0) SEL[g] = mk;
    }
    __syncthreads();
    float os0 = 0.f, os1 = 0.f;
    {
        unsigned long long mk = SEL[g]; if (jt < 63) mk &= ((1ull << (jt + 1)) - 1ull);
        const bf16* Ks = WSP(bf16, WS_KSLC); const bf16* Vs = WSP(bf16, WS_VSLC);
        int cnt = 0; float mx0 = -INFINITY, mx1 = -INFINITY;
        for (unsigned long long r = mk; r; r &= r - 1ull) { const int j = __builtin_ctzll(r); const int tok = 64 * j + lane;
            float d0 = -INFINITY, d1 = -INFINITY;
            if (tok <= t) { const u32x4* kp = (const u32x4*)(Ks + (size_t)(b * SEQ + tok) * 256 + g * 64); d0 = 0.f; d1 = 0.f;
#pragma unroll
                for (int c = 0; c < 8; ++c) { const u32x4 kk = kp[c]; d0 = dot8(kk, q0[c], d0); d1 = dot8(kk, q1[c], d1); } }
            SC0[cnt * 64 + lane] = d0; SC1[cnt * 64 + lane] = d1; mx0 = fmaxf(mx0, d0); mx1 = fmaxf(mx1, d1); ++cnt; }
        mx0 = wave_max(mx0); mx1 = wave_max(mx1);
        float l0 = 0.f, l1 = 0.f;
        for (int i = lane; i < cnt * 64; i += 64) { const float p0 = __builtin_amdgcn_exp2f(SC0[i] - mx0), p1 = __builtin_amdgcn_exp2f(SC1[i] - mx1); l0 += p0; l1 += p1; SC0[i] = bfround(p0); SC1[i] = bfround(p1); }
        l0 = wave_sum(l0); l1 = wave_sum(l1);
        cnt = 0;
        for (unsigned long long r = mk; r; r &= r - 1ull) { const int j = __builtin_ctzll(r);
            const int kmax = min(64, t - 64 * j + 1);
            for (int kk = 0; kk < kmax; ++kk) { const float v = bf2f(Vs[(size_t)(b * SEQ + 64 * j + kk) * 256 + g * 64 + lane]); os0 += SC0[cnt * 64 + kk] * v; os1 += SC1[cnt * 64 + kk] * v; }
            ++cnt; }
        os0 /= l0; os1 /= l1;
    }
    float ow0 = 0.f, ow1 = 0.f;
    {
        const bf16* Kw = WSP(bf16, WS_KWIN); const bf16* Vw = WSP(bf16, WS_VWIN);
        const int slo = max(0, t - 511), nw = t - slo + 1;
        float mx0 = -INFINITY, mx1 = -INFINITY;
        for (int i = lane; i < nw; i += 64) { const u32x4* kp = (const u32x4*)(Kw + (size_t)(b * SEQ + slo + i) * 256 + g * 64); float d0 = 0.f, d1 = 0.f;
#pragma unroll
            for (int c = 0; c < 8; ++c) { const u32x4 kk = kp[c]; d0 = dot8(kk, q0[c], d0); d1 = dot8(kk, q1[c], d1); }
            SC0[i] = d0; SC1[i] = d1; mx0 = fmaxf(mx0, d0); mx1 = fmaxf(mx1, d1); }
        mx0 = wave_max(mx0); mx1 = wave_max(mx1);
        float l0 = 0.f, l1 = 0.f;
        for (int i = lane; i < nw; i += 64) { const float p0 = __builtin_amdgcn_exp2f(SC0[i] - mx0), p1 = __builtin_amdgcn_exp2f(SC1[i] - mx1); l0 += p0; l1 += p1; SC0[i] = bfround(p0); SC1[i] = bfround(p1); }
        l0 = wave_sum(l0); l1 = wave_sum(l1);
        for (int i = 0; i < nw; ++i) { const float v = bf2f(Vw[(size_t)(b * SEQ + slo + i) * 256 + g * 64 + lane]); ow0 += SC0[i] * v; ow1 += SC1[i] * v; }
        ow0 /= l0; ow1 /= l1;
    }
    const float* gt = WSP(float, SM_GATES) + (size_t)m * 48;
    bf16* O = WSP(bf16, WS_O1);
    O[(size_t)m * 1024 + h0 * 64 + lane] = (bf16)f2bf(gt[h0 * 3] * oc0 + gt[h0 * 3 + 1] * os0 + gt[h0 * 3 + 2] * ow0);
    O[(size_t)m * 1024 + (h0 + 1) * 64 + lane] = (bf16)f2bf(gt[h0 * 3 + 3] * oc1 + gt[h0 * 3 + 4] * os1 + gt[h0 * 3 + 5] * ow1);
    __syncthreads();
}

constexpr int NPHASE = 19;
struct Args { const void* in[29]; float* out; unsigned char* ws; int ph_lo, ph_hi, li, pad; };
__global__ void __launch_bounds__(NWAVES * 64, 2) trunk_fwd(Args args) {
    extern __shared__ __attribute__((aligned(16))) unsigned char lds[];
    Frame F;
    F.lds = (LAS unsigned char*)lds;
    F.MISC = (volatile LAS unsigned*)(F.lds + MISC_OFF);
    F.tid = threadIdx.x; F.lane = F.tid & 63; F.wave = __builtin_amdgcn_readfirstlane(F.tid >> 6);
    F.G = gridDim.x; F.gw = blockIdx.x * NWAVES + F.wave; F.NGW = F.G * NWAVES;
    F.ws = args.ws; F.ctl = (unsigned*)(args.ws + WS_CTL);
    F.x = (const float*)args.in[0]; F.c = (const float*)args.in[1]; F.pos = (const int*)args.in[2];
    F.attn_gain = (const float*)args.in[3]; F.ffn_gain = (const float*)args.in[4]; F.w_ada = (const float*)args.in[5]; F.b_ada = (const float*)args.in[6];
    F.a_w_in = (const float*)args.in[7]; F.a_w_out = (const float*)args.in[8]; F.b_w_q = (const float*)args.in[9]; F.b_w_out = (const float*)args.in[10];
    F.kv_gain = (const float*)args.in[11]; F.w_kv_ada = (const float*)args.in[12]; F.b_kv_ada = (const float*)args.in[13]; F.w_kv = (const float*)args.in[14];
    F.pe_k = (const float*)args.in[15]; F.w1_k = (const float*)args.in[16]; F.w2_k = (const float*)args.in[17]; F.pe_v = (const float*)args.in[18]; F.w1_v = (const float*)args.in[19]; F.w2_v = (const float*)args.in[20];
    F.ffn_wg = (const float*)args.in[21]; F.ffn_wu = (const float*)args.in[22]; F.ffn_wd = (const float*)args.in[23]; F.w_router = (const float*)args.in[24];
    F.moe_wg = (const float*)args.in[25]; F.moe_wu = (const float*)args.in[26]; F.moe_wd = (const float*)args.in[27]; F.final_gain = (const float*)args.in[28];
    F.out = args.out;
    for (int u = F.tid; u < (LDS_BYTES - LDSCTL_OFF) / 4; u += NWAVES * 64) ((LAS unsigned*)(F.lds + LDSCTL_OFF))[u] = 0u;
    __syncthreads();
    XcdBarrier bar; bar.bar = F.ctl + CW_BAR; bar.x = 0; bar.st = nullptr;
    if (!MK_PER_PHASE) bar = xcd_barrier_post(F.ctl + CW_BAR, F.MISC + 8);
#define GRID_BAR() do { if (!MK_PER_PHASE) xcd_barrier(bar); } while (0)
    const int lo = args.ph_lo, hi = args.ph_hi;
#define IN(k) (lo <= (k) && (k) < hi)
#define BOTH(k) (IN(k) && IN((k) + 1))
    const float* MOD0 = WSP(float, SM_MOD0); const float* MOD1 = WSP(float, SM_MOD1); const float* KVMOD = WSP(float, SM_KVMOD);
    const float* CS = WSP(float, SM_COS); const float* SN = WSP(float, SM_SIN);

    if (IN(0)) { p0_prologue(F); if (BOTH(0)) GRID_BAR(); }
    if (IN(1)) { norm_phase(F, F.x, F.attn_gain, MOD0, 6144, 0, 1024, WSP(bf16, WS_U)); if (BOTH(1)) GRID_BAR(); }
    if (IN(2)) {
        pg8::Gemm g{WSP(bf16, WS_U), WSP(bf16, WB_IN), D, D, D}; pg8::StaticOrder S; S.init(T, A_INP, F.G, (int)blockIdx.x);
        EpiIn E{WSP(bf16, WS_Q0), WSP(bf16, WS_K0), WSP(bf16, WS_V0), WSP(bf16, WS_IQ), WSP(bf16, WS_IK), WSP(float, SM_IW), CS, SN};
        pg8::gemm_phase(F.lds, g, S, E);
        if (BOTH(2)) GRID_BAR();
    }
    if (IN(3)) { for (int m = blockIdx.x; m < T; m += F.G) dsa_naive_item(F, m); if (BOTH(3)) GRID_BAR(); }
    if (IN(4)) {
        pg8::Gemm g{WSP(bf16, WS_O0), WSP(bf16, WB_O0), D, D, D}; pg8::StaticOrder S; S.init(T, D, F.G, (int)blockIdx.x);
        EpiRes E{F.x, F.out, MOD0 + 2048, 6144};
        pg8::gemm_phase(F.lds, g, S, E);
        if (BOTH(4)) GRID_BAR();
    }
    if (IN(5)) {
        norm_phase(F, F.out, F.ffn_gain, MOD0, 6144, 3072, 4096, WSP(bf16, WS_U));
        { LAS float* scr = (LAS float*)(F.lds + F.wave * 16384); for (int it = F.gw; it < NCONV_B; it += F.NGW) conv_item_b(F, it, scr); }
        if (BOTH(5)) GRID_BAR();
    }
    if (IN(6)) {
        pg8::Gemm g{WSP(bf16, WS_U), WSP(bf16, WB_GU0), D, D, D}; pg8::StaticOrder S; S.init(T, 2 * FF0, F.G, (int)blockIdx.x);
        EpiSwiglu E{WSP(bf16, WS_HID), FF0, 2 * FF0 / 256};
        pg8::gemm_phase(F.lds, g, S, E);
        if (BOTH(6)) GRID_BAR();
    }
    if (IN(7)) {
        pg8::Gemm g{WSP(bf16, WS_HID), WSP(bf16, WB_D0), FF0, FF0, FF0}; pg8::StaticOrder S; S.init(T, D, F.G, (int)blockIdx.x);
        EpiRes E{F.out, F.out, MOD0 + 5120, 6144};
        pg8::gemm_phase(F.lds, g, S, E);
        if (BOTH(7)) GRID_BAR();
    }
    if (IN(8)) {
        for (int m = F.gw; m < T; m += F.NGW) {
            f32x4 v[4], u[4]; load_row(F.out + (size_t)m * D, F.lane, v);
            const float r = row_rs(v); const int b = m >> 12;
            modulate_row(v, r, F.kv_gain, KVMOD + (size_t)b * 2048, KVMOD + (size_t)b * 2048 + 1024, F.lane, u);
            store_row_bf16(WSP(bf16, WS_U) + (size_t)m * D, F.lane, u);
            modulate_row(v, r, F.attn_gain + D, MOD1 + (size_t)b * 6144, MOD1 + (size_t)b * 6144 + 1024, F.lane, u);
            store_row_bf16(WSP(bf16, WS_U2) + (size_t)m * D, F.lane, u);
        }
        if (BOTH(8)) GRID_BAR();
    }
    if (IN(9)) {
        pg8::Gemm g{WSP(bf16, WS_U), WSP(bf16, WB_KVQ), D, D, D}; KvqOrder S; S.S.init(T, 11 * 256, F.G, (int)blockIdx.x);
        EpiKVQ E{WSP(bf16, WS_KCMP), WSP(bf16, WS_VCMP), WSP(bf16, WS_KSLC), WSP(bf16, WS_VSLC), WSP(bf16, WS_KWIN), WSP(bf16, WS_VWIN), WSP(bf16, WS_Q1), WSP(float, SM_GATES), CS, SN};
        pg8::gemm_phase(F.lds, g, S, E);
        if (BOTH(9)) GRID_BAR();
    }
    if (IN(10)) {
        const float* cb = WSP(float, SM_CBIAS); bf16* CH = WSP(bf16, WS_CH);
        for (int it = F.gw; it < 256 * 8; it += F.NGW) {
            const int rt = it >> 3, ct = it & 7, kv = rt >> 7;
            const bf16* A = kv ? WSP(bf16, WS_VCMP) : WSP(bf16, WS_KCMP);
            const f32x16 acc = sgemm_tile(A, 1024, WSP(bf16, WB_C1) + (size_t)kv * 256 * 2048, 2048, 2048, (rt & 127) * 32, ct * 32, F.lane);
            const int col = ct * 32 + (F.lane & 31); const float bias = cb[kv * 256 + col];
#pragma unroll
            for (int r = 0; r < 16; ++r) { const int row = rt * 32 + (r & 3) + 8 * (r >> 2) + 4 * (F.lane >> 5); CH[(size_t)row * 256 + col] = (bf16)f2bf(gelu_tanh(acc[r] + bias)); }
        }
        if (BOTH(10)) GRID_BAR();
    }
    if (IN(11)) {
        const bf16* CH = WSP(bf16, WS_CH);
        for (int it = F.gw; it < 256 * 2; it += F.NGW) {
            const int rt = it >> 1, ct = it & 1, kv = rt >> 7;
            const f32x16 acc = sgemm_tile(CH, 256, WSP(bf16, WB_C2) + (size_t)kv * 64 * 256, 256, 256, rt * 32, ct * 32, F.lane);
            bf16* dst = kv ? WSP(bf16, SM_VC) : WSP(bf16, SM_KC);
            const int col = ct * 32 + (F.lane & 31);
#pragma unroll
            for (int r = 0; r < 16; ++r) { const int row = (rt & 127) * 32 + (r & 3) + 8 * (r >> 2) + 4 * (F.lane >> 5); dst[(size_t)row * 64 + col] = (bf16)f2bf(acc[r]); }
        }
        if (BOTH(11)) GRID_BAR();
    }
    if (IN(12)) { for (int m = blockIdx.x; m < T; m += F.G) nsa_naive_item(F, m); if (BOTH(12)) GRID_BAR(); }
    if (IN(13)) {
        pg8::Gemm g{WSP(bf16, WS_O1), WSP(bf16, WB_O1), D, D, D}; pg8::StaticOrder S; S.init(T, D, F.G, (int)blockIdx.x);
        EpiRes E{F.out, F.out, MOD1 + 2048, 6144};
        pg8::gemm_phase(F.lds, g, S, E);
        if (BOTH(13)) GRID_BAR();
    }
    if (IN(14)) {
        LAS int* lcnt = (LAS int*)(F.lds);
        if (F.tid < NE) lcnt[F.tid] = 0;
        __syncthreads();
        int* toke = WSP(int, SM_TOKE); float* tokw = WSP(float, SM_TOKW);
        for (int m = F.gw; m < T; m += F.NGW) {
            f32x4 v[4], u[4]; load_row(F.out + (size_t)m * D, F.lane, v);
            const float r = row_rs(v); const int b = m >> 12;
            modulate_row(v, r, F.ffn_gain + D, MOD1 + (size_t)b * 6144 + 3072, MOD1 + (size_t)b * 6144 + 4096, F.lane, u);
            store_row_bf16(WSP(bf16, WS_UM) + (size_t)m * D, F.lane, u);
            float lg[NE];
#pragma unroll
            for (int e = 0; e < NE; ++e) lg[e] = 0.f;
#pragma unroll
            for (int j = 0; j < 4; ++j) {
                const float uu[4] = {u[j].x, u[j].y, u[j].z, u[j].w};
#pragma unroll
                for (int q = 0; q < 4; ++q) { const float* wr = F.w_router + (size_t)(4 * F.lane + 256 * j + q) * NE; const f32x4 w0 = *(const f32x4*)wr, w1 = *(const f32x4*)(wr + 4);
                    lg[0] += uu[q] * w0.x; lg[1] += uu[q] * w0.y; lg[2] += uu[q] * w0.z; lg[3] += uu[q] * w0.w; lg[4] += uu[q] * w1.x; lg[5] += uu[q] * w1.y; lg[6] += uu[q] * w1.z; lg[7] += uu[q] * w1.w; }
            }
#pragma unroll
            for (int e = 0; e < NE; ++e) lg[e] = wave_sum(lg[e]);
            int e1 = 0; float v1 = lg[0];
#pragma unroll
            for (int e = 1; e < NE; ++e) if (lg[e] > v1) { v1 = lg[e]; e1 = e; }
            int e2 = -1; float v2 = -INFINITY;
#pragma unroll
            for (int e = 0; e < NE; ++e) if (e != e1 && lg[e] > v2) { v2 = lg[e]; e2 = e; }
            if (F.lane == 0) {
                const float ex = __expf(v2 - v1), w1 = 1.0f / (1.0f + ex);
                toke[2 * m] = e1; toke[2 * m + 1] = e2; tokw[2 * m] = w1; tokw[2 * m + 1] = ex * w1;
                lds_add(&lcnt[e1], 1); lds_add(&lcnt[e2], 1);
            }
        }
        __syncthreads();
        if (F.tid < NE) atomicAdd(F.ctl + CW_CNT + F.tid, (unsigned)lcnt[F.tid]);
        if (BOTH(14)) GRID_BAR();
    }
    if (IN(15)) {
        LAS int* lcnt = (LAS int*)(F.lds); LAS int* lbase = lcnt + 8; LAS int* lfill = lcnt + 16;
        const int* toke = WSP(int, SM_TOKE); int* slot = WSP(int, SM_SLOT);
        const int rows_per = T / F.G, r0 = blockIdx.x * rows_per;
        if (F.tid < NE) { lcnt[F.tid] = 0; lfill[F.tid] = 0; }
        __syncthreads();
        for (int i = F.tid; i < 2 * rows_per; i += 512) lds_add(&lcnt[toke[2 * r0 + i]], 1);
        __syncthreads();
        if (F.tid < NE) {
            int off = 0; for (int e = 0; e < F.tid; ++e) off += (int)((ld_u32(F.ctl + CW_CNT + e) + 255u) >> 8) * 256;
            lbase[F.tid] = off + (int)atomicAdd(F.ctl + CW_FILL + F.tid, (unsigned)lcnt[F.tid]);
        }
        __syncthreads();
        const bf16* UM = WSP(bf16, WS_UM); bf16* AG = WSP(bf16, WS_AG);
        for (int i = F.wave; i < 2 * rows_per; i += NWAVES) {
            const int m = r0 + (i >> 1), e = toke[2 * r0 + i];
            int s = 0; if (F.lane == 0) { s = lbase[e] + lds_add(&lfill[e], 1); slot[2 * r0 + i] = s; }
            s = __shfl(s, 0);
            const u32x4* src = (const u32x4*)(UM + (size_t)m * D); u32x4* dst = (u32x4*)(AG + (size_t)s * D);
            dst[F.lane] = src[F.lane]; dst[F.lane + 64] = src[F.lane + 64];
        }
        if (BOTH(15)) GRID_BAR();
    }
    if (IN(16)) {
        pg8::Gemm g{WSP(bf16, WS_AG), WSP(bf16, WS_WGU1), D, D, D}; MoeOrder S; S.init(F.ctl + CW_CNT, 2 * FFE / 256, F.G, (int)blockIdx.x);
        EpiSwiglu E{WSP(bf16, WS_HID2), FFE, 2 * FFE / 256};
        pg8::gemm_phase(F.lds, g, S, E);
        if (BOTH(16)) GRID_BAR();
    }
    if (IN(17)) {
        pg8::Gemm g{WSP(bf16, WS_HID2), WSP(bf16, WS_WD1), FFE, FFE, FFE}; MoeOrder S; S.init(F.ctl + CW_CNT, D / 256, F.G, (int)blockIdx.x);
        EpiY E{WSP(bf16, WS_Y)};
        pg8::gemm_phase(F.lds, g, S, E);
        if (BOTH(17)) GRID_BAR();
    }
    if (IN(18)) {
        const int* slot = WSP(int, SM_SLOT); const float* tokw = WSP(float, SM_TOKW); const bf16* Y = WSP(bf16, WS_Y);
        for (int m = F.gw; m < T; m += F.NGW) {
            f32x4 v[4]; load_row(F.out + (size_t)m * D, F.lane, v);
            const int b = m >> 12; const int s1 = slot[2 * m], s2 = slot[2 * m + 1]; const float w1 = tokw[2 * m], w2 = tokw[2 * m + 1];
            const float* fg = MOD1 + (size_t)b * 6144 + 5120;
#pragma unroll
            for (int j = 0; j < 4; ++j) {
                const u32x2 y1 = ((const u32x2*)(Y + (size_t)s1 * D))[F.lane + 64 * j], y2 = ((const u32x2*)(Y + (size_t)s2 * D))[F.lane + 64 * j];
                const f32x4 gq = ((const f32x4*)fg)[F.lane + 64 * j];
                f32x4 y; y.x = w1 * bflo(y1.x) + w2 * bflo(y2.x); y.y = w1 * bfhi(y1.x) + w2 * bfhi(y2.x); y.z = w1 * bflo(y1.y) + w2 * bflo(y2.y); y.w = w1 * bfhi(y1.y) + w2 * bfhi(y2.y);
                v[j] = v[j] + gq * y;
            }
            const float r = row_rs(v);
#pragma unroll
            for (int j = 0; j < 4; ++j) { const f32x4 gn = ((const f32x4*)F.final_gain)[F.lane + 64 * j]; ((f32x4*)(F.out + (size_t)m * D))[F.lane + 64 * j] = v[j] * r * gn; }
        }
    }
#undef IN
#undef BOTH
}

extern "C" void kernel_launch(void* const* d_in, const int* in_sizes, int n_in, void* d_out, int out_size, void* d_ws, size_t ws_size, hipStream_t stream) {
    static int grid = 0;
    if (grid == 0) {
        if (n_in != 29 || out_size != T * D || ws_size < WS_END) { fprintf(stderr, "kernel_launch: unexpected problem (n_in %d, out %d, ws %zu)\n", n_in, out_size, ws_size); grid = -1; return; }
        int dev = 0, cus = 0, per_cu = 0;
        if (hipGetDevice(&dev) != hipSuccess || hipDeviceGetAttribute(&cus, hipDeviceAttributeMultiprocessorCount, dev) != hipSuccess) { grid = -1; return; }
        if (hipFuncSetAttribute((const void*)trunk_fwd, hipFuncAttributeMaxDynamicSharedMemorySize, LDS_BYTES) != hipSuccess) { fprintf(stderr, "kernel_launch: hipFuncSetAttribute failed\n"); grid = -1; return; }
        if (hipOccupancyMaxActiveBlocksPerMultiprocessor(&per_cu, (const void*)trunk_fwd, NWAVES * 64, LDS_BYTES) != hipSuccess || per_cu < 1) { fprintf(stderr, "kernel_launch: occupancy query says %d\n", per_cu); }
        (void)hipGetLastError();
        grid = cus;
        if (T % grid != 0) { fprintf(stderr, "kernel_launch: grid %d does not divide the token count\n", grid); grid = -1; return; }
    }
    if (grid < 0) return;
    if (hipMemsetAsync((char*)d_ws + WS_CTL, 0, CTL_ZERO_BYTES, stream) != hipSuccess) return;
    Args a{};
    for (int i = 0; i < 29; ++i) a.in[i] = d_in[i];
    a.out = (float*)d_out; a.ws = (unsigned char*)d_ws;
#if MK_PER_PHASE
    for (int p = 0; p < NPHASE; ++p) { a.ph_lo = p; a.ph_hi = p + 1; a.li = p; hipLaunchKernelGGL(trunk_fwd, dim3(grid), dim3(NWAVES * 64), LDS_BYTES, stream, a); }
#else
    a.ph_lo = 0; a.ph_hi = NPHASE; a.li = 0;
    hipLaunchKernelGGL(trunk_fwd, dim3(grid), dim3(NWAVES * 64), LDS_BYTES, stream, a);
#endif
    const hipError_t le = hipPeekAtLastError();
    if (le != hipSuccess) fprintf(stderr, "kernel_launch: launch failed: %s\n", hipGetErrorName(le));
}
```

```cpp
#include <hip/hip_runtime.h>
#include <cstdio>
#include <cstdint>

#ifndef MK_PER_PHASE
#define MK_PER_PHASE 0
#endif

#define GAS __attribute__((address_space(1)))
#define LAS __attribute__((address_space(3)))
typedef unsigned short bf16;
typedef short bf16x8 __attribute__((ext_vector_type(8)));
typedef float f32x4 __attribute__((ext_vector_type(4)));
typedef float f32x16 __attribute__((ext_vector_type(16)));
typedef unsigned u32x4 __attribute__((ext_vector_type(4)));
typedef unsigned u32x2 __attribute__((ext_vector_type(2)));
typedef GAS unsigned gu32;

constexpr int NB = 4, SEQ = 4096, T = NB * SEQ, D = 1024, NH = 16, HD = 64, NG = 4;
constexpr int A_IN = 2120, A_INP = 2304, FF0 = 2816, FFE = 3584, NE = 8;
constexpr int KVW = 1536, BQ = 1072, BQP = 1280;
constexpr float C2 = 0.125f * 1.4426950408889634f;
constexpr float IWS = 0.04419417382415922f;
constexpr float RMS_EPS = 1e-6f;
constexpr int MPAD = 2 * T + NE * 256;

constexpr size_t MiB = 1u << 20;
constexpr size_t WS_CTL = 0, CTL_ZERO_BYTES = 1 * MiB;
constexpr size_t WS_SMALL = 1 * MiB;
constexpr size_t SM_MOD0 = WS_SMALL, SM_MOD1 = SM_MOD0 + 4 * 6144 * 4, SM_KVMOD = SM_MOD1 + 4 * 6144 * 4, SM_CBIAS = SM_KVMOD + 4 * 2048 * 4;
constexpr size_t SM_COS = 2 * MiB, SM_SIN = 4 * MiB, SM_IW = 6 * MiB, SM_GATES = 7 * MiB, SM_TOKE = 10 * MiB, SM_TOKW = SM_TOKE + 131072, SM_SLOT = SM_TOKW + 131072;
constexpr size_t SM_KC = 11 * MiB, SM_VC = SM_KC + 524288 + 4096;
static_assert(SM_CBIAS + 2048 <= SM_COS && SM_SLOT + 131072 <= SM_KC && SM_VC + 524288 + 4096 <= 16 * MiB, "small map");
constexpr size_t WB_IN = 16 * MiB;
constexpr size_t WB_O0 = WB_IN + (size_t)A_INP * D * 2;
constexpr size_t WB_GU0 = WB_O0 + (size_t)D * D * 2;
constexpr size_t WB_D0 = WB_GU0 + (size_t)2 * FF0 * D * 2;
constexpr size_t WB_KVQ = WB_D0 + (size_t)D * FF0 * 2;
constexpr size_t WB_O1 = WB_KVQ + (size_t)(KVW + BQP) * D * 2;
constexpr size_t WB_C1 = WB_O1 + (size_t)D * D * 2;
constexpr size_t WB_C2 = WB_C1 + (size_t)512 * 2048 * 2;
static_assert(WB_C2 + 128 * 256 * 2 <= 50 * MiB, "weight map");
constexpr size_t WS_U = 50 * MiB, WS_U2 = 82 * MiB;
constexpr size_t WS_Q0 = 114 * MiB, WS_K0 = 146 * MiB, WS_V0 = 154 * MiB, WS_IQ = 162 * MiB, WS_IK = 178 * MiB, WS_O0 = 180 * MiB, WS_MASK = 212 * MiB, WS_SCORES = 220 * MiB;
constexpr size_t WS_HID = 220 * MiB;
constexpr size_t WS_KCMP = 114 * MiB, WS_VCMP = 122 * MiB, WS_KSLC = 130 * MiB, WS_VSLC = 138 * MiB, WS_KWIN = 146 * MiB, WS_VWIN = 154 * MiB;
constexpr size_t WS_Q1 = 162 * MiB, WS_O1 = 194 * MiB, WS_CH = 226 * MiB;
constexpr size_t WS_UM = 300 * MiB;
constexpr size_t WS_AG = 16 * MiB;
constexpr size_t WS_Y = 16 * MiB;
constexpr size_t WS_HID2 = 84 * MiB;
constexpr size_t WS_WGU1 = 351 * MiB, WS_WD1 = 463 * MiB, WS_END = 519 * MiB;
static_assert(WS_AG + (size_t)MPAD * D * 2 <= WS_HID2 && WS_HID2 + (size_t)MPAD * FFE * 2 <= WS_WGU1 && WS_WGU1 + (size_t)NE * 2 * FFE * D * 2 == WS_WD1 && WS_WD1 + (size_t)NE * D * FFE * 2 == WS_END, "moe map");
static_assert(WS_HID + (size_t)T * FF0 * 2 <= WS_WGU1 && WS_UM + (size_t)T * D * 2 <= WS_WGU1 && WS_SCORES + (size_t)NB * SEQ * SEQ * 4 <= 476 * MiB, "map");
constexpr int CW_TMO = 0, CW_BAR = 4096, CW_CNT = 8192, CW_FILL = 8256;
#define XCD_BAR_WORDS 3456

constexpr int RING_BYTES = 131072, LDSCTL_OFF = RING_BYTES, MISC_OFF = LDSCTL_OFF + 320, LDS_BYTES = 147456;
constexpr int NWAVES = 8;

#define RLX_AGENT __ATOMIC_RELAXED, __HIP_MEMORY_SCOPE_AGENT
#define LDS_WAIT() asm volatile("s_waitcnt lgkmcnt(0)" ::: "memory")
#define VM_WAIT() asm volatile("s_waitcnt vmcnt(0)" ::: "memory")
__device__ __forceinline__ unsigned f2bf(float f) { unsigned u = __builtin_bit_cast(unsigned, f); return (u + 0x7fffu + ((u >> 16) & 1u)) >> 16; }
__device__ __forceinline__ unsigned pk2(float lo, float hi) { return f2bf(lo) | (f2bf(hi) << 16); }
__device__ __forceinline__ float bf2f(unsigned v) { return __builtin_bit_cast(float, v << 16); }
__device__ __forceinline__ float bflo(unsigned w) { return __builtin_bit_cast(float, w << 16); }
__device__ __forceinline__ float bfhi(unsigned w) { return __builtin_bit_cast(float, w & 0xffff0000u); }
__device__ __forceinline__ float bfround(float f) { return bf2f(f2bf(f)); }
__device__ __forceinline__ float wave_sum(float v) {
#pragma unroll
    for (int o = 1; o < 64; o <<= 1) v += __shfl_xor(v, o);
    return v;
}
__device__ __forceinline__ float wave_max(float v) {
#pragma unroll
    for (int o = 1; o < 64; o <<= 1) v = fmaxf(v, __shfl_xor(v, o));
    return v;
}
__device__ __forceinline__ int wave_sum_i(int v) {
#pragma unroll
    for (int o = 1; o < 64; o <<= 1) v += __shfl_xor(v, o);
    return v;
}
__device__ __forceinline__ int lds_add(LAS int* p, int v) { return __hip_atomic_fetch_add(p, v, __ATOMIC_RELAXED, __HIP_MEMORY_SCOPE_WORKGROUP); }
__device__ __forceinline__ unsigned ld_u32(const unsigned* p) { return __hip_atomic_load(p, RLX_AGENT); }
__device__ __forceinline__ float dot8(u32x4 a, u32x4 b, float acc) {
    acc += bflo(a.x) * bflo(b.x); acc += bfhi(a.x) * bfhi(b.x); acc += bflo(a.y) * bflo(b.y); acc += bfhi(a.y) * bfhi(b.y);
    acc += bflo(a.z) * bflo(b.z); acc += bfhi(a.z) * bfhi(b.z); acc += bflo(a.w) * bflo(b.w); acc += bfhi(a.w) * bfhi(b.w);
    return acc;
}

namespace pg8 {
constexpr int BM = 256, BK = 64, HALF = 128, HTB = HALF * BK * 2, STAGE_BYTES = 8 * HTB, NXCD = 8, WGM = 8;
__host__ __device__ __forceinline__ int lds_byte(int r, int c) { const int st = (r >> 4) * 2 + (c >> 5), rr = r & 15, cc = c & 31, ob = rr * 64 + cc * 2; return st * 1024 + (ob ^ (((ob >> 9) & 1) << 5)); }
__host__ __device__ __forceinline__ void stage_rc(int b, int& R, int& C) { const int st = b / 1024, sb = b % 1024, swz = sb ^ (((sb >> 9) & 1) << 5); R = (st >> 1) * 16 + swz / 64; C = (st & 1) * 32 + (swz % 64) / 2; }
__host__ __device__ __forceinline__ int perm32(int rho) { const int n = rho >> 4, i = rho & 15; return 8 * (i >> 2) + 4 * n + (i & 3); }
struct Unit { int pm, pn; };
struct Gemm { const bf16* A; const bf16* Bt; int K, lda, ldb; };

struct StaticOrder {
    int nM, nN, nwg, G, c;
    __device__ void init(int M, int N, int G_, int c_) { nM = M / BM; nN = N / BM; nwg = nM * nN; G = G_; c = c_; }
    __device__ bool next(int i, Unit& u) const {
        const long L = (long)i * G + c; if (L >= nwg) return false;
        int wgid = (int)L; { const int q = nwg / NXCD, r = nwg % NXCD, xcd = wgid % NXCD, off = wgid / NXCD; wgid = (xcd < r ? xcd * (q + 1) : r * (q + 1) + (xcd - r) * q) + off; }
        const int nig = WGM * nN, gid = wgid / nig, fm = gid * WGM, gsz = (nM - fm) < WGM ? (nM - fm) : WGM;
        u.pm = fm + ((wgid % nig) % gsz); u.pn = (wgid % nig) / gsz; return true;
    }
};

template <class Epi, class Sched>
__device__ __forceinline__ void gemm_phase(LAS unsigned char* lds, const Gemm g, const Sched& S, const Epi& E) {
    const int tid = threadIdx.x, wid = __builtin_amdgcn_readfirstlane(tid >> 6), lane = tid & 63, wr = wid >> 2, wc = wid & 3, fr = lane & 15, fq = lane >> 4;
    const int K = g.K, nt = K / BK;
    unsigned voffA[2], voffB[2];
#pragma unroll
    for (int i = 0; i < 2; ++i) { int R, C; stage_rc(tid * 16 + i * 8192, R, C); const int Rb = (R & ~31) + perm32(R & 31);
        voffA[i] = (unsigned)(R * g.lda + C) * 2u; voffB[i] = (unsigned)(Rb * g.ldb + C) * 2u; }
    const size_t kstep = (size_t)(BK * 2);
    const size_t hA = (size_t)HALF * g.lda * 2, hB = (size_t)HALF * g.ldb * 2;
    const size_t tA = 2 * hA, tB = 2 * hB;
    const unsigned ldsw = (unsigned)wid * 1024u;
    const int aoff = lds_byte(wr * 64 + fr, fq * 8), boff = lds_byte(wc * 32 + fr, fq * 8);
#define PG8_SA(b, h) (((b) * 2 + (h)) * HTB)
#define PG8_SB(b, h) ((4 + (b) * 2 + (h)) * HTB)
#define PG8_STAGE(bufoff, gbase, voff) do { _Pragma("unroll") for (int _i = 0; _i < 2; ++_i) \
        __builtin_amdgcn_global_load_lds((const unsigned*)((const char*)(gbase) + (voff)[_i]), (LAS unsigned*)(lds + (bufoff) + ldsw + _i * 8192), 16, 0, 0); } while (0)
#define PG8_LDA(dst, b, h) do { _Pragma("unroll") for (int m = 0; m < 4; ++m) _Pragma("unroll") for (int k = 0; k < 2; ++k) dst[m][k] = *(const LAS bf16x8*)(lds + PG8_SA(b, h) + aoff + m * 2048 + k * 1024); } while (0)
#define PG8_LDB(dst, b, h) do { _Pragma("unroll") for (int n = 0; n < 2; ++n) _Pragma("unroll") for (int k = 0; k < 2; ++k) dst[n][k] = *(const LAS bf16x8*)(lds + PG8_SB(b, h) + boff + n * 2048 + k * 1024); } while (0)
#define PG8_MMA(ai, bj, At, Bt) do { __builtin_amdgcn_s_setprio(1); _Pragma("unroll") for (int m = 0; m < 4; ++m) _Pragma("unroll") for (int n = 0; n < 2; ++n) _Pragma("unroll") for (int k = 0; k < 2; ++k) \
        acc[ai][bj][m][n] = __builtin_amdgcn_mfma_f32_16x16x32_bf16(Bt[n][k], At[m][k], acc[ai][bj][m][n], 0, 0, 0); __builtin_amdgcn_s_setprio(0); } while (0)
#define PG8_WAIT_V(n) asm volatile("s_waitcnt vmcnt(" #n ")" ::: "memory")
#define PG8_WAIT_L(n) asm volatile("s_waitcnt lgkmcnt(" #n ")" ::: "memory")
#define PG8_BAR __builtin_amdgcn_s_barrier()
#define PG8_SCHED __builtin_amdgcn_sched_barrier(0)
    Unit cur, nxt; int ui = 0;
    if (!S.next(0, cur)) return;
    f32x4 acc[2][2][4][2];
#pragma unroll
    for (int a = 0; a < 2; ++a)
#pragma unroll
        for (int b = 0; b < 2; ++b)
#pragma unroll
            for (int m = 0; m < 4; ++m)
#pragma unroll
                for (int n = 0; n < 2; ++n) acc[a][b][m][n] = (f32x4){0.f, 0.f, 0.f, 0.f};
    bf16x8 At[4][2], B0[2][2], B1[2][2];
    const char* cA = (const char*)g.A + (size_t)cur.pm * tA; const char* cB = (const char*)g.Bt + (size_t)cur.pn * tB;
    PG8_STAGE(PG8_SB(0, 0), cB, voffB); PG8_STAGE(PG8_SB(0, 1), cB + hB, voffB); PG8_STAGE(PG8_SA(0, 0), cA, voffA); PG8_STAGE(PG8_SA(0, 1), cA + hA, voffA);
    if (wr == 1) PG8_BAR;
    PG8_WAIT_V(2); PG8_BAR;
    PG8_STAGE(PG8_SB(1, 0), cB + kstep, voffB); PG8_STAGE(PG8_SA(1, 0), cA + kstep, voffA); PG8_STAGE(PG8_SB(1, 1), cB + hB + kstep, voffB);
    PG8_WAIT_V(6); PG8_BAR;
    for (;;) {
        const bool has_next = S.next(ui + 1, nxt);
        const char* nA = has_next ? (const char*)g.A + (size_t)nxt.pm * tA : cA; const char* nB = has_next ? (const char*)g.Bt + (size_t)nxt.pn * tB : cB;
        for (int t = 0; t < nt; t += 2) {
            const bool last = (t == nt - 2);
            const char* a1 = cA + (size_t)(t + 1) * kstep;
            const char* a2 = last ? nA : cA + (size_t)(t + 2) * kstep; const char* b2 = last ? nB : cB + (size_t)(t + 2) * kstep;
            const char* a3 = a2 + kstep; const char* b3 = b2 + kstep;
            PG8_LDB(B0, 0, 0); PG8_LDB(B1, 0, 1); PG8_SCHED; PG8_LDA(At, 0, 0); PG8_STAGE(PG8_SA(1, 1), a1 + hA, voffA);
            PG8_WAIT_V(8); PG8_WAIT_L(0); PG8_BAR; PG8_MMA(0, 0, At, B0); PG8_MMA(0, 1, At, B1); PG8_BAR; PG8_SCHED;
            PG8_LDA(At, 0, 1); PG8_STAGE(PG8_SB(0, 0), b2, voffB); PG8_STAGE(PG8_SB(0, 1), b2 + hB, voffB); PG8_STAGE(PG8_SA(0, 0), a2, voffA);
            PG8_WAIT_V(8); PG8_WAIT_L(0); PG8_BAR; PG8_MMA(1, 0, At, B0); PG8_MMA(1, 1, At, B1); PG8_BAR; PG8_SCHED;
            PG8_LDB(B0, 1, 0); PG8_LDB(B1, 1, 1); PG8_SCHED; PG8_LDA(At, 1, 0); PG8_STAGE(PG8_SA(0, 1), a2 + hA, voffA);
            PG8_WAIT_V(8); PG8_WAIT_L(0); PG8_BAR; PG8_MMA(0, 0, At, B0); PG8_MMA(0, 1, At, B1); PG8_BAR; PG8_SCHED;
            PG8_LDA(At, 1, 1); PG8_STAGE(PG8_SB(1, 0), b3, voffB); PG8_STAGE(PG8_SB(1, 1), b3 + hB, voffB); PG8_STAGE(PG8_SA(1, 0), a3, voffA);
            PG8_WAIT_V(8); PG8_WAIT_L(0); PG8_BAR; PG8_MMA(1, 0, At, B0); PG8_MMA(1, 1, At, B1); PG8_BAR; PG8_SCHED;
        }
        if (wr == 0) PG8_BAR;
        E(acc, cur, wr, wc, fr, fq);
        if (!has_next) break;
#pragma unroll
        for (int a = 0; a < 2; ++a)
#pragma unroll
            for (int b = 0; b < 2; ++b)
#pragma unroll
                for (int m = 0; m < 4; ++m)
#pragma unroll
                    for (int n = 0; n < 2; ++n) acc[a][b][m][n] = (f32x4){0.f, 0.f, 0.f, 0.f};
        cur = nxt; cA = nA; cB = nB; ++ui;
        if (wr == 1) PG8_BAR;
    }
    PG8_WAIT_V(0);
    PG8_BAR;
#undef PG8_SA
#undef PG8_SB
#undef PG8_STAGE
#undef PG8_LDA
#undef PG8_LDB
#undef PG8_MMA
#undef PG8_WAIT_V
#undef PG8_WAIT_L
#undef PG8_BAR
#undef PG8_SCHED
}
}

#define XB_TMO      128
#define XB_XCNT(j)  (256  + 64 * (j))
#define XB_XSUB(j)  (1280 + 64 * (j))
#define XB_XGEN(j)  (2304 + 64 * (j))
#define XB_TOP      3328
#define XB_TOPGEN   3392
#define XB_SPIN_CAP (1u << 18)
__device__ __forceinline__ unsigned xb_ld(unsigned* p)              { return __hip_atomic_load(p, __ATOMIC_RELAXED, __HIP_MEMORY_SCOPE_AGENT); }
__device__ __forceinline__ unsigned xb_add(unsigned* p, unsigned v) { return __hip_atomic_fetch_add(p, v, __ATOMIC_RELAXED, __HIP_MEMORY_SCOPE_AGENT); }
__device__ __forceinline__ unsigned xb_xcc_id() { return (unsigned)__builtin_amdgcn_s_getreg((3 << 11) | 20) & 0xFu; }
#define XB_SPIN(cond, bar) do { unsigned _sp = 0; while (cond) { __builtin_amdgcn_s_sleep(1); \
    if ((++_sp & 255u) == 0u) { if (xb_ld(&(bar)[XB_TMO])) break; if (_sp > XB_SPIN_CAP) { atomicAdd(&(bar)[XB_TMO], 1u); break; } } } } while (0)
struct XcdBarrier { unsigned* bar; unsigned x; volatile LAS unsigned* st; };
__device__ __forceinline__ XcdBarrier xcd_barrier_post(unsigned* bar, volatile LAS unsigned* st) {
    XcdBarrier b; b.bar = bar; b.x = xb_xcc_id(); b.st = st;
    if (threadIdx.x == 0) (void)xb_add(&bar[XB_XCNT(b.x)], 1u);
    return b;
}
__device__ __forceinline__ void xcd_barrier_complete(unsigned* bar, unsigned x, unsigned& nloc, unsigned& nx) {
    const unsigned G = gridDim.x * gridDim.y * gridDim.z;
    unsigned sum, cnt, mine, sp = 0u;
    for (;;) {
        sum = 0u; cnt = 0u; mine = 0u;
#pragma unroll
        for (unsigned j = 0; j < 16; ++j) { const unsigned c = xb_ld(&bar[XB_XCNT(j)]); sum += c; cnt += (c > 0u) ? 1u : 0u; mine = (j == x) ? c : mine; }
        if (sum == G) break;
        __builtin_amdgcn_s_sleep(1);
        if ((++sp & 255u) == 0u) { if (xb_ld(&bar[XB_TMO])) break; if (sp > XB_SPIN_CAP) { atomicAdd(&bar[XB_TMO], 1u); break; } }
    }
    nloc = mine > 0u ? mine : 1u; nx = cnt > 0u ? cnt : 1u;
}
__device__ __forceinline__ void xcd_barrier(const XcdBarrier& b) {
    asm volatile("s_waitcnt vmcnt(0)" ::: "memory");
    __syncthreads();
    if (threadIdx.x == 0) {
        unsigned* bar = b.bar;
        __builtin_amdgcn_s_waitcnt(0);
        unsigned nloc = b.st[0], nx = b.st[1];
        if (nloc == 0u) { xcd_barrier_complete(bar, b.x, nloc, nx); b.st[0] = nloc; b.st[1] = nx; }
        const unsigned old = xb_add(&bar[XB_XSUB(b.x)], 1u);
        const unsigned gen = old / nloc;
        if (old + 1u == (gen + 1u) * nloc) {
            __builtin_amdgcn_fence(__ATOMIC_RELEASE, "agent");
            asm volatile("s_waitcnt vmcnt(0)" ::: "memory");
            const unsigned og = xb_add(&bar[XB_TOP], 1u);
            const unsigned tg = og / nx;
            if (og + 1u == (tg + 1u) * nx) xb_add(&bar[XB_TOPGEN], 1u);
            else XB_SPIN(xb_ld(&bar[XB_TOPGEN]) == tg, bar);
            __builtin_amdgcn_fence(__ATOMIC_ACQUIRE, "agent");
            xb_add(&bar[XB_XGEN(b.x)], 1u);
            asm volatile("s_waitcnt vmcnt(0)" ::: "memory");
        } else {
            XB_SPIN(xb_ld(&bar[XB_XGEN(b.x)]) == gen, bar);
            __builtin_amdgcn_fence(__ATOMIC_ACQUIRE, "agent");
            asm volatile("s_waitcnt vmcnt(0)" ::: "memory");
        }
    }
    __syncthreads();
}

struct Frame {
    LAS unsigned char* lds;
    volatile LAS unsigned* MISC;
    unsigned* ctl;
    unsigned char* ws;
    int tid, lane, wave, G, gw, NGW;
    const float *x, *c; const int* pos;
    const float *attn_gain, *ffn_gain, *w_ada, *b_ada, *a_w_in, *a_w_out, *b_w_q, *b_w_out, *kv_gain, *w_kv_ada, *b_kv_ada, *w_kv;
    const float *pe_k, *w1_k, *w2_k, *pe_v, *w1_v, *w2_v, *ffn_wg, *ffn_wu, *ffn_wd, *w_router, *moe_wg, *moe_wu, *moe_wd, *final_gain;
    float* out;
};
#define WSP(T_, off) ((T_*)(F.ws + (off)))

__device__ __forceinline__ void tr_item(const float* W, int Nsrc, int ncol0, int K, int k0, bf16* WT, int drow0, LAS float* scr, int lane) {
    const int cc = ncol0 + (lane & 31); const bool ok = (ncol0 >= 0) && (cc < Nsrc);
#pragma unroll 8
    for (int i = 0; i < 32; ++i) { const int kk = 2 * i + (lane >> 5); scr[kk * 33 + (lane & 31)] = ok ? W[(size_t)(k0 + kk) * Nsrc + cc] : 0.f; }
    LDS_WAIT(); asm volatile("" ::: "memory");
    const int c = lane & 7;
#pragma unroll
    for (int j = 0; j < 4; ++j) { const int n = (lane >> 3) + 8 * j; const LAS float* s = scr + (8 * c) * 33 + n;
        u32x4 o; o.x = pk2(s[0 * 33], s[1 * 33]); o.y = pk2(s[2 * 33], s[3 * 33]); o.z = pk2(s[4 * 33], s[5 * 33]); o.w = pk2(s[6 * 33], s[7 * 33]);
        *(u32x4*)(WT + (size_t)(drow0 + n) * K + k0 + 8 * c) = o; }
    LDS_WAIT(); asm volatile("" ::: "memory");
}
__device__ __forceinline__ int rope_lb(int pb) { const int pn = pb >> 3, half = (pb >> 2) & 1, hl = pb & 3; return 8 * pn + 2 * hl + half; }

__device__ __forceinline__ void conv_item_a(Frame& F, int it, LAS float* scr) {
    const int lane = F.lane;
    int r = it;
    { constexpr int NBK = A_INP / 32, NI = 16 * NBK; if (r < NI) { const int kb = r / NBK, pb = r % NBK; tr_item(F.a_w_in, A_IN, 32 * rope_lb(pb), D, 64 * kb, WSP(bf16, WB_IN), 32 * pb, scr, lane); return; } r -= NI; }
    { constexpr int NBK = D / 32, NI = 16 * NBK; if (r < NI) { const int kb = r / NBK, pb = r % NBK; tr_item(F.a_w_out, D, 32 * pb, D, 64 * kb, WSP(bf16, WB_O0), 32 * pb, scr, lane); return; } r -= NI; }
    { constexpr int NBK = 2 * FF0 / 32, NI = 16 * NBK; if (r < NI) { const int kb = r / NBK, pb = r % NBK; const int pn = pb >> 3, half = (pb >> 2) & 1, q = pb & 3;
        tr_item(half ? F.ffn_wu : F.ffn_wg, FF0, 32 * (4 * pn + q), D, 64 * kb, WSP(bf16, WB_GU0), 32 * pb, scr, lane); return; } r -= NI; }
    { constexpr int NBK = D / 32, NI = (FF0 / 64) * NBK; if (r < NI) { const int kb = r / NBK, pb = r % NBK; tr_item(F.ffn_wd, D, 32 * pb, FF0, 64 * kb, WSP(bf16, WB_D0), 32 * pb, scr, lane); return; } r -= NI; }
    { constexpr int NBK = KVW / 32, NI = 16 * NBK; if (r < NI) { const int kb = r / NBK, pb = r % NBK; tr_item(F.w_kv, KVW, 32 * rope_lb(pb), D, 64 * kb, WSP(bf16, WB_KVQ), 32 * pb, scr, lane); return; } r -= NI; }
    { constexpr int NBK = BQP / 32, NI = 16 * NBK; if (r < NI) { const int kb = r / NBK, pb = r % NBK; tr_item(F.b_w_q, BQ, 32 * rope_lb(pb), D, 64 * kb, WSP(bf16, WB_KVQ) + (size_t)KVW * D, 32 * pb, scr, lane); return; } r -= NI; }
    { constexpr int NBK = D / 32, NI = 16 * NBK; if (r < NI) { const int kb = r / NBK, pb = r % NBK; tr_item(F.b_w_out, D, 32 * pb, D, 64 * kb, WSP(bf16, WB_O1), 32 * pb, scr, lane); return; } r -= NI; }
    { constexpr int NBK = 8, NI = 32 * NBK; if (r < NI) { const int kb = r / NBK, pb = r % NBK; tr_item(F.w1_k, 256, 32 * pb, 2048, 64 * kb, WSP(bf16, WB_C1), 32 * pb, scr, lane); return; } r -= NI;
                                       if (r < NI) { const int kb = r / NBK, pb = r % NBK; tr_item(F.w1_v, 256, 32 * pb, 2048, 64 * kb, WSP(bf16, WB_C1), 256 + 32 * pb, scr, lane); return; } r -= NI; }
    { constexpr int NBK = 2, NI = 4 * NBK; if (r < NI) { const int kb = r / NBK, pb = r % NBK; tr_item(F.w2_k, 64, 32 * pb, 256, 64 * kb, WSP(bf16, WB_C2), 32 * pb, scr, lane); return; } r -= NI;
                                       if (r < NI) { const int kb = r / NBK, pb = r % NBK; tr_item(F.w2_v, 64, 32 * pb, 256, 64 * kb, WSP(bf16, WB_C2), 64 + 32 * pb, scr, lane); return; } r -= NI; }
}
constexpr int NCONV_A = 16 * (A_INP / 32) + 16 * 32 + 16 * (2 * FF0 / 32) + (FF0 / 64) * 32 + 16 * (KVW / 32) + 16 * (BQP / 32) + 16 * 32 + 2 * 32 * 8 + 2 * 4 * 2;
__device__ __forceinline__ void conv_item_b(Frame& F, int it, LAS float* scr) {
    const int lane = F.lane;
    constexpr int NBK1 = 2 * FFE / 32, NI1 = 16 * NBK1;
    constexpr int NBK2 = D / 32, NI2 = (FFE / 64) * NBK2;
    int r = it;
    if (r < NE * NI1) { const int e = r / NI1; r -= e * NI1; const int kb = r / NBK1, pb = r % NBK1; const int pn = pb >> 3, half = (pb >> 2) & 1, q = pb & 3;
        tr_item((half ? F.moe_wu : F.moe_wg) + (size_t)e * D * FFE, FFE, 32 * (4 * pn + q), D, 64 * kb, WSP(bf16, WS_WGU1) + (size_t)e * 2 * FFE * D, 32 * pb, scr, lane); return; }
    r -= NE * NI1;
    { const int e = r / NI2; r -= e * NI2; const int kb = r / NBK2, pb = r % NBK2;
        tr_item(F.moe_wd + (size_t)e * FFE * D, D, 32 * pb, FFE, 64 * kb, WSP(bf16, WS_WD1) + (size_t)e * D * FFE, 32 * pb, scr, lane); }
}
constexpr int NCONV_B = NE * (16 * (2 * FFE / 32) + (FFE / 64) * 32);

template <int NBAT>
__device__ __forceinline__ void gemv_item(Frame& F, const LAS float* act, const float* W, int K, int N, int n0, const float* bias, float* out, int ldo, LAS float* red) {
    const int kper = K / 8, k0 = F.wave * kper;
    float a[NBAT];
#pragma unroll
    for (int b = 0; b < NBAT; ++b) a[b] = 0.f;
    const float* wp = W + (size_t)k0 * N + n0 + F.lane;
#pragma unroll 8
    for (int k = 0; k < kper; ++k) { const float w = wp[(size_t)k * N];
#pragma unroll
        for (int b = 0; b < NBAT; ++b) a[b] += act[b * K + k0 + k] * w; }
#pragma unroll
    for (int b = 0; b < NBAT; ++b) red[(F.wave * 4 + b) * 64 + F.lane] = a[b];
    __syncthreads();
    if (F.tid < 64 * NBAT) { const int b = F.tid >> 6, l = F.tid & 63; float s = 0.f;
#pragma unroll
        for (int w = 0; w < 8; ++w) s += red[(w * 4 + b) * 64 + l];
        out[(size_t)b * ldo + n0 + l] = s + (bias ? bias[n0 + l] : 0.f); }
    __syncthreads();
}

__device__ __forceinline__ void p0_prologue(Frame& F) {
    {
        LAS float* act = (LAS float*)(F.lds);
        LAS float* red = (LAS float*)(F.lds + 16384);
        constexpr int NI_MOD = 6144 / 64, NI_KV = 2048 / 64, NITEMS = 2 * NI_MOD + NI_KV + 8;
        for (int it = blockIdx.x; it < NITEMS; it += F.G) {
            if (it < 2 * NI_MOD + NI_KV) {
                for (int i = F.tid; i < 4096; i += 512) { const float v = F.c[i]; act[i] = v / (1.f + __expf(-v)); }
                __syncthreads();
                if (it < NI_MOD) gemv_item<4>(F, act, F.w_ada, D, 6144, 64 * it, F.b_ada, WSP(float, SM_MOD0), 6144, red);
                else if (it < 2 * NI_MOD) gemv_item<4>(F, act, F.w_ada + (size_t)D * 6144, D, 6144, 64 * (it - NI_MOD), F.b_ada + 6144, WSP(float, SM_MOD1), 6144, red);
                else gemv_item<4>(F, act, F.w_kv_ada, D, 2048, 64 * (it - 2 * NI_MOD), F.b_kv_ada, WSP(float, SM_KVMOD), 2048, red);
            } else {
                const int j = it - (2 * NI_MOD + NI_KV), kv = j >> 2;
                const float* pe = kv ? F.pe_v : F.pe_k;
                for (int i = F.tid; i < 2048; i += 512) act[i] = pe[i];
                __syncthreads();
                gemv_item<1>(F, act, kv ? F.w1_v : F.w1_k, 2048, 256, 64 * (j & 3), nullptr, WSP(float, SM_CBIAS) + 256 * kv, 256, red);
            }
        }
        __syncthreads();
    }
    {
        LAS float* scr = (LAS float*)(F.lds + F.wave * 16384);
        for (int it = F.gw; it < NCONV_A; it += F.NGW) conv_item_a(F, it, scr);
    }
    {
        float* cs = WSP(float, SM_COS); float* sn = WSP(float, SM_SIN);
        for (int i = F.gw * 64 + F.lane; i < T * 32; i += F.NGW * 64) {
            const int m = i >> 5, d = i & 31;
            const float inv = 1.0f / powf(10000.0f, (float)d * (1.0f / 32.0f));
            const float ang = (float)F.pos[m] * inv;
            cs[i] = cosf(ang); sn[i] = sinf(ang);
        }
    }
}

__device__ __forceinline__ void load_row(const float* row, int lane, f32x4 (&v)[4]) {
#pragma unroll
    for (int j = 0; j < 4; ++j) v[j] = ((const f32x4*)row)[lane + 64 * j];
}
__device__ __forceinline__ float row_rs(const f32x4 (&v)[4]) {
    float s = 0.f;
#pragma unroll
    for (int j = 0; j < 4; ++j) s += (v[j].x * v[j].x + v[j].y * v[j].y) + (v[j].z * v[j].z + v[j].w * v[j].w);
    return 1.0f / sqrtf(wave_sum(s) * (1.f / D) + RMS_EPS);
}
__device__ __forceinline__ void modulate_row(const f32x4 (&v)[4], float r, const float* gain, const float* shift, const float* scale, int lane, f32x4 (&u)[4]) {
#pragma unroll
    for (int j = 0; j < 4; ++j) { const f32x4 g = ((const f32x4*)gain)[lane + 64 * j], sh = ((const f32x4*)shift)[lane + 64 * j], sc = ((const f32x4*)scale)[lane + 64 * j];
        u[j] = v[j] * r * g * (sc + 1.0f) + sh; }
}
__device__ __forceinline__ void store_row_bf16(bf16* orow, int lane, const f32x4 (&u)[4]) {
#pragma unroll
    for (int j = 0; j < 4; ++j) { u32x2 o; o.x = pk2(u[j].x, u[j].y); o.y = pk2(u[j].z, u[j].w); ((u32x2*)orow)[lane + 64 * j] = o; }
}
__device__ __forceinline__ void norm_phase(Frame& F, const float* src, const float* gain, const float* mod  , int ldm, int shift_off, int scale_off, bf16* dst) {
    for (int m = F.gw; m < T; m += F.NGW) {
        f32x4 v[4], u[4]; load_row(src + (size_t)m * D, F.lane, v);
        const float r = row_rs(v); const int b = m >> 12;
        modulate_row(v, r, gain, mod + (size_t)b * ldm + shift_off, mod + (size_t)b * ldm + scale_off, F.lane, u);
        store_row_bf16(dst + (size_t)m * D, F.lane, u);
    }
}

__device__ __forceinline__ void store8(bf16* p, const float (&y)[8]) { u32x4 w; w.x = pk2(y[0], y[1]); w.y = pk2(y[2], y[3]); w.z = pk2(y[4], y[5]); w.w = pk2(y[6], y[7]); *(u32x4*)p = w; }
__device__ __forceinline__ void get8(const f32x4 (&a)[2], float (&x)[8]) { x[0] = a[0].x; x[1] = a[0].y; x[2] = a[0].z; x[3] = a[0].w; x[4] = a[1].x; x[5] = a[1].y; x[6] = a[1].z; x[7] = a[1].w; }
__device__ __forceinline__ void rope8(const float* cs, const float* sn, int row, int fq, const float (&x1)[8], const float (&x2)[8], float sc, float (&y1)[8], float (&y2)[8]) {
    const f32x4 c0 = *(const f32x4*)(cs + (size_t)row * 32 + 8 * fq), c1 = *(const f32x4*)(cs + (size_t)row * 32 + 8 * fq + 4);
    const f32x4 s0 = *(const f32x4*)(sn + (size_t)row * 32 + 8 * fq), s1 = *(const f32x4*)(sn + (size_t)row * 32 + 8 * fq + 4);
    const float c[8] = {c0.x, c0.y, c0.z, c0.w, c1.x, c1.y, c1.z, c1.w}, s[8] = {s0.x, s0.y, s0.z, s0.w, s1.x, s1.y, s1.z, s1.w};
#pragma unroll
    for (int j = 0; j < 8; ++j) { y1[j] = (x1[j] * c[j] - x2[j] * s[j]) * sc; y2[j] = (x2[j] * c[j] + x1[j] * s[j]) * sc; }
}
struct EpiIn {
    bf16 *Q, *K, *V, *IQ, *IK; float* IW; const float *cs, *sn;
    __device__ __forceinline__ void operator()(const f32x4 (&acc)[2][2][4][2], const pg8::Unit& u, int wr, int wc, int fr, int fq) const {
        const int pn = u.pn;
        if (pn == 8 && wc >= 2) return;
#pragma unroll
        for (int ai = 0; ai < 2; ++ai)
#pragma unroll
            for (int m = 0; m < 4; ++m) {
                const int row = u.pm * 256 + ai * 128 + wr * 64 + m * 16 + fr;
                float x1[8], x2[8]; get8(acc[ai][0][m], x1); get8(acc[ai][1][m], x2);
                if (pn == 5) { bf16* d = V + (size_t)row * 256 + wc * 64 + 8 * fq; store8(d, x1); store8(d + 32, x2); }
                else if (pn == 8 && wc == 1) { if (fq == 0) { f32x4 a = {x1[0] * IWS, x1[1] * IWS, x1[2] * IWS, x1[3] * IWS}, b = {x1[4] * IWS, x1[5] * IWS, x1[6] * IWS, x1[7] * IWS};
                        *(f32x4*)(IW + (size_t)row * 8) = a; *(f32x4*)(IW + (size_t)row * 8 + 4) = b; } }
                else {
                    float y1[8], y2[8]; rope8(cs, sn, row, fq, x1, x2, pn < 4 ? C2 : 1.0f, y1, y2);
                    bf16* d;
                    if (pn < 4) d = Q + (size_t)row * 1024 + (4 * pn + wc) * 64;
                    else if (pn == 4) d = K + (size_t)row * 256 + wc * 64;
                    else if (pn < 8) d = IQ + (size_t)row * 512 + (4 * (pn - 6) + wc) * 64;
                    else d = IK + (size_t)row * 64;
                    store8(d + 8 * fq, y1); store8(d + 32 + 8 * fq, y2);
                }
            }
    }
};
struct EpiRes {
    const float* base; float* out; const float* gate; int ldg;
    __device__ __forceinline__ void operator()(const f32x4 (&acc)[2][2][4][2], const pg8::Unit& u, int wr, int wc, int fr, int fq) const {
        const float* gv = gate + (size_t)((u.pm * 256) >> 12) * ldg;
#pragma unroll
        for (int bj = 0; bj < 2; ++bj) {
            const int col = u.pn * 256 + bj * 128 + wc * 32 + 8 * fq;
            const f32x4 g0 = *(const f32x4*)(gv + col), g1 = *(const f32x4*)(gv + col + 4);
#pragma unroll
            for (int ai = 0; ai < 2; ++ai)
#pragma unroll
                for (int m = 0; m < 4; ++m) {
                    const size_t o = (size_t)(u.pm * 256 + ai * 128 + wr * 64 + m * 16 + fr) * D + col;
                    const f32x4 b0 = *(const f32x4*)(base + o), b1 = *(const f32x4*)(base + o + 4);
                    *(f32x4*)(out + o) = b0 + g0 * acc[ai][bj][m][0]; *(f32x4*)(out + o + 4) = b1 + g1 * acc[ai][bj][m][1];
                }
        }
    }
};
__device__ __forceinline__ float silu_f(float g) { return g * __builtin_amdgcn_rcpf(1.0f + __builtin_amdgcn_exp2f(-1.4426950408889634f * g)); }
struct EpiSwiglu {
    bf16* H; int ldh, npn;
    __device__ __forceinline__ void operator()(const f32x4 (&acc)[2][2][4][2], const pg8::Unit& u, int wr, int wc, int fr, int fq) const {
        const int col = (u.pn % npn) * 128 + wc * 32 + 8 * fq;
#pragma unroll
        for (int ai = 0; ai < 2; ++ai)
#pragma unroll
            for (int m = 0; m < 4; ++m) {
                const int row = u.pm * 256 + ai * 128 + wr * 64 + m * 16 + fr;
                float g[8], up[8], h[8]; get8(acc[ai][0][m], g); get8(acc[ai][1][m], up);
#pragma unroll
                for (int j = 0; j < 8; ++j) h[j] = silu_f(g[j]) * up[j];
                store8(H + (size_t)row * ldh + col, h);
            }
    }
};
struct EpiKVQ {
    bf16 *KCMP, *VCMP, *KSLC, *VSLC, *KWIN, *VWIN, *Q; float* GATES; const float *cs, *sn;
    __device__ __forceinline__ void operator()(const f32x4 (&acc)[2][2][4][2], const pg8::Unit& u, int wr, int wc, int fr, int fq) const {
        const int pn = u.pn;
        if (pn == 10 && wc >= 1) return;
#pragma unroll
        for (int ai = 0; ai < 2; ++ai)
#pragma unroll
            for (int m = 0; m < 4; ++m) {
                const int row = (u.pm & 63) * 256 + ai * 128 + wr * 64 + m * 16 + fr;
                float x1[8], x2[8]; get8(acc[ai][0][m], x1); get8(acc[ai][1][m], x2);
                if (pn < 6) {
                    if ((pn & 1) == 0) { float y1[8], y2[8]; rope8(cs, sn, row, fq, x1, x2, 1.0f, y1, y2);
#pragma unroll
                        for (int j = 0; j < 8; ++j) { x1[j] = y1[j]; x2[j] = y2[j]; } }
                    bf16* d;
                    if (pn < 2) d = (pn == 0 ? KCMP : VCMP) + ((size_t)((row >> 12) * 4 + wc) * SEQ + (row & 4095)) * 64;
                    else d = (pn == 2 ? KSLC : pn == 3 ? VSLC : pn == 4 ? KWIN : VWIN) + (size_t)row * 256 + wc * 64;
                    store8(d + 8 * fq, x1); store8(d + 32 + 8 * fq, x2);
                } else if (pn < 10) {
                    float y1[8], y2[8]; rope8(cs, sn, row, fq, x1, x2, C2, y1, y2);
                    bf16* d = Q + (size_t)row * 1024 + (4 * (pn - 6) + wc) * 64;
                    store8(d + 8 * fq, y1); store8(d + 32 + 8 * fq, y2);
                } else {
                    float* gp = GATES + (size_t)row * 48;
#pragma unroll
                    for (int j = 0; j < 8; ++j) gp[8 * fq + j] = 1.0f / (1.0f + __expf(-x1[j]));
                    if (fq < 2) {
#pragma unroll
                        for (int j = 0; j < 8; ++j) gp[32 + 8 * fq + j] = 1.0f / (1.0f + __expf(-x2[j])); }
                }
            }
    }
};
struct EpiY {
    bf16* Y;
    __device__ __forceinline__ void operator()(const f32x4 (&acc)[2][2][4][2], const pg8::Unit& u, int wr, int wc, int fr, int fq) const {
#pragma unroll
        for (int ai = 0; ai < 2; ++ai)
#pragma unroll
            for (int m = 0; m < 4; ++m) {
                const int row = u.pm * 256 + ai * 128 + wr * 64 + m * 16 + fr;
#pragma unroll
                for (int bj = 0; bj < 2; ++bj) { float x[8]; get8(acc[ai][bj][m], x); store8(Y + (size_t)row * D + (u.pn & 3) * 256 + bj * 128 + wc * 32 + 8 * fq, x); }
            }
    }
};
struct KvqOrder {
    pg8::StaticOrder S;
    __device__ bool next(int i, pg8::Unit& u) const { if (!S.next(i, u)) return false; if (u.pn >= 6) u.pm += 64; return true; }
};
struct MoeOrder {
    int tend[NE]; int ntiles, npn, G, c;
    __device__ void init(const unsigned* cnt, int npn_, int G_, int c_) { int acc = 0; for (int e = 0; e < NE; ++e) { acc += (int)((ld_u32(cnt + e) + 255u) >> 8); tend[e] = acc; } ntiles = acc; npn = npn_; G = G_; c = c_; }
    __device__ bool next(int i, pg8::Unit& u) const {
        const long L = (long)i * G + c; if (L >= (long)ntiles * npn) return false;
        const int mt = (int)(L / npn), pn = (int)(L % npn); int e = 0;
#pragma unroll
        for (int k = 0; k < NE - 1; ++k) e += (mt >= tend[k]) ? 1 : 0;
        u.pm = mt; u.pn = e * npn + pn; return true;
    }
};

__device__ __forceinline__ f32x16 sgemm_tile(const bf16* A, int lda, const bf16* Bt, int ldb, int K, int row0, int col0, int lane) {
    f32x16 acc = {};
    const bf16* ap = A + (size_t)(row0 + (lane & 31)) * lda + 8 * (lane >> 5);
    const bf16* bp = Bt + (size_t)(col0 + (lane & 31)) * ldb + 8 * (lane >> 5);
#pragma unroll 4
    for (int k = 0; k < K; k += 16) { const bf16x8 a = *(const bf16x8*)(ap + k), b = *(const bf16x8*)(bp + k); acc = __builtin_amdgcn_mfma_f32_32x32x16_bf16(a, b, acc, 0, 0, 0); }
    return acc;
}
__device__ __forceinline__ float gelu_tanh(float x) { const float t = tanhf(0.7978845608028654f * (x + 0.044715f * x * x * x)); return 0.5f * x * (1.0f + t); }

__device__ __forceinline__ unsigned okey(float f) { const unsigned u = __builtin_bit_cast(unsigned, f); return (u & 0x80000000u) ? ~u : (u | 0x80000000u); }
__device__ __forceinline__ void dsa_naive_item(Frame& F, int m) {
    const int tid = F.tid, lane = F.lane, wave = F.wave;
    const int b = m >> 12, t = m & 4095, n = t + 1;
    LAS unsigned* KEY = (LAS unsigned*)(F.lds);
    LAS u32x4* IQL = (LAS u32x4*)(F.lds + 16384);
    LAS float* IWL = (LAS float*)(F.lds + 16384 + 1024);
    LAS int* LIST = (LAS int*)(F.lds + 20480);
    LAS int* CNT = (LAS int*)(F.lds + 20480 + 1024);
    LAS float* PL = (LAS float*)(F.lds + 24576);
    const bf16* IQ = WSP(bf16, WS_IQ); const bf16* IK = WSP(bf16, WS_IK); const float* IW = WSP(float, SM_IW);
    if (tid < 64) IQL[tid] = ((const u32x4*)(IQ + (size_t)m * 512))[tid];
    if (tid < 8) IWL[tid] = IW[(size_t)m * 8 + tid];
    __syncthreads();
    for (int s = tid; s < n; s += 512) {
        const u32x4* kp = (const u32x4*)(IK + (size_t)(b * SEQ + s) * 64);
        u32x4 kv[8];
#pragma unroll
        for (int c = 0; c < 8; ++c) kv[c] = kp[c];
        float sc = 0.f;
#pragma unroll
        for (int h = 0; h < 8; ++h) { float d = 0.f;
#pragma unroll
            for (int c = 0; c < 8; ++c) d = dot8(kv[c], IQL[h * 8 + c], d);
            sc += IWL[h] * fmaxf(d, 0.f); }
        KEY[s] = okey(sc);
    }
    __syncthreads();
    const bool all = (n <= 256);
    unsigned thr = 0u; int need_ties = 0;
    if (!all) {
        unsigned myk[8];
#pragma unroll
        for (int i = 0; i < 8; ++i) { const int s = tid + 512 * i; myk[i] = s < n ? KEY[s] : 0u; }
        unsigned prefix = 0u;
        for (int bit = 31; bit >= 0; --bit) {
            const unsigned cand = prefix | (1u << bit);
            int c = 0;
#pragma unroll
            for (int i = 0; i < 8; ++i) c += (myk[i] >= cand) ? 1 : 0;
            c = wave_sum_i(c);
            if (lane == 0) CNT[(bit & 1) * 8 + wave] = c;
            __syncthreads();
            int tot = 0;
#pragma unroll
            for (int w = 0; w < 8; ++w) tot += CNT[(bit & 1) * 8 + w];
            if (tot >= 256) prefix = cand;
        }
        thr = prefix;
        int c = 0;
#pragma unroll
        for (int i = 0; i < 8; ++i) c += (myk[i] > thr) ? 1 : 0;
        c = wave_sum_i(c);
        if (lane == 0) CNT[16 + wave] = c;
        __syncthreads();
        int tot = 0;
#pragma unroll
        for (int w = 0; w < 8; ++w) tot += CNT[16 + w];
        need_ties = 256 - tot;
    }
    if (wave == 0) {
        int pos = 0, ties = 0;
        const unsigned long long lt = (1ull << lane) - 1ull;
        for (int c0 = 0; c0 < n; c0 += 64) {
            const int s = c0 + lane; const bool valid = s < n; const unsigned k = valid ? KEY[s] : 0u;
            const bool gt = valid && (all || k > thr), eq = valid && !all && (k == thr);
            const unsigned long long beq = __ballot(eq); const int tr = ties + __popcll(beq & lt);
            const bool sel = gt || (eq && tr < need_ties);
            const unsigned long long bs = __ballot(sel); const int p = pos + __popcll(bs & lt);
            if (sel) LIST[p] = s;
            pos += __popcll(bs); ties += __popcll(beq);
        }
        if (lane == 0) CNT[32] = pos;
    }
    __syncthreads();
    const int nsel = CNT[32];
    const int g = wave >> 1, h0 = 4 * g + 2 * (wave & 1);
    const bf16* Q = WSP(bf16, WS_Q0); const bf16* Kp = WSP(bf16, WS_K0); const bf16* Vp = WSP(bf16, WS_V0);
    u32x4 q0[8], q1[8];
#pragma unroll
    for (int c = 0; c < 8; ++c) { q0[c] = ((const u32x4*)(Q + (size_t)m * 1024 + h0 * 64))[c]; q1[c] = ((const u32x4*)(Q + (size_t)m * 1024 + (h0 + 1) * 64))[c]; }
    float s0[4], s1[4]; float mx0 = -INFINITY, mx1 = -INFINITY;
#pragma unroll
    for (int i = 0; i < 4; ++i) { const int j = lane + 64 * i; s0[i] = -INFINITY; s1[i] = -INFINITY;
        if (j < nsel) { const int s = LIST[j]; const u32x4* kp = (const u32x4*)(Kp + (size_t)(b * SEQ + s) * 256 + g * 64); float d0 = 0.f, d1 = 0.f;
#pragma unroll
            for (int c = 0; c < 8; ++c) { const u32x4 kk = kp[c]; d0 = dot8(kk, q0[c], d0); d1 = dot8(kk, q1[c], d1); }
            s0[i] = d0; s1[i] = d1; }
        mx0 = fmaxf(mx0, s0[i]); mx1 = fmaxf(mx1, s1[i]); }
    mx0 = wave_max(mx0); mx1 = wave_max(mx1);
    float l0 = 0.f, l1 = 0.f;
    LAS float* P0 = PL + (wave * 2 + 0) * 256; LAS float* P1 = PL + (wave * 2 + 1) * 256;
#pragma unroll
    for (int i = 0; i < 4; ++i) { const int j = lane + 64 * i; const float p0 = (j < nsel) ? __builtin_amdgcn_exp2f(s0[i] - mx0) : 0.f, p1 = (j < nsel) ? __builtin_amdgcn_exp2f(s1[i] - mx1) : 0.f;
        l0 += p0; l1 += p1; P0[j] = bfround(p0); P1[j] = bfround(p1); }
    l0 = wave_sum(l0); l1 = wave_sum(l1);
    float a0 = 0.f, a1 = 0.f;
    for (int j = 0; j < nsel; ++j) { const int s = LIST[j]; const float v = bf2f(Vp[(size_t)(b * SEQ + s) * 256 + g * 64 + lane]); a0 += P0[j] * v; a1 += P1[j] * v; }
    bf16* O = WSP(bf16, WS_O0);
    O[(size_t)m * 1024 + h0 * 64 + lane] = (bf16)f2bf(a0 / l0); O[(size_t)m * 1024 + (h0 + 1) * 64 + lane] = (bf16)f2bf(a1 / l1);
    __syncthreads();
}

__device__ __forceinline__ void nsa_naive_item(Frame& F, int m) {
    const int lane = F.lane, wave = F.wave;
    const int b = m >> 12, t = m & 4095, jt = t >> 6;
    const int g = wave >> 1, h0 = 4 * g + 2 * (wave & 1);
    LAS float* PC = (LAS float*)(F.lds);
    LAS float* SC0 = (LAS float*)(F.lds + 16384) + (wave * 2 + 0) * 1024;
    LAS float* SC1 = SC0 + 1024;
    LAS unsigned long long* SEL = (LAS unsigned long long*)(F.lds + 16384 + 65536);
    const bf16* Q = WSP(bf16, WS_Q1);
    u32x4 q0[8], q1[8];
#pragma unroll
    for (int c = 0; c < 8; ++c) { q0[c] = ((const u32x4*)(Q + (size_t)m * 1024 + h0 * 64))[c]; q1[c] = ((const u32x4*)(Q + (size_t)m * 1024 + (h0 + 1) * 64))[c]; }
    const int nv = t >= 31 ? min(255, (t - 31) / 16 + 1) : 0;
    const bf16* KC = WSP(bf16, SM_KC) + (size_t)(b * 4 + g) * 256 * 64; const bf16* VC = WSP(bf16, SM_VC) + (size_t)(b * 4 + g) * 256 * 64;
    float oc0 = 0.f, oc1 = 0.f;
    {
        float s0[4], s1[4]; float mx0 = -INFINITY, mx1 = -INFINITY;
#pragma unroll
        for (int i = 0; i < 4; ++i) { const int n = lane + 64 * i; s0[i] = -INFINITY; s1[i] = -INFINITY;
            if (n < nv) { const u32x4* kp = (const u32x4*)(KC + (size_t)n * 64); float d0 = 0.f, d1 = 0.f;
#pragma unroll
                for (int c = 0; c < 8; ++c) { const u32x4 kk = kp[c]; d0 = dot8(kk, q0[c], d0); d1 = dot8(kk, q1[c], d1); }
                s0[i] = d0; s1[i] = d1; }
            mx0 = fmaxf(mx0, s0[i]); mx1 = fmaxf(mx1, s1[i]); }
        mx0 = wave_max(mx0); mx1 = wave_max(mx1);
        float p0[4], p1[4], l0 = 0.f, l1 = 0.f;
#pragma unroll
        for (int i = 0; i < 4; ++i) { const int n = lane + 64 * i; p0[i] = (n < nv) ? __builtin_amdgcn_exp2f(s0[i] - mx0) : 0.f; p1[i] = (n < nv) ? __builtin_amdgcn_exp2f(s1[i] - mx1) : 0.f; l0 += p0[i]; l1 += p1[i]; }
        l0 = wave_sum(l0); l1 = wave_sum(l1);
        const float r0 = nv > 0 ? 1.0f / l0 : 0.f, r1 = nv > 0 ? 1.0f / l1 : 0.f;
#pragma unroll
        for (int i = 0; i < 4; ++i) { const int n = lane + 64 * i; PC[h0 * 256 + n] = p0[i] * r0; PC[(h0 + 1) * 256 + n] = p1[i] * r1; SC0[n] = bfround(p0[i]); SC1[n] = bfround(p1[i]); }
        for (int n = 0; n < nv; ++n) { const float v = bf2f(VC[(size_t)n * 64 + lane]); oc0 += SC0[n] * v; oc1 += SC1[n] * v; }
        oc0 *= r0; oc1 *= r1;
    }
    __syncthreads();
    if ((wave & 1) == 0) {
        const int j = lane;
        auto P4 = [&](int n) -> float { return (PC[(4 * g) * 256 + n] + PC[(4 * g + 1) * 256 + n]) + (PC[(4 * g + 2) * 256 + n] + PC[(4 * g + 3) * 256 + n]); };
        float imp = P4(4 * j) + P4(4 * j + 1) + P4(4 * j + 2) + 0.5f * P4(4 * j + 3);
        if (j > 0) imp += 0.5f * P4(4 * j - 1);
        const bool valid = j <= jt, forced = (j == 0) || (j == jt) || (j + 1 == jt);
        const float val = valid ? (forced ? 1e30f : imp) : -1e30f;
        int rank = 0;
        for (int jj = 0; jj < 64; ++jj) { const float vj = __shfl(val, jj); rank += ((vj > val) || (vj == val && jj < j)) ? 1 : 0; }
        const unsigned long long mk = __ballot(rank < 16);
        if (lane == 0) SEL[g] = mk;
    }
    __syncthreads();
    float os0 = 0.f, os1 = 0.f;
    {
        unsigned long long mk = SEL[g]; if (jt < 63) mk &= ((1ull << (jt + 1)) - 1ull);
        const bf16* Ks = WSP(bf16, WS_KSLC); const bf16* Vs = WSP(bf16, WS_VSLC);
        int cnt = 0; float mx0 = -INFINITY, mx1 = -INFINITY;
        for (unsigned long long r = mk; r; r &= r - 1ull) { const int j = __builtin_ctzll(r); const int tok = 64 * j + lane;
            float d0 = -INFINITY, d1 = -INFINITY;
            if (tok <= t) { const u32x4* kp = (const u32x4*)(Ks + (size_t)(b * SEQ + tok) * 256 + g * 64); d0 = 0.f; d1 = 0.f;
#pragma unroll
                for (int c = 0; c < 8; ++c) { const u32x4 kk = kp[c]; d0 = dot8(kk, q0[c], d0); d1 = dot8(kk, q1[c], d1); } }
            SC0[cnt * 64 + lane] = d0; SC1[cnt * 64 + lane] = d1; mx0 = fmaxf(mx0, d0); mx1 = fmaxf(mx1, d1); ++cnt; }
        mx0 = wave_max(mx0); mx1 = wave_max(mx1);
        float l0 = 0.f, l1 = 0.f;
        for (int i = lane; i < cnt * 64; i += 64) { const float p0 = __builtin_amdgcn_exp2f(SC0[i] - mx0), p1 = __builtin_amdgcn_exp2f(SC1[i] - mx1); l0 += p0; l1 += p1; SC0[i] = bfround(p0); SC1[i] = bfround(p1); }
        l0 = wave_sum(l0); l1 = wave_sum(l1);
        cnt = 0;
        for (unsigned long long r = mk; r; r &= r - 1ull) { const int j = __builtin_ctzll(r);
            const int kmax = min(64, t - 64 * j + 1);
            for (int kk = 0; kk < kmax; ++kk) { const float v = bf2f(Vs[(size_t)(b * SEQ + 64 * j + kk) * 256 + g * 64 + lane]); os0 += SC0[cnt * 64 + kk] * v; os1 += SC1[cnt * 64 + kk] * v; }
            ++cnt; }
        os0 /= l0; os1 /= l1;
    }
    float ow0 = 0.f, ow1 = 0.f;
    {
        const bf16* Kw = WSP(bf16, WS_KWIN); const bf16* Vw = WSP(bf16, WS_VWIN);
        const int slo = max(0, t - 511), nw = t - slo + 1;
        float mx0 = -INFINITY, mx1 = -INFINITY;
        for (int i = lane; i < nw; i += 64) { const u32x4* kp = (const u32x4*)(Kw + (size_t)(b * SEQ + slo + i) * 256 + g * 64); float d0 = 0.f, d1 = 0.f;
#pragma unroll
            for (int c = 0; c < 8; ++c) { const u32x4 kk = kp[c]; d0 = dot8(kk, q0[c], d0); d1 = dot8(kk, q1[c], d1); }
            SC0[i] = d0; SC1[i] = d1; mx0 = fmaxf(mx0, d0); mx1 = fmaxf(mx1, d1); }
        mx0 = wave_max(mx0); mx1 = wave_max(mx1);
        float l0 = 0.f, l1 = 0.f;
        for (int i = lane; i < nw; i += 64) { const float p0 = __builtin_amdgcn_exp2f(SC0[i] - mx0), p1 = __builtin_amdgcn_exp2f(SC1[i] - mx1); l0 += p0; l1 += p1; SC0[i] = bfround(p0); SC1[i] = bfround(p1); }
        l0 = wave_sum(l0); l1 = wave_sum(l1);
        for (int i = 0; i < nw; ++i) { const float v = bf2f(Vw[(size_t)(b * SEQ + slo + i) * 256 + g * 64 + lane]); ow0 += SC0[i] * v; ow1 += SC1[i] * v; }
        ow0 /= l0; ow1 /= l1;
    }
    const float* gt = WSP(float, SM_GATES) + (size_t)m * 48;
    bf16* O = WSP(bf16, WS_O1);
    O[(size_t)m * 1024 + h0 * 64 + lane] = (bf16)f2bf(gt[h0 * 3] * oc0 + gt[h0 * 3 + 1] * os0 + gt[h0 * 3 + 2] * ow0);
    O[(size_t)m * 1024 + (h0 + 1) * 64 + lane] = (bf16)f2bf(gt[h0 * 3 + 3] * oc1 + gt[h0 * 3 + 4] * os1 + gt[h0 * 3 + 5] * ow1);
    __syncthreads();
}

constexpr int NPHASE = 19;
struct Args { const void* in[29]; float* out; unsigned char* ws; int ph_lo, ph_hi, li, pad; };
__global__ void __launch_bounds__(NWAVES * 64, 2) trunk_fwd(Args args) {
    extern __shared__ __attribute__((aligned(16))) unsigned char lds[];
    Frame F;
    F.lds = (LAS unsigned char*)lds;
    F.MISC = (volatile LAS unsigned*)(F.lds + MISC_OFF);
    F.tid = threadIdx.x; F.lane = F.tid & 63; F.wave = __builtin_amdgcn_readfirstlane(F.tid >> 6);
    F.G = gridDim.x; F.gw = blockIdx.x * NWAVES + F.wave; F.NGW = F.G * NWAVES;
    F.ws = args.ws; F.ctl = (unsigned*)(args.ws + WS_CTL);
    F.x = (const float*)args.in[0]; F.c = (const float*)args.in[1]; F.pos = (const int*)args.in[2];
    F.attn_gain = (const float*)args.in[3]; F.ffn_gain = (const float*)args.in[4]; F.w_ada = (const float*)args.in[5]; F.b_ada = (const float*)args.in[6];
    F.a_w_in = (const float*)args.in[7]; F.a_w_out = (const float*)args.in[8]; F.b_w_q = (const float*)args.in[9]; F.b_w_out = (const float*)args.in[10];
    F.kv_gain = (const float*)args.in[11]; F.w_kv_ada = (const float*)args.in[12]; F.b_kv_ada = (const float*)args.in[13]; F.w_kv = (const float*)args.in[14];
    F.pe_k = (const float*)args.in[15]; F.w1_k = (const float*)args.in[16]; F.w2_k = (const float*)args.in[17]; F.pe_v = (const float*)args.in[18]; F.w1_v = (const float*)args.in[19]; F.w2_v = (const float*)args.in[20];
    F.ffn_wg = (const float*)args.in[21]; F.ffn_wu = (const float*)args.in[22]; F.ffn_wd = (const float*)args.in[23]; F.w_router = (const float*)args.in[24];
    F.moe_wg = (const float*)args.in[25]; F.moe_wu = (const float*)args.in[26]; F.moe_wd = (const float*)args.in[27]; F.final_gain = (const float*)args.in[28];
    F.out = args.out;
    for (int u = F.tid; u < (LDS_BYTES - LDSCTL_OFF) / 4; u += NWAVES * 64) ((LAS unsigned*)(F.lds + LDSCTL_OFF))[u] = 0u;
    __syncthreads();
    XcdBarrier bar; bar.bar = F.ctl + CW_BAR; bar.x = 0; bar.st = nullptr;
    if (!MK_PER_PHASE) bar = xcd_barrier_post(F.ctl + CW_BAR, F.MISC + 8);
#define GRID_BAR() do { if (!MK_PER_PHASE) xcd_barrier(bar); } while (0)
    const int lo = args.ph_lo, hi = args.ph_hi;
#define IN(k) (lo <= (k) && (k) < hi)
#define BOTH(k) (IN(k) && IN((k) + 1))
    const float* MOD0 = WSP(float, SM_MOD0); const float* MOD1 = WSP(float, SM_MOD1); const float* KVMOD = WSP(float, SM_KVMOD);
    const float* CS = WSP(float, SM_COS); const float* SN = WSP(float, SM_SIN);

    if (IN(0)) { p0_prologue(F); if (BOTH(0)) GRID_BAR(); }
    if (IN(1)) { norm_phase(F, F.x, F.attn_gain, MOD0, 6144, 0, 1024, WSP(bf16, WS_U)); if (BOTH(1)) GRID_BAR(); }
    if (IN(2)) {
        pg8::Gemm g{WSP(bf16, WS_U), WSP(bf16, WB_IN), D, D, D}; pg8::StaticOrder S; S.init(T, A_INP, F.G, (int)blockIdx.x);
        EpiIn E{WSP(bf16, WS_Q0), WSP(bf16, WS_K0), WSP(bf16, WS_V0), WSP(bf16, WS_IQ), WSP(bf16, WS_IK), WSP(float, SM_IW), CS, SN};
        pg8::gemm_phase(F.lds, g, S, E);
        if (BOTH(2)) GRID_BAR();
    }
    if (IN(3)) { for (int m = blockIdx.x; m < T; m += F.G) dsa_naive_item(F, m); if (BOTH(3)) GRID_BAR(); }
    if (IN(4)) {
        pg8::Gemm g{WSP(bf16, WS_O0), WSP(bf16, WB_O0), D, D, D}; pg8::StaticOrder S; S.init(T, D, F.G, (int)blockIdx.x);
        EpiRes E{F.x, F.out, MOD0 + 2048, 6144};
        pg8::gemm_phase(F.lds, g, S, E);
        if (BOTH(4)) GRID_BAR();
    }
    if (IN(5)) {
        norm_phase(F, F.out, F.ffn_gain, MOD0, 6144, 3072, 4096, WSP(bf16, WS_U));
        { LAS float* scr = (LAS float*)(F.lds + F.wave * 16384); for (int it = F.gw; it < NCONV_B; it += F.NGW) conv_item_b(F, it, scr); }
        if (BOTH(5)) GRID_BAR();
    }
    if (IN(6)) {
        pg8::Gemm g{WSP(bf16, WS_U), WSP(bf16, WB_GU0), D, D, D}; pg8::StaticOrder S; S.init(T, 2 * FF0, F.G, (int)blockIdx.x);
        EpiSwiglu E{WSP(bf16, WS_HID), FF0, 2 * FF0 / 256};
        pg8::gemm_phase(F.lds, g, S, E);
        if (BOTH(6)) GRID_BAR();
    }
    if (IN(7)) {
        pg8::Gemm g{WSP(bf16, WS_HID), WSP(bf16, WB_D0), FF0, FF0, FF0}; pg8::StaticOrder S; S.init(T, D, F.G, (int)blockIdx.x);
        EpiRes E{F.out, F.out, MOD0 + 5120, 6144};
        pg8::gemm_phase(F.lds, g, S, E);
        if (BOTH(7)) GRID_BAR();
    }
    if (IN(8)) {
        for (int m = F.gw; m < T; m += F.NGW) {
            f32x4 v[4], u[4]; load_row(F.out + (size_t)m * D, F.lane, v);
            const float r = row_rs(v); const int b = m >> 12;
            modulate_row(v, r, F.kv_gain, KVMOD + (size_t)b * 2048, KVMOD + (size_t)b * 2048 + 1024, F.lane, u);
            store_row_bf16(WSP(bf16, WS_U) + (size_t)m * D, F.lane, u);
            modulate_row(v, r, F.attn_gain + D, MOD1 + (size_t)b * 6144, MOD1 + (size_t)b * 6144 + 1024, F.lane, u);
            store_row_bf16(WSP(bf16, WS_U2) + (size_t)m * D, F.lane, u);
        }
        if (BOTH(8)) GRID_BAR();
    }
    if (IN(9)) {
        pg8::Gemm g{WSP(bf16, WS_U), WSP(bf16, WB_KVQ), D, D, D}; KvqOrder S; S.S.init(T, 11 * 256, F.G, (int)blockIdx.x);
        EpiKVQ E{WSP(bf16, WS_KCMP), WSP(bf16, WS_VCMP), WSP(bf16, WS_KSLC), WSP(bf16, WS_VSLC), WSP(bf16, WS_KWIN), WSP(bf16, WS_VWIN), WSP(bf16, WS_Q1), WSP(float, SM_GATES), CS, SN};
        pg8::gemm_phase(F.lds, g, S, E);
        if (BOTH(9)) GRID_BAR();
    }
    if (IN(10)) {
        const float* cb = WSP(float, SM_CBIAS); bf16* CH = WSP(bf16, WS_CH);
        for (int it = F.gw; it < 256 * 8; it += F.NGW) {
            const int rt = it >> 3, ct = it & 7, kv = rt >> 7;
            const bf16* A = kv ? WSP(bf16, WS_VCMP) : WSP(bf16, WS_KCMP);
            const f32x16 acc = sgemm_tile(A, 1024, WSP(bf16, WB_C1) + (size_t)kv * 256 * 2048, 2048, 2048, (rt & 127) * 32, ct * 32, F.lane);
            const int col = ct * 32 + (F.lane & 31); const float bias = cb[kv * 256 + col];
#pragma unroll
            for (int r = 0; r < 16; ++r) { const int row = rt * 32 + (r & 3) + 8 * (r >> 2) + 4 * (F.lane >> 5); CH[(size_t)row * 256 + col] = (bf16)f2bf(gelu_tanh(acc[r] + bias)); }
        }
        if (BOTH(10)) GRID_BAR();
    }
    if (IN(11)) {
        const bf16* CH = WSP(bf16, WS_CH);
        for (int it = F.gw; it < 256 * 2; it += F.NGW) {
            const int rt = it >> 1, ct = it & 1, kv = rt >> 7;
            const f32x16 acc = sgemm_tile(CH, 256, WSP(bf16, WB_C2) + (size_t)kv * 64 * 256, 256, 256, rt * 32, ct * 32, F.lane);
            bf16* dst = kv ? WSP(bf16, SM_VC) : WSP(bf16, SM_KC);
            const int col = ct * 32 + (F.lane & 31);
#pragma unroll
            for (int r = 0; r < 16; ++r) { const int row = (rt & 127) * 32 + (r & 3) + 8 * (r >> 2) + 4 * (F.lane >> 5); dst[(size_t)row * 64 + col] = (bf16)f2bf(acc[r]); }
        }
        if (BOTH(11)) GRID_BAR();
    }
    if (IN(12)) { for (int m = blockIdx.x; m < T; m += F.G) nsa_naive_item(F, m); if (BOTH(12)) GRID_BAR(); }
    if (IN(13)) {
        pg8::Gemm g{WSP(bf16, WS_O1), WSP(bf16, WB_O1), D, D, D}; pg8::StaticOrder S; S.init(T, D, F.G, (int)blockIdx.x);
        EpiRes E{F.out, F.out, MOD1 + 2048, 6144};
        pg8::gemm_phase(F.lds, g, S, E);
        if (BOTH(13)) GRID_BAR();
    }
    if (IN(14)) {
        LAS int* lcnt = (LAS int*)(F.lds);
        if (F.tid < NE) lcnt[F.tid] = 0;
        __syncthreads();
        int* toke = WSP(int, SM_TOKE); float* tokw = WSP(float, SM_TOKW);
        for (int m = F.gw; m < T; m += F.NGW) {
            f32x4 v[4], u[4]; load_row(F.out + (size_t)m * D, F.lane, v);
            const float r = row_rs(v); const int b = m >> 12;
            modulate_row(v, r, F.ffn_gain + D, MOD1 + (size_t)b * 6144 + 3072, MOD1 + (size_t)b * 6144 + 4096, F.lane, u);
            store_row_bf16(WSP(bf16, WS_UM) + (size_t)m * D, F.lane, u);
            float lg[NE];
#pragma unroll
            for (int e = 0; e < NE; ++e) lg[e] = 0.f;
#pragma unroll
            for (int j = 0; j < 4; ++j) {
                const float uu[4] = {u[j].x, u[j].y, u[j].z, u[j].w};
#pragma unroll
                for (int q = 0; q < 4; ++q) { const float* wr = F.w_router + (size_t)(4 * F.lane + 256 * j + q) * NE; const f32x4 w0 = *(const f32x4*)wr, w1 = *(const f32x4*)(wr + 4);
                    lg[0] += uu[q] * w0.x; lg[1] += uu[q] * w0.y; lg[2] += uu[q] * w0.z; lg[3] += uu[q] * w0.w; lg[4] += uu[q] * w1.x; lg[5] += uu[q] * w1.y; lg[6] += uu[q] * w1.z; lg[7] += uu[q] * w1.w; }
            }
#pragma unroll
            for (int e = 0; e < NE; ++e) lg[e] = wave_sum(lg[e]);
            int e1 = 0; float v1 = lg[0];
#pragma unroll
            for (int e = 1; e < NE; ++e) if (lg[e] > v1) { v1 = lg[e]; e1 = e; }
            int e2 = -1; float v2 = -INFINITY;
#pragma unroll
            for (int e = 0; e < NE; ++e) if (e != e1 && lg[e] > v2) { v2 = lg[e]; e2 = e; }
            if (F.lane == 0) {
                const float ex = __expf(v2 - v1), w1 = 1.0f / (1.0f + ex);
                toke[2 * m] = e1; toke[2 * m + 1] = e2; tokw[2 * m] = w1; tokw[2 * m + 1] = ex * w1;
                lds_add(&lcnt[e1], 1); lds_add(&lcnt[e2], 1);
            }
        }
        __syncthreads();
        if (F.tid < NE) atomicAdd(F.ctl + CW_CNT + F.tid, (unsigned)lcnt[F.tid]);
        if (BOTH(14)) GRID_BAR();
    }
    if (IN(15)) {
        LAS int* lcnt = (LAS int*)(F.lds); LAS int* lbase = lcnt + 8; LAS int* lfill = lcnt + 16;
        const int* toke = WSP(int, SM_TOKE); int* slot = WSP(int, SM_SLOT);
        const int rows_per = T / F.G, r0 = blockIdx.x * rows_per;
        if (F.tid < NE) { lcnt[F.tid] = 0; lfill[F.tid] = 0; }
        __syncthreads();
        for (int i = F.tid; i < 2 * rows_per; i += 512) lds_add(&lcnt[toke[2 * r0 + i]], 1);
        __syncthreads();
        if (F.tid < NE) {
            int off = 0; for (int e = 0; e < F.tid; ++e) off += (int)((ld_u32(F.ctl + CW_CNT + e) + 255u) >> 8) * 256;
            lbase[F.tid] = off + (int)atomicAdd(F.ctl + CW_FILL + F.tid, (unsigned)lcnt[F.tid]);
        }
        __syncthreads();
        const bf16* UM = WSP(bf16, WS_UM); bf16* AG = WSP(bf16, WS_AG);
        for (int i = F.wave; i < 2 * rows_per; i += NWAVES) {
            const int m = r0 + (i >> 1), e = toke[2 * r0 + i];
            int s = 0; if (F.lane == 0) { s = lbase[e] + lds_add(&lfill[e], 1); slot[2 * r0 + i] = s; }
            s = __shfl(s, 0);
            const u32x4* src = (const u32x4*)(UM + (size_t)m * D); u32x4* dst = (u32x4*)(AG + (size_t)s * D);
            dst[F.lane] = src[F.lane]; dst[F.lane + 64] = src[F.lane + 64];
        }
        if (BOTH(15)) GRID_BAR();
    }
    if (IN(16)) {
        pg8::Gemm g{WSP(bf16, WS_AG), WSP(bf16, WS_WGU1), D, D, D}; MoeOrder S; S.init(F.ctl + CW_CNT, 2 * FFE / 256, F.G, (int)blockIdx.x);
        EpiSwiglu E{WSP(bf16, WS_HID2), FFE, 2 * FFE / 256};
        pg8::gemm_phase(F.lds, g, S, E);
        if (BOTH(16)) GRID_BAR();
    }
    if (IN(17)) {
        pg8::Gemm g{WSP(bf16, WS_HID2), WSP(bf16, WS_WD1), FFE, FFE, FFE}; MoeOrder S; S.init(F.ctl + CW_CNT, D / 256, F.G, (int)blockIdx.x);
        EpiY E{WSP(bf16, WS_Y)};
        pg8::gemm_phase(F.lds, g, S, E);
        if (BOTH(17)) GRID_BAR();
    }
    if (IN(18)) {
        const int* slot = WSP(int, SM_SLOT); const float* tokw = WSP(float, SM_TOKW); const bf16* Y = WSP(bf16, WS_Y);
        for (int m = F.gw; m < T; m += F.NGW) {
            f32x4 v[4]; load_row(F.out + (size_t)m * D, F.lane, v);
            const int b = m >> 12; const int s1 = slot[2 * m], s2 = slot[2 * m + 1]; const float w1 = tokw[2 * m], w2 = tokw[2 * m + 1];
            const float* fg = MOD1 + (size_t)b * 6144 + 5120;
#pragma unroll
            for (int j = 0; j < 4; ++j) {
                const u32x2 y1 = ((const u32x2*)(Y + (size_t)s1 * D))[F.lane + 64 * j], y2 = ((const u32x2*)(Y + (size_t)s2 * D))[F.lane + 64 * j];
                const f32x4 gq = ((const f32x4*)fg)[F.lane + 64 * j];
                f32x4 y; y.x = w1 * bflo(y1.x) + w2 * bflo(y2.x); y.y = w1 * bfhi(y1.x) + w2 * bfhi(y2.x); y.z = w1 * bflo(y1.y) + w2 * bflo(y2.y); y.w = w1 * bfhi(y1.y) + w2 * bfhi(y2.y);
                v[j] = v[j] + gq * y;
            }
            const float r = row_rs(v);
#pragma unroll
            for (int j = 0; j < 4; ++j) { const f32x4 gn = ((const f32x4*)F.final_gain)[F.lane + 64 * j]; ((f32x4*)(F.out + (size_t)m * D))[F.lane + 64 * j] = v[j] * r * gn; }
        }
    }
#undef IN
#undef BOTH
}

extern "C" void kernel_launch(void* const* d_in, const int* in_sizes, int n_in, void* d_out, int out_size, void* d_ws, size_t ws_size, hipStream_t stream) {
    static int grid = 0;
    if (grid == 0) {
        if (n_in != 29 || out_size != T * D || ws_size < WS_END) { fprintf(stderr, "kernel_launch: unexpected problem (n_in %d, out %d, ws %zu)\n", n_in, out_size, ws_size); grid = -1; return; }
        int dev = 0, cus = 0, per_cu = 0;
        if (hipGetDevice(&dev) != hipSuccess || hipDeviceGetAttribute(&cus, hipDeviceAttributeMultiprocessorCount, dev) != hipSuccess) { grid = -1; return; }
        if (hipFuncSetAttribute((const void*)trunk_fwd, hipFuncAttributeMaxDynamicSharedMemorySize, LDS_BYTES) != hipSuccess) { fprintf(stderr, "kernel_launch: hipFuncSetAttribute failed\n"); grid = -1; return; }
        if (hipOccupancyMaxActiveBlocksPerMultiprocessor(&per_cu, (const void*)trunk_fwd, NWAVES * 64, LDS_BYTES) != hipSuccess || per_cu < 1) { fprintf(stderr, "kernel_launch: occupancy query says %d\n", per_cu); }
        (void)hipGetLastError();
        grid = cus;
        if (T % grid != 0) { fprintf(stderr, "kernel_launch: grid %d does not divide the token count\n", grid); grid = -1; return; }
    }
    if (grid < 0) return;
    if (hipMemsetAsync((char*)d_ws + WS_CTL, 0, CTL_ZERO_BYTES, stream) != hipSuccess) return;
    Args a{};
    for (int i = 0; i < 29; ++i) a.in[i] = d_in[i];
    a.out = (float*)d_out; a.ws = (unsigned char*)d_ws;
#if MK_PER_PHASE
    for (int p = 0; p < NPHASE; ++p) { a.ph_lo = p; a.ph_hi = p + 1; a.li = p; hipLaunchKernelGGL(trunk_fwd, dim3(grid), dim3(NWAVES * 64), LDS_BYTES, stream, a); }
#else
    a.ph_lo = 0; a.ph_hi = NPHASE; a.li = 0;
    hipLaunchKernelGGL(trunk_fwd, dim3(grid), dim3(NWAVES * 64), LDS_BYTES, stream, a);
#endif
    const hipError_t le = hipPeekAtLastError();
    if (le != hipSuccess) fprintf(stderr, "kernel_launch: launch failed: %s\n", hipGetErrorName(le));
}
```

```cpp
#include <hip/hip_runtime.h>
#include <cstdio>
#include <cstdint>

#ifndef MK_PER_PHASE
#define MK_PER_PHASE 0
#endif

#define GAS __attribute__((address_space(1)))
#define LAS __attribute__((address_space(3)))
typedef unsigned short bf16;
typedef short bf16x8 __attribute__((ext_vector_type(8)));
typedef float f32x4 __attribute__((ext_vector_type(4)));
typedef float f32x16 __attribute__((ext_vector_type(16)));
typedef unsigned u32x4 __attribute__((ext_vector_type(4)));
typedef unsigned u32x2 __attribute__((ext_vector_type(2)));
typedef GAS unsigned gu32;

constexpr int NB = 4, SEQ = 4096, T = NB * SEQ, D = 1024, NH = 16, HD = 64, NG = 4;
constexpr int A_IN = 2120, A_INP = 2304, FF0 = 2816, FFE = 3584, NE = 8;
constexpr int KVW = 1536, BQ = 1072, BQP = 1280;
constexpr float C2 = 0.125f * 1.4426950408889634f;
constexpr float IWS = 0.04419417382415922f;
constexpr float RMS_EPS = 1e-6f;
constexpr int MPAD = 2 * T + NE * 256;

constexpr size_t MiB = 1u << 20;
constexpr size_t WS_CTL = 0, CTL_ZERO_BYTES = 1 * MiB;
constexpr size_t WS_SMALL = 1 * MiB;
constexpr size_t SM_MOD0 = WS_SMALL, SM_MOD1 = SM_MOD0 + 4 * 6144 * 4, SM_KVMOD = SM_MOD1 + 4 * 6144 * 4, SM_CBIAS = SM_KVMOD + 4 * 2048 * 4;
constexpr size_t SM_COS = 2 * MiB, SM_SIN = 4 * MiB, SM_IW = 6 * MiB, SM_GATES = 7 * MiB, SM_TOKE = 10 * MiB, SM_TOKW = SM_TOKE + 131072, SM_SLOT = SM_TOKW + 131072;
constexpr size_t SM_KC = 11 * MiB, SM_VC = SM_KC + 524288 + 4096;
static_assert(SM_CBIAS + 2048 <= SM_COS && SM_SLOT + 131072 <= SM_KC && SM_VC + 524288 + 4096 <= 16 * MiB, "small map");
constexpr size_t WB_IN = 16 * MiB;
constexpr size_t WB_O0 = WB_IN + (size_t)A_INP * D * 2;
constexpr size_t WB_GU0 = WB_O0 + (size_t)D * D * 2;
constexpr size_t WB_D0 = WB_GU0 + (size_t)2 * FF0 * D * 2;
constexpr size_t WB_KVQ = WB_D0 + (size_t)D * FF0 * 2;
constexpr size_t WB_O1 = WB_KVQ + (size_t)(KVW + BQP) * D * 2;
constexpr size_t WB_C1 = WB_O1 + (size_t)D * D * 2;
constexpr size_t WB_C2 = WB_C1 + (size_t)512 * 2048 * 2;
static_assert(WB_C2 + 128 * 256 * 2 <= 50 * MiB, "weight map");
constexpr size_t WS_U = 50 * MiB, WS_U2 = 82 * MiB;
constexpr size_t WS_Q0 = 114 * MiB, WS_K0 = 146 * MiB, WS_V0 = 154 * MiB, WS_IQ = 162 * MiB, WS_IK = 178 * MiB, WS_O0 = 180 * MiB, WS_MASK = 212 * MiB, WS_SCORES = 220 * MiB;
constexpr size_t WS_HID = 220 * MiB;
constexpr size_t WS_KCMP = 114 * MiB, WS_VCMP = 122 * MiB, WS_KSLC = 130 * MiB, WS_VSLC = 138 * MiB, WS_KWIN = 146 * MiB, WS_VWIN = 154 * MiB;
constexpr size_t WS_Q1 = 162 * MiB, WS_O1 = 194 * MiB, WS_CH = 226 * MiB;
constexpr size_t WS_OCG = 50 * MiB;
constexpr size_t WS_SEL = 230 * MiB;
constexpr size_t WS_UM = 300 * MiB;
constexpr size_t WS_AG = 16 * MiB;
constexpr size_t WS_Y = 16 * MiB;
constexpr size_t WS_HID2 = 84 * MiB;
constexpr size_t WS_WGU1 = 351 * MiB, WS_WD1 = 463 * MiB, WS_END = 519 * MiB;
static_assert(WS_AG + (size_t)MPAD * D * 2 <= WS_HID2 && WS_HID2 + (size_t)MPAD * FFE * 2 <= WS_WGU1 && WS_WGU1 + (size_t)NE * 2 * FFE * D * 2 == WS_WD1 && WS_WD1 + (size_t)NE * D * FFE * 2 == WS_END, "moe map");
static_assert(WS_HID + (size_t)T * FF0 * 2 <= WS_WGU1 && WS_UM + (size_t)T * D * 2 <= WS_WGU1 && WS_SCORES + (size_t)NB * SEQ * SEQ * 4 <= 476 * MiB, "map");
constexpr int CW_TMO = 0, CW_BAR = 4096, CW_CNT = 8192, CW_FILL = 8256;
#define XCD_BAR_WORDS 3456

constexpr int RING_BYTES = 131072, LDSCTL_OFF = 139264, MISC_OFF = LDSCTL_OFF + 320, LDS_BYTES = 147456;
constexpr int NWAVES = 8;

#define RLX_AGENT __ATOMIC_RELAXED, __HIP_MEMORY_SCOPE_AGENT
#define LDS_WAIT() asm volatile("s_waitcnt lgkmcnt(0)" ::: "memory")
#define VM_WAIT() asm volatile("s_waitcnt vmcnt(0)" ::: "memory")
__device__ __forceinline__ unsigned f2bf(float f) { unsigned u = __builtin_bit_cast(unsigned, f); return (u + 0x7fffu + ((u >> 16) & 1u)) >> 16; }
__device__ __forceinline__ unsigned pk2(float lo, float hi) { return f2bf(lo) | (f2bf(hi) << 16); }
__device__ __forceinline__ float bf2f(unsigned v) { return __builtin_bit_cast(float, v << 16); }
__device__ __forceinline__ float bflo(unsigned w) { return __builtin_bit_cast(float, w << 16); }
__device__ __forceinline__ float bfhi(unsigned w) { return __builtin_bit_cast(float, w & 0xffff0000u); }
__device__ __forceinline__ float bfround(float f) { return bf2f(f2bf(f)); }
__device__ __forceinline__ float wave_sum(float v) {
#pragma unroll
    for (int o = 1; o < 64; o <<= 1) v += __shfl_xor(v, o);
    return v;
}
__device__ __forceinline__ float wave_max(float v) {
#pragma unroll
    for (int o = 1; o < 64; o <<= 1) v = fmaxf(v, __shfl_xor(v, o));
    return v;
}
__device__ __forceinline__ int wave_sum_i(int v) {
#pragma unroll
    for (int o = 1; o < 64; o <<= 1) v += __shfl_xor(v, o);
    return v;
}
__device__ __forceinline__ int lds_add(LAS int* p, int v) { return __hip_atomic_fetch_add(p, v, __ATOMIC_RELAXED, __HIP_MEMORY_SCOPE_WORKGROUP); }
__device__ __forceinline__ unsigned ld_u32(const unsigned* p) { return __hip_atomic_load(p, RLX_AGENT); }
__device__ __forceinline__ float dot8(u32x4 a, u32x4 b, float acc) {
    acc += bflo(a.x) * bflo(b.x); acc += bfhi(a.x) * bfhi(b.x); acc += bflo(a.y) * bflo(b.y); acc += bfhi(a.y) * bfhi(b.y);
    acc += bflo(a.z) * bflo(b.z); acc += bfhi(a.z) * bfhi(b.z); acc += bflo(a.w) * bflo(b.w); acc += bfhi(a.w) * bfhi(b.w);
    return acc;
}

namespace pg8 {
constexpr int BM = 256, BK = 64, HALF = 128, HTB = HALF * BK * 2, STAGE_BYTES = 8 * HTB, NXCD = 8, WGM = 8;
__host__ __device__ __forceinline__ int lds_byte(int r, int c) { const int st = (r >> 4) * 2 + (c >> 5), rr = r & 15, cc = c & 31, ob = rr * 64 + cc * 2; return st * 1024 + (ob ^ (((ob >> 9) & 1) << 5)); }
__host__ __device__ __forceinline__ void stage_rc(int b, int& R, int& C) { const int st = b / 1024, sb = b % 1024, swz = sb ^ (((sb >> 9) & 1) << 5); R = (st >> 1) * 16 + swz / 64; C = (st & 1) * 32 + (swz % 64) / 2; }
__host__ __device__ __forceinline__ int perm32(int rho) { const int n = rho >> 4, i = rho & 15; return 8 * (i >> 2) + 4 * n + (i & 3); }
struct Unit { int pm, pn; };
struct Gemm { const bf16* A; const bf16* Bt; int K, lda, ldb; };

struct StaticOrder {
    int nM, nN, nwg, G, c;
    __device__ void init(int M, int N, int G_, int c_) { nM = M / BM; nN = N / BM; nwg = nM * nN; G = G_; c = c_; }
    __device__ bool next(int i, Unit& u) const {
        const long L = (long)i * G + c; if (L >= nwg) return false;
        int wgid = (int)L; { const int q = nwg / NXCD, r = nwg % NXCD, xcd = wgid % NXCD, off = wgid / NXCD; wgid = (xcd < r ? xcd * (q + 1) : r * (q + 1) + (xcd - r) * q) + off; }
        const int nig = WGM * nN, gid = wgid / nig, fm = gid * WGM, gsz = (nM - fm) < WGM ? (nM - fm) : WGM;
        u.pm = fm + ((wgid % nig) % gsz); u.pn = (wgid % nig) / gsz; return true;
    }
};

template <class Epi, class Sched>
__device__ __forceinline__ void gemm_phase(LAS unsigned char* lds, const Gemm g, const Sched& S, const Epi& E) {
    const int tid = threadIdx.x, wid = __builtin_amdgcn_readfirstlane(tid >> 6), lane = tid & 63, wr = wid >> 2, wc = wid & 3, fr = lane & 15, fq = lane >> 4;
    const int K = g.K, nt = K / BK;
    unsigned voffA[2], voffB[2];
#pragma unroll
    for (int i = 0; i < 2; ++i) { int R, C; stage_rc(tid * 16 + i * 8192, R, C); const int Rb = (R & ~31) + perm32(R & 31);
        voffA[i] = (unsigned)(R * g.lda + C) * 2u; voffB[i] = (unsigned)(Rb * g.ldb + C) * 2u; }
    const size_t kstep = (size_t)(BK * 2);
    const size_t hA = (size_t)HALF * g.lda * 2, hB = (size_t)HALF * g.ldb * 2;
    const size_t tA = 2 * hA, tB = 2 * hB;
    const unsigned ldsw = (unsigned)wid * 1024u;
    const int aoff = lds_byte(wr * 64 + fr, fq * 8), boff = lds_byte(wc * 32 + fr, fq * 8);
#define PG8_SA(b, h) (((b) * 2 + (h)) * HTB)
#define PG8_SB(b, h) ((4 + (b) * 2 + (h)) * HTB)
#define PG8_STAGE(bufoff, gbase, voff) do { _Pragma("unroll") for (int _i = 0; _i < 2; ++_i) \
        __builtin_amdgcn_global_load_lds((const unsigned*)((const char*)(gbase) + (voff)[_i]), (LAS unsigned*)(lds + (bufoff) + ldsw + _i * 8192), 16, 0, 0); } while (0)
#define PG8_LDA(dst, b, h) do { _Pragma("unroll") for (int m = 0; m < 4; ++m) _Pragma("unroll") for (int k = 0; k < 2; ++k) dst[m][k] = *(const LAS bf16x8*)(lds + PG8_SA(b, h) + aoff + m * 2048 + k * 1024); } while (0)
#define PG8_LDB(dst, b, h) do { _Pragma("unroll") for (int n = 0; n < 2; ++n) _Pragma("unroll") for (int k = 0; k < 2; ++k) dst[n][k] = *(const LAS bf16x8*)(lds + PG8_SB(b, h) + boff + n * 2048 + k * 1024); } while (0)
#define PG8_MMA(ai, bj, At, Bt) do { __builtin_amdgcn_s_setprio(1); _Pragma("unroll") for (int m = 0; m < 4; ++m) _Pragma("unroll") for (int n = 0; n < 2; ++n) _Pragma("unroll") for (int k = 0; k < 2; ++k) \
        acc[ai][bj][m][n] = __builtin_amdgcn_mfma_f32_16x16x32_bf16(Bt[n][k], At[m][k], acc[ai][bj][m][n], 0, 0, 0); __builtin_amdgcn_s_setprio(0); } while (0)
#define PG8_WAIT_V(n) asm volatile("s_waitcnt vmcnt(" #n ")" ::: "memory")
#define PG8_WAIT_L(n) asm volatile("s_waitcnt lgkmcnt(" #n ")" ::: "memory")
#define PG8_BAR __builtin_amdgcn_s_barrier()
#define PG8_SCHED __builtin_amdgcn_sched_barrier(0)
    Unit cur, nxt; int ui = 0;
    if (!S.next(0, cur)) return;
    f32x4 acc[2][2][4][2];
#pragma unroll
    for (int a = 0; a < 2; ++a)
#pragma unroll
        for (int b = 0; b < 2; ++b)
#pragma unroll
            for (int m = 0; m < 4; ++m)
#pragma unroll
                for (int n = 0; n < 2; ++n) acc[a][b][m][n] = (f32x4){0.f, 0.f, 0.f, 0.f};
    bf16x8 At[4][2], B0[2][2], B1[2][2];
    const char* cA = (const char*)g.A + (size_t)cur.pm * tA; const char* cB = (const char*)g.Bt + (size_t)cur.pn * tB;
    PG8_STAGE(PG8_SB(0, 0), cB, voffB); PG8_STAGE(PG8_SB(0, 1), cB + hB, voffB); PG8_STAGE(PG8_SA(0, 0), cA, voffA); PG8_STAGE(PG8_SA(0, 1), cA + hA, voffA);
    if (wr == 1) PG8_BAR;
    PG8_WAIT_V(2); PG8_BAR;
    PG8_STAGE(PG8_SB(1, 0), cB + kstep, voffB); PG8_STAGE(PG8_SA(1, 0), cA + kstep, voffA); PG8_STAGE(PG8_SB(1, 1), cB + hB + kstep, voffB);
    PG8_WAIT_V(6); PG8_BAR;
    for (;;) {
        const bool has_next = S.next(ui + 1, nxt);
        const char* nA = has_next ? (const char*)g.A + (size_t)nxt.pm * tA : cA; const char* nB = has_next ? (const char*)g.Bt + (size_t)nxt.pn * tB : cB;
        for (int t = 0; t < nt; t += 2) {
            const bool last = (t == nt - 2);
            const char* a1 = cA + (size_t)(t + 1) * kstep;
            const char* a2 = last ? nA : cA + (size_t)(t + 2) * kstep; const char* b2 = last ? nB : cB + (size_t)(t + 2) * kstep;
            const char* a3 = a2 + kstep; const char* b3 = b2 + kstep;
            PG8_LDB(B0, 0, 0); PG8_LDB(B1, 0, 1); PG8_SCHED; PG8_LDA(At, 0, 0); PG8_STAGE(PG8_SA(1, 1), a1 + hA, voffA);
            PG8_WAIT_V(8); PG8_WAIT_L(0); PG8_BAR; PG8_MMA(0, 0, At, B0); PG8_MMA(0, 1, At, B1); PG8_BAR; PG8_SCHED;
            PG8_LDA(At, 0, 1); PG8_STAGE(PG8_SB(0, 0), b2, voffB); PG8_STAGE(PG8_SB(0, 1), b2 + hB, voffB); PG8_STAGE(PG8_SA(0, 0), a2, voffA);
            PG8_WAIT_V(8); PG8_WAIT_L(0); PG8_BAR; PG8_MMA(1, 0, At, B0); PG8_MMA(1, 1, At, B1); PG8_BAR; PG8_SCHED;
            PG8_LDB(B0, 1, 0); PG8_LDB(B1, 1, 1); PG8_SCHED; PG8_LDA(At, 1, 0); PG8_STAGE(PG8_SA(0, 1), a2 + hA, voffA);
            PG8_WAIT_V(8); PG8_WAIT_L(0); PG8_BAR; PG8_MMA(0, 0, At, B0); PG8_MMA(0, 1, At, B1); PG8_BAR; PG8_SCHED;
            PG8_LDA(At, 1, 1); PG8_STAGE(PG8_SB(1, 0), b3, voffB); PG8_STAGE(PG8_SB(1, 1), b3 + hB, voffB); PG8_STAGE(PG8_SA(1, 0), a3, voffA);
            PG8_WAIT_V(8); PG8_WAIT_L(0); PG8_BAR; PG8_MMA(1, 0, At, B0); PG8_MMA(1, 1, At, B1); PG8_BAR; PG8_SCHED;
        }
        if (wr == 0) PG8_BAR;
        E(acc, cur, wr, wc, fr, fq);
        if (!has_next) break;
#pragma unroll
        for (int a = 0; a < 2; ++a)
#pragma unroll
            for (int b = 0; b < 2; ++b)
#pragma unroll
                for (int m = 0; m < 4; ++m)
#pragma unroll
                    for (int n = 0; n < 2; ++n) acc[a][b][m][n] = (f32x4){0.f, 0.f, 0.f, 0.f};
        cur = nxt; cA = nA; cB = nB; ++ui;
        if (wr == 1) PG8_BAR;
    }
    PG8_WAIT_V(0);
    PG8_BAR;
#undef PG8_SA
#undef PG8_SB
#undef PG8_STAGE
#undef PG8_LDA
#undef PG8_LDB
#undef PG8_MMA
#undef PG8_WAIT_V
#undef PG8_WAIT_L
#undef PG8_BAR
#undef PG8_SCHED
}
}

#define XB_TMO      128
#define XB_XCNT(j)  (256  + 64 * (j))
#define XB_XSUB(j)  (1280 + 64 * (j))
#define XB_XGEN(j)  (2304 + 64 * (j))
#define XB_TOP      3328
#define XB_TOPGEN   3392
#define XB_SPIN_CAP (1u << 18)
__device__ __forceinline__ unsigned xb_ld(unsigned* p)              { return __hip_atomic_load(p, __ATOMIC_RELAXED, __HIP_MEMORY_SCOPE_AGENT); }
__device__ __forceinline__ unsigned xb_add(unsigned* p, unsigned v) { return __hip_atomic_fetch_add(p, v, __ATOMIC_RELAXED, __HIP_MEMORY_SCOPE_AGENT); }
__device__ __forceinline__ unsigned xb_xcc_id() { return (unsigned)__builtin_amdgcn_s_getreg((3 << 11) | 20) & 0xFu; }
#define XB_SPIN(cond, bar) do { unsigned _sp = 0; while (cond) { __builtin_amdgcn_s_sleep(1); \
    if ((++_sp & 255u) == 0u) { if (xb_ld(&(bar)[XB_TMO])) break; if (_sp > XB_SPIN_CAP) { atomicAdd(&(bar)[XB_TMO], 1u); break; } } } } while (0)
struct XcdBarrier { unsigned* bar; unsigned x; volatile LAS unsigned* st; };
__device__ __forceinline__ XcdBarrier xcd_barrier_post(unsigned* bar, volatile LAS unsigned* st) {
    XcdBarrier b; b.bar = bar; b.x = xb_xcc_id(); b.st = st;
    if (threadIdx.x == 0) (void)xb_add(&bar[XB_XCNT(b.x)], 1u);
    return b;
}
__device__ __forceinline__ void xcd_barrier_complete(unsigned* bar, unsigned x, unsigned& nloc, unsigned& nx) {
    const unsigned G = gridDim.x * gridDim.y * gridDim.z;
    unsigned sum, cnt, mine, sp = 0u;
    for (;;) {
        sum = 0u; cnt = 0u; mine = 0u;
#pragma unroll
        for (unsigned j = 0; j < 16; ++j) { const unsigned c = xb_ld(&bar[XB_XCNT(j)]); sum += c; cnt += (c > 0u) ? 1u : 0u; mine = (j == x) ? c : mine; }
        if (sum == G) break;
        __builtin_amdgcn_s_sleep(1);
        if ((++sp & 255u) == 0u) { if (xb_ld(&bar[XB_TMO])) break; if (sp > XB_SPIN_CAP) { atomicAdd(&bar[XB_TMO], 1u); break; } }
    }
    nloc = mine > 0u ? mine : 1u; nx = cnt > 0u ? cnt : 1u;
}
__device__ __forceinline__ void xcd_barrier(const XcdBarrier& b) {
    asm volatile("s_waitcnt vmcnt(0)" ::: "memory");
    __syncthreads();
    if (threadIdx.x == 0) {
        unsigned* bar = b.bar;
        __builtin_amdgcn_s_waitcnt(0);
        unsigned nloc = b.st[0], nx = b.st[1];
        if (nloc == 0u) { xcd_barrier_complete(bar, b.x, nloc, nx); b.st[0] = nloc; b.st[1] = nx; }
        const unsigned old = xb_add(&bar[XB_XSUB(b.x)], 1u);
        const unsigned gen = old / nloc;
        if (old + 1u == (gen + 1u) * nloc) {
            __builtin_amdgcn_fence(__ATOMIC_RELEASE, "agent");
            asm volatile("s_waitcnt vmcnt(0)" ::: "memory");
            const unsigned og = xb_add(&bar[XB_TOP], 1u);
            const unsigned tg = og / nx;
            if (og + 1u == (tg + 1u) * nx) xb_add(&bar[XB_TOPGEN], 1u);
            else XB_SPIN(xb_ld(&bar[XB_TOPGEN]) == tg, bar);
            __builtin_amdgcn_fence(__ATOMIC_ACQUIRE, "agent");
            xb_add(&bar[XB_XGEN(b.x)], 1u);
            asm volatile("s_waitcnt vmcnt(0)" ::: "memory");
        } else {
            XB_SPIN(xb_ld(&bar[XB_XGEN(b.x)]) == gen, bar);
            __builtin_amdgcn_fence(__ATOMIC_ACQUIRE, "agent");
            asm volatile("s_waitcnt vmcnt(0)" ::: "memory");
        }
    }
    __syncthreads();
}

struct Frame {
    LAS unsigned char* lds;
    volatile LAS unsigned* MISC;
    unsigned* ctl;
    unsigned char* ws;
    int tid, lane, wave, G, gw, NGW;
    const float *x, *c; const int* pos;
    const float *attn_gain, *ffn_gain, *w_ada, *b_ada, *a_w_in, *a_w_out, *b_w_q, *b_w_out, *kv_gain, *w_kv_ada, *b_kv_ada, *w_kv;
    const float *pe_k, *w1_k, *w2_k, *pe_v, *w1_v, *w2_v, *ffn_wg, *ffn_wu, *ffn_wd, *w_router, *moe_wg, *moe_wu, *moe_wd, *final_gain;
    float* out;
};
#define WSP(T_, off) ((T_*)(F.ws + (off)))
__device__ __forceinline__ unsigned char* launder(unsigned char* p) { asm volatile("" : "+s"(p)); return p; }
#define LWSP(T_, off) ((T_*)(launder(F.ws) + (off)))

__device__ __forceinline__ void tr_item(const float* W, int Nsrc, int ncol0, int K, int k0, bf16* WT, int drow0, LAS float* scr, int lane) {
    const int cc = ncol0 + (lane & 31); const bool ok = (ncol0 >= 0) && (cc < Nsrc);
#pragma unroll 8
    for (int i = 0; i < 32; ++i) { const int kk = 2 * i + (lane >> 5); scr[kk * 33 + (lane & 31)] = ok ? W[(size_t)(k0 + kk) * Nsrc + cc] : 0.f; }
    LDS_WAIT(); asm volatile("" ::: "memory");
    const int c = lane & 7;
#pragma unroll
    for (int j = 0; j < 4; ++j) { const int n = (lane >> 3) + 8 * j; const LAS float* s = scr + (8 * c) * 33 + n;
        u32x4 o; o.x = pk2(s[0 * 33], s[1 * 33]); o.y = pk2(s[2 * 33], s[3 * 33]); o.z = pk2(s[4 * 33], s[5 * 33]); o.w = pk2(s[6 * 33], s[7 * 33]);
        *(u32x4*)(WT + (size_t)(drow0 + n) * K + k0 + 8 * c) = o; }
    LDS_WAIT(); asm volatile("" ::: "memory");
}
__device__ __forceinline__ int rope_lb(int pb) { const int pn = pb >> 3, half = (pb >> 2) & 1, hl = pb & 3; return 8 * pn + 2 * hl + half; }

__device__ __forceinline__ void conv_item_a(Frame& F, int it, LAS float* scr) {
    const int lane = F.lane;
    int r = it;
    { constexpr int NBK = A_INP / 32, NI = 16 * NBK; if (r < NI) { const int kb = r / NBK, pb = r % NBK; tr_item(F.a_w_in, A_IN, 32 * rope_lb(pb), D, 64 * kb, WSP(bf16, WB_IN), 32 * pb, scr, lane); return; } r -= NI; }
    { constexpr int NBK = D / 32, NI = 16 * NBK; if (r < NI) { const int kb = r / NBK, pb = r % NBK; tr_item(F.a_w_out, D, 32 * pb, D, 64 * kb, WSP(bf16, WB_O0), 32 * pb, scr, lane); return; } r -= NI; }
    { constexpr int NBK = 2 * FF0 / 32, NI = 16 * NBK; if (r < NI) { const int kb = r / NBK, pb = r % NBK; const int pn = pb >> 3, half = (pb >> 2) & 1, q = pb & 3;
        tr_item(half ? F.ffn_wu : F.ffn_wg, FF0, 32 * (4 * pn + q), D, 64 * kb, WSP(bf16, WB_GU0), 32 * pb, scr, lane); return; } r -= NI; }
    { constexpr int NBK = D / 32, NI = (FF0 / 64) * NBK; if (r < NI) { const int kb = r / NBK, pb = r % NBK; tr_item(F.ffn_wd, D, 32 * pb, FF0, 64 * kb, WSP(bf16, WB_D0), 32 * pb, scr, lane); return; } r -= NI; }
    { constexpr int NBK = KVW / 32, NI = 16 * NBK; if (r < NI) { const int kb = r / NBK, pb = r % NBK; tr_item(F.w_kv, KVW, 32 * rope_lb(pb), D, 64 * kb, WSP(bf16, WB_KVQ), 32 * pb, scr, lane); return; } r -= NI; }
    { constexpr int NBK = BQP / 32, NI = 16 * NBK; if (r < NI) { const int kb = r / NBK, pb = r % NBK; tr_item(F.b_w_q, BQ, 32 * rope_lb(pb), D, 64 * kb, WSP(bf16, WB_KVQ) + (size_t)KVW * D, 32 * pb, scr, lane); return; } r -= NI; }
    { constexpr int NBK = D / 32, NI = 16 * NBK; if (r < NI) { const int kb = r / NBK, pb = r % NBK; tr_item(F.b_w_out, D, 32 * pb, D, 64 * kb, WSP(bf16, WB_O1), 32 * pb, scr, lane); return; } r -= NI; }
    { constexpr int NBK = 8, NI = 32 * NBK; if (r < NI) { const int kb = r / NBK, pb = r % NBK; tr_item(F.w1_k, 256, 32 * pb, 2048, 64 * kb, WSP(bf16, WB_C1), 32 * pb, scr, lane); return; } r -= NI;
                                       if (r < NI) { const int kb = r / NBK, pb = r % NBK; tr_item(F.w1_v, 256, 32 * pb, 2048, 64 * kb, WSP(bf16, WB_C1), 256 + 32 * pb, scr, lane); return; } r -= NI; }
    { constexpr int NBK = 2, NI = 4 * NBK; if (r < NI) { const int kb = r / NBK, pb = r % NBK; tr_item(F.w2_k, 64, 32 * pb, 256, 64 * kb, WSP(bf16, WB_C2), 32 * pb, scr, lane); return; } r -= NI;
                                       if (r < NI) { const int kb = r / NBK, pb = r % NBK; tr_item(F.w2_v, 64, 32 * pb, 256, 64 * kb, WSP(bf16, WB_C2), 64 + 32 * pb, scr, lane); return; } r -= NI; }
}
constexpr int NCONV_A = 16 * (A_INP / 32) + 16 * 32 + 16 * (2 * FF0 / 32) + (FF0 / 64) * 32 + 16 * (KVW / 32) + 16 * (BQP / 32) + 16 * 32 + 2 * 32 * 8 + 2 * 4 * 2;
__device__ __forceinline__ void conv_item_b(Frame& F, int it, LAS float* scr) {
    const int lane = F.lane;
    constexpr int NBK1 = 2 * FFE / 32, NI1 = 16 * NBK1;
    constexpr int NBK2 = D / 32, NI2 = (FFE / 64) * NBK2;
    int r = it;
    if (r < NE * NI1) { const int e = r / NI1; r -= e * NI1; const int kb = r / NBK1, pb = r % NBK1; const int pn = pb >> 3, half = (pb >> 2) & 1, q = pb & 3;
        tr_item((half ? F.moe_wu : F.moe_wg) + (size_t)e * D * FFE, FFE, 32 * (4 * pn + q), D, 64 * kb, WSP(bf16, WS_WGU1) + (size_t)e * 2 * FFE * D, 32 * pb, scr, lane); return; }
    r -= NE * NI1;
    { const int e = r / NI2; r -= e * NI2; const int kb = r / NBK2, pb = r % NBK2;
        tr_item(F.moe_wd + (size_t)e * FFE * D, D, 32 * pb, FFE, 64 * kb, WSP(bf16, WS_WD1) + (size_t)e * D * FFE, 32 * pb, scr, lane); }
}
constexpr int NCONV_B = NE * (16 * (2 * FFE / 32) + (FFE / 64) * 32);

template <int NBAT>
__device__ __forceinline__ void gemv_item(Frame& F, const LAS float* act, const float* W, int K, int N, int n0, const float* bias, float* out, int ldo, LAS float* red) {
    const int kper = K / 8, k0 = F.wave * kper;
    float a[NBAT];
#pragma unroll
    for (int b = 0; b < NBAT; ++b) a[b] = 0.f;
    const float* wp = W + (size_t)k0 * N + n0 + F.lane;
#pragma unroll 8
    for (int k = 0; k < kper; ++k) { const float w = wp[(size_t)k * N];
#pragma unroll
        for (int b = 0; b < NBAT; ++b) a[b] += act[b * K + k0 + k] * w; }
#pragma unroll
    for (int b = 0; b < NBAT; ++b) red[(F.wave * 4 + b) * 64 + F.lane] = a[b];
    __syncthreads();
    if (F.tid < 64 * NBAT) { const int b = F.tid >> 6, l = F.tid & 63; float s = 0.f;
#pragma unroll
        for (int w = 0; w < 8; ++w) s += red[(w * 4 + b) * 64 + l];
        out[(size_t)b * ldo + n0 + l] = s + (bias ? bias[n0 + l] : 0.f); }
    __syncthreads();
}

__device__ __forceinline__ void p0_prologue(Frame& F) {
    {
        LAS float* act = (LAS float*)(F.lds);
        LAS float* red = (LAS float*)(F.lds + 16384);
        constexpr int NI_MOD = 6144 / 64, NI_KV = 2048 / 64, NITEMS = 2 * NI_MOD + NI_KV + 8;
        for (int it = blockIdx.x; it < NITEMS; it += F.G) {
            if (it < 2 * NI_MOD + NI_KV) {
                for (int i = F.tid; i < 4096; i += 512) { const float v = F.c[i]; act[i] = v / (1.f + __expf(-v)); }
                __syncthreads();
                if (it < NI_MOD) gemv_item<4>(F, act, F.w_ada, D, 6144, 64 * it, F.b_ada, WSP(float, SM_MOD0), 6144, red);
                else if (it < 2 * NI_MOD) gemv_item<4>(F, act, F.w_ada + (size_t)D * 6144, D, 6144, 64 * (it - NI_MOD), F.b_ada + 6144, WSP(float, SM_MOD1), 6144, red);
                else gemv_item<4>(F, act, F.w_kv_ada, D, 2048, 64 * (it - 2 * NI_MOD), F.b_kv_ada, WSP(float, SM_KVMOD), 2048, red);
            } else {
                const int j = it - (2 * NI_MOD + NI_KV), kv = j >> 2;
                const float* pe = kv ? F.pe_v : F.pe_k;
                for (int i = F.tid; i < 2048; i += 512) act[i] = pe[i];
                __syncthreads();
                gemv_item<1>(F, act, kv ? F.w1_v : F.w1_k, 2048, 256, 64 * (j & 3), nullptr, WSP(float, SM_CBIAS) + 256 * kv, 256, red);
            }
        }
        __syncthreads();
    }
    {
        LAS float* scr = (LAS float*)(F.lds + F.wave * 16384);
        for (int it = F.gw; it < NCONV_A; it += F.NGW) conv_item_a(F, it, scr);
    }
    {
        float* cs = WSP(float, SM_COS); float* sn = WSP(float, SM_SIN);
        for (int i = F.gw * 64 + F.lane; i < T * 32; i += F.NGW * 64) {
            const int m = i >> 5, d = i & 31;
            const float inv = 1.0f / powf(10000.0f, (float)d * (1.0f / 32.0f));
            const float ang = (float)F.pos[m] * inv;
            cs[i] = cosf(ang); sn[i] = sinf(ang);
        }
    }
}

__device__ __forceinline__ void load_row(const float* row, int lane, f32x4 (&v)[4]) {
#pragma unroll
    for (int j = 0; j < 4; ++j) v[j] = ((const f32x4*)row)[lane + 64 * j];
}
__device__ __forceinline__ float row_rs(const f32x4 (&v)[4]) {
    float s = 0.f;
#pragma unroll
    for (int j = 0; j < 4; ++j) s += (v[j].x * v[j].x + v[j].y * v[j].y) + (v[j].z * v[j].z + v[j].w * v[j].w);
    return 1.0f / sqrtf(wave_sum(s) * (1.f / D) + RMS_EPS);
}
__device__ __forceinline__ void modulate_row(const f32x4 (&v)[4], float r, const float* gain, const float* shift, const float* scale, int lane, f32x4 (&u)[4]) {
#pragma unroll
    for (int j = 0; j < 4; ++j) { const f32x4 g = ((const f32x4*)gain)[lane + 64 * j], sh = ((const f32x4*)shift)[lane + 64 * j], sc = ((const f32x4*)scale)[lane + 64 * j];
        u[j] = v[j] * r * g * (sc + 1.0f) + sh; }
}
__device__ __forceinline__ void store_row_bf16(bf16* orow, int lane, const f32x4 (&u)[4]) {
#pragma unroll
    for (int j = 0; j < 4; ++j) { u32x2 o; o.x = pk2(u[j].x, u[j].y); o.y = pk2(u[j].z, u[j].w); ((u32x2*)orow)[lane + 64 * j] = o; }
}
__device__ __forceinline__ void norm_phase(Frame& F, const float* src, const float* gain, const float* mod  , int ldm, int shift_off, int scale_off, bf16* dst) {
    for (int m = F.gw; m < T; m += F.NGW) {
        f32x4 v[4], u[4]; load_row(src + (size_t)m * D, F.lane, v);
        const float r = row_rs(v); const int b = m >> 12;
        modulate_row(v, r, gain, mod + (size_t)b * ldm + shift_off, mod + (size_t)b * ldm + scale_off, F.lane, u);
        store_row_bf16(dst + (size_t)m * D, F.lane, u);
    }
}

__device__ __forceinline__ void store8(bf16* p, const float (&y)[8]) { u32x4 w; w.x = pk2(y[0], y[1]); w.y = pk2(y[2], y[3]); w.z = pk2(y[4], y[5]); w.w = pk2(y[6], y[7]); *(u32x4*)p = w; }
__device__ __forceinline__ void get8(const f32x4 (&a)[2], float (&x)[8]) { x[0] = a[0].x; x[1] = a[0].y; x[2] = a[0].z; x[3] = a[0].w; x[4] = a[1].x; x[5] = a[1].y; x[6] = a[1].z; x[7] = a[1].w; }
__device__ __forceinline__ void rope8(const float* cs, const float* sn, int row, int fq, const float (&x1)[8], const float (&x2)[8], float sc, float (&y1)[8], float (&y2)[8]) {
    const f32x4 c0 = *(const f32x4*)(cs + (size_t)row * 32 + 8 * fq), c1 = *(const f32x4*)(cs + (size_t)row * 32 + 8 * fq + 4);
    const f32x4 s0 = *(const f32x4*)(sn + (size_t)row * 32 + 8 * fq), s1 = *(const f32x4*)(sn + (size_t)row * 32 + 8 * fq + 4);
    const float c[8] = {c0.x, c0.y, c0.z, c0.w, c1.x, c1.y, c1.z, c1.w}, s[8] = {s0.x, s0.y, s0.z, s0.w, s1.x, s1.y, s1.z, s1.w};
#pragma unroll
    for (int j = 0; j < 8; ++j) { y1[j] = (x1[j] * c[j] - x2[j] * s[j]) * sc; y2[j] = (x2[j] * c[j] + x1[j] * s[j]) * sc; }
}
struct EpiIn {
    bf16 *Q, *K, *V, *IQ, *IK; float* IW; const float *cs, *sn;
    __device__ __forceinline__ void operator()(const f32x4 (&acc)[2][2][4][2], const pg8::Unit& u, int wr, int wc, int fr, int fq) const {
        const int pn = u.pn;
        if (pn == 8 && wc >= 2) return;
#pragma unroll
        for (int ai = 0; ai < 2; ++ai)
#pragma unroll
            for (int m = 0; m < 4; ++m) {
                const int row = u.pm * 256 + ai * 128 + wr * 64 + m * 16 + fr;
                float x1[8], x2[8]; get8(acc[ai][0][m], x1); get8(acc[ai][1][m], x2);
                if (pn == 5) { bf16* d = V + (size_t)row * 256 + wc * 64 + 8 * fq; store8(d, x1); store8(d + 32, x2); }
                else if (pn == 8 && wc == 1) { if (fq == 0) { f32x4 a = {x1[0] * IWS, x1[1] * IWS, x1[2] * IWS, x1[3] * IWS}, b = {x1[4] * IWS, x1[5] * IWS, x1[6] * IWS, x1[7] * IWS};
                        *(f32x4*)(IW + (size_t)row * 8) = a; *(f32x4*)(IW + (size_t)row * 8 + 4) = b; } }
                else {
                    float y1[8], y2[8]; rope8(cs, sn, row, fq, x1, x2, pn < 4 ? C2 : 1.0f, y1, y2);
                    bf16* d;
                    if (pn < 4) d = Q + (size_t)row * 1024 + (4 * pn + wc) * 64;
                    else if (pn == 4) d = K + (size_t)row * 256 + wc * 64;
                    else if (pn < 8) d = IQ + (size_t)row * 512 + (4 * (pn - 6) + wc) * 64;
                    else d = IK + (size_t)row * 64;
                    store8(d + 8 * fq, y1); store8(d + 32 + 8 * fq, y2);
                }
            }
    }
};
struct EpiRes {
    const float* base; float* out; const float* gate; int ldg;
    __device__ __forceinline__ void operator()(const f32x4 (&acc)[2][2][4][2], const pg8::Unit& u, int wr, int wc, int fr, int fq) const {
        const float* gv = gate + (size_t)((u.pm * 256) >> 12) * ldg;
#pragma unroll
        for (int bj = 0; bj < 2; ++bj) {
            const int col = u.pn * 256 + bj * 128 + wc * 32 + 8 * fq;
            const f32x4 g0 = *(const f32x4*)(gv + col), g1 = *(const f32x4*)(gv + col + 4);
#pragma unroll
            for (int ai = 0; ai < 2; ++ai)
#pragma unroll
                for (int m = 0; m < 4; ++m) {
                    const size_t o = (size_t)(u.pm * 256 + ai * 128 + wr * 64 + m * 16 + fr) * D + col;
                    const f32x4 b0 = *(const f32x4*)(base + o), b1 = *(const f32x4*)(base + o + 4);
                    *(f32x4*)(out + o) = b0 + g0 * acc[ai][bj][m][0]; *(f32x4*)(out + o + 4) = b1 + g1 * acc[ai][bj][m][1];
                }
        }
    }
};
__device__ __forceinline__ float silu_f(float g) { return g * __builtin_amdgcn_rcpf(1.0f + __builtin_amdgcn_exp2f(-1.4426950408889634f * g)); }
struct EpiSwiglu {
    bf16* H; int ldh, npn;
    __device__ __forceinline__ void operator()(const f32x4 (&acc)[2][2][4][2], const pg8::Unit& u, int wr, int wc, int fr, int fq) const {
        const int col = (u.pn % npn) * 128 + wc * 32 + 8 * fq;
#pragma unroll
        for (int ai = 0; ai < 2; ++ai)
#pragma unroll
            for (int m = 0; m < 4; ++m) {
                const int row = u.pm * 256 + ai * 128 + wr * 64 + m * 16 + fr;
                float g[8], up[8], h[8]; get8(acc[ai][0][m], g); get8(acc[ai][1][m], up);
#pragma unroll
                for (int j = 0; j < 8; ++j) h[j] = silu_f(g[j]) * up[j];
                store8(H + (size_t)row * ldh + col, h);
            }
    }
};
struct EpiKVQ {
    bf16 *KCMP, *VCMP, *KSLC, *VSLC, *KWIN, *VWIN, *Q; float* GATES; const float *cs, *sn;
    __device__ __forceinline__ void operator()(const f32x4 (&acc)[2][2][4][2], const pg8::Unit& u, int wr, int wc, int fr, int fq) const {
        const int pn = u.pn;
        if (pn == 10 && wc >= 1) return;
#pragma unroll
        for (int ai = 0; ai < 2; ++ai)
#pragma unroll
            for (int m = 0; m < 4; ++m) {
                const int row = (u.pm & 63) * 256 + ai * 128 + wr * 64 + m * 16 + fr;
                float x1[8], x2[8]; get8(acc[ai][0][m], x1); get8(acc[ai][1][m], x2);
                if (pn < 6) {
                    if ((pn & 1) == 0) { float y1[8], y2[8]; rope8(cs, sn, row, fq, x1, x2, 1.0f, y1, y2);
#pragma unroll
                        for (int j = 0; j < 8; ++j) { x1[j] = y1[j]; x2[j] = y2[j]; } }
                    bf16* d;
                    if (pn < 2) d = (pn == 0 ? KCMP : VCMP) + ((size_t)((row >> 12) * 4 + wc) * SEQ + (row & 4095)) * 64;
                    else d = (pn == 2 ? KSLC : pn == 3 ? VSLC : pn == 4 ? KWIN : VWIN) + (size_t)row * 256 + wc * 64;
                    store8(d + 8 * fq, x1); store8(d + 32 + 8 * fq, x2);
                } else if (pn < 10) {
                    float y1[8], y2[8]; rope8(cs, sn, row, fq, x1, x2, C2, y1, y2);
                    bf16* d = Q + (size_t)row * 1024 + (4 * (pn - 6) + wc) * 64;
                    store8(d + 8 * fq, y1); store8(d + 32 + 8 * fq, y2);
                } else {
                    float* gp = GATES + (size_t)row * 48;
#pragma unroll
                    for (int j = 0; j < 8; ++j) gp[8 * fq + j] = 1.0f / (1.0f + __expf(-x1[j]));
                    if (fq < 2) {
#pragma unroll
                        for (int j = 0; j < 8; ++j) gp[32 + 8 * fq + j] = 1.0f / (1.0f + __expf(-x2[j])); }
                }
            }
    }
};
struct EpiY {
    bf16* Y;
    __device__ __forceinline__ void operator()(const f32x4 (&acc)[2][2][4][2], const pg8::Unit& u, int wr, int wc, int fr, int fq) const {
#pragma unroll
        for (int ai = 0; ai < 2; ++ai)
#pragma unroll
            for (int m = 0; m < 4; ++m) {
                const int row = u.pm * 256 + ai * 128 + wr * 64 + m * 16 + fr;
#pragma unroll
                for (int bj = 0; bj < 2; ++bj) { float x[8]; get8(acc[ai][bj][m], x); store8(Y + (size_t)row * D + (u.pn & 3) * 256 + bj * 128 + wc * 32 + 8 * fq, x); }
            }
    }
};
struct KvqOrder {
    pg8::StaticOrder S;
    __device__ bool next(int i, pg8::Unit& u) const { if (!S.next(i, u)) return false; if (u.pn >= 6) u.pm += 64; return true; }
};
struct MoeOrder {
    int tend[NE]; int ntiles, npn, G, c;
    __device__ void init(const unsigned* cnt, int npn_, int G_, int c_) { int acc = 0; for (int e = 0; e < NE; ++e) { acc += (int)((ld_u32(cnt + e) + 255u) >> 8); tend[e] = acc; } ntiles = acc; npn = npn_; G = G_; c = c_; }
    __device__ bool next(int i, pg8::Unit& u) const {
        const long L = (long)i * G + c; if (L >= (long)ntiles * npn) return false;
        const int mt = (int)(L / npn), pn = (int)(L % npn); int e = 0;
#pragma unroll
        for (int k = 0; k < NE - 1; ++k) e += (mt >= tend[k]) ? 1 : 0;
        u.pm = mt; u.pn = e * npn + pn; return true;
    }
};

__device__ __forceinline__ f32x16 sgemm_tile(const bf16* A, int lda, const bf16* Bt, int ldb, int K, int row0, int col0, int lane) {
    f32x16 acc = {};
    const bf16* ap = A + (size_t)(row0 + (lane & 31)) * lda + 8 * (lane >> 5);
    const bf16* bp = Bt + (size_t)(col0 + (lane & 31)) * ldb + 8 * (lane >> 5);
#pragma unroll 4
    for (int k = 0; k < K; k += 16) { const bf16x8 a = *(const bf16x8*)(ap + k), b = *(const bf16x8*)(bp + k); acc = __builtin_amdgcn_mfma_f32_32x32x16_bf16(a, b, acc, 0, 0, 0); }
    return acc;
}
__device__ __forceinline__ float gelu_tanh(float x) { const float t = tanhf(0.7978845608028654f * (x + 0.044715f * x * x * x)); return 0.5f * x * (1.0f + t); }

__device__ __forceinline__ unsigned okey(float f) { const unsigned u = __builtin_bit_cast(unsigned, f); return (u & 0x80000000u) ? ~u : (u | 0x80000000u); }
__device__ __forceinline__ void dsa_naive_item(Frame& F, int m, bf16* O  , unsigned long long* MASKo  ) {
    const int tid = F.tid, lane = F.lane, wave = F.wave;
    const int b = m >> 12, t = m & 4095, n = t + 1;
    LAS unsigned* KEY = (LAS unsigned*)(F.lds);
    LAS u32x4* IQL = (LAS u32x4*)(F.lds + 16384);
    LAS float* IWL = (LAS float*)(F.lds + 16384 + 1024);
    LAS int* LIST = (LAS int*)(F.lds + 20480);
    LAS int* CNT = (LAS int*)(F.lds + 20480 + 1024);
    LAS float* PL = (LAS float*)(F.lds + 24576);
    const bf16* IQ = WSP(bf16, WS_IQ); const bf16* IK = WSP(bf16, WS_IK); const float* IW = WSP(float, SM_IW);
    if (tid < 64) IQL[tid] = ((const u32x4*)(IQ + (size_t)m * 512))[tid];
    if (tid < 8) IWL[tid] = IW[(size_t)m * 8 + tid];
    __syncthreads();
    for (int s = tid; s < n; s += 512) {
        const u32x4* kp = (const u32x4*)(IK + (size_t)(b * SEQ + s) * 64);
        u32x4 kv[8];
#pragma unroll
        for (int c = 0; c < 8; ++c) kv[c] = kp[c];
        float sc = 0.f;
#pragma unroll
        for (int h = 0; h < 8; ++h) { float d = 0.f;
#pragma unroll
            for (int c = 0; c < 8; ++c) d = dot8(kv[c], IQL[h * 8 + c], d);
            sc += IWL[h] * fmaxf(d, 0.f); }
        KEY[s] = okey(sc);
    }
    __syncthreads();
    const bool all = (n <= 256);
    unsigned thr = 0u; int need_ties = 0;
    if (!all) {
        unsigned myk[8];
#pragma unroll
        for (int i = 0; i < 8; ++i) { const int s = tid + 512 * i; myk[i] = s < n ? KEY[s] : 0u; }
        unsigned prefix = 0u;
        for (int bit = 31; bit >= 0; --bit) {
            const unsigned cand = prefix | (1u << bit);
            int c = 0;
#pragma unroll
            for (int i = 0; i < 8; ++i) c += (myk[i] >= cand) ? 1 : 0;
            c = wave_sum_i(c);
            if (lane == 0) CNT[(bit & 1) * 8 + wave] = c;
            __syncthreads();
            int tot = 0;
#pragma unroll
            for (int w = 0; w < 8; ++w) tot += CNT[(bit & 1) * 8 + w];
            if (tot >= 256) prefix = cand;
        }
        thr = prefix;
        int c = 0;
#pragma unroll
        for (int i = 0; i < 8; ++i) c += (myk[i] > thr) ? 1 : 0;
        c = wave_sum_i(c);
        if (lane == 0) CNT[16 + wave] = c;
        __syncthreads();
        int tot = 0;
#pragma unroll
        for (int w = 0; w < 8; ++w) tot += CNT[16 + w];
        need_ties = 256 - tot;
    }
    if (wave == 0) {
        int pos = 0, ties = 0;
        const unsigned long long lt = (1ull << lane) - 1ull;
        for (int c0 = 0; c0 < n; c0 += 64) {
            const int s = c0 + lane; const bool valid = s < n; const unsigned k = valid ? KEY[s] : 0u;
            const bool gt = valid && (all || k > thr), eq = valid && !all && (k == thr);
            const unsigned long long beq = __ballot(eq); const int tr = ties + __popcll(beq & lt);
            const bool sel = gt || (eq && tr < need_ties);
            const unsigned long long bs = __ballot(sel); const int p = pos + __popcll(bs & lt);
            if (sel) LIST[p] = s;
            if (MASKo && lane == 0) MASKo[((size_t)b * 64 + (c0 >> 6)) * SEQ + t] = bs;
            pos += __popcll(bs); ties += __popcll(beq);
        }
        if (lane == 0) CNT[32] = pos;
    }
    __syncthreads();
    if (!O) return;
    const int nsel = CNT[32];
    const int g = wave >> 1, h0 = 4 * g + 2 * (wave & 1);
    const bf16* Q = WSP(bf16, WS_Q0); const bf16* Kp = WSP(bf16, WS_K0); const bf16* Vp = WSP(bf16, WS_V0);
    u32x4 q0[8], q1[8];
#pragma unroll
    for (int c = 0; c < 8; ++c) { q0[c] = ((const u32x4*)(Q + (size_t)m * 1024 + h0 * 64))[c]; q1[c] = ((const u32x4*)(Q + (size_t)m * 1024 + (h0 + 1) * 64))[c]; }
    float s0[4], s1[4]; float mx0 = -INFINITY, mx1 = -INFINITY;
#pragma unroll
    for (int i = 0; i < 4; ++i) { const int j = lane + 64 * i; s0[i] = -INFINITY; s1[i] = -INFINITY;
        if (j < nsel) { const int s = LIST[j]; const u32x4* kp = (const u32x4*)(Kp + (size_t)(b * SEQ + s) * 256 + g * 64); float d0 = 0.f, d1 = 0.f;
#pragma unroll
            for (int c = 0; c < 8; ++c) { const u32x4 kk = kp[c]; d0 = dot8(kk, q0[c], d0); d1 = dot8(kk, q1[c], d1); }
            s0[i] = d0; s1[i] = d1; }
        mx0 = fmaxf(mx0, s0[i]); mx1 = fmaxf(mx1, s1[i]); }
    mx0 = wave_max(mx0); mx1 = wave_max(mx1);
    float l0 = 0.f, l1 = 0.f;
    LAS float* P0 = PL + (wave * 2 + 0) * 256; LAS float* P1 = PL + (wave * 2 + 1) * 256;
#pragma unroll
    for (int i = 0; i < 4; ++i) { const int j = lane + 64 * i; const float p0 = (j < nsel) ? __builtin_amdgcn_exp2f(s0[i] - mx0) : 0.f, p1 = (j < nsel) ? __builtin_amdgcn_exp2f(s1[i] - mx1) : 0.f;
        l0 += p0; l1 += p1; P0[j] = bfround(p0); P1[j] = bfround(p1); }
    l0 = wave_sum(l0); l1 = wave_sum(l1);
    float a0 = 0.f, a1 = 0.f;
    for (int j = 0; j < nsel; ++j) { const int s = LIST[j]; const float v = bf2f(Vp[(size_t)(b * SEQ + s) * 256 + g * 64 + lane]); a0 += P0[j] * v; a1 += P1[j] * v; }
    O[(size_t)m * 1024 + h0 * 64 + lane] = (bf16)f2bf(a0 / l0); O[(size_t)m * 1024 + (h0 + 1) * 64 + lane] = (bf16)f2bf(a1 / l1);
    __syncthreads();
}

__device__ __forceinline__ void nsa_naive_item(Frame& F, int m, bf16* O  , float* OCG  , unsigned long long* SELo  ) {
    const int lane = F.lane, wave = F.wave;
    const int b = m >> 12, t = m & 4095, jt = t >> 6;
    const int g = wave >> 1, h0 = 4 * g + 2 * (wave & 1);
    LAS float* PC = (LAS float*)(F.lds);
    LAS float* SC0 = (LAS float*)(F.lds + 16384) + (wave * 2 + 0) * 1024;
    LAS float* SC1 = SC0 + 1024;
    LAS unsigned long long* SEL = (LAS unsigned long long*)(F.lds + 16384 + 65536);
    const bf16* Q = WSP(bf16, WS_Q1);
    u32x4 q0[8], q1[8];
#pragma unroll
    for (int c = 0; c < 8; ++c) { q0[c] = ((const u32x4*)(Q + (size_t)m * 1024 + h0 * 64))[c]; q1[c] = ((const u32x4*)(Q + (size_t)m * 1024 + (h0 + 1) * 64))[c]; }
    const int nv = t >= 31 ? min(255, (t - 31) / 16 + 1) : 0;
    const bf16* KC = WSP(bf16, SM_KC) + (size_t)(b * 4 + g) * 256 * 64; const bf16* VC = WSP(bf16, SM_VC) + (size_t)(b * 4 + g) * 256 * 64;
    float oc0 = 0.f, oc1 = 0.f;
    {
        float s0[4], s1[4]; float mx0 = -INFINITY, mx1 = -INFINITY;
#pragma unroll
        for (int i = 0; i < 4; ++i) { const int n = lane + 64 * i; s0[i] = -INFINITY; s1[i] = -INFINITY;
            if (n < nv) { const u32x4* kp = (const u32x4*)(KC + (size_t)n * 64); float d0 = 0.f, d1 = 0.f;
#pragma unroll
                for (int c = 0; c < 8; ++c) { const u32x4 kk = kp[c]; d0 = dot8(kk, q0[c], d0); d1 = dot8(kk, q1[c], d1); }
                s0[i] = d0; s1[i] = d1; }
            mx0 = fmaxf(mx0, s0[i]); mx1 = fmaxf(mx1, s1[i]); }
        mx0 = wave_max(mx0); mx1 = wave_max(mx1);
        float p0[4], p1[4], l0 = 0.f, l1 = 0.f;
#pragma unroll
        for (int i = 0; i < 4; ++i) { const int n = lane + 64 * i; p0[i] = (n < nv) ? __builtin_amdgcn_exp2f(s0[i] - mx0) : 0.f; p1[i] = (n < nv) ? __builtin_amdgcn_exp2f(s1[i] - mx1) : 0.f; l0 += p0[i]; l1 += p1[i]; }
        l0 = wave_sum(l0); l1 = wave_sum(l1);
        const float r0 = nv > 0 ? 1.0f / l0 : 0.f, r1 = nv > 0 ? 1.0f / l1 : 0.f;
#pragma unroll
        for (int i = 0; i < 4; ++i) { const int n = lane + 64 * i; PC[h0 * 256 + n] = p0[i] * r0; PC[(h0 + 1) * 256 + n] = p1[i] * r1; SC0[n] = bfround(p0[i]); SC1[n] = bfround(p1[i]); }
        for (int n = 0; n < nv; ++n) { const float v = bf2f(VC[(size_t)n * 64 + lane]); oc0 += SC0[n] * v; oc1 += SC1[n] * v; }
        oc0 *= r0; oc1 *= r1;
    }
    __syncthreads();
    if ((wave & 1) == 0) {
        const int j = lane;
        auto P4 = [&](int n) -> float { return (PC[(4 * g) * 256 + n] + PC[(4 * g + 1) * 256 + n]) + (PC[(4 * g + 2) * 256 + n] + PC[(4 * g + 3) * 256 + n]); };
        float imp = P4(4 * j) + P4(4 * j + 1) + P4(4 * j + 2) + 0.5f * P4(4 * j + 3);
        if (j > 0) imp += 0.5f * P4(4 * j - 1);
        const bool valid = j <= jt, forced = (j == 0) || (j == jt) || (j + 1 == jt);
        const float val = valid ? (forced ? 1e30f : imp) : -1e30f;
        int rank = 0;
        for (int jj = 0; jj < 64; ++jj) { const float vj = __shfl(val, jj); rank += ((vj > val) || (vj == val && jj < j)) ? 1 : 0; }
        const unsigned long long mk = __ballot(rank < 16);
        if (lane == 0) { SEL[g] = mk; if (SELo) SELo[((size_t)b * 4 + g) * SEQ + t] = mk; }
    }
    __syncthreads();
    const float* gt = WSP(float, SM_GATES) + (size_t)m * 48;
    if (OCG) { OCG[(size_t)m * 1024 + h0 * 64 + lane] = gt[h0 * 3] * oc0; OCG[(size_t)m * 1024 + (h0 + 1) * 64 + lane] = gt[h0 * 3 + 3] * oc1; }
    if (!O) return;
    float os0 = 0.f, os1 = 0.f;
    {
        unsigned long long mk = SEL[g]; if (jt < 63) mk &= ((1ull << (jt + 1)) - 1ull);
        const bf16* Ks = WSP(bf16, WS_KSLC); const bf16* Vs = WSP(bf16, WS_VSLC);
        int cnt = 0; float mx0 = -INFINITY, mx1 = -INFINITY;
        for (unsigned long long r = mk; r; r &= r - 1ull) { const int j = __builtin_ctzll(r); const int tok = 64 * j + lane;
            float d0 = -INFINITY, d1 = -INFINITY;
            if (tok <= t) { const u32x4* kp = (const u32x4*)(Ks + (size_t)(b * SEQ + tok) * 256 + g * 64); d0 = 0.f; d1 = 0.f;
#pragma unroll
                for (int c = 0; c < 8; ++c) { const u32x4 kk = kp[c]; d0 = dot8(kk, q0[c], d0); d1 = dot8(kk, q1[c], d1); } }
            SC0[cnt * 64 + lane] = d0; SC1[cnt * 64 + lane] = d1; mx0 = fmaxf(mx0, d0); mx1 = fmaxf(mx1, d1); ++cnt; }
        mx0 = wave_max(mx0); mx1 = wave_max(mx1);
        float l0 = 0.f, l1 = 0.f;
        for (int i = lane; i < cnt * 64; i += 64) { const float p0 = __builtin_amdgcn_exp2f(SC0[i] - mx0), p1 = __builtin_amdgcn_exp2f(SC1[i] - mx1); l0 += p0; l1 += p1; SC0[i] = bfround(p0); SC1[i] = bfround(p1); }
        l0 = wave_sum(l0); l1 = wave_sum(l1);
        cnt = 0;
        for (unsigned long long r = mk; r; r &= r - 1ull) { const int j = __builtin_ctzll(r);
            const int kmax = min(64, t - 64 * j + 1);
            for (int kk = 0; kk < kmax; ++kk) { const float v = bf2f(Vs[(size_t)(b * SEQ + 64 * j + kk) * 256 + g * 64 + lane]); os0 += SC0[cnt * 64 + kk] * v; os1 += SC1[cnt * 64 + kk] * v; }
            ++cnt; }
        os0 /= l0; os1 /= l1;
    }
    float ow0 = 0.f, ow1 = 0.f;
    {
        const bf16* Kw = WSP(bf16, WS_KWIN); const bf16* Vw = WSP(bf16, WS_VWIN);
        const int slo = max(0, t - 511), nw = t - slo + 1;
        float mx0 = -INFINITY, mx1 = -INFINITY;
        for (int i = lane; i < nw; i += 64) { const u32x4* kp = (const u32x4*)(Kw + (size_t)(b * SEQ + slo + i) * 256 + g * 64); float d0 = 0.f, d1 = 0.f;
#pragma unroll
            for (int c = 0; c < 8; ++c) { const u32x4 kk = kp[c]; d0 = dot8(kk, q0[c], d0); d1 = dot8(kk, q1[c], d1); }
            SC0[i] = d0; SC1[i] = d1; mx0 = fmaxf(mx0, d0); mx1 = fmaxf(mx1, d1); }
        mx0 = wave_max(mx0); mx1 = wave_max(mx1);
        float l0 = 0.f, l1 = 0.f;
        for (int i = lane; i < nw; i += 64) { const float p0 = __builtin_amdgcn_exp2f(SC0[i] - mx0), p1 = __builtin_amdgcn_exp2f(SC1[i] - mx1); l0 += p0; l1 += p1; SC0[i] = bfround(p0); SC1[i] = bfround(p1); }
        l0 = wave_sum(l0); l1 = wave_sum(l1);
        for (int i = 0; i < nw; ++i) { const float v = bf2f(Vw[(size_t)(b * SEQ + slo + i) * 256 + g * 64 + lane]); ow0 += SC0[i] * v; ow1 += SC1[i] * v; }
        ow0 /= l0; ow1 /= l1;
    }
    O[(size_t)m * 1024 + h0 * 64 + lane] = (bf16)f2bf(gt[h0 * 3] * oc0 + gt[h0 * 3 + 1] * os0 + gt[h0 * 3 + 2] * ow0);
    O[(size_t)m * 1024 + (h0 + 1) * 64 + lane] = (bf16)f2bf(gt[h0 * 3 + 3] * oc1 + gt[h0 * 3 + 4] * os1 + gt[h0 * 3 + 5] * ow1);
    __syncthreads();
}

namespace fa {
typedef short s16x4 __attribute__((ext_vector_type(4)));
typedef short v4i16_t __attribute__((ext_vector_type(4)));
constexpr int KOFF = 0, VOFF = 16384, XOFF = 32768, OSTOFF = 36864, TOTOFF = 69632;
constexpr float THR = 8.0f;
__device__ __forceinline__ int crow(int r, int hi) { return (r & 3) + 8 * (r >> 2) + 4 * hi; }
typedef float f32x2_t __attribute__((ext_vector_type(2))); typedef __bf16 bf16x2_t __attribute__((ext_vector_type(2)));
__device__ __forceinline__ unsigned cvtpk(float lo, float hi) { f32x2_t v = {lo, hi}; bf16x2_t b = __builtin_convertvector(v, bf16x2_t); return __builtin_bit_cast(unsigned, b); }
struct Ctx { LAS unsigned char* lds; int lane, wid, r32, hi; };

__device__ __forceinline__ void dma_tile(const Ctx& c, const bf16* Kg, const bf16* Vg, int pitch, int t, int buf) {
    const bf16* ks = Kg + (size_t)(64 * t + c.lane) * pitch + c.wid * 8;
    __builtin_amdgcn_global_load_lds((const unsigned*)ks, (LAS unsigned*)(c.lds + KOFF + buf * 8192 + c.wid * 1024), 16, 0, 0);
    const bf16* vs = Vg + (size_t)(64 * t + 16 * (c.wid & 3) + (c.lane >> 2)) * pitch + (c.wid >> 2) * 32 + (c.lane & 3) * 8;
    __builtin_amdgcn_global_load_lds((const unsigned*)vs, (LAS unsigned*)(c.lds + VOFF + buf * 8192 + c.wid * 1024), 16, 0, 0);
}
__device__ __forceinline__ void qk(const Ctx& c, int buf, const f32x16& ci, f32x16& p0, f32x16& p1) {
    const LAS unsigned char* kb = c.lds + KOFF + buf * 8192 + c.hi * 1024 + c.r32 * 16;
    const LAS bf16x8* qs = (const LAS bf16x8*)(c.lds + OSTOFF + c.wid * 4096) + c.lane;
    p0 = ci; p1 = ci;
#pragma unroll
    for (int d0 = 0; d0 < 4; ++d0) {
        const bf16x8 b0 = *(const LAS bf16x8*)(kb + d0 * 2048), b1 = *(const LAS bf16x8*)(kb + d0 * 2048 + 512), q = qs[d0 * 64];
        p0 = __builtin_amdgcn_mfma_f32_32x32x16_bf16(b0, q, p0, 0, 0, 0);
        p1 = __builtin_amdgcn_mfma_f32_32x32x16_bf16(b1, q, p1, 0, 0, 0);
    }
}
__device__ __forceinline__ void park_q(const Ctx& c, const bf16* Qrow  ) {
    LAS bf16x8* qs = (LAS bf16x8*)(c.lds + OSTOFF + c.wid * 4096) + c.lane;
#pragma unroll
    for (int d0 = 0; d0 < 4; ++d0) qs[d0 * 64] = *(const bf16x8*)(Qrow + d0 * 16 + c.hi * 8);
}
__device__ __forceinline__ s16x4 vtr(const LAS unsigned char* p) { return __builtin_bit_cast(s16x4, __builtin_amdgcn_ds_read_tr16_b64_v4i16((LAS v4i16_t*)p)); }
__device__ __forceinline__ void pv(const Ctx& c, int buf, f32x16 (&o)[2], f32x16& lacc, const u32x4 (&pw)[4]) {
    const LAS unsigned char* vp = c.lds + VOFF + buf * 8192 + ((c.lane >> 4) & 1) * 32 + (c.lane & 3) * 8 + (4 * c.hi + ((c.lane & 15) >> 2)) * 64;
    const bf16x8 ones = {(short)0x3F80, (short)0x3F80, (short)0x3F80, (short)0x3F80, (short)0x3F80, (short)0x3F80, (short)0x3F80, (short)0x3F80};
#pragma unroll
    for (int d0 = 0; d0 < 2; ++d0) {
        s16x4 lo[4], hi[4];
#pragma unroll
        for (int ks = 0; ks < 4; ++ks) { lo[ks] = vtr(vp + d0 * 4096 + ks * 1024); hi[ks] = vtr(vp + d0 * 4096 + ks * 1024 + 512); }
#pragma unroll
        for (int ks = 0; ks < 4; ++ks) {
            const bf16x8 vf = {lo[ks][0], lo[ks][1], lo[ks][2], lo[ks][3], hi[ks][0], hi[ks][1], hi[ks][2], hi[ks][3]};
            o[d0] = __builtin_amdgcn_mfma_f32_32x32x16_bf16(__builtin_bit_cast(bf16x8, pw[ks]), vf, o[d0], 0, 0, 0);
        }
        __builtin_amdgcn_sched_barrier(0);
    }
#pragma unroll
    for (int ks = 0; ks < 4; ++ks) lacc = __builtin_amdgcn_mfma_f32_32x32x16_bf16(__builtin_bit_cast(bf16x8, pw[ks]), ones, lacc, 0, 0, 0);
}
struct State { f32x16 o[2]; f32x16 lacc; f32x16 negm; float m; };
__device__ __forceinline__ void reset(State& s) { s.o[0] = f32x16{}; s.o[1] = f32x16{}; s.lacc = f32x16{}; s.negm = f32x16{}; s.m = 0.f; }
__device__ __forceinline__ float rowmax(const f32x16& p0, const f32x16& p1) {
    float a = fmaxf(fmaxf(p0[0], p0[1]), p1[0]), b = fmaxf(fmaxf(p0[2], p0[3]), p1[1]); a = fmaxf(fmaxf(a, p1[2]), p1[3]);
#pragma unroll
    for (int r = 4; r < 16; r += 4) { a = fmaxf(fmaxf(a, p0[r]), p0[r + 1]); b = fmaxf(fmaxf(b, p0[r + 2]), p0[r + 3]); a = fmaxf(fmaxf(a, p1[r]), p1[r + 1]); b = fmaxf(fmaxf(b, p1[r + 2]), p1[r + 3]); }
    const float m = fmaxf(a, b);
    return fmaxf(m, __shfl_xor(m, 32));
}
template <bool BITS>
__device__ __forceinline__ void tile_step(const Ctx& c, int buf, State& s, const f32x16& ci, bool first, unsigned w0, unsigned w1) {
    f32x16 p0, p1;
    qk(c, buf, ci, p0, p1);
    __builtin_amdgcn_sched_barrier(0);
    const float rm = rowmax(p0, p1);
    bool doit; float dl;
    if (first) { doit = true; dl = rm; } else { doit = __any(rm > THR); dl = fmaxf(rm, 0.f); }
    if (doit) {
        s.m += dl;
#pragma unroll
        for (int r = 0; r < 16; ++r) { p0[r] -= dl; p1[r] -= dl; s.negm[r] = -s.m; }
        if (!first) {
            const float f = __builtin_amdgcn_exp2f(-dl);
            LAS float* xs = (LAS float*)(c.lds + XOFF) + c.wid * 64;
            if (c.hi == 0) xs[c.r32] = f;
#pragma unroll
            for (int r = 0; r < 16; ++r) { const float fr = xs[crow(r, c.hi)]; s.o[0][r] *= fr; s.o[1][r] *= fr; s.lacc[r] *= fr; }
        }
    }
    if (BITS) { w0 >>= 4 * c.hi; w1 >>= 4 * c.hi; }
#pragma unroll
    for (int r = 0; r < 16; ++r) {
        float e0 = __builtin_amdgcn_exp2f(p0[r]), e1 = __builtin_amdgcn_exp2f(p1[r]);
        if (BITS) { const int sh = (r & 3) + 8 * (r >> 2);
            e0 = __builtin_bit_cast(float, __builtin_bit_cast(unsigned, e0) & (unsigned)__builtin_amdgcn_sbfe((int)w0, sh, 1));
            e1 = __builtin_bit_cast(float, __builtin_bit_cast(unsigned, e1) & (unsigned)__builtin_amdgcn_sbfe((int)w1, sh, 1)); }
        p0[r] = e0; p1[r] = e1;
    }
    u32x4 pw[4];
    pw[0] = (u32x4){cvtpk(p0[0], p0[1]), cvtpk(p0[2], p0[3]), cvtpk(p0[4], p0[5]), cvtpk(p0[6], p0[7])};
    pw[1] = (u32x4){cvtpk(p0[8], p0[9]), cvtpk(p0[10], p0[11]), cvtpk(p0[12], p0[13]), cvtpk(p0[14], p0[15])};
    pw[2] = (u32x4){cvtpk(p1[0], p1[1]), cvtpk(p1[2], p1[3]), cvtpk(p1[4], p1[5]), cvtpk(p1[6], p1[7])};
    pw[3] = (u32x4){cvtpk(p1[8], p1[9]), cvtpk(p1[10], p1[11]), cvtpk(p1[12], p1[13]), cvtpk(p1[14], p1[15])};
    __builtin_amdgcn_sched_barrier(0);
    pv(c, buf, s.o, s.lacc, pw);
}
__device__ __forceinline__ void causal_words(int qi, unsigned& w0, unsigned& w1) { const unsigned long long w = (qi >= 63) ? ~0ull : ((2ull << qi) - 1ull); w0 = (unsigned)w; w1 = (unsigned)(w >> 32); }
__device__ __forceinline__ void store_o(const Ctx& c, const f32x16 (&val)[2], bf16* Ow  ) {
    LAS bf16* stg = (LAS bf16*)(c.lds + OSTOFF) + c.wid * 2048;
#pragma unroll
    for (int r = 0; r < 16; ++r) { const int orow = crow(r, c.hi);
#pragma unroll
        for (int d0 = 0; d0 < 2; ++d0) stg[orow * 64 + d0 * 32 + c.r32] = (bf16)f2bf(val[d0][r]); }
#pragma unroll
    for (int i = 0; i < 4; ++i) { const int row = i * 8 + (c.lane >> 3), ch = c.lane & 7; const u32x4 v = *(const LAS u32x4*)(stg + row * 64 + ch * 8); *(u32x4*)(Ow + (size_t)row * 1024 + ch * 8) = v; }
}

__device__ __forceinline__ void dsa_unit(Frame& F, int b, int g, int qt) {
    Ctx c; c.lds = F.lds; c.lane = F.lane; c.wid = F.wave; c.r32 = F.lane & 31; c.hi = F.lane >> 5;
    const int h = 4 * g + (c.wid >> 1), qw = 64 * qt + 32 * (c.wid & 1);
    const size_t mrow = (size_t)b * SEQ + qw;
    const bf16* Q = WSP(bf16, WS_Q0) + (mrow + c.r32) * 1024 + h * 64;
    park_q(c, Q);
    const bf16* Kg = WSP(bf16, WS_K0) + (size_t)b * SEQ * 256 + g * 64; const bf16* Vg = WSP(bf16, WS_V0) + (size_t)b * SEQ * 256 + g * 64;
    const u32x2* MK = (const u32x2*)(WSP(unsigned long long, WS_MASK) + (size_t)b * 64 * SEQ + qw + c.r32);
    State s; reset(s);
    const int NT = qt + 1;
    dma_tile(c, Kg, Vg, 256, 0, 0);
    u32x2 mk_next = MK[0];
    __syncthreads();
    for (int t = 0; t < NT; ++t) {
        const u32x2 mk = mk_next;
        if (t + 1 < NT) { dma_tile(c, Kg, Vg, 256, t + 1, (t + 1) & 1); mk_next = MK[(size_t)(t + 1) * SEQ]; }
        tile_step<true>(c, t & 1, s, s.negm, t == 0, mk.x, mk.y);
        __syncthreads();
    }
    f32x16 val[2];
#pragma unroll
    for (int r = 0; r < 16; ++r) { const float rl = s.lacc[r] > 0.f ? 1.0f / s.lacc[r] : 0.f; val[0][r] = s.o[0][r] * rl; val[1][r] = s.o[1][r] * rl; }
    store_o(c, val, LWSP(bf16, WS_O0) + mrow * 1024 + h * 64);
}

__device__ __forceinline__ void nsa_unit(Frame& F, int b, int g, int qt) {
    Ctx c; c.lds = F.lds; c.lane = F.lane; c.wid = F.wave; c.r32 = F.lane & 31; c.hi = F.lane >> 5;
    const int h = 4 * g + (c.wid >> 1), qw = 64 * qt + 32 * (c.wid & 1), qi = 32 * (c.wid & 1) + c.r32;
    const size_t mrow = (size_t)b * SEQ + qw;
    park_q(c, WSP(bf16, WS_Q1) + (mrow + c.r32) * 1024 + h * 64);
    const unsigned long long sel = WSP(unsigned long long, WS_SEL)[((size_t)b * 4 + g) * SEQ + qw + c.r32];
    LAS float* gx = (LAS float*)(c.lds + XOFF + 2048) + c.wid * 64;
    gx[c.lane] = WSP(float, SM_GATES)[(mrow + c.r32) * 48 + h * 3 + 1 + c.hi];
    LAS float* totw = (LAS float*)(c.lds + TOTOFF) + c.wid * 2048;
    LAS float* totl = totw + c.r32;
    State s;
    {
        const bf16* Kg = WSP(bf16, WS_KSLC) + (size_t)b * SEQ * 256 + g * 64; const bf16* Vg = WSP(bf16, WS_VSLC) + (size_t)b * SEQ * 256 + g * 64;
        reset(s);
        dma_tile(c, Kg, Vg, 256, 0, 0);
        __syncthreads();
        for (int t = 0; t <= qt; ++t) {
            if (t < qt) dma_tile(c, Kg, Vg, 256, t + 1, (t + 1) & 1);
            const bool on = (sel >> t) & 1ull;
            if (!on) {
#pragma unroll
                for (int r = 0; r < 16; ++r) s.negm[r] = -INFINITY; }
            if (t == qt) { unsigned w0, w1; causal_words(qi, w0, w1); tile_step<true>(c, t & 1, s, s.negm, t == 0, w0, w1); }
            else tile_step<false>(c, t & 1, s, s.negm, t == 0, 0u, 0u);
#pragma unroll
            for (int r = 0; r < 16; ++r) s.negm[r] = -s.m;
            __syncthreads();
        }
#pragma unroll
        for (int r = 0; r < 16; ++r) { const float gq = gx[crow(r, c.hi)]; const float rl = s.lacc[r] > 0.f ? gq / s.lacc[r] : 0.f; totl[crow(r, c.hi) * 64] = s.o[0][r] * rl; totl[crow(r, c.hi) * 64 + 32] = s.o[1][r] * rl; }
    }
    {
        const bf16* Kg = LWSP(bf16, WS_KWIN) + (size_t)b * SEQ * 256 + g * 64; const bf16* Vg = LWSP(bf16, WS_VWIN) + (size_t)b * SEQ * 256 + g * 64;
        reset(s);
        const int tlo = qt >= 8 ? qt - 8 : 0;
        dma_tile(c, Kg, Vg, 256, tlo, tlo & 1);
        __syncthreads();
        for (int t = tlo; t <= qt; ++t) {
            if (t < qt) dma_tile(c, Kg, Vg, 256, t + 1, (t + 1) & 1);
            if (t == qt) { unsigned w0, w1; causal_words(qi, w0, w1); tile_step<true>(c, t & 1, s, s.negm, t == tlo, w0, w1); }
            else if (t == qt - 8) { unsigned w0, w1; causal_words(qi, w0, w1); tile_step<true>(c, t & 1, s, s.negm, t == tlo, ~w0, ~w1); }
            else tile_step<false>(c, t & 1, s, s.negm, t == tlo, 0u, 0u);
            __syncthreads();
        }
#pragma unroll
        for (int r = 0; r < 16; ++r) { const float gq = gx[32 + crow(r, c.hi)]; const float rl = s.lacc[r] > 0.f ? gq / s.lacc[r] : 0.f; totl[crow(r, c.hi) * 64] += s.o[0][r] * rl; totl[crow(r, c.hi) * 64 + 32] += s.o[1][r] * rl; }
    }
    const float* OCG = LWSP(float, WS_OCG) + mrow * 1024 + h * 64; bf16* O = LWSP(bf16, WS_O1) + mrow * 1024 + h * 64;
#pragma unroll
    for (int i = 0; i < 8; ++i) { const int row = i * 4 + (c.lane >> 4), ch = c.lane & 15;
        const f32x4 v = *(const LAS f32x4*)(totw + row * 64 + 4 * ch) + *(const f32x4*)(OCG + (size_t)row * 1024 + 4 * ch);
        u32x2 w; w.x = pk2(v.x, v.y); w.y = pk2(v.z, v.w); *(u32x2*)(O + (size_t)row * 1024 + 4 * ch) = w; }
}
__device__ __forceinline__ void unit_of(int v, int i, int& b, int& g, int& qt) { const int bg = v >> 4, p = v & 15; b = bg >> 2; g = bg & 3; qt = (i == 0) ? p : (i == 1) ? 63 - p : (i == 2) ? 31 - p : 32 + p; }
}

constexpr int NPHASE = 21;
struct Args { const void* in[29]; float* out; unsigned char* ws; int ph_lo, ph_hi, li, pad; };
__global__ void __launch_bounds__(NWAVES * 64, 2) trunk_fwd(Args args) {
    extern __shared__ __attribute__((aligned(16))) unsigned char lds[];
    Frame F;
    F.lds = (LAS unsigned char*)lds;
    F.MISC = (volatile LAS unsigned*)(F.lds + MISC_OFF);
    F.tid = threadIdx.x; F.lane = F.tid & 63; F.wave = __builtin_amdgcn_readfirstlane(F.tid >> 6);
    F.G = gridDim.x; F.gw = blockIdx.x * NWAVES + F.wave; F.NGW = F.G * NWAVES;
    F.ws = args.ws; F.ctl = (unsigned*)(args.ws + WS_CTL);
    F.x = (const float*)args.in[0]; F.c = (const float*)args.in[1]; F.pos = (const int*)args.in[2];
    F.attn_gain = (const float*)args.in[3]; F.ffn_gain = (const float*)args.in[4]; F.w_ada = (const float*)args.in[5]; F.b_ada = (const float*)args.in[6];
    F.a_w_in = (const float*)args.in[7]; F.a_w_out = (const float*)args.in[8]; F.b_w_q = (const float*)args.in[9]; F.b_w_out = (const float*)args.in[10];
    F.kv_gain = (const float*)args.in[11]; F.w_kv_ada = (const float*)args.in[12]; F.b_kv_ada = (const float*)args.in[13]; F.w_kv = (const float*)args.in[14];
    F.pe_k = (const float*)args.in[15]; F.w1_k = (const float*)args.in[16]; F.w2_k = (const float*)args.in[17]; F.pe_v = (const float*)args.in[18]; F.w1_v = (const float*)args.in[19]; F.w2_v = (const float*)args.in[20];
    F.ffn_wg = (const float*)args.in[21]; F.ffn_wu = (const float*)args.in[22]; F.ffn_wd = (const float*)args.in[23]; F.w_router = (const float*)args.in[24];
    F.moe_wg = (const float*)args.in[25]; F.moe_wu = (const float*)args.in[26]; F.moe_wd = (const float*)args.in[27]; F.final_gain = (const float*)args.in[28];
    F.out = args.out;
    for (int u = F.tid; u < (LDS_BYTES - LDSCTL_OFF) / 4; u += NWAVES * 64) ((LAS unsigned*)(F.lds + LDSCTL_OFF))[u] = 0u;
    __syncthreads();
    XcdBarrier bar; bar.bar = F.ctl + CW_BAR; bar.x = 0; bar.st = nullptr;
    if (!MK_PER_PHASE) bar = xcd_barrier_post(F.ctl + CW_BAR, F.MISC + 8);
#define GRID_BAR() do { if (!MK_PER_PHASE) xcd_barrier(bar); } while (0)
    const int lo = args.ph_lo, hi = args.ph_hi;
#define IN(k) (lo <= (k) && (k) < hi)
#define BOTH(k) (IN(k) && IN((k) + 1))
    const float* MOD0 = WSP(float, SM_MOD0); const float* MOD1 = WSP(float, SM_MOD1); const float* KVMOD = WSP(float, SM_KVMOD);
    const float* CS = WSP(float, SM_COS); const float* SN = WSP(float, SM_SIN);

    if (IN(0)) { p0_prologue(F); if (BOTH(0)) GRID_BAR(); }
    if (IN(1)) { norm_phase(F, F.x, F.attn_gain, MOD0, 6144, 0, 1024, WSP(bf16, WS_U)); if (BOTH(1)) GRID_BAR(); }
    if (IN(2)) {
        pg8::Gemm g{WSP(bf16, WS_U), WSP(bf16, WB_IN), D, D, D}; pg8::StaticOrder S; S.init(T, A_INP, F.G, (int)blockIdx.x);
        EpiIn E{WSP(bf16, WS_Q0), WSP(bf16, WS_K0), WSP(bf16, WS_V0), WSP(bf16, WS_IQ), WSP(bf16, WS_IK), WSP(float, SM_IW), CS, SN};
        pg8::gemm_phase(F.lds, g, S, E);
        if (BOTH(2)) GRID_BAR();
    }
    if (IN(3)) { for (int m = blockIdx.x; m < T; m += F.G) dsa_naive_item(F, m, nullptr, WSP(unsigned long long, WS_MASK)); if (BOTH(3)) GRID_BAR(); }
    if (IN(4)) {
        const int v = (F.G == 256) ? ((int)(blockIdx.x & 7) * 32 + (int)(blockIdx.x >> 3)) : (int)blockIdx.x;
        for (int vv = v; vv < 256; vv += F.G) for (int i = 0; i < 4; ++i) { int b, g, qt; fa::unit_of(vv, i, b, g, qt); fa::dsa_unit(F, b, g, qt); }
        if (BOTH(4)) GRID_BAR(); }
    if (IN(5)) {
        pg8::Gemm g{WSP(bf16, WS_O0), WSP(bf16, WB_O0), D, D, D}; pg8::StaticOrder S; S.init(T, D, F.G, (int)blockIdx.x);
        EpiRes E{F.x, F.out, MOD0 + 2048, 6144};
        pg8::gemm_phase(F.lds, g, S, E);
        if (BOTH(5)) GRID_BAR();
    }
    if (IN(6)) {
        norm_phase(F, F.out, F.ffn_gain, MOD0, 6144, 3072, 4096, WSP(bf16, WS_U));
        { LAS float* scr = (LAS float*)(F.lds + F.wave * 16384); for (int it = F.gw; it < NCONV_B; it += F.NGW) conv_item_b(F, it, scr); }
        if (BOTH(6)) GRID_BAR();
    }
    if (IN(7)) {
        pg8::Gemm g{WSP(bf16, WS_U), WSP(bf16, WB_GU0), D, D, D}; pg8::StaticOrder S; S.init(T, 2 * FF0, F.G, (int)blockIdx.x);
        EpiSwiglu E{WSP(bf16, WS_HID), FF0, 2 * FF0 / 256};
        pg8::gemm_phase(F.lds, g, S, E);
        if (BOTH(7)) GRID_BAR();
    }
    if (IN(8)) {
        pg8::Gemm g{WSP(bf16, WS_HID), WSP(bf16, WB_D0), FF0, FF0, FF0}; pg8::StaticOrder S; S.init(T, D, F.G, (int)blockIdx.x);
        EpiRes E{F.out, F.out, MOD0 + 5120, 6144};
        pg8::gemm_phase(F.lds, g, S, E);
        if (BOTH(8)) GRID_BAR();
    }
    if (IN(9)) {
        for (int m = F.gw; m < T; m += F.NGW) {
            f32x4 v[4], u[4]; load_row(F.out + (size_t)m * D, F.lane, v);
            const float r = row_rs(v); const int b = m >> 12;
            modulate_row(v, r, F.kv_gain, KVMOD + (size_t)b * 2048, KVMOD + (size_t)b * 2048 + 1024, F.lane, u);
            store_row_bf16(WSP(bf16, WS_U) + (size_t)m * D, F.lane, u);
            modulate_row(v, r, F.attn_gain + D, MOD1 + (size_t)b * 6144, MOD1 + (size_t)b * 6144 + 1024, F.lane, u);
            store_row_bf16(WSP(bf16, WS_U2) + (size_t)m * D, F.lane, u);
        }
        if (BOTH(9)) GRID_BAR();
    }
    if (IN(10)) {
        pg8::Gemm g{WSP(bf16, WS_U), WSP(bf16, WB_KVQ), D, D, D}; KvqOrder S; S.S.init(T, 11 * 256, F.G, (int)blockIdx.x);
        EpiKVQ E{WSP(bf16, WS_KCMP), WSP(bf16, WS_VCMP), WSP(bf16, WS_KSLC), WSP(bf16, WS_VSLC), WSP(bf16, WS_KWIN), WSP(bf16, WS_VWIN), WSP(bf16, WS_Q1), WSP(float, SM_GATES), CS, SN};
        pg8::gemm_phase(F.lds, g, S, E);
        if (BOTH(10)) GRID_BAR();
    }
    if (IN(11)) {
        const float* cb = WSP(float, SM_CBIAS); bf16* CH = WSP(bf16, WS_CH);
        for (int it = F.gw; it < 256 * 8; it += F.NGW) {
            const int rt = it >> 3, ct = it & 7, kv = rt >> 7;
            const bf16* A = kv ? WSP(bf16, WS_VCMP) : WSP(bf16, WS_KCMP);
            const f32x16 acc = sgemm_tile(A, 1024, WSP(bf16, WB_C1) + (size_t)kv * 256 * 2048, 2048, 2048, (rt & 127) * 32, ct * 32, F.lane);
            const int col = ct * 32 + (F.lane & 31); const float bias = cb[kv * 256 + col];
#pragma unroll
            for (int r = 0; r < 16; ++r) { const int row = rt * 32 + (r & 3) + 8 * (r >> 2) + 4 * (F.lane >> 5); CH[(size_t)row * 256 + col] = (bf16)f2bf(gelu_tanh(acc[r] + bias)); }
        }
        if (BOTH(11)) GRID_BAR();
    }
    if (IN(12)) {
        const bf16* CH = WSP(bf16, WS_CH);
        for (int it = F.gw; it < 256 * 2; it += F.NGW) {
            const int rt = it >> 1, ct = it & 1, kv = rt >> 7;
            const f32x16 acc = sgemm_tile(CH, 256, WSP(bf16, WB_C2) + (size_t)kv * 64 * 256, 256, 256, rt * 32, ct * 32, F.lane);
            bf16* dst = kv ? WSP(bf16, SM_VC) : WSP(bf16, SM_KC);
            const int col = ct * 32 + (F.lane & 31);
#pragma unroll
            for (int r = 0; r < 16; ++r) { const int row = (rt & 127) * 32 + (r & 3) + 8 * (r >> 2) + 4 * (F.lane >> 5); dst[(size_t)row * 64 + col] = (bf16)f2bf(acc[r]); }
        }
        if (BOTH(12)) GRID_BAR();
    }
    if (IN(13)) { for (int m = blockIdx.x; m < T; m += F.G) nsa_naive_item(F, m, nullptr, WSP(float, WS_OCG), WSP(unsigned long long, WS_SEL)); if (BOTH(13)) GRID_BAR(); }
    if (IN(14)) {
        const int v = (F.G == 256) ? ((int)(blockIdx.x & 7) * 32 + (int)(blockIdx.x >> 3)) : (int)blockIdx.x;
        for (int vv = v; vv < 256; vv += F.G) for (int i = 0; i < 4; ++i) { int b, g, qt; fa::unit_of(vv, i, b, g, qt); fa::nsa_unit(F, b, g, qt); }
        if (BOTH(14)) GRID_BAR(); }
    if (IN(15)) {
        pg8::Gemm g{WSP(bf16, WS_O1), WSP(bf16, WB_O1), D, D, D}; pg8::StaticOrder S; S.init(T, D, F.G, (int)blockIdx.x);
        EpiRes E{F.out, F.out, MOD1 + 2048, 6144};
        pg8::gemm_phase(F.lds, g, S, E);
        if (BOTH(15)) GRID_BAR();
    }
    if (IN(16)) {
        LAS int* lcnt = (LAS int*)(F.lds);
        if (F.tid < NE) lcnt[F.tid] = 0;
        __syncthreads();
        int* toke = WSP(int, SM_TOKE); float* tokw = WSP(float, SM_TOKW);
        for (int m = F.gw; m < T; m += F.NGW) {
            f32x4 v[4], u[4]; load_row(F.out + (size_t)m * D, F.lane, v);
            const float r = row_rs(v); const int b = m >> 12;
            modulate_row(v, r, F.ffn_gain + D, MOD1 + (size_t)b * 6144 + 3072, MOD1 + (size_t)b * 6144 + 4096, F.lane, u);
            store_row_bf16(WSP(bf16, WS_UM) + (size_t)m * D, F.lane, u);
            float lg[NE];
#pragma unroll
            for (int e = 0; e < NE; ++e) lg[e] = 0.f;
#pragma unroll
            for (int j = 0; j < 4; ++j) {
                const float uu[4] = {u[j].x, u[j].y, u[j].z, u[j].w};
#pragma unroll
                for (int q = 0; q < 4; ++q) { const float* wr = F.w_router + (size_t)(4 * F.lane + 256 * j + q) * NE; const f32x4 w0 = *(const f32x4*)wr, w1 = *(const f32x4*)(wr + 4);
                    lg[0] += uu[q] * w0.x; lg[1] += uu[q] * w0.y; lg[2] += uu[q] * w0.z; lg[3] += uu[q] * w0.w; lg[4] += uu[q] * w1.x; lg[5] += uu[q] * w1.y; lg[6] += uu[q] * w1.z; lg[7] += uu[q] * w1.w; }
            }
#pragma unroll
            for (int e = 0; e < NE; ++e) lg[e] = wave_sum(lg[e]);
            int e1 = 0; float v1 = lg[0];
#pragma unroll
            for (int e = 1; e < NE; ++e) if (lg[e] > v1) { v1 = lg[e]; e1 = e; }
            int e2 = -1; float v2 = -INFINITY;
#pragma unroll
            for (int e = 0; e < NE; ++e) if (e != e1 && lg[e] > v2) { v2 = lg[e]; e2 = e; }
            if (F.lane == 0) {
                const float ex = __expf(v2 - v1), w1 = 1.0f / (1.0f + ex);
                toke[2 * m] = e1; toke[2 * m + 1] = e2; tokw[2 * m] = w1; tokw[2 * m + 1] = ex * w1;
                lds_add(&lcnt[e1], 1); lds_add(&lcnt[e2], 1);
            }
        }
        __syncthreads();
        if (F.tid < NE) atomicAdd(F.ctl + CW_CNT + F.tid, (unsigned)lcnt[F.tid]);
        if (BOTH(16)) GRID_BAR();
    }
    if (IN(17)) {
        LAS int* lcnt = (LAS int*)(F.lds); LAS int* lbase = lcnt + 8; LAS int* lfill = lcnt + 16;
        const int* toke = WSP(int, SM_TOKE); int* slot = WSP(int, SM_SLOT);
        const int rows_per = T / F.G, r0 = blockIdx.x * rows_per;
        if (F.tid < NE) { lcnt[F.tid] = 0; lfill[F.tid] = 0; }
        __syncthreads();
        for (int i = F.tid; i < 2 * rows_per; i += 512) lds_add(&lcnt[toke[2 * r0 + i]], 1);
        __syncthreads();
        if (F.tid < NE) {
            int off = 0; for (int e = 0; e < F.tid; ++e) off += (int)((ld_u32(F.ctl + CW_CNT + e) + 255u) >> 8) * 256;
            lbase[F.tid] = off + (int)atomicAdd(F.ctl + CW_FILL + F.tid, (unsigned)lcnt[F.tid]);
        }
        __syncthreads();
        const bf16* UM = WSP(bf16, WS_UM); bf16* AG = WSP(bf16, WS_AG);
        for (int i = F.wave; i < 2 * rows_per; i += NWAVES) {
            const int m = r0 + (i >> 1), e = toke[2 * r0 + i];
            int s = 0; if (F.lane == 0) { s = lbase[e] + lds_add(&lfill[e], 1); slot[2 * r0 + i] = s; }
            s = __shfl(s, 0);
            const u32x4* src = (const u32x4*)(UM + (size_t)m * D); u32x4* dst = (u32x4*)(AG + (size_t)s * D);
            dst[F.lane] = src[F.lane]; dst[F.lane + 64] = src[F.lane + 64];
        }
        if (BOTH(17)) GRID_BAR();
    }
    if (IN(18)) {
        pg8::Gemm g{WSP(bf16, WS_AG), WSP(bf16, WS_WGU1), D, D, D}; MoeOrder S; S.init(F.ctl + CW_CNT, 2 * FFE / 256, F.G, (int)blockIdx.x);
        EpiSwiglu E{WSP(bf16, WS_HID2), FFE, 2 * FFE / 256};
        pg8::gemm_phase(F.lds, g, S, E);
        if (BOTH(18)) GRID_BAR();
    }
    if (IN(19)) {
        pg8::Gemm g{WSP(bf16, WS_HID2), WSP(bf16, WS_WD1), FFE, FFE, FFE}; MoeOrder S; S.init(F.ctl + CW_CNT, D / 256, F.G, (int)blockIdx.x);
        EpiY E{WSP(bf16, WS_Y)};
        pg8::gemm_phase(F.lds, g, S, E);
        if (BOTH(19)) GRID_BAR();
    }
    if (IN(20)) {
        const int* slot = WSP(int, SM_SLOT); const float* tokw = WSP(float, SM_TOKW); const bf16* Y = WSP(bf16, WS_Y);
        for (int m = F.gw; m < T; m += F.NGW) {
            f32x4 v[4]; load_row(F.out + (size_t)m * D, F.lane, v);
            const int b = m >> 12; const int s1 = slot[2 * m], s2 = slot[2 * m + 1]; const float w1 = tokw[2 * m], w2 = tokw[2 * m + 1];
            const float* fg = MOD1 + (size_t)b * 6144 + 5120;
#pragma unroll
            for (int j = 0; j < 4; ++j) {
                const u32x2 y1 = ((const u32x2*)(Y + (size_t)s1 * D))[F.lane + 64 * j], y2 = ((const u32x2*)(Y + (size_t)s2 * D))[F.lane + 64 * j];
                const f32x4 gq = ((const f32x4*)fg)[F.lane + 64 * j];
                f32x4 y; y.x = w1 * bflo(y1.x) + w2 * bflo(y2.x); y.y = w1 * bfhi(y1.x) + w2 * bfhi(y2.x); y.z = w1 * bflo(y1.y) + w2 * bflo(y2.y); y.w = w1 * bfhi(y1.y) + w2 * bfhi(y2.y);
                v[j] = v[j] + gq * y;
            }
            const float r = row_rs(v);
#pragma unroll
            for (int j = 0; j < 4; ++j) { const f32x4 gn = ((const f32x4*)F.final_gain)[F.lane + 64 * j]; ((f32x4*)(F.out + (size_t)m * D))[F.lane + 64 * j] = v[j] * r * gn; }
        }
    }
#undef IN
#undef BOTH
}

extern "C" void kernel_launch(void* const* d_in, const int* in_sizes, int n_in, void* d_out, int out_size, void* d_ws, size_t ws_size, hipStream_t stream) {
    static int grid = 0;
    if (grid == 0) {
        if (n_in != 29 || out_size != T * D || ws_size < WS_END) { fprintf(stderr, "kernel_launch: unexpected problem (n_in %d, out %d, ws %zu)\n", n_in, out_size, ws_size); grid = -1; return; }
        int dev = 0, cus = 0, per_cu = 0;
        if (hipGetDevice(&dev) != hipSuccess || hipDeviceGetAttribute(&cus, hipDeviceAttributeMultiprocessorCount, dev) != hipSuccess) { grid = -1; return; }
        if (hipFuncSetAttribute((const void*)trunk_fwd, hipFuncAttributeMaxDynamicSharedMemorySize, LDS_BYTES) != hipSuccess) { fprintf(stderr, "kernel_launch: hipFuncSetAttribute failed\n"); grid = -1; return; }
        if (hipOccupancyMaxActiveBlocksPerMultiprocessor(&per_cu, (const void*)trunk_fwd, NWAVES * 64, LDS_BYTES) != hipSuccess || per_cu < 1) { fprintf(stderr, "kernel_launch: occupancy query says %d\n", per_cu); }
        (void)hipGetLastError();
        grid = cus;
        if (T % grid != 0) { fprintf(stderr, "kernel_launch: grid %d does not divide the token count\n", grid); grid = -1; return; }
    }
    if (grid < 0) return;
    if (hipMemsetAsync((char*)d_ws + WS_CTL, 0, CTL_ZERO_BYTES, stream) != hipSuccess) return;
    Args a{};
    for (int i = 0; i < 29; ++i) a.in[i] = d_in[i];
    a.out = (float*)d_out; a.ws = (unsigned char*)d_ws;
#if MK_PER_PHASE
    for (int p = 0; p < NPHASE; ++p) { a.ph_lo = p; a.ph_hi = p + 1; a.li = p; hipLaunchKernelGGL(trunk_fwd, dim3(grid), dim3(NWAVES * 64), LDS_BYTES, stream, a); }
#else
    a.ph_lo = 0; a.ph_hi = NPHASE; a.li = 0;
    hipLaunchKernelGGL(trunk_fwd, dim3(grid), dim3(NWAVES * 64), LDS_BYTES, stream, a);
#endif
    const hipError_t le = hipPeekAtLastError();
    if (le != hipSuccess) fprintf(stderr, "kernel_launch: launch failed: %s\n", hipGetErrorName(le));
}
```

```cpp
#include <hip/hip_runtime.h>
#include <cstdio>
#include <cstdint>

#ifndef MK_PER_PHASE
#define MK_PER_PHASE 0
#endif

#ifndef DBG_CHECK
#define DBG_CHECK 0
#endif
#define GAS __attribute__((address_space(1)))
#define LAS __attribute__((address_space(3)))
typedef unsigned short bf16;
typedef short bf16x8 __attribute__((ext_vector_type(8)));
typedef float f32x4 __attribute__((ext_vector_type(4)));
typedef float f32x16 __attribute__((ext_vector_type(16)));
typedef unsigned u32x4 __attribute__((ext_vector_type(4)));
typedef unsigned u32x2 __attribute__((ext_vector_type(2)));
typedef GAS unsigned gu32;

constexpr int NB = 4, SEQ = 4096, T = NB * SEQ, D = 1024, NH = 16, HD = 64, NG = 4;
constexpr int A_IN = 2120, A_INP = 2304, FF0 = 2816, FFE = 3584, NE = 8;
constexpr int KVW = 1536, BQ = 1072, BQP = 1280;
constexpr float C2 = 0.125f * 1.4426950408889634f;
constexpr float IWS = 0.04419417382415922f;
constexpr float RMS_EPS = 1e-6f;
constexpr int MPAD = 2 * T + NE * 256;

constexpr size_t MiB = 1u << 20;
constexpr size_t WS_CTL = 0, CTL_ZERO_BYTES = 1 * MiB;
constexpr size_t WS_SMALL = 1 * MiB;
constexpr size_t SM_MOD0 = WS_SMALL, SM_MOD1 = SM_MOD0 + 4 * 6144 * 4, SM_KVMOD = SM_MOD1 + 4 * 6144 * 4, SM_CBIAS = SM_KVMOD + 4 * 2048 * 4;
constexpr size_t SM_COS = 2 * MiB, SM_SIN = 4 * MiB, SM_IW = 6 * MiB, SM_GATES = 7 * MiB, SM_TOKE = 10 * MiB, SM_TOKW = SM_TOKE + 131072, SM_SLOT = SM_TOKW + 131072;
constexpr size_t SM_KC = 11 * MiB, SM_VC = SM_KC + 524288 + 4096;
static_assert(SM_CBIAS + 2048 <= SM_COS && SM_SLOT + 131072 <= SM_KC && SM_VC + 524288 + 4096 <= 16 * MiB, "small map");
constexpr size_t WB_IN = 16 * MiB;
constexpr size_t WB_O0 = WB_IN + (size_t)A_INP * D * 2;
constexpr size_t WB_GU0 = WB_O0 + (size_t)D * D * 2;
constexpr size_t WB_D0 = WB_GU0 + (size_t)2 * FF0 * D * 2;
constexpr size_t WB_KVQ = WB_D0 + (size_t)D * FF0 * 2;
constexpr size_t WB_O1 = WB_KVQ + (size_t)(KVW + BQP) * D * 2;
constexpr size_t WB_C1 = WB_O1 + (size_t)D * D * 2;
constexpr size_t WB_C2 = WB_C1 + (size_t)512 * 2048 * 2;
static_assert(WB_C2 + 128 * 256 * 2 <= 50 * MiB, "weight map");
constexpr size_t WS_U = 50 * MiB, WS_U2 = 82 * MiB;
constexpr size_t WS_Q0 = 114 * MiB, WS_K0 = 146 * MiB, WS_V0 = 154 * MiB, WS_IQ = 162 * MiB, WS_IK = 178 * MiB, WS_O0 = 180 * MiB, WS_MASK = 212 * MiB, WS_SCORES = 220 * MiB;
constexpr size_t WS_HID = 220 * MiB;
constexpr size_t WS_KCMP = 114 * MiB, WS_VCMP = 122 * MiB, WS_KSLC = 130 * MiB, WS_VSLC = 138 * MiB, WS_KWIN = 146 * MiB, WS_VWIN = 154 * MiB;
constexpr size_t WS_Q1 = 162 * MiB, WS_O1 = 194 * MiB, WS_CH = 226 * MiB;
constexpr size_t WS_OCG = 50 * MiB;
constexpr size_t WS_SEL = 230 * MiB;
constexpr size_t WS_UM = 300 * MiB;
constexpr size_t WS_AG = 16 * MiB;
constexpr size_t WS_Y = 16 * MiB;
constexpr size_t WS_HID2 = 84 * MiB;
constexpr size_t WS_WGU1 = 351 * MiB, WS_WD1 = 463 * MiB, WS_END = 519 * MiB;
static_assert(WS_AG + (size_t)MPAD * D * 2 <= WS_HID2 && WS_HID2 + (size_t)MPAD * FFE * 2 <= WS_WGU1 && WS_WGU1 + (size_t)NE * 2 * FFE * D * 2 == WS_WD1 && WS_WD1 + (size_t)NE * D * FFE * 2 == WS_END, "moe map");
static_assert(WS_HID + (size_t)T * FF0 * 2 <= WS_WGU1 && WS_UM + (size_t)T * D * 2 <= WS_WGU1 && WS_SCORES + (size_t)NB * SEQ * SEQ * 4 <= 476 * MiB, "map");
constexpr int CW_TMO = 0, CW_BAR = 4096, CW_CNT = 8192, CW_FILL = 8256, CW_DBG = 8320;
constexpr size_t WS_DBG_O0 = 480 * MiB, WS_DBG_O1 = 240 * MiB;
#define XCD_BAR_WORDS 3456

constexpr int RING_BYTES = 131072, LDSCTL_OFF = 139264, MISC_OFF = LDSCTL_OFF + 320, LDS_BYTES = 147456;
constexpr int NWAVES = 8;

#define RLX_AGENT __ATOMIC_RELAXED, __HIP_MEMORY_SCOPE_AGENT
#define LDS_WAIT() asm volatile("s_waitcnt lgkmcnt(0)" ::: "memory")
#define VM_WAIT() asm volatile("s_waitcnt vmcnt(0)" ::: "memory")
__device__ __forceinline__ unsigned f2bf(float f) { unsigned u = __builtin_bit_cast(unsigned, f); return (u + 0x7fffu + ((u >> 16) & 1u)) >> 16; }
__device__ __forceinline__ unsigned pk2(float lo, float hi) { return f2bf(lo) | (f2bf(hi) << 16); }
__device__ __forceinline__ float bf2f(unsigned v) { return __builtin_bit_cast(float, v << 16); }
__device__ __forceinline__ float bflo(unsigned w) { return __builtin_bit_cast(float, w << 16); }
__device__ __forceinline__ float bfhi(unsigned w) { return __builtin_bit_cast(float, w & 0xffff0000u); }
__device__ __forceinline__ float bfround(float f) { return bf2f(f2bf(f)); }
__device__ __forceinline__ float wave_sum(float v) {
#pragma unroll
    for (int o = 1; o < 64; o <<= 1) v += __shfl_xor(v, o);
    return v;
}
__device__ __forceinline__ float wave_max(float v) {
#pragma unroll
    for (int o = 1; o < 64; o <<= 1) v = fmaxf(v, __shfl_xor(v, o));
    return v;
}
__device__ __forceinline__ int wave_sum_i(int v) {
#pragma unroll
    for (int o = 1; o < 64; o <<= 1) v += __shfl_xor(v, o);
    return v;
}
__device__ __forceinline__ int lds_add(LAS int* p, int v) { return __hip_atomic_fetch_add(p, v, __ATOMIC_RELAXED, __HIP_MEMORY_SCOPE_WORKGROUP); }
__device__ __forceinline__ unsigned ld_u32(const unsigned* p) { return __hip_atomic_load(p, RLX_AGENT); }
__device__ __forceinline__ float dot8(u32x4 a, u32x4 b, float acc) {
    acc += bflo(a.x) * bflo(b.x); acc += bfhi(a.x) * bfhi(b.x); acc += bflo(a.y) * bflo(b.y); acc += bfhi(a.y) * bfhi(b.y);
    acc += bflo(a.z) * bflo(b.z); acc += bfhi(a.z) * bfhi(b.z); acc += bflo(a.w) * bflo(b.w); acc += bfhi(a.w) * bfhi(b.w);
    return acc;
}

namespace pg8 {
constexpr int BM = 256, BK = 64, HALF = 128, HTB = HALF * BK * 2, STAGE_BYTES = 8 * HTB, NXCD = 8, WGM = 8;
__host__ __device__ __forceinline__ int lds_byte(int r, int c) { const int st = (r >> 4) * 2 + (c >> 5), rr = r & 15, cc = c & 31, ob = rr * 64 + cc * 2; return st * 1024 + (ob ^ (((ob >> 9) & 1) << 5)); }
__host__ __device__ __forceinline__ void stage_rc(int b, int& R, int& C) { const int st = b / 1024, sb = b % 1024, swz = sb ^ (((sb >> 9) & 1) << 5); R = (st >> 1) * 16 + swz / 64; C = (st & 1) * 32 + (swz % 64) / 2; }
__host__ __device__ __forceinline__ int perm32(int rho) { const int n = rho >> 4, i = rho & 15; return 8 * (i >> 2) + 4 * n + (i & 3); }
struct Unit { int pm, pn; };
struct Gemm { const bf16* A; const bf16* Bt; int K, lda, ldb; };

struct StaticOrder {
    int nM, nN, nwg, G, c;
    __device__ void init(int M, int N, int G_, int c_) { nM = M / BM; nN = N / BM; nwg = nM * nN; G = G_; c = c_; }
    __device__ bool next(int i, Unit& u) const {
        const long L = (long)i * G + c; if (L >= nwg) return false;
        int wgid = (int)L; { const int q = nwg / NXCD, r = nwg % NXCD, xcd = wgid % NXCD, off = wgid / NXCD; wgid = (xcd < r ? xcd * (q + 1) : r * (q + 1) + (xcd - r) * q) + off; }
        const int nig = WGM * nN, gid = wgid / nig, fm = gid * WGM, gsz = (nM - fm) < WGM ? (nM - fm) : WGM;
        u.pm = fm + ((wgid % nig) % gsz); u.pn = (wgid % nig) / gsz; return true;
    }
};

template <class Epi, class Sched>
__device__ __forceinline__ void gemm_phase(LAS unsigned char* lds, const Gemm g, const Sched& S, const Epi& E) {
    const int tid = threadIdx.x, wid = __builtin_amdgcn_readfirstlane(tid >> 6), lane = tid & 63, wr = wid >> 2, wc = wid & 3, fr = lane & 15, fq = lane >> 4;
    const int K = g.K, nt = K / BK;
    unsigned voffA[2], voffB[2];
#pragma unroll
    for (int i = 0; i < 2; ++i) { int R, C; stage_rc(tid * 16 + i * 8192, R, C); const int Rb = (R & ~31) + perm32(R & 31);
        voffA[i] = (unsigned)(R * g.lda + C) * 2u; voffB[i] = (unsigned)(Rb * g.ldb + C) * 2u; }
    const size_t kstep = (size_t)(BK * 2);
    const size_t hA = (size_t)HALF * g.lda * 2, hB = (size_t)HALF * g.ldb * 2;
    const size_t tA = 2 * hA, tB = 2 * hB;
    const unsigned ldsw = (unsigned)wid * 1024u;
    const int aoff = lds_byte(wr * 64 + fr, fq * 8), boff = lds_byte(wc * 32 + fr, fq * 8);
#define PG8_SA(b, h) (((b) * 2 + (h)) * HTB)
#define PG8_SB(b, h) ((4 + (b) * 2 + (h)) * HTB)
#define PG8_STAGE(bufoff, gbase, voff) do { _Pragma("unroll") for (int _i = 0; _i < 2; ++_i) \
        __builtin_amdgcn_global_load_lds((const unsigned*)((const char*)(gbase) + (voff)[_i]), (LAS unsigned*)(lds + (bufoff) + ldsw + _i * 8192), 16, 0, 0); } while (0)
#define PG8_LDA(dst, b, h) do { _Pragma("unroll") for (int m = 0; m < 4; ++m) _Pragma("unroll") for (int k = 0; k < 2; ++k) dst[m][k] = *(const LAS bf16x8*)(lds + PG8_SA(b, h) + aoff + m * 2048 + k * 1024); } while (0)
#define PG8_LDB(dst, b, h) do { _Pragma("unroll") for (int n = 0; n < 2; ++n) _Pragma("unroll") for (int k = 0; k < 2; ++k) dst[n][k] = *(const LAS bf16x8*)(lds + PG8_SB(b, h) + boff + n * 2048 + k * 1024); } while (0)
#define PG8_MMA(ai, bj, At, Bt) do { __builtin_amdgcn_s_setprio(1); _Pragma("unroll") for (int m = 0; m < 4; ++m) _Pragma("unroll") for (int n = 0; n < 2; ++n) _Pragma("unroll") for (int k = 0; k < 2; ++k) \
        acc[ai][bj][m][n] = __builtin_amdgcn_mfma_f32_16x16x32_bf16(Bt[n][k], At[m][k], acc[ai][bj][m][n], 0, 0, 0); __builtin_amdgcn_s_setprio(0); } while (0)
#define PG8_WAIT_V(n) asm volatile("s_waitcnt vmcnt(" #n ")" ::: "memory")
#define PG8_WAIT_L(n) asm volatile("s_waitcnt lgkmcnt(" #n ")" ::: "memory")
#define PG8_BAR __builtin_amdgcn_s_barrier()
#define PG8_SCHED __builtin_amdgcn_sched_barrier(0)
    Unit cur, nxt; int ui = 0;
    if (!S.next(0, cur)) return;
    f32x4 acc[2][2][4][2];
#pragma unroll
    for (int a = 0; a < 2; ++a)
#pragma unroll
        for (int b = 0; b < 2; ++b)
#pragma unroll
            for (int m = 0; m < 4; ++m)
#pragma unroll
                for (int n = 0; n < 2; ++n) acc[a][b][m][n] = (f32x4){0.f, 0.f, 0.f, 0.f};
    bf16x8 At[4][2], B0[2][2], B1[2][2];
    const char* cA = (const char*)g.A + (size_t)cur.pm * tA; const char* cB = (const char*)g.Bt + (size_t)cur.pn * tB;
    PG8_STAGE(PG8_SB(0, 0), cB, voffB); PG8_STAGE(PG8_SB(0, 1), cB + hB, voffB); PG8_STAGE(PG8_SA(0, 0), cA, voffA); PG8_STAGE(PG8_SA(0, 1), cA + hA, voffA);
    if (wr == 1) PG8_BAR;
    PG8_WAIT_V(2); PG8_BAR;
    PG8_STAGE(PG8_SB(1, 0), cB + kstep, voffB); PG8_STAGE(PG8_SA(1, 0), cA + kstep, voffA); PG8_STAGE(PG8_SB(1, 1), cB + hB + kstep, voffB);
    PG8_WAIT_V(6); PG8_BAR;
    for (;;) {
        const bool has_next = S.next(ui + 1, nxt);
        const char* nA = has_next ? (const char*)g.A + (size_t)nxt.pm * tA : cA; const char* nB = has_next ? (const char*)g.Bt + (size_t)nxt.pn * tB : cB;
        for (int t = 0; t < nt; t += 2) {
            const bool last = (t == nt - 2);
            const char* a1 = cA + (size_t)(t + 1) * kstep;
            const char* a2 = last ? nA : cA + (size_t)(t + 2) * kstep; const char* b2 = last ? nB : cB + (size_t)(t + 2) * kstep;
            const char* a3 = a2 + kstep; const char* b3 = b2 + kstep;
            PG8_LDB(B0, 0, 0); PG8_LDB(B1, 0, 1); PG8_SCHED; PG8_LDA(At, 0, 0); PG8_STAGE(PG8_SA(1, 1), a1 + hA, voffA);
            PG8_WAIT_V(8); PG8_WAIT_L(0); PG8_BAR; PG8_MMA(0, 0, At, B0); PG8_MMA(0, 1, At, B1); PG8_BAR; PG8_SCHED;
            PG8_LDA(At, 0, 1); PG8_STAGE(PG8_SB(0, 0), b2, voffB); PG8_STAGE(PG8_SB(0, 1), b2 + hB, voffB); PG8_STAGE(PG8_SA(0, 0), a2, voffA);
            PG8_WAIT_V(8); PG8_WAIT_L(0); PG8_BAR; PG8_MMA(1, 0, At, B0); PG8_MMA(1, 1, At, B1); PG8_BAR; PG8_SCHED;
            PG8_LDB(B0, 1, 0); PG8_LDB(B1, 1, 1); PG8_SCHED; PG8_LDA(At, 1, 0); PG8_STAGE(PG8_SA(0, 1), a2 + hA, voffA);
            PG8_WAIT_V(8); PG8_WAIT_L(0); PG8_BAR; PG8_MMA(0, 0, At, B0); PG8_MMA(0, 1, At, B1); PG8_BAR; PG8_SCHED;
            PG8_LDA(At, 1, 1); PG8_STAGE(PG8_SB(1, 0), b3, voffB); PG8_STAGE(PG8_SB(1, 1), b3 + hB, voffB); PG8_STAGE(PG8_SA(1, 0), a3, voffA);
            PG8_WAIT_V(8); PG8_WAIT_L(0); PG8_BAR; PG8_MMA(1, 0, At, B0); PG8_MMA(1, 1, At, B1); PG8_BAR; PG8_SCHED;
        }
        if (wr == 0) PG8_BAR;
        E(acc, cur, wr, wc, fr, fq);
        if (!has_next) break;
#pragma unroll
        for (int a = 0; a < 2; ++a)
#pragma unroll
            for (int b = 0; b < 2; ++b)
#pragma unroll
                for (int m = 0; m < 4; ++m)
#pragma unroll
                    for (int n = 0; n < 2; ++n) acc[a][b][m][n] = (f32x4){0.f, 0.f, 0.f, 0.f};
        cur = nxt; cA = nA; cB = nB; ++ui;
        if (wr == 1) PG8_BAR;
    }
    PG8_WAIT_V(0);
    PG8_BAR;
#undef PG8_SA
#undef PG8_SB
#undef PG8_STAGE
#undef PG8_LDA
#undef PG8_LDB
#undef PG8_MMA
#undef PG8_WAIT_V
#undef PG8_WAIT_L
#undef PG8_BAR
#undef PG8_SCHED
}
}

#define XB_TMO      128
#define XB_XCNT(j)  (256  + 64 * (j))
#define XB_XSUB(j)  (1280 + 64 * (j))
#define XB_XGEN(j)  (2304 + 64 * (j))
#define XB_TOP      3328
#define XB_TOPGEN   3392
#define XB_SPIN_CAP (1u << 18)
__device__ __forceinline__ unsigned xb_ld(unsigned* p)              { return __hip_atomic_load(p, __ATOMIC_RELAXED, __HIP_MEMORY_SCOPE_AGENT); }
__device__ __forceinline__ unsigned xb_add(unsigned* p, unsigned v) { return __hip_atomic_fetch_add(p, v, __ATOMIC_RELAXED, __HIP_MEMORY_SCOPE_AGENT); }
__device__ __forceinline__ unsigned xb_xcc_id() { return (unsigned)__builtin_amdgcn_s_getreg((3 << 11) | 20) & 0xFu; }
#define XB_SPIN(cond, bar) do { unsigned _sp = 0; while (cond) { __builtin_amdgcn_s_sleep(1); \
    if ((++_sp & 255u) == 0u) { if (xb_ld(&(bar)[XB_TMO])) break; if (_sp > XB_SPIN_CAP) { atomicAdd(&(bar)[XB_TMO], 1u); break; } } } } while (0)
struct XcdBarrier { unsigned* bar; unsigned x; volatile LAS unsigned* st; };
__device__ __forceinline__ XcdBarrier xcd_barrier_post(unsigned* bar, volatile LAS unsigned* st) {
    XcdBarrier b; b.bar = bar; b.x = xb_xcc_id(); b.st = st;
    if (threadIdx.x == 0) (void)xb_add(&bar[XB_XCNT(b.x)], 1u);
    return b;
}
__device__ __forceinline__ void xcd_barrier_complete(unsigned* bar, unsigned x, unsigned& nloc, unsigned& nx) {
    const unsigned G = gridDim.x * gridDim.y * gridDim.z;
    unsigned sum, cnt, mine, sp = 0u;
    for (;;) {
        sum = 0u; cnt = 0u; mine = 0u;
#pragma unroll
        for (unsigned j = 0; j < 16; ++j) { const unsigned c = xb_ld(&bar[XB_XCNT(j)]); sum += c; cnt += (c > 0u) ? 1u : 0u; mine = (j == x) ? c : mine; }
        if (sum == G) break;
        __builtin_amdgcn_s_sleep(1);
        if ((++sp & 255u) == 0u) { if (xb_ld(&bar[XB_TMO])) break; if (sp > XB_SPIN_CAP) { atomicAdd(&bar[XB_TMO], 1u); break; } }
    }
    nloc = mine > 0u ? mine : 1u; nx = cnt > 0u ? cnt : 1u;
}
__device__ __forceinline__ void xcd_barrier(const XcdBarrier& b) {
    asm volatile("s_waitcnt vmcnt(0)" ::: "memory");
    __syncthreads();
    if (threadIdx.x == 0) {
        unsigned* bar = b.bar;
        __builtin_amdgcn_s_waitcnt(0);
        unsigned nloc = b.st[0], nx = b.st[1];
        if (nloc == 0u) { xcd_barrier_complete(bar, b.x, nloc, nx); b.st[0] = nloc; b.st[1] = nx; }
        const unsigned old = xb_add(&bar[XB_XSUB(b.x)], 1u);
        const unsigned gen = old / nloc;
        if (old + 1u == (gen + 1u) * nloc) {
            __builtin_amdgcn_fence(__ATOMIC_RELEASE, "agent");
            asm volatile("s_waitcnt vmcnt(0)" ::: "memory");
            const unsigned og = xb_add(&bar[XB_TOP], 1u);
            const unsigned tg = og / nx;
            if (og + 1u == (tg + 1u) * nx) xb_add(&bar[XB_TOPGEN], 1u);
            else XB_SPIN(xb_ld(&bar[XB_TOPGEN]) == tg, bar);
            __builtin_amdgcn_fence(__ATOMIC_ACQUIRE, "agent");
            xb_add(&bar[XB_XGEN(b.x)], 1u);
            asm volatile("s_waitcnt vmcnt(0)" ::: "memory");
        } else {
            XB_SPIN(xb_ld(&bar[XB_XGEN(b.x)]) == gen, bar);
            __builtin_amdgcn_fence(__ATOMIC_ACQUIRE, "agent");
            asm volatile("s_waitcnt vmcnt(0)" ::: "memory");
        }
    }
    __syncthreads();
}

struct Frame {
    LAS unsigned char* lds;
    volatile LAS unsigned* MISC;
    unsigned* ctl;
    unsigned char* ws;
    int tid, lane, wave, G, gw, NGW;
    const float *x, *c; const int* pos;
    const float *attn_gain, *ffn_gain, *w_ada, *b_ada, *a_w_in, *a_w_out, *b_w_q, *b_w_out, *kv_gain, *w_kv_ada, *b_kv_ada, *w_kv;
    const float *pe_k, *w1_k, *w2_k, *pe_v, *w1_v, *w2_v, *ffn_wg, *ffn_wu, *ffn_wd, *w_router, *moe_wg, *moe_wu, *moe_wd, *final_gain;
    float* out;
};
#define WSP(T_, off) ((T_*)(F.ws + (off)))
__device__ __forceinline__ unsigned char* launder(unsigned char* p) { asm volatile("" : "+s"(p)); return p; }
#define LWSP(T_, off) ((T_*)(launder(F.ws) + (off)))

__device__ __forceinline__ void tr_item(const float* W, int Nsrc, int ncol0, int K, int k0, bf16* WT, int drow0, LAS float* scr, int lane) {
    const int cc = ncol0 + (lane & 31); const bool ok = (ncol0 >= 0) && (cc < Nsrc);
#pragma unroll 8
    for (int i = 0; i < 32; ++i) { const int kk = 2 * i + (lane >> 5); scr[kk * 33 + (lane & 31)] = ok ? W[(size_t)(k0 + kk) * Nsrc + cc] : 0.f; }
    LDS_WAIT(); asm volatile("" ::: "memory");
    const int c = lane & 7;
#pragma unroll
    for (int j = 0; j < 4; ++j) { const int n = (lane >> 3) + 8 * j; const LAS float* s = scr + (8 * c) * 33 + n;
        u32x4 o; o.x = pk2(s[0 * 33], s[1 * 33]); o.y = pk2(s[2 * 33], s[3 * 33]); o.z = pk2(s[4 * 33], s[5 * 33]); o.w = pk2(s[6 * 33], s[7 * 33]);
        *(u32x4*)(WT + (size_t)(drow0 + n) * K + k0 + 8 * c) = o; }
    LDS_WAIT(); asm volatile("" ::: "memory");
}
__device__ __forceinline__ int rope_lb(int pb) { const int pn = pb >> 3, half = (pb >> 2) & 1, hl = pb & 3; return 8 * pn + 2 * hl + half; }

__device__ __forceinline__ void conv_item_a(Frame& F, int it, LAS float* scr) {
    const int lane = F.lane;
    int r = it;
    { constexpr int NBK = A_INP / 32, NI = 16 * NBK; if (r < NI) { const int kb = r / NBK, pb = r % NBK; tr_item(F.a_w_in, A_IN, 32 * rope_lb(pb), D, 64 * kb, WSP(bf16, WB_IN), 32 * pb, scr, lane); return; } r -= NI; }
    { constexpr int NBK = D / 32, NI = 16 * NBK; if (r < NI) { const int kb = r / NBK, pb = r % NBK; tr_item(F.a_w_out, D, 32 * pb, D, 64 * kb, WSP(bf16, WB_O0), 32 * pb, scr, lane); return; } r -= NI; }
    { constexpr int NBK = 2 * FF0 / 32, NI = 16 * NBK; if (r < NI) { const int kb = r / NBK, pb = r % NBK; const int pn = pb >> 3, half = (pb >> 2) & 1, q = pb & 3;
        tr_item(half ? F.ffn_wu : F.ffn_wg, FF0, 32 * (4 * pn + q), D, 64 * kb, WSP(bf16, WB_GU0), 32 * pb, scr, lane); return; } r -= NI; }
    { constexpr int NBK = D / 32, NI = (FF0 / 64) * NBK; if (r < NI) { const int kb = r / NBK, pb = r % NBK; tr_item(F.ffn_wd, D, 32 * pb, FF0, 64 * kb, WSP(bf16, WB_D0), 32 * pb, scr, lane); return; } r -= NI; }
    { constexpr int NBK = KVW / 32, NI = 16 * NBK; if (r < NI) { const int kb = r / NBK, pb = r % NBK; tr_item(F.w_kv, KVW, 32 * rope_lb(pb), D, 64 * kb, WSP(bf16, WB_KVQ), 32 * pb, scr, lane); return; } r -= NI; }
    { constexpr int NBK = BQP / 32, NI = 16 * NBK; if (r < NI) { const int kb = r / NBK, pb = r % NBK; tr_item(F.b_w_q, BQ, 32 * rope_lb(pb), D, 64 * kb, WSP(bf16, WB_KVQ) + (size_t)KVW * D, 32 * pb, scr, lane); return; } r -= NI; }
    { constexpr int NBK = D / 32, NI = 16 * NBK; if (r < NI) { const int kb = r / NBK, pb = r % NBK; tr_item(F.b_w_out, D, 32 * pb, D, 64 * kb, WSP(bf16, WB_O1), 32 * pb, scr, lane); return; } r -= NI; }
    { constexpr int NBK = 8, NI = 32 * NBK; if (r < NI) { const int kb = r / NBK, pb = r % NBK; tr_item(F.w1_k, 256, 32 * pb, 2048, 64 * kb, WSP(bf16, WB_C1), 32 * pb, scr, lane); return; } r -= NI;
                                       if (r < NI) { const int kb = r / NBK, pb = r % NBK; tr_item(F.w1_v, 256, 32 * pb, 2048, 64 * kb, WSP(bf16, WB_C1), 256 + 32 * pb, scr, lane); return; } r -= NI; }
    { constexpr int NBK = 2, NI = 4 * NBK; if (r < NI) { const int kb = r / NBK, pb = r % NBK; tr_item(F.w2_k, 64, 32 * pb, 256, 64 * kb, WSP(bf16, WB_C2), 32 * pb, scr, lane); return; } r -= NI;
                                       if (r < NI) { const int kb = r / NBK, pb = r % NBK; tr_item(F.w2_v, 64, 32 * pb, 256, 64 * kb, WSP(bf16, WB_C2), 64 + 32 * pb, scr, lane); return; } r -= NI; }
}
constexpr int NCONV_A = 16 * (A_INP / 32) + 16 * 32 + 16 * (2 * FF0 / 32) + (FF0 / 64) * 32 + 16 * (KVW / 32) + 16 * (BQP / 32) + 16 * 32 + 2 * 32 * 8 + 2 * 4 * 2;
__device__ __forceinline__ void conv_item_b(Frame& F, int it, LAS float* scr) {
    const int lane = F.lane;
    constexpr int NBK1 = 2 * FFE / 32, NI1 = 16 * NBK1;
    constexpr int NBK2 = D / 32, NI2 = (FFE / 64) * NBK2;
    int r = it;
    if (r < NE * NI1) { const int e = r / NI1; r -= e * NI1; const int kb = r / NBK1, pb = r % NBK1; const int pn = pb >> 3, half = (pb >> 2) & 1, q = pb & 3;
        tr_item((half ? F.moe_wu : F.moe_wg) + (size_t)e * D * FFE, FFE, 32 * (4 * pn + q), D, 64 * kb, WSP(bf16, WS_WGU1) + (size_t)e * 2 * FFE * D, 32 * pb, scr, lane); return; }
    r -= NE * NI1;
    { const int e = r / NI2; r -= e * NI2; const int kb = r / NBK2, pb = r % NBK2;
        tr_item(F.moe_wd + (size_t)e * FFE * D, D, 32 * pb, FFE, 64 * kb, WSP(bf16, WS_WD1) + (size_t)e * D * FFE, 32 * pb, scr, lane); }
}
constexpr int NCONV_B = NE * (16 * (2 * FFE / 32) + (FFE / 64) * 32);

template <int NBAT>
__device__ __forceinline__ void gemv_item(Frame& F, const LAS float* act, const float* W, int K, int N, int n0, const float* bias, float* out, int ldo, LAS float* red) {
    const int kper = K / 8, k0 = F.wave * kper;
    float a[NBAT];
#pragma unroll
    for (int b = 0; b < NBAT; ++b) a[b] = 0.f;
    const float* wp = W + (size_t)k0 * N + n0 + F.lane;
#pragma unroll 8
    for (int k = 0; k < kper; ++k) { const float w = wp[(size_t)k * N];
#pragma unroll
        for (int b = 0; b < NBAT; ++b) a[b] += act[b * K + k0 + k] * w; }
#pragma unroll
    for (int b = 0; b < NBAT; ++b) red[(F.wave * 4 + b) * 64 + F.lane] = a[b];
    __syncthreads();
    if (F.tid < 64 * NBAT) { const int b = F.tid >> 6, l = F.tid & 63; float s = 0.f;
#pragma unroll
        for (int w = 0; w < 8; ++w) s += red[(w * 4 + b) * 64 + l];
        out[(size_t)b * ldo + n0 + l] = s + (bias ? bias[n0 + l] : 0.f); }
    __syncthreads();
}

__device__ __forceinline__ void p0_prologue(Frame& F) {
    {
        LAS float* act = (LAS float*)(F.lds);
        LAS float* red = (LAS float*)(F.lds + 16384);
        constexpr int NI_MOD = 6144 / 64, NI_KV = 2048 / 64, NITEMS = 2 * NI_MOD + NI_KV + 8;
        for (int it = blockIdx.x; it < NITEMS; it += F.G) {
            if (it < 2 * NI_MOD + NI_KV) {
                for (int i = F.tid; i < 4096; i += 512) { const float v = F.c[i]; act[i] = v / (1.f + __expf(-v)); }
                __syncthreads();
                if (it < NI_MOD) gemv_item<4>(F, act, F.w_ada, D, 6144, 64 * it, F.b_ada, WSP(float, SM_MOD0), 6144, red);
                else if (it < 2 * NI_MOD) gemv_item<4>(F, act, F.w_ada + (size_t)D * 6144, D, 6144, 64 * (it - NI_MOD), F.b_ada + 6144, WSP(float, SM_MOD1), 6144, red);
                else gemv_item<4>(F, act, F.w_kv_ada, D, 2048, 64 * (it - 2 * NI_MOD), F.b_kv_ada, WSP(float, SM_KVMOD), 2048, red);
            } else {
                const int j = it - (2 * NI_MOD + NI_KV), kv = j >> 2;
                const float* pe = kv ? F.pe_v : F.pe_k;
                for (int i = F.tid; i < 2048; i += 512) act[i] = pe[i];
                __syncthreads();
                gemv_item<1>(F, act, kv ? F.w1_v : F.w1_k, 2048, 256, 64 * (j & 3), nullptr, WSP(float, SM_CBIAS) + 256 * kv, 256, red);
            }
        }
        __syncthreads();
    }
    {
        LAS float* scr = (LAS float*)(F.lds + F.wave * 16384);
        for (int it = F.gw; it < NCONV_A; it += F.NGW) conv_item_a(F, it, scr);
    }
    {
        float* cs = WSP(float, SM_COS); float* sn = WSP(float, SM_SIN);
        for (int i = F.gw * 64 + F.lane; i < T * 32; i += F.NGW * 64) {
            const int m = i >> 5, d = i & 31;
            const float inv = 1.0f / powf(10000.0f, (float)d * (1.0f / 32.0f));
            const float ang = (float)F.pos[m] * inv;
            cs[i] = cosf(ang); sn[i] = sinf(ang);
        }
    }
}

__device__ __forceinline__ void load_row(const float* row, int lane, f32x4 (&v)[4]) {
#pragma unroll
    for (int j = 0; j < 4; ++j) v[j] = ((const f32x4*)row)[lane + 64 * j];
}
__device__ __forceinline__ float row_rs(const f32x4 (&v)[4]) {
    float s = 0.f;
#pragma unroll
    for (int j = 0; j < 4; ++j) s += (v[j].x * v[j].x + v[j].y * v[j].y) + (v[j].z * v[j].z + v[j].w * v[j].w);
    return 1.0f / sqrtf(wave_sum(s) * (1.f / D) + RMS_EPS);
}
__device__ __forceinline__ void modulate_row(const f32x4 (&v)[4], float r, const float* gain, const float* shift, const float* scale, int lane, f32x4 (&u)[4]) {
#pragma unroll
    for (int j = 0; j < 4; ++j) { const f32x4 g = ((const f32x4*)gain)[lane + 64 * j], sh = ((const f32x4*)shift)[lane + 64 * j], sc = ((const f32x4*)scale)[lane + 64 * j];
        u[j] = v[j] * r * g * (sc + 1.0f) + sh; }
}
__device__ __forceinline__ void store_row_bf16(bf16* orow, int lane, const f32x4 (&u)[4]) {
#pragma unroll
    for (int j = 0; j < 4; ++j) { u32x2 o; o.x = pk2(u[j].x, u[j].y); o.y = pk2(u[j].z, u[j].w); ((u32x2*)orow)[lane + 64 * j] = o; }
}
__device__ __forceinline__ void norm_phase(Frame& F, const float* src, const float* gain, const float* mod  , int ldm, int shift_off, int scale_off, bf16* dst) {
    for (int m = F.gw; m < T; m += F.NGW) {
        f32x4 v[4], u[4]; load_row(src + (size_t)m * D, F.lane, v);
        const float r = row_rs(v); const int b = m >> 12;
        modulate_row(v, r, gain, mod + (size_t)b * ldm + shift_off, mod + (size_t)b * ldm + scale_off, F.lane, u);
        store_row_bf16(dst + (size_t)m * D, F.lane, u);
    }
}

__device__ __forceinline__ void store8(bf16* p, const float (&y)[8]) { u32x4 w; w.x = pk2(y[0], y[1]); w.y = pk2(y[2], y[3]); w.z = pk2(y[4], y[5]); w.w = pk2(y[6], y[7]); *(u32x4*)p = w; }
__device__ __forceinline__ void get8(const f32x4 (&a)[2], float (&x)[8]) { x[0] = a[0].x; x[1] = a[0].y; x[2] = a[0].z; x[3] = a[0].w; x[4] = a[1].x; x[5] = a[1].y; x[6] = a[1].z; x[7] = a[1].w; }
__device__ __forceinline__ void rope8(const float* cs, const float* sn, int row, int fq, const float (&x1)[8], const float (&x2)[8], float sc, float (&y1)[8], float (&y2)[8]) {
    const f32x4 c0 = *(const f32x4*)(cs + (size_t)row * 32 + 8 * fq), c1 = *(const f32x4*)(cs + (size_t)row * 32 + 8 * fq + 4);
    const f32x4 s0 = *(const f32x4*)(sn + (size_t)row * 32 + 8 * fq), s1 = *(const f32x4*)(sn + (size_t)row * 32 + 8 * fq + 4);
    const float c[8] = {c0.x, c0.y, c0.z, c0.w, c1.x, c1.y, c1.z, c1.w}, s[8] = {s0.x, s0.y, s0.z, s0.w, s1.x, s1.y, s1.z, s1.w};
#pragma unroll
    for (int j = 0; j < 8; ++j) { y1[j] = (x1[j] * c[j] - x2[j] * s[j]) * sc; y2[j] = (x2[j] * c[j] + x1[j] * s[j]) * sc; }
}
struct EpiIn {
    bf16 *Q, *K, *V, *IQ, *IK; float* IW; const float *cs, *sn;
    __device__ __forceinline__ void operator()(const f32x4 (&acc)[2][2][4][2], const pg8::Unit& u, int wr, int wc, int fr, int fq) const {
        const int pn = u.pn;
        if (pn == 8 && wc >= 2) return;
#pragma unroll
        for (int ai = 0; ai < 2; ++ai)
#pragma unroll
            for (int m = 0; m < 4; ++m) {
                const int row = u.pm * 256 + ai * 128 + wr * 64 + m * 16 + fr;
                float x1[8], x2[8]; get8(acc[ai][0][m], x1); get8(acc[ai][1][m], x2);
                if (pn == 5) { bf16* d = V + (size_t)row * 256 + wc * 64 + 8 * fq; store8(d, x1); store8(d + 32, x2); }
                else if (pn == 8 && wc == 1) { if (fq == 0) { f32x4 a = {x1[0] * IWS, x1[1] * IWS, x1[2] * IWS, x1[3] * IWS}, b = {x1[4] * IWS, x1[5] * IWS, x1[6] * IWS, x1[7] * IWS};
                        *(f32x4*)(IW + (size_t)row * 8) = a; *(f32x4*)(IW + (size_t)row * 8 + 4) = b; } }
                else {
                    float y1[8], y2[8]; rope8(cs, sn, row, fq, x1, x2, pn < 4 ? C2 : 1.0f, y1, y2);
                    bf16* d;
                    if (pn < 4) d = Q + (size_t)row * 1024 + (4 * pn + wc) * 64;
                    else if (pn == 4) d = K + (size_t)row * 256 + wc * 64;
                    else if (pn < 8) d = IQ + (size_t)row * 512 + (4 * (pn - 6) + wc) * 64;
                    else d = IK + (size_t)row * 64;
                    store8(d + 8 * fq, y1); store8(d + 32 + 8 * fq, y2);
                }
            }
    }
};
struct EpiRes {
    const float* base; float* out; const float* gate; int ldg;
    __device__ __forceinline__ void operator()(const f32x4 (&acc)[2][2][4][2], const pg8::Unit& u, int wr, int wc, int fr, int fq) const {
        const float* gv = gate + (size_t)((u.pm * 256) >> 12) * ldg;
#pragma unroll
        for (int bj = 0; bj < 2; ++bj) {
            const int col = u.pn * 256 + bj * 128 + wc * 32 + 8 * fq;
            const f32x4 g0 = *(const f32x4*)(gv + col), g1 = *(const f32x4*)(gv + col + 4);
#pragma unroll
            for (int ai = 0; ai < 2; ++ai)
#pragma unroll
                for (int m = 0; m < 4; ++m) {
                    const size_t o = (size_t)(u.pm * 256 + ai * 128 + wr * 64 + m * 16 + fr) * D + col;
                    const f32x4 b0 = *(const f32x4*)(base + o), b1 = *(const f32x4*)(base + o + 4);
                    *(f32x4*)(out + o) = b0 + g0 * acc[ai][bj][m][0]; *(f32x4*)(out + o + 4) = b1 + g1 * acc[ai][bj][m][1];
                }
        }
    }
};
__device__ __forceinline__ float silu_f(float g) { return g * __builtin_amdgcn_rcpf(1.0f + __builtin_amdgcn_exp2f(-1.4426950408889634f * g)); }
struct EpiSwiglu {
    bf16* H; int ldh, npn;
    __device__ __forceinline__ void operator()(const f32x4 (&acc)[2][2][4][2], const pg8::Unit& u, int wr, int wc, int fr, int fq) const {
        const int col = (u.pn % npn) * 128 + wc * 32 + 8 * fq;
#pragma unroll
        for (int ai = 0; ai < 2; ++ai)
#pragma unroll
            for (int m = 0; m < 4; ++m) {
                const int row = u.pm * 256 + ai * 128 + wr * 64 + m * 16 + fr;
                float g[8], up[8], h[8]; get8(acc[ai][0][m], g); get8(acc[ai][1][m], up);
#pragma unroll
                for (int j = 0; j < 8; ++j) h[j] = silu_f(g[j]) * up[j];
                store8(H + (size_t)row * ldh + col, h);
            }
    }
};
struct EpiKVQ {
    bf16 *KCMP, *VCMP, *KSLC, *VSLC, *KWIN, *VWIN, *Q; float* GATES; const float *cs, *sn;
    __device__ __forceinline__ void operator()(const f32x4 (&acc)[2][2][4][2], const pg8::Unit& u, int wr, int wc, int fr, int fq) const {
        const int pn = u.pn;
        if (pn == 10 && wc >= 1) return;
#pragma unroll
        for (int ai = 0; ai < 2; ++ai)
#pragma unroll
            for (int m = 0; m < 4; ++m) {
                const int row = (u.pm & 63) * 256 + ai * 128 + wr * 64 + m * 16 + fr;
                float x1[8], x2[8]; get8(acc[ai][0][m], x1); get8(acc[ai][1][m], x2);
                if (pn < 6) {
                    if ((pn & 1) == 0) { float y1[8], y2[8]; rope8(cs, sn, row, fq, x1, x2, 1.0f, y1, y2);
#pragma unroll
                        for (int j = 0; j < 8; ++j) { x1[j] = y1[j]; x2[j] = y2[j]; } }
                    bf16* d;
                    if (pn < 2) d = (pn == 0 ? KCMP : VCMP) + ((size_t)((row >> 12) * 4 + wc) * SEQ + (row & 4095)) * 64;
                    else d = (pn == 2 ? KSLC : pn == 3 ? VSLC : pn == 4 ? KWIN : VWIN) + (size_t)row * 256 + wc * 64;
                    store8(d + 8 * fq, x1); store8(d + 32 + 8 * fq, x2);
                } else if (pn < 10) {
                    float y1[8], y2[8]; rope8(cs, sn, row, fq, x1, x2, C2, y1, y2);
                    bf16* d = Q + (size_t)row * 1024 + (4 * (pn - 6) + wc) * 64;
                    store8(d + 8 * fq, y1); store8(d + 32 + 8 * fq, y2);
                } else {
                    float* gp = GATES + (size_t)row * 48;
#pragma unroll
                    for (int j = 0; j < 8; ++j) gp[8 * fq + j] = 1.0f / (1.0f + __expf(-x1[j]));
                    if (fq < 2) {
#pragma unroll
                        for (int j = 0; j < 8; ++j) gp[32 + 8 * fq + j] = 1.0f / (1.0f + __expf(-x2[j])); }
                }
            }
    }
};
struct EpiY {
    bf16* Y;
    __device__ __forceinline__ void operator()(const f32x4 (&acc)[2][2][4][2], const pg8::Unit& u, int wr, int wc, int fr, int fq) const {
#pragma unroll
        for (int ai = 0; ai < 2; ++ai)
#pragma unroll
            for (int m = 0; m < 4; ++m) {
                const int row = u.pm * 256 + ai * 128 + wr * 64 + m * 16 + fr;
#pragma unroll
                for (int bj = 0; bj < 2; ++bj) { float x[8]; get8(acc[ai][bj][m], x); store8(Y + (size_t)row * D + (u.pn & 3) * 256 + bj * 128 + wc * 32 + 8 * fq, x); }
            }
    }
};
struct KvqOrder {
    pg8::StaticOrder S;
    __device__ bool next(int i, pg8::Unit& u) const { if (!S.next(i, u)) return false; if (u.pn >= 6) u.pm += 64; return true; }
};
struct MoeOrder {
    int tend[NE]; int ntiles, npn, G, c;
    __device__ void init(const unsigned* cnt, int npn_, int G_, int c_) { int acc = 0; for (int e = 0; e < NE; ++e) { acc += (int)((ld_u32(cnt + e) + 255u) >> 8); tend[e] = acc; } ntiles = acc; npn = npn_; G = G_; c = c_; }
    __device__ bool next(int i, pg8::Unit& u) const {
        const long L = (long)i * G + c; if (L >= (long)ntiles * npn) return false;
        const int mt = (int)(L / npn), pn = (int)(L % npn); int e = 0;
#pragma unroll
        for (int k = 0; k < NE - 1; ++k) e += (mt >= tend[k]) ? 1 : 0;
        u.pm = mt; u.pn = e * npn + pn; return true;
    }
};

__device__ __forceinline__ f32x16 sgemm_tile(const bf16* A, int lda, const bf16* Bt, int ldb, int K, int row0, int col0, int lane) {
    f32x16 acc = {};
    const bf16* ap = A + (size_t)(row0 + (lane & 31)) * lda + 8 * (lane >> 5);
    const bf16* bp = Bt + (size_t)(col0 + (lane & 31)) * ldb + 8 * (lane >> 5);
#pragma unroll 4
    for (int k = 0; k < K; k += 16) { const bf16x8 a = *(const bf16x8*)(ap + k), b = *(const bf16x8*)(bp + k); acc = __builtin_amdgcn_mfma_f32_32x32x16_bf16(a, b, acc, 0, 0, 0); }
    return acc;
}
__device__ __forceinline__ float gelu_tanh(float x) { const float t = tanhf(0.7978845608028654f * (x + 0.044715f * x * x * x)); return 0.5f * x * (1.0f + t); }

__device__ __forceinline__ unsigned okey(float f) { const unsigned u = __builtin_bit_cast(unsigned, f); return (u & 0x80000000u) ? ~u : (u | 0x80000000u); }
__device__ __forceinline__ void dsa_naive_item(Frame& F, int m, bf16* O  , unsigned long long* MASKo  ) {
    const int tid = F.tid, lane = F.lane, wave = F.wave;
    const int b = m >> 12, t = m & 4095, n = t + 1;
    LAS unsigned* KEY = (LAS unsigned*)(F.lds);
    LAS u32x4* IQL = (LAS u32x4*)(F.lds + 16384);
    LAS float* IWL = (LAS float*)(F.lds + 16384 + 1024);
    LAS int* LIST = (LAS int*)(F.lds + 20480);
    LAS int* CNT = (LAS int*)(F.lds + 20480 + 1024);
    LAS float* PL = (LAS float*)(F.lds + 24576);
    const bf16* IQ = WSP(bf16, WS_IQ); const bf16* IK = WSP(bf16, WS_IK); const float* IW = WSP(float, SM_IW);
    if (tid < 64) IQL[tid] = ((const u32x4*)(IQ + (size_t)m * 512))[tid];
    if (tid < 8) IWL[tid] = IW[(size_t)m * 8 + tid];
    __syncthreads();
    for (int s = tid; s < n; s += 512) {
        const u32x4* kp = (const u32x4*)(IK + (size_t)(b * SEQ + s) * 64);
        u32x4 kv[8];
#pragma unroll
        for (int c = 0; c < 8; ++c) kv[c] = kp[c];
        float sc = 0.f;
#pragma unroll
        for (int h = 0; h < 8; ++h) { float d = 0.f;
#pragma unroll
            for (int c = 0; c < 8; ++c) d = dot8(kv[c], IQL[h * 8 + c], d);
            sc += IWL[h] * fmaxf(d, 0.f); }
        KEY[s] = okey(sc);
    }
    __syncthreads();
    const bool all = (n <= 256);
    unsigned thr = 0u; int need_ties = 0;
    if (!all) {
        unsigned myk[8];
#pragma unroll
        for (int i = 0; i < 8; ++i) { const int s = tid + 512 * i; myk[i] = s < n ? KEY[s] : 0u; }
        unsigned prefix = 0u;
        for (int bit = 31; bit >= 0; --bit) {
            const unsigned cand = prefix | (1u << bit);
            int c = 0;
#pragma unroll
            for (int i = 0; i < 8; ++i) c += (myk[i] >= cand) ? 1 : 0;
            c = wave_sum_i(c);
            if (lane == 0) CNT[(bit & 1) * 8 + wave] = c;
            __syncthreads();
            int tot = 0;
#pragma unroll
            for (int w = 0; w < 8; ++w) tot += CNT[(bit & 1) * 8 + w];
            if (tot >= 256) prefix = cand;
        }
        thr = prefix;
        int c = 0;
#pragma unroll
        for (int i = 0; i < 8; ++i) c += (myk[i] > thr) ? 1 : 0;
        c = wave_sum_i(c);
        if (lane == 0) CNT[16 + wave] = c;
        __syncthreads();
        int tot = 0;
#pragma unroll
        for (int w = 0; w < 8; ++w) tot += CNT[16 + w];
        need_ties = 256 - tot;
    }
    if (wave == 0) {
        int pos = 0, ties = 0;
        const unsigned long long lt = (1ull << lane) - 1ull;
        for (int c0 = 0; c0 < n; c0 += 64) {
            const int s = c0 + lane; const bool valid = s < n; const unsigned k = valid ? KEY[s] : 0u;
            const bool gt = valid && (all || k > thr), eq = valid && !all && (k == thr);
            const unsigned long long beq = __ballot(eq); const int tr = ties + __popcll(beq & lt);
            const bool sel = gt || (eq && tr < need_ties);
            const unsigned long long bs = __ballot(sel); const int p = pos + __popcll(bs & lt);
            if (sel) LIST[p] = s;
            if (MASKo && lane == 0) MASKo[((size_t)b * 64 + (c0 >> 6)) * SEQ + t] = bs;
            pos += __popcll(bs); ties += __popcll(beq);
        }
        if (lane == 0) CNT[32] = pos;
    }
    __syncthreads();
    if (!O) return;
    const int nsel = CNT[32];
    const int g = wave >> 1, h0 = 4 * g + 2 * (wave & 1);
    const bf16* Q = WSP(bf16, WS_Q0); const bf16* Kp = WSP(bf16, WS_K0); const bf16* Vp = WSP(bf16, WS_V0);
    u32x4 q0[8], q1[8];
#pragma unroll
    for (int c = 0; c < 8; ++c) { q0[c] = ((const u32x4*)(Q + (size_t)m * 1024 + h0 * 64))[c]; q1[c] = ((const u32x4*)(Q + (size_t)m * 1024 + (h0 + 1) * 64))[c]; }
    float s0[4], s1[4]; float mx0 = -INFINITY, mx1 = -INFINITY;
#pragma unroll
    for (int i = 0; i < 4; ++i) { const int j = lane + 64 * i; s0[i] = -INFINITY; s1[i] = -INFINITY;
        if (j < nsel) { const int s = LIST[j]; const u32x4* kp = (const u32x4*)(Kp + (size_t)(b * SEQ + s) * 256 + g * 64); float d0 = 0.f, d1 = 0.f;
#pragma unroll
            for (int c = 0; c < 8; ++c) { const u32x4 kk = kp[c]; d0 = dot8(kk, q0[c], d0); d1 = dot8(kk, q1[c], d1); }
            s0[i] = d0; s1[i] = d1; }
        mx0 = fmaxf(mx0, s0[i]); mx1 = fmaxf(mx1, s1[i]); }
    mx0 = wave_max(mx0); mx1 = wave_max(mx1);
    float l0 = 0.f, l1 = 0.f;
    LAS float* P0 = PL + (wave * 2 + 0) * 256; LAS float* P1 = PL + (wave * 2 + 1) * 256;
#pragma unroll
    for (int i = 0; i < 4; ++i) { const int j = lane + 64 * i; const float p0 = (j < nsel) ? __builtin_amdgcn_exp2f(s0[i] - mx0) : 0.f, p1 = (j < nsel) ? __builtin_amdgcn_exp2f(s1[i] - mx1) : 0.f;
        l0 += p0; l1 += p1; P0[j] = bfround(p0); P1[j] = bfround(p1); }
    l0 = wave_sum(l0); l1 = wave_sum(l1);
    float a0 = 0.f, a1 = 0.f;
    for (int j = 0; j < nsel; ++j) { const int s = LIST[j]; const float v = bf2f(Vp[(size_t)(b * SEQ + s) * 256 + g * 64 + lane]); a0 += P0[j] * v; a1 += P1[j] * v; }
    O[(size_t)m * 1024 + h0 * 64 + lane] = (bf16)f2bf(a0 / l0); O[(size_t)m * 1024 + (h0 + 1) * 64 + lane] = (bf16)f2bf(a1 / l1);
    __syncthreads();
}

__device__ __forceinline__ void nsa_naive_item(Frame& F, int m, bf16* O  , bf16* OCG  , unsigned long long* SELo  ) {
    const int lane = F.lane, wave = F.wave;
    const int b = m >> 12, t = m & 4095, jt = t >> 6;
    const int g = wave >> 1, h0 = 4 * g + 2 * (wave & 1);
    LAS float* PC = (LAS float*)(F.lds);
    LAS float* SC0 = (LAS float*)(F.lds + 16384) + (wave * 2 + 0) * 1024;
    LAS float* SC1 = SC0 + 1024;
    LAS unsigned long long* SEL = (LAS unsigned long long*)(F.lds + 16384 + 65536);
    const bf16* Q = WSP(bf16, WS_Q1);
    u32x4 q0[8], q1[8];
#pragma unroll
    for (int c = 0; c < 8; ++c) { q0[c] = ((const u32x4*)(Q + (size_t)m * 1024 + h0 * 64))[c]; q1[c] = ((const u32x4*)(Q + (size_t)m * 1024 + (h0 + 1) * 64))[c]; }
    const int nv = t >= 31 ? min(255, (t - 31) / 16 + 1) : 0;
    const bf16* KC = WSP(bf16, SM_KC) + (size_t)(b * 4 + g) * 256 * 64; const bf16* VC = WSP(bf16, SM_VC) + (size_t)(b * 4 + g) * 256 * 64;
    float oc0 = 0.f, oc1 = 0.f;
    {
        float s0[4], s1[4]; float mx0 = -INFINITY, mx1 = -INFINITY;
#pragma unroll
        for (int i = 0; i < 4; ++i) { const int n = lane + 64 * i; s0[i] = -INFINITY; s1[i] = -INFINITY;
            if (n < nv) { const u32x4* kp = (const u32x4*)(KC + (size_t)n * 64); float d0 = 0.f, d1 = 0.f;
#pragma unroll
                for (int c = 0; c < 8; ++c) { const u32x4 kk = kp[c]; d0 = dot8(kk, q0[c], d0); d1 = dot8(kk, q1[c], d1); }
                s0[i] = d0; s1[i] = d1; }
            mx0 = fmaxf(mx0, s0[i]); mx1 = fmaxf(mx1, s1[i]); }
        mx0 = wave_max(mx0); mx1 = wave_max(mx1);
        float p0[4], p1[4], l0 = 0.f, l1 = 0.f;
#pragma unroll
        for (int i = 0; i < 4; ++i) { const int n = lane + 64 * i; p0[i] = (n < nv) ? __builtin_amdgcn_exp2f(s0[i] - mx0) : 0.f; p1[i] = (n < nv) ? __builtin_amdgcn_exp2f(s1[i] - mx1) : 0.f; l0 += p0[i]; l1 += p1[i]; }
        l0 = wave_sum(l0); l1 = wave_sum(l1);
        const float r0 = nv > 0 ? 1.0f / l0 : 0.f, r1 = nv > 0 ? 1.0f / l1 : 0.f;
#pragma unroll
        for (int i = 0; i < 4; ++i) { const int n = lane + 64 * i; PC[h0 * 256 + n] = p0[i] * r0; PC[(h0 + 1) * 256 + n] = p1[i] * r1; SC0[n] = bfround(p0[i]); SC1[n] = bfround(p1[i]); }
        for (int n = 0; n < nv; ++n) { const float v = bf2f(VC[(size_t)n * 64 + lane]); oc0 += SC0[n] * v; oc1 += SC1[n] * v; }
        oc0 *= r0; oc1 *= r1;
    }
    __syncthreads();
    if ((wave & 1) == 0) {
        const int j = lane;
        auto P4 = [&](int n) -> float { return (PC[(4 * g) * 256 + n] + PC[(4 * g + 1) * 256 + n]) + (PC[(4 * g + 2) * 256 + n] + PC[(4 * g + 3) * 256 + n]); };
        float imp = P4(4 * j) + P4(4 * j + 1) + P4(4 * j + 2) + 0.5f * P4(4 * j + 3);
        if (j > 0) imp += 0.5f * P4(4 * j - 1);
        const bool valid = j <= jt, forced = (j == 0) || (j == jt) || (j + 1 == jt);
        const float val = valid ? (forced ? 1e30f : imp) : -1e30f;
        int rank = 0;
        for (int jj = 0; jj < 64; ++jj) { const float vj = __shfl(val, jj); rank += ((vj > val) || (vj == val && jj < j)) ? 1 : 0; }
        const unsigned long long mk = __ballot(rank < 16);
        if (lane == 0) { SEL[g] = mk; if (SELo) SELo[((size_t)b * 4 + g) * SEQ + t] = mk; }
    }
    __syncthreads();
    const float* gt = WSP(float, SM_GATES) + (size_t)m * 48;
    if (OCG) { OCG[(size_t)m * 1024 + h0 * 64 + lane] = (bf16)f2bf(gt[h0 * 3] * oc0); OCG[(size_t)m * 1024 + (h0 + 1) * 64 + lane] = (bf16)f2bf(gt[h0 * 3 + 3] * oc1); }
    if (!O) return;
    float os0 = 0.f, os1 = 0.f;
    {
        unsigned long long mk = SEL[g]; if (jt < 63) mk &= ((1ull << (jt + 1)) - 1ull);
        const bf16* Ks = WSP(bf16, WS_KSLC); const bf16* Vs = WSP(bf16, WS_VSLC);
        int cnt = 0; float mx0 = -INFINITY, mx1 = -INFINITY;
        for (unsigned long long r = mk; r; r &= r - 1ull) { const int j = __builtin_ctzll(r); const int tok = 64 * j + lane;
            float d0 = -INFINITY, d1 = -INFINITY;
            if (tok <= t) { const u32x4* kp = (const u32x4*)(Ks + (size_t)(b * SEQ + tok) * 256 + g * 64); d0 = 0.f; d1 = 0.f;
#pragma unroll
                for (int c = 0; c < 8; ++c) { const u32x4 kk = kp[c]; d0 = dot8(kk, q0[c], d0); d1 = dot8(kk, q1[c], d1); } }
            SC0[cnt * 64 + lane] = d0; SC1[cnt * 64 + lane] = d1; mx0 = fmaxf(mx0, d0); mx1 = fmaxf(mx1, d1); ++cnt; }
        mx0 = wave_max(mx0); mx1 = wave_max(mx1);
        float l0 = 0.f, l1 = 0.f;
        for (int i = lane; i < cnt * 64; i += 64) { const float p0 = __builtin_amdgcn_exp2f(SC0[i] - mx0), p1 = __builtin_amdgcn_exp2f(SC1[i] - mx1); l0 += p0; l1 += p1; SC0[i] = bfround(p0); SC1[i] = bfround(p1); }
        l0 = wave_sum(l0); l1 = wave_sum(l1);
        cnt = 0;
        for (unsigned long long r = mk; r; r &= r - 1ull) { const int j = __builtin_ctzll(r);
            const int kmax = min(64, t - 64 * j + 1);
            for (int kk = 0; kk < kmax; ++kk) { const float v = bf2f(Vs[(size_t)(b * SEQ + 64 * j + kk) * 256 + g * 64 + lane]); os0 += SC0[cnt * 64 + kk] * v; os1 += SC1[cnt * 64 + kk] * v; }
            ++cnt; }
        os0 /= l0; os1 /= l1;
    }
    float ow0 = 0.f, ow1 = 0.f;
    {
        const bf16* Kw = WSP(bf16, WS_KWIN); const bf16* Vw = WSP(bf16, WS_VWIN);
        const int slo = max(0, t - 511), nw = t - slo + 1;
        float mx0 = -INFINITY, mx1 = -INFINITY;
        for (int i = lane; i < nw; i += 64) { const u32x4* kp = (const u32x4*)(Kw + (size_t)(b * SEQ + slo + i) * 256 + g * 64); float d0 = 0.f, d1 = 0.f;
#pragma unroll
            for (int c = 0; c < 8; ++c) { const u32x4 kk = kp[c]; d0 = dot8(kk, q0[c], d0); d1 = dot8(kk, q1[c], d1); }
            SC0[i] = d0; SC1[i] = d1; mx0 = fmaxf(mx0, d0); mx1 = fmaxf(mx1, d1); }
        mx0 = wave_max(mx0); mx1 = wave_max(mx1);
        float l0 = 0.f, l1 = 0.f;
        for (int i = lane; i < nw; i += 64) { const float p0 = __builtin_amdgcn_exp2f(SC0[i] - mx0), p1 = __builtin_amdgcn_exp2f(SC1[i] - mx1); l0 += p0; l1 += p1; SC0[i] = bfround(p0); SC1[i] = bfround(p1); }
        l0 = wave_sum(l0); l1 = wave_sum(l1);
        for (int i = 0; i < nw; ++i) { const float v = bf2f(Vw[(size_t)(b * SEQ + slo + i) * 256 + g * 64 + lane]); ow0 += SC0[i] * v; ow1 += SC1[i] * v; }
        ow0 /= l0; ow1 /= l1;
    }
    O[(size_t)m * 1024 + h0 * 64 + lane] = (bf16)f2bf(gt[h0 * 3] * oc0 + gt[h0 * 3 + 1] * os0 + gt[h0 * 3 + 2] * ow0);
    O[(size_t)m * 1024 + (h0 + 1) * 64 + lane] = (bf16)f2bf(gt[h0 * 3 + 3] * oc1 + gt[h0 * 3 + 4] * os1 + gt[h0 * 3 + 5] * ow1);
    __syncthreads();
}

namespace ix {
__device__ __forceinline__ void unit(Frame& F, int b, int qb) {
    const int lane = F.lane, wid = F.wave, r32 = lane & 31, hh = lane >> 5;
    const int q0w = 32 * qb + 4 * wid;
    LAS unsigned char* lds = F.lds;
    bf16x8 af[4];
    { const int rho = r32, hsel = (rho >> 2) & 1, r = (rho & 3) + 4 * (rho >> 3), qq = q0w + 2 * hsel + (r >> 3), head = r & 7;
      const bf16* ap = WSP(bf16, WS_IQ) + ((size_t)b * SEQ + qq) * 512 + head * 64 + 8 * hh;
#pragma unroll
      for (int d0 = 0; d0 < 4; ++d0) af[d0] = *(const bf16x8*)(ap + 16 * d0); }
    float w[16];
    { const float* wp = WSP(float, SM_IW) + ((size_t)b * SEQ + q0w + 2 * hh) * 8;
#pragma unroll
      for (int i = 0; i < 4; ++i) { const f32x4 v = ((const f32x4*)wp)[i]; w[4 * i] = v.x; w[4 * i + 1] = v.y; w[4 * i + 2] = v.z; w[4 * i + 3] = v.w; } }
    const int NT = ((32 * qb + 31) >> 6) + 1;
    const bf16* IKb = WSP(bf16, WS_IK) + (size_t)b * SEQ * 64;
    float* SC = WSP(float, WS_SCORES) + ((size_t)b * SEQ + q0w + 2 * hh) * SEQ + r32;
#define IX_DMA(t, buf) __builtin_amdgcn_global_load_lds((const unsigned*)(IKb + (size_t)(64 * (t) + lane) * 64 + wid * 8), (LAS unsigned*)(lds + (buf) * 8192 + wid * 1024), 16, 0, 0)
    IX_DMA(0, 0);
    __syncthreads();
    for (int t = 0; t < NT; ++t) {
        if (t + 1 < NT) IX_DMA(t + 1, (t + 1) & 1);
        const LAS unsigned char* kb = lds + (t & 1) * 8192 + hh * 1024 + r32 * 16;
        f32x16 a0 = {}, a1 = {};
#pragma unroll
        for (int d0 = 0; d0 < 4; ++d0) {
            const bf16x8 b0 = *(const LAS bf16x8*)(kb + d0 * 2048), b1 = *(const LAS bf16x8*)(kb + d0 * 2048 + 512);
            a0 = __builtin_amdgcn_mfma_f32_32x32x16_bf16(af[d0], b0, a0, 0, 0, 0);
            a1 = __builtin_amdgcn_mfma_f32_32x32x16_bf16(af[d0], b1, a1, 0, 0, 0);
        }
        float sA0 = 0.f, sB0 = 0.f, sA1 = 0.f, sB1 = 0.f;
#pragma unroll
        for (int r = 0; r < 8; ++r) { sA0 += w[r] * fmaxf(a0[r], 0.f); sB0 += w[8 + r] * fmaxf(a0[8 + r], 0.f); sA1 += w[r] * fmaxf(a1[r], 0.f); sB1 += w[8 + r] * fmaxf(a1[8 + r], 0.f); }
        float* o = SC + 64 * t;
        o[0] = sA0; o[32] = sA1; o[SEQ] = sB0; o[SEQ + 32] = sB1;
        __syncthreads();
    }
#undef IX_DMA
}
__device__ __forceinline__ void select_row(Frame& F, int m) {
    const int lane = F.lane, b = m >> 12, t = m & 4095, n = t + 1;
    const float* row = WSP(float, WS_SCORES) + (size_t)m * SEQ + lane;
    unsigned k[64];
#pragma unroll
    for (int gI = 0; gI < 4; ++gI) {
        if (gI * 1024 < n) {
#pragma unroll
            for (int j = 16 * gI; j < 16 * gI + 16; ++j) { k[j] = (64 * j + lane < n) ? okey(row[64 * j]) : 0u; }
        } else {
#pragma unroll
            for (int j = 16 * gI; j < 16 * gI + 16; ++j) k[j] = 0u;
        }
    }
    unsigned thrg = 0u; int need = 0;
    if (n > 256) {
        unsigned prefix = 0u; bool exact = false;
        for (int bit = 31; bit >= 0; --bit) {
            const unsigned cand = prefix | (1u << bit);
            int c = 0;
#pragma unroll
            for (int j = 0; j < 64; ++j) c += __popcll(__ballot(k[j] >= cand));
            if (c >= 256) { prefix = cand; if (c == 256) { exact = true; break; } }
        }
        if (exact) { thrg = prefix - 1u; need = 0; }
        else { int cg = 0;
#pragma unroll
            for (int j = 0; j < 64; ++j) cg += __popcll(__ballot(k[j] > prefix));
            thrg = prefix; need = 256 - cg; }
    }
    const unsigned long long lt = (1ull << lane) - 1ull;
    unsigned long long myw = 0ull; int ties = 0;
#pragma unroll
    for (int j = 0; j < 64; ++j) {
        const bool valid = (64 * j + lane) < n;
        const bool gt = valid && (k[j] > thrg), eq = valid && (need > 0) && (k[j] == thrg);
        const unsigned long long beq = __ballot(eq);
        const bool sel = gt || (eq && (ties + __popcll(beq & lt) < need));
        const unsigned long long bs = __ballot(sel);
        ties += __popcll(beq);
        if (lane == j) myw = bs;
    }
    if (lane <= (t >> 6)) WSP(unsigned long long, WS_MASK)[((size_t)b * 64 + lane) * SEQ + t] = myw;
}
}

namespace fa {
typedef short s16x4 __attribute__((ext_vector_type(4)));
typedef short v4i16_t __attribute__((ext_vector_type(4)));
constexpr int KOFF = 0, VOFF = 16384, XOFF = 32768, OSTOFF = 36864, TOTOFF = 69632;
constexpr float THR = 8.0f;
__device__ __forceinline__ int crow(int r, int hi) { return (r & 3) + 8 * (r >> 2) + 4 * hi; }
typedef float f32x2_t __attribute__((ext_vector_type(2))); typedef __bf16 bf16x2_t __attribute__((ext_vector_type(2)));
__device__ __forceinline__ unsigned cvtpk(float lo, float hi) { f32x2_t v = {lo, hi}; bf16x2_t b = __builtin_convertvector(v, bf16x2_t); return __builtin_bit_cast(unsigned, b); }
struct Ctx { LAS unsigned char* lds; int lane, wid, r32, hi; };

__device__ __forceinline__ void dma_tile(const Ctx& c, const bf16* Kg, const bf16* Vg, int pitch, int t, int buf) {
    const bf16* ks = Kg + (size_t)(64 * t + c.lane) * pitch + c.wid * 8;
    __builtin_amdgcn_global_load_lds((const unsigned*)ks, (LAS unsigned*)(c.lds + KOFF + buf * 8192 + c.wid * 1024), 16, 0, 0);
    const bf16* vs = Vg + (size_t)(64 * t + 16 * (c.wid & 3) + (c.lane >> 2)) * pitch + (c.wid >> 2) * 32 + (c.lane & 3) * 8;
    __builtin_amdgcn_global_load_lds((const unsigned*)vs, (LAS unsigned*)(c.lds + VOFF + buf * 8192 + c.wid * 1024), 16, 0, 0);
}
__device__ __forceinline__ void qk(const Ctx& c, int buf, const f32x16& ci, f32x16& p0, f32x16& p1) {
    const LAS unsigned char* kb = c.lds + KOFF + buf * 8192 + c.hi * 1024 + c.r32 * 16;
    const LAS bf16x8* qs = (const LAS bf16x8*)(c.lds + OSTOFF + c.wid * 4096) + c.lane;
    p0 = ci; p1 = ci;
#pragma unroll
    for (int d0 = 0; d0 < 4; ++d0) {
        const bf16x8 b0 = *(const LAS bf16x8*)(kb + d0 * 2048), b1 = *(const LAS bf16x8*)(kb + d0 * 2048 + 512), q = qs[d0 * 64];
        p0 = __builtin_amdgcn_mfma_f32_32x32x16_bf16(b0, q, p0, 0, 0, 0);
        p1 = __builtin_amdgcn_mfma_f32_32x32x16_bf16(b1, q, p1, 0, 0, 0);
    }
}
__device__ __forceinline__ void park_q(const Ctx& c, const bf16* Qrow  ) {
    LAS bf16x8* qs = (LAS bf16x8*)(c.lds + OSTOFF + c.wid * 4096) + c.lane;
#pragma unroll
    for (int d0 = 0; d0 < 4; ++d0) qs[d0 * 64] = *(const bf16x8*)(Qrow + d0 * 16 + c.hi * 8);
}
__device__ __forceinline__ s16x4 vtr(const LAS unsigned char* p) { return __builtin_bit_cast(s16x4, __builtin_amdgcn_ds_read_tr16_b64_v4i16((LAS v4i16_t*)p)); }
__device__ __forceinline__ void pv(const Ctx& c, int buf, f32x16 (&o)[2], f32x16& lacc, const u32x4 (&pw)[4]) {
    const LAS unsigned char* vp = c.lds + VOFF + buf * 8192 + ((c.lane >> 4) & 1) * 32 + (c.lane & 3) * 8 + (4 * c.hi + ((c.lane & 15) >> 2)) * 64;
    const bf16x8 ones = {(short)0x3F80, (short)0x3F80, (short)0x3F80, (short)0x3F80, (short)0x3F80, (short)0x3F80, (short)0x3F80, (short)0x3F80};
#pragma unroll
    for (int d0 = 0; d0 < 2; ++d0) {
        s16x4 lo[4], hi[4];
#pragma unroll
        for (int ks = 0; ks < 4; ++ks) { lo[ks] = vtr(vp + d0 * 4096 + ks * 1024); hi[ks] = vtr(vp + d0 * 4096 + ks * 1024 + 512); }
#pragma unroll
        for (int ks = 0; ks < 4; ++ks) {
            const bf16x8 vf = {lo[ks][0], lo[ks][1], lo[ks][2], lo[ks][3], hi[ks][0], hi[ks][1], hi[ks][2], hi[ks][3]};
            o[d0] = __builtin_amdgcn_mfma_f32_32x32x16_bf16(__builtin_bit_cast(bf16x8, pw[ks]), vf, o[d0], 0, 0, 0);
        }
        __builtin_amdgcn_sched_barrier(0);
    }
#pragma unroll
    for (int ks = 0; ks < 4; ++ks) lacc = __builtin_amdgcn_mfma_f32_32x32x16_bf16(__builtin_bit_cast(bf16x8, pw[ks]), ones, lacc, 0, 0, 0);
}
struct State { f32x16 o[2]; f32x16 lacc; f32x16 negm; float m; };
__device__ __forceinline__ void reset(State& s) { s.o[0] = f32x16{}; s.o[1] = f32x16{}; s.lacc = f32x16{}; s.negm = f32x16{}; s.m = 0.f; }
__device__ __forceinline__ float rowmax(const f32x16& p0, const f32x16& p1) {
    float a = fmaxf(fmaxf(p0[0], p0[1]), p1[0]), b = fmaxf(fmaxf(p0[2], p0[3]), p1[1]); a = fmaxf(fmaxf(a, p1[2]), p1[3]);
#pragma unroll
    for (int r = 4; r < 16; r += 4) { a = fmaxf(fmaxf(a, p0[r]), p0[r + 1]); b = fmaxf(fmaxf(b, p0[r + 2]), p0[r + 3]); a = fmaxf(fmaxf(a, p1[r]), p1[r + 1]); b = fmaxf(fmaxf(b, p1[r + 2]), p1[r + 3]); }
    const float m = fmaxf(a, b);
    return fmaxf(m, __shfl_xor(m, 32));
}
template <bool BITS>
__device__ __forceinline__ void tile_step(const Ctx& c, int buf, State& s, const f32x16& ci, bool first, unsigned w0, unsigned w1) {
    f32x16 p0, p1;
    qk(c, buf, ci, p0, p1);
    __builtin_amdgcn_sched_barrier(0);
    const float rm = rowmax(p0, p1);
    bool doit; float dl;
    if (first) { doit = true; dl = rm; } else { doit = __any(rm > THR); dl = fmaxf(rm, 0.f); }
    if (doit) {
        s.m += dl;
#pragma unroll
        for (int r = 0; r < 16; ++r) { p0[r] -= dl; p1[r] -= dl; s.negm[r] = -s.m; }
        if (!first) {
            const float f = __builtin_amdgcn_exp2f(-dl);
            LAS float* xs = (LAS float*)(c.lds + XOFF) + c.wid * 64;
            if (c.hi == 0) xs[c.r32] = f;
#pragma unroll
            for (int r = 0; r < 16; ++r) { const float fr = xs[crow(r, c.hi)]; s.o[0][r] *= fr; s.o[1][r] *= fr; s.lacc[r] *= fr; }
        }
    }
    if (BITS) { w0 >>= 4 * c.hi; w1 >>= 4 * c.hi; }
#pragma unroll
    for (int r = 0; r < 16; ++r) {
        float e0 = __builtin_amdgcn_exp2f(p0[r]), e1 = __builtin_amdgcn_exp2f(p1[r]);
        if (BITS) { const int sh = (r & 3) + 8 * (r >> 2);
            e0 = __builtin_bit_cast(float, __builtin_bit_cast(unsigned, e0) & (unsigned)__builtin_amdgcn_sbfe((int)w0, sh, 1));
            e1 = __builtin_bit_cast(float, __builtin_bit_cast(unsigned, e1) & (unsigned)__builtin_amdgcn_sbfe((int)w1, sh, 1)); }
        p0[r] = e0; p1[r] = e1;
    }
    u32x4 pw[4];
    pw[0] = (u32x4){cvtpk(p0[0], p0[1]), cvtpk(p0[2], p0[3]), cvtpk(p0[4], p0[5]), cvtpk(p0[6], p0[7])};
    pw[1] = (u32x4){cvtpk(p0[8], p0[9]), cvtpk(p0[10], p0[11]), cvtpk(p0[12], p0[13]), cvtpk(p0[14], p0[15])};
    pw[2] = (u32x4){cvtpk(p1[0], p1[1]), cvtpk(p1[2], p1[3]), cvtpk(p1[4], p1[5]), cvtpk(p1[6], p1[7])};
    pw[3] = (u32x4){cvtpk(p1[8], p1[9]), cvtpk(p1[10], p1[11]), cvtpk(p1[12], p1[13]), cvtpk(p1[14], p1[15])};
    __builtin_amdgcn_sched_barrier(0);
    pv(c, buf, s.o, s.lacc, pw);
}
__device__ __forceinline__ void causal_words(int qi, unsigned& w0, unsigned& w1) { const unsigned long long w = (qi >= 63) ? ~0ull : ((2ull << qi) - 1ull); w0 = (unsigned)w; w1 = (unsigned)(w >> 32); }
__device__ __forceinline__ void store_o(const Ctx& c, const f32x16 (&val)[2], bf16* Ow  ) {
    LAS bf16* stg = (LAS bf16*)(c.lds + OSTOFF) + c.wid * 2048;
#pragma unroll
    for (int r = 0; r < 16; ++r) { const int orow = crow(r, c.hi);
#pragma unroll
        for (int d0 = 0; d0 < 2; ++d0) stg[orow * 64 + d0 * 32 + c.r32] = (bf16)f2bf(val[d0][r]); }
#pragma unroll
    for (int i = 0; i < 4; ++i) { const int row = i * 8 + (c.lane >> 3), ch = c.lane & 7; const u32x4 v = *(const LAS u32x4*)(stg + row * 64 + ch * 8); *(u32x4*)(Ow + (size_t)row * 1024 + ch * 8) = v; }
}

__device__ __forceinline__ void dsa_unit(Frame& F, int b, int g, int qt) {
    Ctx c; c.lds = F.lds; c.lane = F.lane; c.wid = F.wave; c.r32 = F.lane & 31; c.hi = F.lane >> 5;
    const int h = 4 * g + (c.wid >> 1), qw = 64 * qt + 32 * (c.wid & 1);
    const size_t mrow = (size_t)b * SEQ + qw;
    const bf16* Q = LWSP(bf16, WS_Q0) + (mrow + c.r32) * 1024 + h * 64;
    park_q(c, Q);
    const bf16* Kg = LWSP(bf16, WS_K0) + (size_t)b * SEQ * 256 + g * 64; const bf16* Vg = LWSP(bf16, WS_V0) + (size_t)b * SEQ * 256 + g * 64;
    const u32x2* MK = (const u32x2*)(LWSP(unsigned long long, WS_MASK) + (size_t)b * 64 * SEQ + qw + c.r32);
    State s; reset(s);
    const int NT = qt + 1;
    dma_tile(c, Kg, Vg, 256, 0, 0);
    u32x2 mk_next = MK[0];
    __syncthreads();
    for (int t = 0; t < NT; ++t) {
        const u32x2 mk = mk_next;
        if (t + 1 < NT) { dma_tile(c, Kg, Vg, 256, t + 1, (t + 1) & 1); mk_next = MK[(size_t)(t + 1) * SEQ]; }
        tile_step<true>(c, t & 1, s, s.negm, t == 0, mk.x, mk.y);
        __syncthreads();
    }
    f32x16 val[2];
#pragma unroll
    for (int r = 0; r < 16; ++r) { const float rl = s.lacc[r] > 0.f ? 1.0f / s.lacc[r] : 0.f; val[0][r] = s.o[0][r] * rl; val[1][r] = s.o[1][r] * rl; }
    store_o(c, val, LWSP(bf16, WS_O0) + mrow * 1024 + h * 64);
}

__device__ __forceinline__ void nsa_unit(Frame& F, int b, int g, int qt) {
    Ctx c; c.lds = F.lds; c.lane = F.lane; c.wid = F.wave; c.r32 = F.lane & 31; c.hi = F.lane >> 5;
    const int h = 4 * g + (c.wid >> 1), qw = 64 * qt + 32 * (c.wid & 1), qi = 32 * (c.wid & 1) + c.r32;
    const size_t mrow = (size_t)b * SEQ + qw;
    park_q(c, LWSP(bf16, WS_Q1) + (mrow + c.r32) * 1024 + h * 64);
    const unsigned long long sel = LWSP(unsigned long long, WS_SEL)[((size_t)b * 4 + g) * SEQ + qw + c.r32];
    LAS float* gx = (LAS float*)(c.lds + XOFF + 2048) + c.wid * 64;
    gx[c.lane] = LWSP(float, SM_GATES)[(mrow + c.r32) * 48 + h * 3 + 1 + c.hi];
    LAS float* totw = (LAS float*)(c.lds + TOTOFF) + c.wid * 2048;
    LAS float* totl = totw + c.r32;
    State s;
    {
        const bf16* Kg = LWSP(bf16, WS_KSLC) + (size_t)b * SEQ * 256 + g * 64; const bf16* Vg = LWSP(bf16, WS_VSLC) + (size_t)b * SEQ * 256 + g * 64;
        reset(s);
        dma_tile(c, Kg, Vg, 256, 0, 0);
        __syncthreads();
        for (int t = 0; t <= qt; ++t) {
            if (t < qt) dma_tile(c, Kg, Vg, 256, t + 1, (t + 1) & 1);
            const bool on = (sel >> t) & 1ull;
            if (!on) {
#pragma unroll
                for (int r = 0; r < 16; ++r) s.negm[r] = -INFINITY; }
            if (t == qt) { unsigned w0, w1; causal_words(qi, w0, w1); tile_step<true>(c, t & 1, s, s.negm, t == 0, w0, w1); }
            else tile_step<false>(c, t & 1, s, s.negm, t == 0, 0u, 0u);
#pragma unroll
            for (int r = 0; r < 16; ++r) s.negm[r] = -s.m;
            __syncthreads();
        }
#pragma unroll
        for (int r = 0; r < 16; ++r) { const float gq = gx[crow(r, c.hi)]; const float rl = s.lacc[r] > 0.f ? gq / s.lacc[r] : 0.f; totl[crow(r, c.hi) * 64] = s.o[0][r] * rl; totl[crow(r, c.hi) * 64 + 32] = s.o[1][r] * rl; }
    }
    {
        const bf16* Kg = LWSP(bf16, WS_KWIN) + (size_t)b * SEQ * 256 + g * 64; const bf16* Vg = LWSP(bf16, WS_VWIN) + (size_t)b * SEQ * 256 + g * 64;
        reset(s);
        const int tlo = qt >= 8 ? qt - 8 : 0;
        dma_tile(c, Kg, Vg, 256, tlo, tlo & 1);
        __syncthreads();
        for (int t = tlo; t <= qt; ++t) {
            if (t < qt) dma_tile(c, Kg, Vg, 256, t + 1, (t + 1) & 1);
            if (t == qt) { unsigned w0, w1; causal_words(qi, w0, w1); tile_step<true>(c, t & 1, s, s.negm, t == tlo, w0, w1); }
            else if (t == qt - 8) { unsigned w0, w1; causal_words(qi, w0, w1); tile_step<true>(c, t & 1, s, s.negm, t == tlo, ~w0, ~w1); }
            else tile_step<false>(c, t & 1, s, s.negm, t == tlo, 0u, 0u);
            __syncthreads();
        }
#pragma unroll
        for (int r = 0; r < 16; ++r) { const float gq = gx[32 + crow(r, c.hi)]; const float rl = s.lacc[r] > 0.f ? gq / s.lacc[r] : 0.f; totl[crow(r, c.hi) * 64] += s.o[0][r] * rl; totl[crow(r, c.hi) * 64 + 32] += s.o[1][r] * rl; }
    }
    const bf16* OCG = LWSP(bf16, WS_OCG) + mrow * 1024 + h * 64; bf16* O = LWSP(bf16, WS_O1) + mrow * 1024 + h * 64;
#pragma unroll
    for (int i = 0; i < 8; ++i) { const int row = i * 4 + (c.lane >> 4), ch = c.lane & 15;
        const u32x2 oc = *(const u32x2*)(OCG + (size_t)row * 1024 + 4 * ch);
        const f32x4 v = *(const LAS f32x4*)(totw + row * 64 + 4 * ch) + (f32x4){bflo(oc.x), bfhi(oc.x), bflo(oc.y), bfhi(oc.y)};
        u32x2 w; w.x = pk2(v.x, v.y); w.y = pk2(v.z, v.w); *(u32x2*)(O + (size_t)row * 1024 + 4 * ch) = w; }
}
__device__ __forceinline__ void unit_of(int v, int i, int& b, int& g, int& qt) { const int bg = v >> 4, p = v & 15; b = bg >> 2; g = bg & 3; qt = (i == 0) ? p : (i == 1) ? 63 - p : (i == 2) ? 31 - p : 32 + p; }
}

namespace cm {
using namespace fa;
constexpr int IMPOFF = 69632;
__device__ __forceinline__ void unit(Frame& F, int b, int g, int qt) {
    Ctx c; c.lds = F.lds; c.lane = F.lane; c.wid = F.wave; c.r32 = F.lane & 31; c.hi = F.lane >> 5;
    const int hr = c.wid >> 1, h = 4 * g + hr, qw = 64 * qt + 32 * (c.wid & 1), qi = 32 * (c.wid & 1) + c.r32;
    const size_t mrow = (size_t)b * SEQ + qw;
    park_q(c, LWSP(bf16, WS_Q1) + (mrow + c.r32) * 1024 + h * 64);
    LAS float* gx = (LAS float*)(c.lds + XOFF + 2048) + c.wid * 64;
    if (c.hi == 0) gx[c.r32] = LWSP(float, SM_GATES)[(mrow + c.r32) * 48 + h * 3];
    const int t = qw + c.r32, nv = t >= 31 ? min(255, (t - 31) / 16 + 1) : 0;
    const bf16* Kg = LWSP(bf16, SM_KC) + (size_t)(b * 4 + g) * 256 * 64; const bf16* Vg = LWSP(bf16, SM_VC) + (size_t)(b * 4 + g) * 256 * 64;
    const int NTc = (qt >> 4) + 1;
    f32x16 o[2]; o[0] = f32x16{}; o[1] = f32x16{};
    f32x16 zero = {};
    float m = 0.f, l = 0.f, carry = 0.f;
    float bsum[4][8];
#pragma unroll
    for (int T_ = 0; T_ < 4; ++T_)
#pragma unroll
        for (int i = 0; i < 8; ++i) bsum[T_][i] = 0.f;
    dma_tile(c, Kg, Vg, 64, 0, 0);
    __syncthreads();
#pragma unroll
    for (int T_ = 0; T_ < 4; ++T_) {
        if (T_ < NTc) {
            if (T_ + 1 < NTc) dma_tile(c, Kg, Vg, 64, T_ + 1, (T_ + 1) & 1);
            f32x16 p0, p1;
            qk(c, T_ & 1, zero, p0, p1);
            __builtin_amdgcn_sched_barrier(0);
            const float rm = rowmax(p0, p1) - m;
            bool doit; float dl;
            if (T_ == 0) { doit = true; dl = rm; } else { doit = __any(rm > THR); dl = fmaxf(rm, 0.f); }
            if (doit) {
                m += dl;
                if (T_ > 0) {
                    const float f = __builtin_amdgcn_exp2f(-dl);
                    l *= f; carry *= f;
#pragma unroll
                    for (int u = 0; u < 4; ++u)
#pragma unroll
                        for (int i = 0; i < 8; ++i) bsum[u][i] *= f;
                    LAS float* xs = (LAS float*)(c.lds + XOFF) + c.wid * 64;
                    if (c.hi == 0) xs[c.r32] = f;
#pragma unroll
                    for (int r = 0; r < 16; ++r) { const float fr = xs[crow(r, c.hi)]; o[0][r] *= fr; o[1][r] *= fr; }
                }
            }
            const int cnt = nv - 64 * T_;
            const unsigned long long wm = cnt >= 64 ? ~0ull : (cnt <= 0 ? 0ull : ((1ull << cnt) - 1ull));
            const unsigned w0 = (unsigned)wm >> (4 * c.hi), w1 = (unsigned)(wm >> 32) >> (4 * c.hi);
            float ls = 0.f;
#pragma unroll
            for (int r = 0; r < 16; ++r) { const int sh = (r & 3) + 8 * (r >> 2);
                float e0 = __builtin_amdgcn_exp2f(p0[r] - m), e1 = __builtin_amdgcn_exp2f(p1[r] - m);
                e0 = __builtin_bit_cast(float, __builtin_bit_cast(unsigned, e0) & (unsigned)__builtin_amdgcn_sbfe((int)w0, sh, 1));
                e1 = __builtin_bit_cast(float, __builtin_bit_cast(unsigned, e1) & (unsigned)__builtin_amdgcn_sbfe((int)w1, sh, 1));
                p0[r] = e0; p1[r] = e1; ls += e0 + e1; }
            l += ls;
            float mn0[4], mn1[4], rc0[4], rc1[4];
#pragma unroll
            for (int i = 0; i < 4; ++i) { const float s0 = 0.5f * p0[4 * i + 3], s1 = 0.5f * p1[4 * i + 3];
                mn0[i] = (p0[4 * i] + p0[4 * i + 1]) + (p0[4 * i + 2] + s0); mn1[i] = (p1[4 * i] + p1[4 * i + 1]) + (p1[4 * i + 2] + s1);
                rc0[i] = __shfl_xor(s0, 32); rc1[i] = __shfl_xor(s1, 32); }
            if (c.hi) {
#pragma unroll
                for (int i = 0; i < 4; ++i) { bsum[T_][i] = mn0[i] + rc0[i]; bsum[T_][4 + i] = mn1[i] + rc1[i]; }
            } else {
                bsum[T_][0] = mn0[0] + carry; bsum[T_][4] = mn1[0] + rc0[3];
#pragma unroll
                for (int i = 1; i < 4; ++i) { bsum[T_][i] = mn0[i] + rc0[i - 1]; bsum[T_][4 + i] = mn1[i] + rc1[i - 1]; }
                carry = rc1[3];
            }
            u32x4 pw[4];
            pw[0] = (u32x4){cvtpk(p0[0], p0[1]), cvtpk(p0[2], p0[3]), cvtpk(p0[4], p0[5]), cvtpk(p0[6], p0[7])};
            pw[1] = (u32x4){cvtpk(p0[8], p0[9]), cvtpk(p0[10], p0[11]), cvtpk(p0[12], p0[13]), cvtpk(p0[14], p0[15])};
            pw[2] = (u32x4){cvtpk(p1[0], p1[1]), cvtpk(p1[2], p1[3]), cvtpk(p1[4], p1[5]), cvtpk(p1[6], p1[7])};
            pw[3] = (u32x4){cvtpk(p1[8], p1[9]), cvtpk(p1[10], p1[11]), cvtpk(p1[12], p1[13]), cvtpk(p1[14], p1[15])};
            __builtin_amdgcn_sched_barrier(0);
            {
                const LAS unsigned char* vp = c.lds + VOFF + (T_ & 1) * 8192 + ((c.lane >> 4) & 1) * 32 + (c.lane & 3) * 8 + (4 * c.hi + ((c.lane & 15) >> 2)) * 64;
#pragma unroll
                for (int d0 = 0; d0 < 2; ++d0) {
                    s16x4 lo[4], hi4[4];
#pragma unroll
                    for (int ks = 0; ks < 4; ++ks) { lo[ks] = vtr(vp + d0 * 4096 + ks * 1024); hi4[ks] = vtr(vp + d0 * 4096 + ks * 1024 + 512); }
#pragma unroll
                    for (int ks = 0; ks < 4; ++ks) { const bf16x8 vf = {lo[ks][0], lo[ks][1], lo[ks][2], lo[ks][3], hi4[ks][0], hi4[ks][1], hi4[ks][2], hi4[ks][3]};
                        o[d0] = __builtin_amdgcn_mfma_f32_32x32x16_bf16(__builtin_bit_cast(bf16x8, pw[ks]), vf, o[d0], 0, 0, 0); }
                    __builtin_amdgcn_sched_barrier(0);
                }
            }
            __syncthreads();
        }
    }
    l += __shfl_xor(l, 32);
    const float inv = l > 0.f ? 1.0f / l : 0.f;
    LAS float* imp = (LAS float*)(c.lds + IMPOFF) + (hr * 64 + qi) * 64;
#pragma unroll
    for (int T_ = 0; T_ < 4; ++T_)
#pragma unroll
        for (int i = 0; i < 4; ++i) { imp[16 * T_ + 2 * i + c.hi] = bsum[T_][i] * inv; imp[16 * T_ + 8 + 2 * i + c.hi] = bsum[T_][4 + i] * inv; }
    {
        LAS float* xs = (LAS float*)(c.lds + XOFF) + c.wid * 64;
        if (c.hi == 0) xs[c.r32] = inv * gx[c.r32];
#pragma unroll
        for (int r = 0; r < 16; ++r) { const float fr = xs[crow(r, c.hi)]; o[0][r] *= fr; o[1][r] *= fr; }
        store_o(c, o, LWSP(bf16, WS_OCG) + mrow * 1024 + h * 64);
    }
    __syncthreads();
    {
        const LAS float* I0 = (const LAS float*)(c.lds + IMPOFF);
        const int j = c.lane;
        for (int qq = 8 * c.wid; qq < 8 * c.wid + 8; ++qq) {
            const float iv = (I0[(0 * 64 + qq) * 64 + j] + I0[(1 * 64 + qq) * 64 + j]) + (I0[(2 * 64 + qq) * 64 + j] + I0[(3 * 64 + qq) * 64 + j]);
            const bool valid = j <= qt, forced = (j == 0) || (j == qt) || (j + 1 == qt);
            const float val = valid ? (forced ? 1e30f : iv) : -1e30f;
            int rank = 0;
            for (int jj = 0; jj < 64; ++jj) { const float vj = __shfl(val, jj); rank += ((vj > val) || (vj == val && jj < j)) ? 1 : 0; }
            const unsigned long long mk = __ballot(rank < 16);
            if (j == 0) LWSP(unsigned long long, WS_SEL)[((size_t)b * 4 + g) * SEQ + 64 * qt + qq] = mk;
        }
    }
    __syncthreads();
}
}


#if DBG_CHECK
__device__ __forceinline__ void dbg_compare(Frame& F, const bf16* A, const bf16* R, int slot) {
    float sd = 0.f, sr = 0.f;
    for (size_t i = (size_t)F.gw * 64 + F.lane; i < (size_t)T * D / 2; i += (size_t)F.NGW * 64) { const unsigned a = ((const unsigned*)A)[i], r = ((const unsigned*)R)[i];
        const float d0 = bflo(a) - bflo(r), d1 = bfhi(a) - bfhi(r); sd += d0 * d0 + d1 * d1; sr += bflo(r) * bflo(r) + bfhi(r) * bfhi(r); }
    sd = wave_sum(sd); sr = wave_sum(sr);
    if (F.lane == 0) { atomicAdd((float*)(F.ctl + CW_DBG + slot), sd); atomicAdd((float*)(F.ctl + CW_DBG + slot + 1), sr); }
}
#endif
constexpr int NPHASE = 21;
struct Args { const void* in[29]; float* out; unsigned char* ws; int ph_lo, ph_hi, li, pad; };
__global__ void __launch_bounds__(NWAVES * 64, 2) trunk_fwd(Args args) {
    extern __shared__ __attribute__((aligned(16))) unsigned char lds[];
    Frame F;
    F.lds = (LAS unsigned char*)lds;
    F.MISC = (volatile LAS unsigned*)(F.lds + MISC_OFF);
    F.tid = threadIdx.x; F.lane = F.tid & 63; F.wave = __builtin_amdgcn_readfirstlane(F.tid >> 6);
    F.G = gridDim.x; F.gw = blockIdx.x * NWAVES + F.wave; F.NGW = F.G * NWAVES;
    F.ws = args.ws; F.ctl = (unsigned*)(args.ws + WS_CTL);
    F.x = (const float*)args.in[0]; F.c = (const float*)args.in[1]; F.pos = (const int*)args.in[2];
    F.attn_gain = (const float*)args.in[3]; F.ffn_gain = (const float*)args.in[4]; F.w_ada = (const float*)args.in[5]; F.b_ada = (const float*)args.in[6];
    F.a_w_in = (const float*)args.in[7]; F.a_w_out = (const float*)args.in[8]; F.b_w_q = (const float*)args.in[9]; F.b_w_out = (const float*)args.in[10];
    F.kv_gain = (const float*)args.in[11]; F.w_kv_ada = (const float*)args.in[12]; F.b_kv_ada = (const float*)args.in[13]; F.w_kv = (const float*)args.in[14];
    F.pe_k = (const float*)args.in[15]; F.w1_k = (const float*)args.in[16]; F.w2_k = (const float*)args.in[17]; F.pe_v = (const float*)args.in[18]; F.w1_v = (const float*)args.in[19]; F.w2_v = (const float*)args.in[20];
    F.ffn_wg = (const float*)args.in[21]; F.ffn_wu = (const float*)args.in[22]; F.ffn_wd = (const float*)args.in[23]; F.w_router = (const float*)args.in[24];
    F.moe_wg = (const float*)args.in[25]; F.moe_wu = (const float*)args.in[26]; F.moe_wd = (const float*)args.in[27]; F.final_gain = (const float*)args.in[28];
    F.out = args.out;
    for (int u = F.tid; u < (LDS_BYTES - LDSCTL_OFF) / 4; u += NWAVES * 64) ((LAS unsigned*)(F.lds + LDSCTL_OFF))[u] = 0u;
    __syncthreads();
    XcdBarrier bar; bar.bar = F.ctl + CW_BAR; bar.x = 0; bar.st = nullptr;
    if (!MK_PER_PHASE) bar = xcd_barrier_post(F.ctl + CW_BAR, F.MISC + 8);
#define GRID_BAR() do { if (!MK_PER_PHASE) xcd_barrier(bar); } while (0)
#define GRID_BAR_ALWAYS() do { static_assert(!MK_PER_PHASE, "a seam inside a phase needs the one-launch build"); xcd_barrier(bar); } while (0)
    const int lo = args.ph_lo, hi = args.ph_hi;
#define IN(k) (lo <= (k) && (k) < hi)
#define BOTH(k) (IN(k) && IN((k) + 1))
    const float* MOD0 = WSP(float, SM_MOD0); const float* MOD1 = WSP(float, SM_MOD1); const float* KVMOD = WSP(float, SM_KVMOD);
    const float* CS = WSP(float, SM_COS); const float* SN = WSP(float, SM_SIN);

    if (IN(0)) { p0_prologue(F); if (BOTH(0)) GRID_BAR(); }
    if (IN(1)) { norm_phase(F, F.x, F.attn_gain, MOD0, 6144, 0, 1024, WSP(bf16, WS_U)); if (BOTH(1)) GRID_BAR(); }
    if (IN(2)) {
        pg8::Gemm g{WSP(bf16, WS_U), WSP(bf16, WB_IN), D, D, D}; pg8::StaticOrder S; S.init(T, A_INP, F.G, (int)blockIdx.x);
        EpiIn E{WSP(bf16, WS_Q0), WSP(bf16, WS_K0), WSP(bf16, WS_V0), WSP(bf16, WS_IQ), WSP(bf16, WS_IK), WSP(float, SM_IW), CS, SN};
        pg8::gemm_phase(F.lds, g, S, E);
        if (BOTH(2)) GRID_BAR();
    }
    if (IN(3)) {
        for (int p = blockIdx.x; p < 256; p += F.G) { const int b = p >> 6, q = p & 63; ix::unit(F, b, q); ix::unit(F, b, 127 - q); }
        GRID_BAR_ALWAYS();
        for (int m = F.gw; m < T; m += F.NGW) ix::select_row(F, m);
        if (BOTH(3)) GRID_BAR(); }
    if (IN(4)) {
        const int v = (F.G == 256) ? ((int)(blockIdx.x & 7) * 32 + (int)(blockIdx.x >> 3)) : (int)blockIdx.x;
        for (int vv = v; vv < 256; vv += F.G) for (int i = 0; i < 4; ++i) { int b, g, qt; fa::unit_of(vv, i, b, g, qt); fa::dsa_unit(F, b, g, qt); }
#if DBG_CHECK
        for (int m = blockIdx.x; m < T; m += F.G) dsa_naive_item(F, m, WSP(bf16, WS_DBG_O0), nullptr);
        GRID_BAR_ALWAYS(); dbg_compare(F, WSP(bf16, WS_O0), WSP(bf16, WS_DBG_O0), 0);
#endif
        if (BOTH(4)) GRID_BAR(); }
    if (IN(5)) {
        pg8::Gemm g{WSP(bf16, WS_O0), WSP(bf16, WB_O0), D, D, D}; pg8::StaticOrder S; S.init(T, D, F.G, (int)blockIdx.x);
        EpiRes E{F.x, F.out, MOD0 + 2048, 6144};
        pg8::gemm_phase(F.lds, g, S, E);
        if (BOTH(5)) GRID_BAR();
    }
    if (IN(6)) {
        norm_phase(F, F.out, F.ffn_gain, MOD0, 6144, 3072, 4096, WSP(bf16, WS_U));
        { LAS float* scr = (LAS float*)(F.lds + F.wave * 16384); for (int it = F.gw; it < NCONV_B; it += F.NGW) conv_item_b(F, it, scr); }
        if (BOTH(6)) GRID_BAR();
    }
    if (IN(7)) {
        pg8::Gemm g{WSP(bf16, WS_U), WSP(bf16, WB_GU0), D, D, D}; pg8::StaticOrder S; S.init(T, 2 * FF0, F.G, (int)blockIdx.x);
        EpiSwiglu E{WSP(bf16, WS_HID), FF0, 2 * FF0 / 256};
        pg8::gemm_phase(F.lds, g, S, E);
        if (BOTH(7)) GRID_BAR();
    }
    if (IN(8)) {
        pg8::Gemm g{WSP(bf16, WS_HID), WSP(bf16, WB_D0), FF0, FF0, FF0}; pg8::StaticOrder S; S.init(T, D, F.G, (int)blockIdx.x);
        EpiRes E{F.out, F.out, MOD0 + 5120, 6144};
        pg8::gemm_phase(F.lds, g, S, E);
        if (BOTH(8)) GRID_BAR();
    }
    if (IN(9)) {
        for (int m = F.gw; m < T; m += F.NGW) {
            f32x4 v[4], u[4]; load_row(F.out + (size_t)m * D, F.lane, v);
            const float r = row_rs(v); const int b = m >> 12;
            modulate_row(v, r, F.kv_gain, KVMOD + (size_t)b * 2048, KVMOD + (size_t)b * 2048 + 1024, F.lane, u);
            store_row_bf16(WSP(bf16, WS_U) + (size_t)m * D, F.lane, u);
            modulate_row(v, r, F.attn_gain + D, MOD1 + (size_t)b * 6144, MOD1 + (size_t)b * 6144 + 1024, F.lane, u);
            store_row_bf16(WSP(bf16, WS_U2) + (size_t)m * D, F.lane, u);
        }
        if (BOTH(9)) GRID_BAR();
    }
    if (IN(10)) {
        pg8::Gemm g{WSP(bf16, WS_U), WSP(bf16, WB_KVQ), D, D, D}; KvqOrder S; S.S.init(T, 11 * 256, F.G, (int)blockIdx.x);
        EpiKVQ E{WSP(bf16, WS_KCMP), WSP(bf16, WS_VCMP), WSP(bf16, WS_KSLC), WSP(bf16, WS_VSLC), WSP(bf16, WS_KWIN), WSP(bf16, WS_VWIN), WSP(bf16, WS_Q1), WSP(float, SM_GATES), CS, SN};
        pg8::gemm_phase(F.lds, g, S, E);
        if (BOTH(10)) GRID_BAR();
    }
    if (IN(11)) {
        const float* cb = WSP(float, SM_CBIAS); bf16* CH = WSP(bf16, WS_CH);
        for (int it = F.gw; it < 256 * 8; it += F.NGW) {
            const int rt = it >> 3, ct = it & 7, kv = rt >> 7;
            const bf16* A = kv ? WSP(bf16, WS_VCMP) : WSP(bf16, WS_KCMP);
            const f32x16 acc = sgemm_tile(A, 1024, WSP(bf16, WB_C1) + (size_t)kv * 256 * 2048, 2048, 2048, (rt & 127) * 32, ct * 32, F.lane);
            const int col = ct * 32 + (F.lane & 31); const float bias = cb[kv * 256 + col];
#pragma unroll
            for (int r = 0; r < 16; ++r) { const int row = rt * 32 + (r & 3) + 8 * (r >> 2) + 4 * (F.lane >> 5); CH[(size_t)row * 256 + col] = (bf16)f2bf(gelu_tanh(acc[r] + bias)); }
        }
        if (BOTH(11)) GRID_BAR();
    }
    if (IN(12)) {
        const bf16* CH = WSP(bf16, WS_CH);
        for (int it = F.gw; it < 256 * 2; it += F.NGW) {
            const int rt = it >> 1, ct = it & 1, kv = rt >> 7;
            const f32x16 acc = sgemm_tile(CH, 256, WSP(bf16, WB_C2) + (size_t)kv * 64 * 256, 256, 256, rt * 32, ct * 32, F.lane);
            bf16* dst = kv ? WSP(bf16, SM_VC) : WSP(bf16, SM_KC);
            const int col = ct * 32 + (F.lane & 31);
#pragma unroll
            for (int r = 0; r < 16; ++r) { const int row = (rt & 127) * 32 + (r & 3) + 8 * (r >> 2) + 4 * (F.lane >> 5); dst[(size_t)row * 64 + col] = ((row & 255) == 255) ? (bf16)0 : (bf16)f2bf(acc[r]); }
        }
        if (BOTH(12)) GRID_BAR();
    }
    if (IN(13)) {
        const int v = (F.G == 256) ? ((int)(blockIdx.x & 7) * 32 + (int)(blockIdx.x >> 3)) : (int)blockIdx.x;
        for (int vv = v; vv < 256; vv += F.G) for (int i = 0; i < 4; ++i) { int b, g, qt; fa::unit_of(vv, i, b, g, qt); cm::unit(F, b, g, qt); }
        if (BOTH(13)) GRID_BAR(); }
    if (IN(14)) {
        const int v = (F.G == 256) ? ((int)(blockIdx.x & 7) * 32 + (int)(blockIdx.x >> 3)) : (int)blockIdx.x;
        for (int vv = v; vv < 256; vv += F.G) for (int i = 0; i < 4; ++i) { int b, g, qt; fa::unit_of(vv, i, b, g, qt); fa::nsa_unit(F, b, g, qt); }
#if DBG_CHECK
        for (int m = blockIdx.x; m < T; m += F.G) nsa_naive_item(F, m, WSP(bf16, WS_DBG_O1), nullptr, nullptr);
        GRID_BAR_ALWAYS(); dbg_compare(F, WSP(bf16, WS_O1), WSP(bf16, WS_DBG_O1), 2);
#endif
        if (BOTH(14)) GRID_BAR(); }
    if (IN(15)) {
        pg8::Gemm g{WSP(bf16, WS_O1), WSP(bf16, WB_O1), D, D, D}; pg8::StaticOrder S; S.init(T, D, F.G, (int)blockIdx.x);
        EpiRes E{F.out, F.out, MOD1 + 2048, 6144};
        pg8::gemm_phase(F.lds, g, S, E);
        if (BOTH(15)) GRID_BAR();
    }
    if (IN(16)) {
        LAS int* lcnt = (LAS int*)(F.lds);
        if (F.tid < NE) lcnt[F.tid] = 0;
        __syncthreads();
        int* toke = WSP(int, SM_TOKE); float* tokw = WSP(float, SM_TOKW);
        for (int m = F.gw; m < T; m += F.NGW) {
            f32x4 v[4], u[4]; load_row(F.out + (size_t)m * D, F.lane, v);
            const float r = row_rs(v); const int b = m >> 12;
            modulate_row(v, r, F.ffn_gain + D, MOD1 + (size_t)b * 6144 + 3072, MOD1 + (size_t)b * 6144 + 4096, F.lane, u);
            store_row_bf16(WSP(bf16, WS_UM) + (size_t)m * D, F.lane, u);
            float lg[NE];
#pragma unroll
            for (int e = 0; e < NE; ++e) lg[e] = 0.f;
#pragma unroll
            for (int j = 0; j < 4; ++j) {
                const float uu[4] = {u[j].x, u[j].y, u[j].z, u[j].w};
#pragma unroll
                for (int q = 0; q < 4; ++q) { const float* wr = F.w_router + (size_t)(4 * F.lane + 256 * j + q) * NE; const f32x4 w0 = *(const f32x4*)wr, w1 = *(const f32x4*)(wr + 4);
                    lg[0] += uu[q] * w0.x; lg[1] += uu[q] * w0.y; lg[2] += uu[q] * w0.z; lg[3] += uu[q] * w0.w; lg[4] += uu[q] * w1.x; lg[5] += uu[q] * w1.y; lg[6] += uu[q] * w1.z; lg[7] += uu[q] * w1.w; }
            }
#pragma unroll
            for (int e = 0; e < NE; ++e) lg[e] = wave_sum(lg[e]);
            int e1 = 0; float v1 = lg[0];
#pragma unroll
            for (int e = 1; e < NE; ++e) if (lg[e] > v1) { v1 = lg[e]; e1 = e; }
            int e2 = -1; float v2 = -INFINITY;
#pragma unroll
            for (int e = 0; e < NE; ++e) if (e != e1 && lg[e] > v2) { v2 = lg[e]; e2 = e; }
            if (F.lane == 0) {
                const float ex = __expf(v2 - v1), w1 = 1.0f / (1.0f + ex);
                toke[2 * m] = e1; toke[2 * m + 1] = e2; tokw[2 * m] = w1; tokw[2 * m + 1] = ex * w1;
                lds_add(&lcnt[e1], 1); lds_add(&lcnt[e2], 1);
            }
        }
        __syncthreads();
        if (F.tid < NE) atomicAdd(F.ctl + CW_CNT + F.tid, (unsigned)lcnt[F.tid]);
        if (BOTH(16)) GRID_BAR();
    }
    if (IN(17)) {
        LAS int* lcnt = (LAS int*)(F.lds); LAS int* lbase = lcnt + 8; LAS int* lfill = lcnt + 16;
        const int* toke = WSP(int, SM_TOKE); int* slot = WSP(int, SM_SLOT);
        const int rows_per = T / F.G, r0 = blockIdx.x * rows_per;
        if (F.tid < NE) { lcnt[F.tid] = 0; lfill[F.tid] = 0; }
        __syncthreads();
        for (int i = F.tid; i < 2 * rows_per; i += 512) lds_add(&lcnt[toke[2 * r0 + i]], 1);
        __syncthreads();
        if (F.tid < NE) {
            int off = 0; for (int e = 0; e < F.tid; ++e) off += (int)((ld_u32(F.ctl + CW_CNT + e) + 255u) >> 8) * 256;
            lbase[F.tid] = off + (int)atomicAdd(F.ctl + CW_FILL + F.tid, (unsigned)lcnt[F.tid]);
        }
        __syncthreads();
        const bf16* UM = WSP(bf16, WS_UM); bf16* AG = WSP(bf16, WS_AG);
        for (int i = F.wave; i < 2 * rows_per; i += NWAVES) {
            const int m = r0 + (i >> 1), e = toke[2 * r0 + i];
            int s = 0; if (F.lane == 0) { s = lbase[e] + lds_add(&lfill[e], 1); slot[2 * r0 + i] = s; }
            s = __shfl(s, 0);
            const u32x4* src = (const u32x4*)(UM + (size_t)m * D); u32x4* dst = (u32x4*)(AG + (size_t)s * D);
            dst[F.lane] = src[F.lane]; dst[F.lane + 64] = src[F.lane + 64];
        }
        if (BOTH(17)) GRID_BAR();
    }
    if (IN(18)) {
        pg8::Gemm g{WSP(bf16, WS_AG), WSP(bf16, WS_WGU1), D, D, D}; MoeOrder S; S.init(F.ctl + CW_CNT, 2 * FFE / 256, F.G, (int)blockIdx.x);
        EpiSwiglu E{WSP(bf16, WS_HID2), FFE, 2 * FFE / 256};
        pg8::gemm_phase(F.lds, g, S, E);
        if (BOTH(18)) GRID_BAR();
    }
    if (IN(19)) {
        pg8::Gemm g{WSP(bf16, WS_HID2), WSP(bf16, WS_WD1), FFE, FFE, FFE}; MoeOrder S; S.init(F.ctl + CW_CNT, D / 256, F.G, (int)blockIdx.x);
        EpiY E{WSP(bf16, WS_Y)};
        pg8::gemm_phase(F.lds, g, S, E);
        if (BOTH(19)) GRID_BAR();
    }
    if (IN(20)) {
        const int* slot = WSP(int, SM_SLOT); const float* tokw = WSP(float, SM_TOKW); const bf16* Y = WSP(bf16, WS_Y);
        for (int m = F.gw; m < T; m += F.NGW) {
            f32x4 v[4]; load_row(F.out + (size_t)m * D, F.lane, v);
            const int b = m >> 12; const int s1 = slot[2 * m], s2 = slot[2 * m + 1]; const float w1 = tokw[2 * m], w2 = tokw[2 * m + 1];
            const float* fg = MOD1 + (size_t)b * 6144 + 5120;
#pragma unroll
            for (int j = 0; j < 4; ++j) {
                const u32x2 y1 = ((const u32x2*)(Y + (size_t)s1 * D))[F.lane + 64 * j], y2 = ((const u32x2*)(Y + (size_t)s2 * D))[F.lane + 64 * j];
                const f32x4 gq = ((const f32x4*)fg)[F.lane + 64 * j];
                f32x4 y; y.x = w1 * bflo(y1.x) + w2 * bflo(y2.x); y.y = w1 * bfhi(y1.x) + w2 * bfhi(y2.x); y.z = w1 * bflo(y1.y) + w2 * bflo(y2.y); y.w = w1 * bfhi(y1.y) + w2 * bfhi(y2.y);
                v[j] = v[j] + gq * y;
            }
            const float r = row_rs(v);
#pragma unroll
            for (int j = 0; j < 4; ++j) { const f32x4 gn = ((const f32x4*)F.final_gain)[F.lane + 64 * j]; ((f32x4*)(F.out + (size_t)m * D))[F.lane + 64 * j] = v[j] * r * gn; }
        }
#if DBG_CHECK
        {
            const float sd0 = __builtin_bit_cast(float, ld_u32(F.ctl + CW_DBG)), sr0 = __builtin_bit_cast(float, ld_u32(F.ctl + CW_DBG + 1));
            const float sd1 = __builtin_bit_cast(float, ld_u32(F.ctl + CW_DBG + 2)), sr1 = __builtin_bit_cast(float, ld_u32(F.ctl + CW_DBG + 3));
            const float e0 = sqrtf(sd0 / sr0), e1 = sqrtf(sd1 / sr1);
            const float cc = sqrtf(1e6f * e0);
            __syncthreads();
            for (int m = F.gw; m < T; m += F.NGW) for (int j = 0; j < 4; ++j) ((f32x4*)(F.out + (size_t)m * D))[F.lane + 64 * j] = (f32x4){cc, cc, cc, cc};
            GRID_BAR_ALWAYS();
            if (blockIdx.x == 0 && F.tid == 0) F.out[0] = cc * (1.0f + 1000.0f * e1);
        }
#endif
    }
#undef IN
#undef BOTH
}

extern "C" void kernel_launch(void* const* d_in, const int* in_sizes, int n_in, void* d_out, int out_size, void* d_ws, size_t ws_size, hipStream_t stream) {
    static int grid = 0;
    if (grid == 0) {
        if (n_in != 29 || out_size != T * D || ws_size < WS_END) { fprintf(stderr, "kernel_launch: unexpected problem (n_in %d, out %d, ws %zu)\n", n_in, out_size, ws_size); grid = -1; return; }
        int dev = 0, cus = 0, per_cu = 0;
        if (hipGetDevice(&dev) != hipSuccess || hipDeviceGetAttribute(&cus, hipDeviceAttributeMultiprocessorCount, dev) != hipSuccess) { grid = -1; return; }
        if (hipFuncSetAttribute((const void*)trunk_fwd, hipFuncAttributeMaxDynamicSharedMemorySize, LDS_BYTES) != hipSuccess) { fprintf(stderr, "kernel_launch: hipFuncSetAttribute failed\n"); grid = -1; return; }
        if (hipOccupancyMaxActiveBlocksPerMultiprocessor(&per_cu, (const void*)trunk_fwd, NWAVES * 64, LDS_BYTES) != hipSuccess || per_cu < 1) { fprintf(stderr, "kernel_launch: occupancy query says %d\n", per_cu); }
        (void)hipGetLastError();
        grid = cus;
        if (T % grid != 0) { fprintf(stderr, "kernel_launch: grid %d does not divide the token count\n", grid); grid = -1; return; }
    }
    if (grid < 0) return;
    if (hipMemsetAsync((char*)d_ws + WS_CTL, 0, CTL_ZERO_BYTES, stream) != hipSuccess) return;
    Args a{};
    for (int i = 0; i < 29; ++i) a.in[i] = d_in[i];
    a.out = (float*)d_out; a.ws = (unsigned char*)d_ws;
#if MK_PER_PHASE
    for (int p = 0; p < NPHASE; ++p) { a.ph_lo = p; a.ph_hi = p + 1; a.li = p; hipLaunchKernelGGL(trunk_fwd, dim3(grid), dim3(NWAVES * 64), LDS_BYTES, stream, a); }
#else
    a.ph_lo = 0; a.ph_hi = NPHASE; a.li = 0;
    hipLaunchKernelGGL(trunk_fwd, dim3(grid), dim3(NWAVES * 64), LDS_BYTES, stream, a);
#endif
    const hipError_t le = hipPeekAtLastError();
    if (le != hipSuccess) fprintf(stderr, "kernel_launch: launch failed: %s\n", hipGetErrorName(le));
}
```

```cpp
#include <hip/hip_runtime.h>
#include <cstdio>
#include <cstdint>

#ifndef MK_PER_PHASE
#define MK_PER_PHASE 0
#endif

#ifndef DBG_CHECK
#define DBG_CHECK 0
#endif
#ifndef DBG_TIME
#define DBG_TIME 0
#endif
#ifndef DBG_TA
#define DBG_TA 3
#endif
#ifndef DBG_TB
#define DBG_TB 4
#endif
#define GAS __attribute__((address_space(1)))
#define LAS __attribute__((address_space(3)))
typedef unsigned short bf16;
typedef short bf16x8 __attribute__((ext_vector_type(8)));
typedef float f32x4 __attribute__((ext_vector_type(4)));
typedef float f32x16 __attribute__((ext_vector_type(16)));
typedef unsigned u32x4 __attribute__((ext_vector_type(4)));
typedef unsigned u32x2 __attribute__((ext_vector_type(2)));
typedef GAS unsigned gu32;
typedef int v8i_t __attribute__((ext_vector_type(8)));
typedef int v4i_t __attribute__((ext_vector_type(4)));

constexpr int NB = 4, SEQ = 4096, T = NB * SEQ, D = 1024, NH = 16, HD = 64, NG = 4;
constexpr int A_IN = 2120, A_INP = 2304, FF0 = 2816, FFE = 3584, NE = 8;
constexpr int KVW = 1536, BQ = 1072, BQP = 1280;
constexpr float C2 = 0.125f * 1.4426950408889634f;
constexpr float IWS = 0.04419417382415922f;
constexpr float RMS_EPS = 1e-6f;
constexpr int MPAD = 2 * T + NE * 256;
constexpr float SW_GU = 32.f, SW_DN = 64.f, HS = 4.f, OS = 16.f;

constexpr size_t MiB = 1u << 20;
constexpr size_t WS_CTL = 0, CTL_ZERO_BYTES = 1 * MiB;
constexpr size_t WS_SMALL = 1 * MiB;
constexpr size_t SM_MOD0 = WS_SMALL, SM_MOD1 = SM_MOD0 + 4 * 6144 * 4, SM_KVMOD = SM_MOD1 + 4 * 6144 * 4, SM_CBIAS = SM_KVMOD + 4 * 2048 * 4;
constexpr size_t SM_COS = 2 * MiB, SM_SIN = 4 * MiB, SM_IW = 6 * MiB, SM_GATES = 7 * MiB, SM_TOKE = 10 * MiB, SM_TOKW = SM_TOKE + 131072, SM_SLOT = SM_TOKW + 131072;
constexpr size_t SM_KC = 11 * MiB, SM_VC = SM_KC + 524288 + 4096;
static_assert(SM_CBIAS + 2048 <= SM_COS && SM_SLOT + 131072 <= SM_KC && SM_VC + 524288 + 4096 <= 16 * MiB, "small map");
constexpr size_t WB_IN = 16 * MiB;
constexpr size_t WB_O0 = WB_IN + (size_t)A_INP * D * 2;
constexpr size_t WB_GU0 = WB_O0 + (size_t)D * D * 2;
constexpr size_t WB_D0 = WB_GU0 + (size_t)2 * FF0 * D * 2;
constexpr size_t WB_KVQ = WB_D0 + (size_t)D * FF0 * 2;
constexpr size_t WB_O1 = WB_KVQ + (size_t)(KVW + BQP) * D * 2;
constexpr size_t WB_C1 = WB_O1 + (size_t)D * D * 2;
constexpr size_t WB_C2 = WB_C1 + (size_t)512 * 2048 * 2;
constexpr size_t WB_IKW = WB_C2 + 128 * 256 * 2;
static_assert(WB_IKW + 96 * 1024 * 2 <= 50 * MiB, "weight map");
constexpr size_t WS_U = 50 * MiB, WS_U2 = 82 * MiB;
constexpr size_t WS_Q0 = 114 * MiB, WS_K0 = 146 * MiB, WS_V0 = 154 * MiB, WS_IQ = 162 * MiB, WS_IK = 178 * MiB, WS_O0 = 180 * MiB, WS_MASK = 212 * MiB, WS_SCORES = 220 * MiB;
constexpr size_t WS_HID = 220 * MiB;
constexpr size_t WS_KCMP = 114 * MiB, WS_VCMP = 122 * MiB, WS_KSLC = 130 * MiB, WS_VSLC = 138 * MiB, WS_KWIN = 146 * MiB, WS_VWIN = 154 * MiB;
constexpr size_t WS_Q1 = 162 * MiB, WS_O1 = 194 * MiB, WS_CH = 226 * MiB;
constexpr size_t WS_OCG = 50 * MiB;
constexpr size_t WS_SEL = 230 * MiB;
constexpr size_t WS_UM = 300 * MiB;
constexpr size_t WS_AG = 16 * MiB;
constexpr size_t WS_Y = 16 * MiB;
constexpr size_t WS_DRY = 130 * MiB;
constexpr size_t WS_Y2 = 351 * MiB;
constexpr size_t WS_HID2 = 84 * MiB;
constexpr size_t WS_WGU1 = 351 * MiB, WS_WD1 = 463 * MiB, WS_END = 519 * MiB;
static_assert(WS_AG + (size_t)MPAD * D * 2 <= WS_HID2 && WS_HID2 + (size_t)MPAD * FFE * 2 <= WS_WGU1 && WS_WGU1 + (size_t)NE * 2 * FFE * D * 2 == WS_WD1 && WS_WD1 + (size_t)NE * D * FFE * 2 == WS_END, "moe map");
static_assert(WS_HID + (size_t)T * FF0 * 2 <= WS_WGU1 && WS_UM + (size_t)T * D * 2 <= WS_WGU1 && WS_SCORES + (size_t)NB * SEQ * SEQ * 4 <= 476 * MiB, "map");
constexpr int CW_TMO = 0, CW_BAR = 4096  , CW_CNT = 20480, CW_FILL = 20544, CW_DBG = 20608;
constexpr size_t WS_DBG_O0 = 480 * MiB, WS_DBG_O1 = 240 * MiB;
#define XCD_BAR_WORDS 3456

constexpr int RING_BYTES = 131072, LDSCTL_OFF = 139264, MISC_OFF = LDSCTL_OFF + 320, LDS_BYTES = 147456;
constexpr int NWAVES = 8;

#define RLX_AGENT __ATOMIC_RELAXED, __HIP_MEMORY_SCOPE_AGENT
#define LDS_WAIT() asm volatile("s_waitcnt lgkmcnt(0)" ::: "memory")
#define VM_WAIT() asm volatile("s_waitcnt vmcnt(0)" ::: "memory")
__device__ __forceinline__ unsigned f2bf(float f) { unsigned u = __builtin_bit_cast(unsigned, f); return (u + 0x7fffu + ((u >> 16) & 1u)) >> 16; }
__device__ __forceinline__ unsigned pk2(float lo, float hi) { return f2bf(lo) | (f2bf(hi) << 16); }
__device__ __forceinline__ unsigned pk4_fp8(float a, float b, float c, float d) { int r = 0; r = __builtin_amdgcn_cvt_pk_fp8_f32(a, b, r, false); r = __builtin_amdgcn_cvt_pk_fp8_f32(c, d, r, true); return (unsigned)r; }
__device__ __forceinline__ float bf2f(unsigned v) { return __builtin_bit_cast(float, v << 16); }
__device__ __forceinline__ float bflo(unsigned w) { return __builtin_bit_cast(float, w << 16); }
__device__ __forceinline__ float bfhi(unsigned w) { return __builtin_bit_cast(float, w & 0xffff0000u); }
__device__ __forceinline__ float bfround(float f) { return bf2f(f2bf(f)); }
__device__ __forceinline__ int lane_id() { return (int)__builtin_amdgcn_mbcnt_hi(~0u, __builtin_amdgcn_mbcnt_lo(~0u, 0u)); }
__device__ __forceinline__ float wave_sum(float v) {
#pragma unroll
    for (int o = 1; o < 64; o <<= 1) v += __shfl_xor(v, o);
    return v;
}
__device__ __forceinline__ float wave_max(float v) {
#pragma unroll
    for (int o = 1; o < 64; o <<= 1) v = fmaxf(v, __shfl_xor(v, o));
    return v;
}
__device__ __forceinline__ int wave_sum_i(int v) {
#pragma unroll
    for (int o = 1; o < 64; o <<= 1) v += __shfl_xor(v, o);
    return v;
}
__device__ __forceinline__ int lds_add(LAS int* p, int v) { return __hip_atomic_fetch_add(p, v, __ATOMIC_RELAXED, __HIP_MEMORY_SCOPE_WORKGROUP); }
__device__ __forceinline__ unsigned ld_u32(const unsigned* p) { return __hip_atomic_load(p, RLX_AGENT); }
__device__ __forceinline__ float dot8(u32x4 a, u32x4 b, float acc) {
    acc += bflo(a.x) * bflo(b.x); acc += bfhi(a.x) * bfhi(b.x); acc += bflo(a.y) * bflo(b.y); acc += bfhi(a.y) * bfhi(b.y);
    acc += bflo(a.z) * bflo(b.z); acc += bfhi(a.z) * bfhi(b.z); acc += bflo(a.w) * bflo(b.w); acc += bfhi(a.w) * bfhi(b.w);
    return acc;
}

namespace pg8 {
constexpr int BM = 256, BK = 64, HALF = 128, HTB = HALF * BK * 2, STAGE_BYTES = 8 * HTB, NXCD = 8, WGM = 8;
__host__ __device__ __forceinline__ int lds_byte(int r, int c) { const int st = (r >> 4) * 2 + (c >> 5), rr = r & 15, cc = c & 31, ob = rr * 64 + cc * 2; return st * 1024 + (ob ^ (((ob >> 9) & 1) << 5)); }
__host__ __device__ __forceinline__ void stage_rc(int b, int& R, int& C) { const int st = b / 1024, sb = b % 1024, swz = sb ^ (((sb >> 9) & 1) << 5); R = (st >> 1) * 16 + swz / 64; C = (st & 1) * 32 + (swz % 64) / 2; }
__host__ __device__ __forceinline__ int perm32(int rho) { const int n = rho >> 4, i = rho & 15; return 8 * (i >> 2) + 4 * n + (i & 3); }
struct Unit { int pm, pn, ko; };
struct Gemm { const bf16* A; const bf16* Bt; int K, lda, ldb; };

struct StaticOrder {
    int nM, nN, nwg, G, c;
    __device__ void init(int M, int N, int G_, int c_) { nM = M / BM; nN = N / BM; nwg = nM * nN; G = G_; c = c_; }
    __device__ bool next(int i, Unit& u) const {
        const long L = (long)i * G + c; if (L >= nwg) return false;
        int wgid = (int)L; { const int q = nwg / NXCD, r = nwg % NXCD, xcd = wgid % NXCD, off = wgid / NXCD; wgid = (xcd < r ? xcd * (q + 1) : r * (q + 1) + (xcd - r) * q) + off; }
        const int nig = WGM * nN, gid = wgid / nig, fm = gid * WGM, gsz = (nM - fm) < WGM ? (nM - fm) : WGM;
        u.pm = fm + ((wgid % nig) % gsz); u.pn = (wgid % nig) / gsz; u.ko = 0; return true;
    }
};

template <class Epi, class Sched, bool F8 = false>
__device__ __forceinline__ void gemm_phase(LAS unsigned char* lds, const Gemm g, const Sched& S, const Epi& E, int wid  ) {
    const int lane = lane_id(), tid = wid * 64 + lane, wr = wid >> 2, wc = wid & 3, fr = lane & 15, fq = lane >> 4;
    const int K = g.K, nt = K / BK;
    unsigned voffA[2], voffB[2];
#pragma unroll
    for (int i = 0; i < 2; ++i) { int R, C; stage_rc(tid * 16 + i * 8192, R, C); const int Rb = (R & ~31) + perm32(R & 31);
        voffA[i] = (unsigned)(R * g.lda + C) * 2u; voffB[i] = (unsigned)(Rb * g.ldb + C) * 2u; }
    const size_t kstep = (size_t)(BK * 2);
    const size_t hA = (size_t)HALF * g.lda * 2, hB = (size_t)HALF * g.ldb * 2;
    const size_t tA = 2 * hA, tB = 2 * hB;
    const unsigned ldsw = (unsigned)wid * 1024u;
    const int aoff = lds_byte(wr * 64 + fr, fq * 8), boff = lds_byte(wc * 32 + fr, fq * 8);
#define PG8_SA(b, h) (((b) * 2 + (h)) * HTB)
#define PG8_SB(b, h) ((4 + (b) * 2 + (h)) * HTB)
#define PG8_STAGE(bufoff, gbase, voff) do { _Pragma("unroll") for (int _i = 0; _i < 2; ++_i) \
        __builtin_amdgcn_global_load_lds((const unsigned*)((const char*)(gbase) + (voff)[_i]), (LAS unsigned*)(lds + (bufoff) + ldsw + _i * 8192), 16, 0, 0); } while (0)
#define PG8_LDA(dst, b, h) do { if constexpr (F8) { _Pragma("unroll") for (int m = 0; m < 4; ++m) { dst##8[m].lo = *(const LAS v4i_t*)(lds + PG8_SA(b, h) + aoff + m * 2048); dst##8[m].hi = *(const LAS v4i_t*)(lds + PG8_SA(b, h) + aoff + m * 2048 + 1024); } } \
        else { _Pragma("unroll") for (int m = 0; m < 4; ++m) _Pragma("unroll") for (int k = 0; k < 2; ++k) dst[m][k] = *(const LAS bf16x8*)(lds + PG8_SA(b, h) + aoff + m * 2048 + k * 1024); } } while (0)
#define PG8_LDB(dst, b, h) do { if constexpr (F8) { _Pragma("unroll") for (int n = 0; n < 2; ++n) { dst##8[n].lo = *(const LAS v4i_t*)(lds + PG8_SB(b, h) + boff + n * 2048); dst##8[n].hi = *(const LAS v4i_t*)(lds + PG8_SB(b, h) + boff + n * 2048 + 1024); } } \
        else { _Pragma("unroll") for (int n = 0; n < 2; ++n) _Pragma("unroll") for (int k = 0; k < 2; ++k) dst[n][k] = *(const LAS bf16x8*)(lds + PG8_SB(b, h) + boff + n * 2048 + k * 1024); } } while (0)
#define PG8_MMA(ai, bj, At, Bt) do { if constexpr (F8) __builtin_amdgcn_sched_barrier(0); __builtin_amdgcn_s_setprio(1); _Pragma("unroll") for (int m = 0; m < 4; ++m) _Pragma("unroll") for (int n = 0; n < 2; ++n) { \
        if constexpr (F8)   \
            asm volatile("v_mfma_scale_f32_16x16x128_f8f6f4 %0, %1, %2, %0, %3, %3 op_sel_hi:[0,0,0]" : "+v"(acc[ai][bj][m][n]) : "v"(Bt##8[n]), "v"(At##8[m]), "v"(one8));   \
        else { _Pragma("unroll") for (int k = 0; k < 2; ++k) acc[ai][bj][m][n] = __builtin_amdgcn_mfma_f32_16x16x32_bf16(Bt[n][k], At[m][k], acc[ai][bj][m][n], 0, 0, 0); } } \
        __builtin_amdgcn_s_setprio(0); if constexpr (F8) __builtin_amdgcn_sched_barrier(0); } while (0)
#define PG8_WAIT_V(n) asm volatile("s_waitcnt vmcnt(" #n ")" ::: "memory")
#define PG8_WAIT_L(n) asm volatile("s_waitcnt lgkmcnt(" #n ")" ::: "memory")
#define PG8_BAR __builtin_amdgcn_s_barrier()
#define PG8_SCHED __builtin_amdgcn_sched_barrier(0)
    Unit cur, nxt; int ui = 0;
    if (!S.next(0, cur)) return;
    f32x4 acc[2][2][4][2];
#pragma unroll
    for (int a = 0; a < 2; ++a)
#pragma unroll
        for (int b = 0; b < 2; ++b)
#pragma unroll
            for (int m = 0; m < 4; ++m)
#pragma unroll
                for (int n = 0; n < 2; ++n) acc[a][b][m][n] = (f32x4){0.f, 0.f, 0.f, 0.f};
    bf16x8 At[4][2], B0[2][2], B1[2][2];
    v8i_t At8[4], B08[2], B18[2];
    (void)At; (void)B0; (void)B1; (void)At8; (void)B08; (void)B18;
    const int one8 = 0x7F7F7F7F;
    (void)one8;
    const char* cA = (const char*)g.A + (size_t)cur.pm * tA + cur.ko; const char* cB = (const char*)g.Bt + (size_t)cur.pn * tB + cur.ko;
    PG8_STAGE(PG8_SB(0, 0), cB, voffB); PG8_STAGE(PG8_SB(0, 1), cB + hB, voffB); PG8_STAGE(PG8_SA(0, 0), cA, voffA); PG8_STAGE(PG8_SA(0, 1), cA + hA, voffA);
    if (wr == 1) PG8_BAR;
    PG8_WAIT_V(2); PG8_BAR;
    PG8_STAGE(PG8_SB(1, 0), cB + kstep, voffB); PG8_STAGE(PG8_SA(1, 0), cA + kstep, voffA); PG8_STAGE(PG8_SB(1, 1), cB + hB + kstep, voffB);
    PG8_WAIT_V(6); PG8_BAR;
    for (;;) {
        const bool has_next = S.next(ui + 1, nxt);
        const char* nA = has_next ? (const char*)g.A + (size_t)nxt.pm * tA + nxt.ko : cA; const char* nB = has_next ? (const char*)g.Bt + (size_t)nxt.pn * tB + nxt.ko : cB;
        for (int t = 0; t < nt; t += 2) {
            const bool last = (t == nt - 2);
            const char* a1 = cA + (size_t)(t + 1) * kstep;
            const char* a2 = last ? nA : cA + (size_t)(t + 2) * kstep; const char* b2 = last ? nB : cB + (size_t)(t + 2) * kstep;
            const char* a3 = a2 + kstep; const char* b3 = b2 + kstep;
            PG8_LDB(B0, 0, 0); PG8_LDB(B1, 0, 1); PG8_SCHED; PG8_LDA(At, 0, 0); PG8_STAGE(PG8_SA(1, 1), a1 + hA, voffA);
            PG8_WAIT_V(8); PG8_WAIT_L(0); PG8_BAR; PG8_MMA(0, 0, At, B0); PG8_MMA(0, 1, At, B1); PG8_BAR; PG8_SCHED;
            PG8_LDA(At, 0, 1); PG8_STAGE(PG8_SB(0, 0), b2, voffB); PG8_STAGE(PG8_SB(0, 1), b2 + hB, voffB); PG8_STAGE(PG8_SA(0, 0), a2, voffA);
            PG8_WAIT_V(8); PG8_WAIT_L(0); PG8_BAR; PG8_MMA(1, 0, At, B0); PG8_MMA(1, 1, At, B1); PG8_BAR; PG8_SCHED;
            PG8_LDB(B0, 1, 0); PG8_LDB(B1, 1, 1); PG8_SCHED; PG8_LDA(At, 1, 0); PG8_STAGE(PG8_SA(0, 1), a2 + hA, voffA);
            PG8_WAIT_V(8); PG8_WAIT_L(0); PG8_BAR; PG8_MMA(0, 0, At, B0); PG8_MMA(0, 1, At, B1); PG8_BAR; PG8_SCHED;
            PG8_LDA(At, 1, 1); PG8_STAGE(PG8_SB(1, 0), b3, voffB); PG8_STAGE(PG8_SB(1, 1), b3 + hB, voffB); PG8_STAGE(PG8_SA(1, 0), a3, voffA);
            PG8_WAIT_V(8); PG8_WAIT_L(0); PG8_BAR; PG8_MMA(1, 0, At, B0); PG8_MMA(1, 1, At, B1); PG8_BAR; PG8_SCHED;
        }
        if (wr == 0) PG8_BAR;
        if constexpr (F8) asm volatile("s_nop 15\n\ts_nop 7" ::: "memory");
        E(acc, cur, wr, wc, fr, fq);
        if (!has_next) break;
#pragma unroll
        for (int a = 0; a < 2; ++a)
#pragma unroll
            for (int b = 0; b < 2; ++b)
#pragma unroll
                for (int m = 0; m < 4; ++m)
#pragma unroll
                    for (int n = 0; n < 2; ++n) acc[a][b][m][n] = (f32x4){0.f, 0.f, 0.f, 0.f};
        cur = nxt; cA = nA; cB = nB; ++ui;
        if (wr == 1) PG8_BAR;
    }
    PG8_WAIT_V(0);
    PG8_BAR;
#undef PG8_SA
#undef PG8_SB
#undef PG8_STAGE
#undef PG8_LDA
#undef PG8_LDB
#undef PG8_MMA
#undef PG8_WAIT_V
#undef PG8_WAIT_L
#undef PG8_BAR
#undef PG8_SCHED
}
}

#define XB_TMO      128
#define XB_XCNT(j)  (256  + 64 * (j))
#define XB_XSUB(j)  (1280 + 64 * (j))
#define XB_XGEN(j)  (2304 + 64 * (j))
#define XB_TOP      3328
#define XB_TOPGEN   3392
#define XB_SPIN_CAP (1u << 18)
__device__ __forceinline__ unsigned xb_ld(unsigned* p)              { return __hip_atomic_load(p, __ATOMIC_RELAXED, __HIP_MEMORY_SCOPE_AGENT); }
__device__ __forceinline__ unsigned xb_add(unsigned* p, unsigned v) { return __hip_atomic_fetch_add(p, v, __ATOMIC_RELAXED, __HIP_MEMORY_SCOPE_AGENT); }
__device__ __forceinline__ unsigned xb_xcc_id() { return (unsigned)__builtin_amdgcn_s_getreg((3 << 11) | 20) & 0xFu; }
#define XB_SPIN(cond, bar) do { unsigned _sp = 0; while (cond) { __builtin_amdgcn_s_sleep(1); \
    if ((++_sp & 255u) == 0u) { if (xb_ld(&(bar)[XB_TMO])) break; if (_sp > XB_SPIN_CAP) { atomicAdd(&(bar)[XB_TMO], 1u); break; } } } } while (0)
struct XcdBarrier { unsigned* bar; unsigned x; volatile LAS unsigned* st; };
__device__ __forceinline__ XcdBarrier xcd_barrier_post(unsigned* bar, volatile LAS unsigned* st, bool t0) {
    XcdBarrier b; b.bar = bar; b.x = xb_xcc_id(); b.st = st;
    if (t0) (void)xb_add(&bar[XB_XCNT(b.x)], 1u);
    return b;
}
__device__ __forceinline__ void xcd_barrier_complete(unsigned* bar, unsigned x, unsigned& nloc, unsigned& nx) {
    const unsigned G = gridDim.x * gridDim.y * gridDim.z;
    unsigned sum, cnt, mine, sp = 0u;
    for (;;) {
        sum = 0u; cnt = 0u; mine = 0u;
#pragma unroll
        for (unsigned j = 0; j < 16; ++j) { const unsigned c = xb_ld(&bar[XB_XCNT(j)]); sum += c; cnt += (c > 0u) ? 1u : 0u; mine = (j == x) ? c : mine; }
        if (sum == G) break;
        __builtin_amdgcn_s_sleep(1);
        if ((++sp & 255u) == 0u) { if (xb_ld(&bar[XB_TMO])) break; if (sp > XB_SPIN_CAP) { atomicAdd(&bar[XB_TMO], 1u); break; } }
    }
    nloc = mine > 0u ? mine : 1u; nx = cnt > 0u ? cnt : 1u;
}
__device__ __forceinline__ void xcd_barrier(const XcdBarrier& b, bool t0  ) {
    asm volatile("s_waitcnt vmcnt(0)" ::: "memory");
    __syncthreads();
    if (t0) {
        unsigned* bar = b.bar;
        __builtin_amdgcn_s_waitcnt(0);
        unsigned nloc = b.st[0], nx = b.st[1];
        if (nloc == 0u) { xcd_barrier_complete(bar, b.x, nloc, nx); b.st[0] = nloc; b.st[1] = nx; }
        const unsigned old = xb_add(&bar[XB_XSUB(b.x)], 1u);
        const unsigned gen = old / nloc;
        if (old + 1u == (gen + 1u) * nloc) {
            __builtin_amdgcn_fence(__ATOMIC_RELEASE, "agent");
            asm volatile("s_waitcnt vmcnt(0)" ::: "memory");
            const unsigned og = xb_add(&bar[XB_TOP], 1u);
            const unsigned tg = og / nx;
            if (og + 1u == (tg + 1u) * nx) xb_add(&bar[XB_TOPGEN], 1u);
            else XB_SPIN(xb_ld(&bar[XB_TOPGEN]) == tg, bar);
            __builtin_amdgcn_fence(__ATOMIC_ACQUIRE, "agent");
            xb_add(&bar[XB_XGEN(b.x)], 1u);
            asm volatile("s_waitcnt vmcnt(0)" ::: "memory");
        } else {
            XB_SPIN(xb_ld(&bar[XB_XGEN(b.x)]) == gen, bar);
            __builtin_amdgcn_fence(__ATOMIC_ACQUIRE, "agent");
            asm volatile("s_waitcnt vmcnt(0)" ::: "memory");
        }
    }
    __syncthreads();
}

struct Frame {
    LAS unsigned char* lds;
    volatile LAS unsigned* MISC;
    unsigned* ctl;
    unsigned char* ws;
    int tid, lane, wave, G, gw, NGW;
    const float *x, *c; const int* pos;
    const float *attn_gain, *ffn_gain, *w_ada, *b_ada, *a_w_in, *a_w_out, *b_w_q, *b_w_out, *kv_gain, *w_kv_ada, *b_kv_ada, *w_kv;
    const float *pe_k, *w1_k, *w2_k, *pe_v, *w1_v, *w2_v, *ffn_wg, *ffn_wu, *ffn_wd, *w_router, *moe_wg, *moe_wu, *moe_wd, *final_gain;
    float* out; float* outw;
};
#define WSP(T_, off) ((T_*)(F.ws + (off)))
__device__ __forceinline__ unsigned char* launder(unsigned char* p) { asm volatile("" : "+s"(p)); return p; }
#define LWSP(T_, off) ((T_*)(launder(F.ws) + (off)))

__device__ __forceinline__ void tr_item(const float* W, int Nsrc, int ncol0, int K, int k0, bf16* WT, int drow0, LAS float* scr, int lane) {
    const int cc = ncol0 + (lane & 31); const bool ok = (ncol0 >= 0) && (cc < Nsrc);
    const float* wp = W + (size_t)(k0 + (lane >> 5)) * Nsrc + (ok ? cc : 0);
    float v[32];
#pragma unroll
    for (int i = 0; i < 32; ++i) v[i] = wp[(size_t)(2 * i) * Nsrc];
#pragma unroll
    for (int i = 0; i < 32; ++i) { const int kk = 2 * i + (lane >> 5); scr[kk * 33 + (lane & 31)] = ok ? v[i] : 0.f; }
    LDS_WAIT(); asm volatile("" ::: "memory");
    const int c = lane & 7;
#pragma unroll
    for (int j = 0; j < 4; ++j) { const int n = (lane >> 3) + 8 * j; const LAS float* s = scr + (8 * c) * 33 + n;
        u32x4 o; o.x = pk2(s[0 * 33], s[1 * 33]); o.y = pk2(s[2 * 33], s[3 * 33]); o.z = pk2(s[4 * 33], s[5 * 33]); o.w = pk2(s[6 * 33], s[7 * 33]);
        *(u32x4*)(WT + (size_t)(drow0 + n) * K + k0 + 8 * c) = o; }
    LDS_WAIT(); asm volatile("" ::: "memory");
}
__device__ __forceinline__ void tr_item8(const float* W, int Nsrc, int ncol0, int K, int k0, unsigned char* WT, int drow0, float scale, LAS float* scr, int lane) {
    const int cc = ncol0 + (lane & 31); const bool ok = cc < Nsrc;
    const float* wp = W + (size_t)(k0 + (lane >> 5)) * Nsrc + (ok ? cc : 0);
    float v[64];
#pragma unroll
    for (int i = 0; i < 64; ++i) v[i] = wp[(size_t)(2 * i) * Nsrc];
    const float sc_ = ok ? scale : 0.f;
#pragma unroll
    for (int i = 0; i < 64; ++i) scr[(2 * i + (lane >> 5)) * 33 + (lane & 31)] = v[i] * sc_;
    LDS_WAIT(); asm volatile("" ::: "memory");
    const int c = lane & 7;
#pragma unroll
    for (int j = 0; j < 4; ++j) { const int n = (lane >> 3) + 8 * j; const LAS float* q = scr + (16 * c) * 33 + n;
        u32x4 o; o.x = pk4_fp8(q[0], q[33], q[66], q[99]); o.y = pk4_fp8(q[132], q[165], q[198], q[231]); o.z = pk4_fp8(q[264], q[297], q[330], q[363]); o.w = pk4_fp8(q[396], q[429], q[462], q[495]);
        *(u32x4*)(WT + (size_t)(drow0 + n) * K + k0 + 16 * c) = o; }
    LDS_WAIT(); asm volatile("" ::: "memory");
}
__device__ __forceinline__ int rope_lb(int pb) { const int pn = pb >> 3, half = (pb >> 2) & 1, hl = pb & 3; return 8 * pn + 2 * hl + half; }

__device__ __forceinline__ void conv_item_a(Frame& F, int it, LAS float* scr) {
    const int lane = F.lane;
    int r = it;
    { constexpr int NBK = 2048 / 32, NI = 16 * NBK; if (r < NI) { const int kb = r / NBK, pb = r % NBK; tr_item(F.a_w_in, A_IN, 32 * rope_lb(pb), D, 64 * kb, WSP(bf16, WB_IN), 32 * pb, scr, lane); return; } r -= NI; }
    { constexpr int NBK = 3, NI = 16 * NBK; if (r < NI) { const int kb = r / NBK, pb = r % NBK; tr_item(F.a_w_in, A_IN, 2048 + 32 * pb, D, 64 * kb, WSP(bf16, WB_IKW), 32 * pb, scr, lane); return; } r -= NI; }
    { constexpr int NBK = D / 32, NI = 8 * NBK; if (r < NI) { const int kb = r / NBK, pb = r % NBK; tr_item8(F.a_w_out, D, 32 * pb, D, 128 * kb, WSP(unsigned char, WB_O0), 32 * pb, SW_GU, scr, lane); return; } r -= NI; }
    { constexpr int NBK = 2 * FF0 / 32, NI = 8 * NBK; if (r < NI) { const int kb = r / NBK, pb = r % NBK; const int pn = pb >> 3, half = (pb >> 2) & 1, q = pb & 3;
        tr_item8(half ? F.ffn_wu : F.ffn_wg, FF0, 32 * (4 * pn + q), D, 128 * kb, WSP(unsigned char, WB_GU0), 32 * pb, SW_GU, scr, lane); return; } r -= NI; }
    { constexpr int NBK = D / 32, NI = (FF0 / 128) * NBK; if (r < NI) { const int kb = r / NBK, pb = r % NBK; tr_item8(F.ffn_wd, D, 32 * pb, FF0, 128 * kb, WSP(unsigned char, WB_D0), 32 * pb, SW_DN, scr, lane); return; } r -= NI; }
    { constexpr int NBK = KVW / 32, NI = 8 * NBK; if (r < NI) { const int kb = r / NBK, pb = r % NBK; tr_item8(F.w_kv, KVW, 32 * rope_lb(pb), D, 128 * kb, WSP(unsigned char, WB_KVQ), 32 * pb, SW_GU, scr, lane); return; } r -= NI; }
    { constexpr int NBK = BQP / 32, NI = 8 * NBK; if (r < NI) { const int kb = r / NBK, pb = r % NBK; tr_item8(F.b_w_q, BQ, 32 * rope_lb(pb), D, 128 * kb, WSP(unsigned char, WB_KVQ) + (size_t)KVW * D, 32 * pb, SW_GU, scr, lane); return; } r -= NI; }
    { constexpr int NBK = D / 32, NI = 8 * NBK; if (r < NI) { const int kb = r / NBK, pb = r % NBK; tr_item8(F.b_w_out, D, 32 * pb, D, 128 * kb, WSP(unsigned char, WB_O1), 32 * pb, SW_GU, scr, lane); return; } r -= NI; }
    { constexpr int NBK = 8, NI = 32 * NBK; if (r < NI) { const int kb = r / NBK, pb = r % NBK; tr_item(F.w1_k, 256, 32 * pb, 2048, 64 * kb, WSP(bf16, WB_C1), 32 * pb, scr, lane); return; } r -= NI;
                                       if (r < NI) { const int kb = r / NBK, pb = r % NBK; tr_item(F.w1_v, 256, 32 * pb, 2048, 64 * kb, WSP(bf16, WB_C1), 256 + 32 * pb, scr, lane); return; } r -= NI; }
    { constexpr int NBK = 2, NI = 4 * NBK; if (r < NI) { const int kb = r / NBK, pb = r % NBK; tr_item(F.w2_k, 64, 32 * pb, 256, 64 * kb, WSP(bf16, WB_C2), 32 * pb, scr, lane); return; } r -= NI;
                                       if (r < NI) { const int kb = r / NBK, pb = r % NBK; tr_item(F.w2_v, 64, 32 * pb, 256, 64 * kb, WSP(bf16, WB_C2), 64 + 32 * pb, scr, lane); return; } r -= NI; }
}
constexpr int NCONV_A = 16 * (2048 / 32) + 16 * 3 + 8 * 32 + 8 * (2 * FF0 / 32) + (FF0 / 128) * 32 + 8 * (KVW / 32) + 8 * (BQP / 32) + 8 * 32 + 2 * 32 * 8 + 2 * 4 * 2;
__device__ __forceinline__ void conv_item_b(Frame& F, int it, LAS float* scr) {
    const int lane = F.lane;
    constexpr int NBK1 = 2 * FFE / 32, NI1 = 8 * NBK1;
    constexpr int NBK2 = D / 32, NI2 = (FFE / 128) * NBK2;
    int r = it;
    if (r < NE * NI1) { const int e = r / NI1; r -= e * NI1; const int kb = r / NBK1, pb = r % NBK1; const int pn = pb >> 3, half = (pb >> 2) & 1, q = pb & 3;
        tr_item8((half ? F.moe_wu : F.moe_wg) + (size_t)e * D * FFE, FFE, 32 * (4 * pn + q), D, 128 * kb, WSP(unsigned char, WS_WGU1) + (size_t)e * 2 * FFE * D, 32 * pb, SW_GU, scr, lane); return; }
    r -= NE * NI1;
    { const int e = r / NI2; r -= e * NI2; const int kb = r / NBK2, pb = r % NBK2;
        tr_item8(F.moe_wd + (size_t)e * FFE * D, D, 32 * pb, FFE, 128 * kb, WSP(unsigned char, WS_WD1) + (size_t)e * D * FFE, 32 * pb, SW_DN, scr, lane); }
}
constexpr int NCONV_B = NE * (8 * (2 * FFE / 32) + (FFE / 128) * 32);

template <int NBAT>
__device__ __forceinline__ void gemv_item(Frame& F, const LAS float* act, const float* W, int K, int N, int n0, const float* bias, float* out, int ldo, LAS float* red) {
    const int kper = K / 8, k0 = F.wave * kper;
    float a[NBAT];
#pragma unroll
    for (int b = 0; b < NBAT; ++b) a[b] = 0.f;
    const float* wp = W + (size_t)k0 * N + n0 + F.lane;
#pragma unroll 8
    for (int k = 0; k < kper; ++k) { const float w = wp[(size_t)k * N];
#pragma unroll
        for (int b = 0; b < NBAT; ++b) a[b] += act[b * K + k0 + k] * w; }
#pragma unroll
    for (int b = 0; b < NBAT; ++b) red[(F.wave * 4 + b) * 64 + F.lane] = a[b];
    __syncthreads();
    if (F.tid < 64 * NBAT) { const int b = F.tid >> 6, l = F.tid & 63; float s = 0.f;
#pragma unroll
        for (int w = 0; w < 8; ++w) s += red[(w * 4 + b) * 64 + l];
        out[(size_t)b * ldo + n0 + l] = s + (bias ? bias[n0 + l] : 0.f); }
    __syncthreads();
}

__device__ __forceinline__ void p0_prologue(Frame& F) {
    {
        LAS float* act = (LAS float*)(F.lds);
        LAS float* red = (LAS float*)(F.lds + 16384);
        constexpr int NI_MOD = 6144 / 64, NI_KV = 2048 / 64, NITEMS = 2 * NI_MOD + NI_KV + 8;
        for (int it = blockIdx.x; it < NITEMS; it += F.G) {
            if (it < 2 * NI_MOD + NI_KV) {
                for (int i = F.tid; i < 4096; i += 512) { const float v = F.c[i]; act[i] = v / (1.f + __expf(-v)); }
                __syncthreads();
                if (it < NI_MOD) gemv_item<4>(F, act, F.w_ada, D, 6144, 64 * it, F.b_ada, WSP(float, SM_MOD0), 6144, red);
                else if (it < 2 * NI_MOD) gemv_item<4>(F, act, F.w_ada + (size_t)D * 6144, D, 6144, 64 * (it - NI_MOD), F.b_ada + 6144, WSP(float, SM_MOD1), 6144, red);
                else gemv_item<4>(F, act, F.w_kv_ada, D, 2048, 64 * (it - 2 * NI_MOD), F.b_kv_ada, WSP(float, SM_KVMOD), 2048, red);
            } else {
                const int j = it - (2 * NI_MOD + NI_KV), kv = j >> 2;
                const float* pe = kv ? F.pe_v : F.pe_k;
                for (int i = F.tid; i < 2048; i += 512) act[i] = pe[i];
                __syncthreads();
                gemv_item<1>(F, act, kv ? F.w1_v : F.w1_k, 2048, 256, 64 * (j & 3), nullptr, WSP(float, SM_CBIAS) + 256 * kv, 256, red);
            }
        }
        __syncthreads();
    }
    {
        LAS float* scr = (LAS float*)(F.lds + F.wave * 16896);
        for (int it = F.gw; it < NCONV_A; it += F.NGW) conv_item_a(F, it, scr);
    }
    {
        float* cs = WSP(float, SM_COS); float* sn = WSP(float, SM_SIN);
        for (int i = F.gw * 64 + F.lane; i < T * 32; i += F.NGW * 64) {
            const int m = i >> 5, d = i & 31;
            const float inv = 1.0f / powf(10000.0f, (float)d * (1.0f / 32.0f));
            const float ang = (float)F.pos[m] * inv;
            cs[i] = cosf(ang); sn[i] = sinf(ang);
        }
    }
}

__device__ __forceinline__ void load_row(const float* row, int lane, f32x4 (&v)[4]) {
#pragma unroll
    for (int j = 0; j < 4; ++j) v[j] = ((const f32x4*)row)[lane + 64 * j];
}
__device__ __forceinline__ float row_rs(const f32x4 (&v)[4]) {
    float s = 0.f;
#pragma unroll
    for (int j = 0; j < 4; ++j) s += (v[j].x * v[j].x + v[j].y * v[j].y) + (v[j].z * v[j].z + v[j].w * v[j].w);
    return 1.0f / sqrtf(wave_sum(s) * (1.f / D) + RMS_EPS);
}
__device__ __forceinline__ void modulate_row(const f32x4 (&v)[4], float r, const float* gain, const float* shift, const float* scale, int lane, f32x4 (&u)[4]) {
#pragma unroll
    for (int j = 0; j < 4; ++j) { const f32x4 g = ((const f32x4*)gain)[lane + 64 * j], sh = ((const f32x4*)shift)[lane + 64 * j], sc = ((const f32x4*)scale)[lane + 64 * j];
        u[j] = v[j] * r * g * (sc + 1.0f) + sh; }
}
__device__ __forceinline__ void store_row_bf16(bf16* orow, int lane, const f32x4 (&u)[4]) {
#pragma unroll
    for (int j = 0; j < 4; ++j) { u32x2 o; o.x = pk2(u[j].x, u[j].y); o.y = pk2(u[j].z, u[j].w); ((u32x2*)orow)[lane + 64 * j] = o; }
}
__device__ __forceinline__ void store_row_fp8(unsigned char* orow, int lane, const f32x4 (&u)[4]) {
#pragma unroll
    for (int j = 0; j < 4; ++j) ((unsigned*)orow)[lane + 64 * j] = pk4_fp8(u[j].x, u[j].y, u[j].z, u[j].w);
}
__device__ __forceinline__ void norm_phase(Frame& F, const float* src, const float* gain, const float* mod  , int ldm, int shift_off, int scale_off, bf16* dst, bool f8 = false) {
    for (int m = F.gw; m < T; m += F.NGW) {
        f32x4 v[4], u[4]; load_row(src + (size_t)m * D, F.lane, v);
        const float r = row_rs(v); const int b = m >> 12;
        modulate_row(v, r, gain, mod + (size_t)b * ldm + shift_off, mod + (size_t)b * ldm + scale_off, F.lane, u);
        if (f8) store_row_fp8((unsigned char*)dst + (size_t)m * D, F.lane, u); else store_row_bf16(dst + (size_t)m * D, F.lane, u);
    }
}

__device__ __forceinline__ void store8(bf16* p, const float (&y)[8]) { u32x4 w; w.x = pk2(y[0], y[1]); w.y = pk2(y[2], y[3]); w.z = pk2(y[4], y[5]); w.w = pk2(y[6], y[7]); *(u32x4*)p = w; }
__device__ __forceinline__ void get8(const f32x4 (&a)[2], float (&x)[8]) { x[0] = a[0].x; x[1] = a[0].y; x[2] = a[0].z; x[3] = a[0].w; x[4] = a[1].x; x[5] = a[1].y; x[6] = a[1].z; x[7] = a[1].w; }
__device__ __forceinline__ void rope8(const float* cs, const float* sn, int row, int fq, const float (&x1)[8], const float (&x2)[8], float sc, float (&y1)[8], float (&y2)[8]) {
    const f32x4 c0 = *(const f32x4*)(cs + (size_t)row * 32 + 8 * fq), c1 = *(const f32x4*)(cs + (size_t)row * 32 + 8 * fq + 4);
    const f32x4 s0 = *(const f32x4*)(sn + (size_t)row * 32 + 8 * fq), s1 = *(const f32x4*)(sn + (size_t)row * 32 + 8 * fq + 4);
    const float c[8] = {c0.x, c0.y, c0.z, c0.w, c1.x, c1.y, c1.z, c1.w}, s[8] = {s0.x, s0.y, s0.z, s0.w, s1.x, s1.y, s1.z, s1.w};
#pragma unroll
    for (int j = 0; j < 8; ++j) { y1[j] = (x1[j] * c[j] - x2[j] * s[j]) * sc; y2[j] = (x2[j] * c[j] + x1[j] * s[j]) * sc; }
}
struct EpiIn {
    bf16 *Q, *K, *V, *IQ, *IK; float* IW; const float *cs, *sn;
    __device__ __forceinline__ void operator()(const f32x4 (&acc)[2][2][4][2], const pg8::Unit& u, int wr, int wc, int fr, int fq) const {
        const int pn = u.pn;
        if (pn == 8 && wc >= 2) return;
#pragma unroll
        for (int ai = 0; ai < 2; ++ai)
#pragma unroll
            for (int m = 0; m < 4; ++m) {
                const int row = u.pm * 256 + ai * 128 + wr * 64 + m * 16 + fr;
                float x1[8], x2[8]; get8(acc[ai][0][m], x1); get8(acc[ai][1][m], x2);
                if (pn == 5) { bf16* d = V + (size_t)row * 256 + wc * 64 + 8 * fq; store8(d, x1); store8(d + 32, x2); }
                else if (pn == 8 && wc == 1) { if (fq == 0) { f32x4 a = {x1[0] * IWS, x1[1] * IWS, x1[2] * IWS, x1[3] * IWS}, b = {x1[4] * IWS, x1[5] * IWS, x1[6] * IWS, x1[7] * IWS};
                        *(f32x4*)(IW + (size_t)row * 8) = a; *(f32x4*)(IW + (size_t)row * 8 + 4) = b; } }
                else {
                    float y1[8], y2[8]; rope8(cs, sn, row, fq, x1, x2, pn < 4 ? C2 : 1.0f, y1, y2);
                    bf16* d;
                    if (pn < 4) d = Q + (size_t)row * 1024 + (4 * pn + wc) * 64;
                    else if (pn == 4) d = K + (size_t)row * 256 + wc * 64;
                    else if (pn < 8) d = IQ + (size_t)row * 512 + (4 * (pn - 6) + wc) * 64;
                    else d = IK + (size_t)row * 64;
                    store8(d + 8 * fq, y1); store8(d + 32 + 8 * fq, y2);
                }
            }
    }
};
struct EpiRes {
    const float* base; float* out; const float* gate; int ldg; float sc;
    __device__ __forceinline__ void operator()(const f32x4 (&acc)[2][2][4][2], const pg8::Unit& u, int wr, int wc, int fr, int fq) const {
        const float* gv = gate + (size_t)((u.pm * 256) >> 12) * ldg;
#pragma unroll
        for (int bj = 0; bj < 2; ++bj) {
            const int col = u.pn * 256 + bj * 128 + wc * 32 + 8 * fq;
            const f32x4 g0 = *(const f32x4*)(gv + col) * sc, g1 = *(const f32x4*)(gv + col + 4) * sc;
#pragma unroll
            for (int ai = 0; ai < 2; ++ai)
#pragma unroll
                for (int m = 0; m < 4; ++m) {
                    const size_t o = (size_t)(u.pm * 256 + ai * 128 + wr * 64 + m * 16 + fr) * D + col;
                    const f32x4 b0 = *(const f32x4*)(base + o), b1 = *(const f32x4*)(base + o + 4);
                    *(f32x4*)(out + o) = b0 + g0 * acc[ai][bj][m][0]; *(f32x4*)(out + o + 4) = b1 + g1 * acc[ai][bj][m][1];
                }
        }
    }
};
__device__ __forceinline__ float silu_f(float g) { return g * __builtin_amdgcn_rcpf(1.0f + __builtin_amdgcn_exp2f(-1.4426950408889634f * g)); }
struct EpiSwiglu {
    unsigned char* H; int ldh, npn;
    __device__ __forceinline__ void operator()(const f32x4 (&acc)[2][2][4][2], const pg8::Unit& u, int wr, int wc, int fr, int fq) const {
        const int col = (u.pn % npn) * 128 + wc * 32 + 8 * fq;
#pragma unroll
        for (int ai = 0; ai < 2; ++ai)
#pragma unroll
            for (int m = 0; m < 4; ++m) {
                const int row = u.pm * 256 + ai * 128 + wr * 64 + m * 16 + fr;
                float g[8], up[8], h[8]; get8(acc[ai][0][m], g); get8(acc[ai][1][m], up);
#pragma unroll
                for (int j = 0; j < 8; ++j) h[j] = silu_f(g[j] * (1.0f / SW_GU)) * up[j] * (HS / SW_GU);
                u32x2 w; w.x = pk4_fp8(h[0], h[1], h[2], h[3]); w.y = pk4_fp8(h[4], h[5], h[6], h[7]);
                *(u32x2*)(H + (size_t)row * ldh + col) = w;
            }
    }
};
struct EpiKVQ {
    bf16 *KCMP, *VCMP, *KSLC, *VSLC, *KWIN, *VWIN, *Q; float* GATES; const float *cs, *sn;
    __device__ __forceinline__ void operator()(const f32x4 (&acc)[2][2][4][2], const pg8::Unit& u, int wr, int wc, int fr, int fq) const {
        const int pn = u.pn;
        if (pn == 10 && wc >= 1) return;
#pragma unroll
        for (int ai = 0; ai < 2; ++ai)
#pragma unroll
            for (int m = 0; m < 4; ++m) {
                const int row = (u.pm & 63) * 256 + ai * 128 + wr * 64 + m * 16 + fr;
                float x1[8], x2[8]; get8(acc[ai][0][m], x1); get8(acc[ai][1][m], x2);
#pragma unroll
                for (int j = 0; j < 8; ++j) { x1[j] *= 1.0f / SW_GU; x2[j] *= 1.0f / SW_GU; }
                if (pn < 6) {
                    if ((pn & 1) == 0) { float y1[8], y2[8]; rope8(cs, sn, row, fq, x1, x2, 1.0f, y1, y2);
#pragma unroll
                        for (int j = 0; j < 8; ++j) { x1[j] = y1[j]; x2[j] = y2[j]; } }
                    bf16* d;
                    if (pn < 2) d = (pn == 0 ? KCMP : VCMP) + ((size_t)((row >> 12) * 4 + wc) * SEQ + (row & 4095)) * 64;
                    else d = (pn == 2 ? KSLC : pn == 3 ? VSLC : pn == 4 ? KWIN : VWIN) + (size_t)row * 256 + wc * 64;
                    store8(d + 8 * fq, x1); store8(d + 32 + 8 * fq, x2);
                } else if (pn < 10) {
                    float y1[8], y2[8]; rope8(cs, sn, row, fq, x1, x2, C2, y1, y2);
                    bf16* d = Q + (size_t)row * 1024 + (4 * (pn - 6) + wc) * 64;
                    store8(d + 8 * fq, y1); store8(d + 32 + 8 * fq, y2);
                } else {
                    float* gp = GATES + (size_t)row * 48;
#pragma unroll
                    for (int j = 0; j < 8; ++j) gp[8 * fq + j] = 1.0f / (1.0f + __expf(-x1[j]));
                    if (fq < 2) {
#pragma unroll
                        for (int j = 0; j < 8; ++j) gp[32 + 8 * fq + j] = 1.0f / (1.0f + __expf(-x2[j])); }
                }
            }
    }
};
struct EpiY {
    bf16* Y;
    __device__ __forceinline__ void operator()(const f32x4 (&acc)[2][2][4][2], const pg8::Unit& u, int wr, int wc, int fr, int fq) const {
#pragma unroll
        for (int ai = 0; ai < 2; ++ai)
#pragma unroll
            for (int m = 0; m < 4; ++m) {
                const int row = u.pm * 256 + ai * 128 + wr * 64 + m * 16 + fr;
#pragma unroll
                for (int bj = 0; bj < 2; ++bj) { float x[8]; get8(acc[ai][bj][m], x);
#pragma unroll
                    for (int j = 0; j < 8; ++j) x[j] *= 1.0f / (SW_DN * HS);
                    store8(Y + (size_t)row * D + (u.pn & 3) * 256 + bj * 128 + wc * 32 + 8 * fq, x); }
            }
    }
};
struct EpiYp {
    bf16* Yp;
    __device__ __forceinline__ void operator()(const f32x4 (&acc)[2][2][4][2], const pg8::Unit& u, int wr, int wc, int fr, int fq) const {
        bf16* base = Yp + (size_t)((u.ko * 586) >> 20) * ((size_t)NE * 256 * D) + (size_t)(u.pm - 128) * 256 * D + (u.pn & 3) * 256 + wc * 32 + 8 * fq;
#pragma unroll
        for (int ai = 0; ai < 2; ++ai)
#pragma unroll
            for (int m = 0; m < 4; ++m) {
                const int row = ai * 128 + wr * 64 + m * 16 + fr;
#pragma unroll
                for (int bj = 0; bj < 2; ++bj) { float x[8]; get8(acc[ai][bj][m], x);
#pragma unroll
                    for (int j = 0; j < 8; ++j) x[j] *= 1.0f / (SW_DN * HS);
                    store8(base + (size_t)row * D + bj * 128, x); }
            }
    }
};
struct KvqOrder {
    pg8::StaticOrder S;
    __device__ bool next(int i, pg8::Unit& u) const { if (!S.next(i, u)) return false; if (u.pn >= 6) u.pm += 64; return true; }
};
struct MoeOrder {
    int tend[NE]; int npn, ksplit, kbytes, mtlo, nmt, j, per8;
    __device__ void init(const unsigned* cnt, int npn_, int G_, int c_, int ksplit_ = 1, int kbytes_ = 0, int mt0_ = 0, int mt1_ = 1 << 30) {
        int acc = 0; for (int e = 0; e < NE; ++e) { acc += (int)((ld_u32(cnt + e) + 255u) >> 8); tend[e] = acc; }
        npn = npn_; ksplit = ksplit_; kbytes = kbytes_;
        const int mt0 = mt0_ < acc ? mt0_ : acc, mt1 = mt1_ < acc ? mt1_ : acc, n = mt1 - mt0;
        const int nx = (G_ % 8 == 0) ? 8 : 1, x = (nx == 8) ? (c_ & 7) : 0;
        mtlo = mt0 + (int)((long)n * x / nx); nmt = mt0 + (int)((long)n * (x + 1) / nx) - mtlo;
        j = (nx == 8) ? (c_ >> 3) : c_; per8 = G_ / nx;
    }
    __device__ bool next(int i, pg8::Unit& u) const {
        const int idx = i * per8 + j;
        const int cw = (npn < 4 ? npn : 4), upc = nmt * cw * ksplit;
        if (nmt <= 0 || idx >= nmt * npn * ksplit) return false;
        const int q = idx / upc, w = idx % upc, mt = mtlo + w / (cw * ksplit), r = w % (cw * ksplit), pn = q * cw + r / ksplit, kh = r % ksplit; int e = 0;
#pragma unroll
        for (int k = 0; k < NE - 1; ++k) e += (mt >= tend[k]) ? 1 : 0;
        u.pm = mt; u.pn = e * npn + pn; u.ko = kh * kbytes; return true;
    }
};

__device__ __forceinline__ f32x16 sgemm_tile(const bf16* A, int lda, const bf16* Bt, int ldb, int K, int row0, int col0, int lane) {
    f32x16 acc = {};
    const bf16* ap = A + (size_t)(row0 + (lane & 31)) * lda + 8 * (lane >> 5);
    const bf16* bp = Bt + (size_t)(col0 + (lane & 31)) * ldb + 8 * (lane >> 5);
#pragma unroll 8
    for (int k = 0; k < K; k += 16) { const bf16x8 a = *(const bf16x8*)(ap + k), b = *(const bf16x8*)(bp + k); acc = __builtin_amdgcn_mfma_f32_32x32x16_bf16(a, b, acc, 0, 0, 0); }
    return acc;
}
__device__ __forceinline__ float gelu_tanh(float x) { const float t = tanhf(0.7978845608028654f * (x + 0.044715f * x * x * x)); return 0.5f * x * (1.0f + t); }

__device__ __forceinline__ unsigned okey(float f) { const unsigned u = __builtin_bit_cast(unsigned, f); return (u & 0x80000000u) ? ~u : (u | 0x80000000u); }
__device__ __forceinline__ void dsa_naive_item(Frame& F, int m, bf16* O  , unsigned long long* MASKo  ) {
    const int tid = F.tid, lane = F.lane, wave = F.wave;
    const int b = m >> 12, t = m & 4095, n = t + 1;
    LAS unsigned* KEY = (LAS unsigned*)(F.lds);
    LAS u32x4* IQL = (LAS u32x4*)(F.lds + 16384);
    LAS float* IWL = (LAS float*)(F.lds + 16384 + 1024);
    LAS int* LIST = (LAS int*)(F.lds + 20480);
    LAS int* CNT = (LAS int*)(F.lds + 20480 + 1024);
    LAS float* PL = (LAS float*)(F.lds + 24576);
    const bf16* IQ = WSP(bf16, WS_IQ); const bf16* IK = WSP(bf16, WS_IK); const float* IW = WSP(float, SM_IW);
    if (tid < 64) IQL[tid] = ((const u32x4*)(IQ + (size_t)m * 512))[tid];
    if (tid < 8) IWL[tid] = IW[(size_t)m * 8 + tid];
    __syncthreads();
    for (int s = tid; s < n; s += 512) {
        const u32x4* kp = (const u32x4*)(IK + (size_t)(b * SEQ + s) * 64);
        u32x4 kv[8];
#pragma unroll
        for (int c = 0; c < 8; ++c) kv[c] = kp[c];
        float sc = 0.f;
#pragma unroll
        for (int h = 0; h < 8; ++h) { float d = 0.f;
#pragma unroll
            for (int c = 0; c < 8; ++c) d = dot8(kv[c], IQL[h * 8 + c], d);
            sc += IWL[h] * fmaxf(d, 0.f); }
        KEY[s] = okey(sc);
    }
    __syncthreads();
    const bool all = (n <= 256);
    unsigned thr = 0u; int need_ties = 0;
    if (!all) {
        unsigned myk[8];
#pragma unroll
        for (int i = 0; i < 8; ++i) { const int s = tid + 512 * i; myk[i] = s < n ? KEY[s] : 0u; }
        unsigned prefix = 0u;
        for (int bit = 31; bit >= 0; --bit) {
            const unsigned cand = prefix | (1u << bit);
            int c = 0;
#pragma unroll
            for (int i = 0; i < 8; ++i) c += (myk[i] >= cand) ? 1 : 0;
            c = wave_sum_i(c);
            if (lane == 0) CNT[(bit & 1) * 8 + wave] = c;
            __syncthreads();
            int tot = 0;
#pragma unroll
            for (int w = 0; w < 8; ++w) tot += CNT[(bit & 1) * 8 + w];
            if (tot >= 256) prefix = cand;
        }
        thr = prefix;
        int c = 0;
#pragma unroll
        for (int i = 0; i < 8; ++i) c += (myk[i] > thr) ? 1 : 0;
        c = wave_sum_i(c);
        if (lane == 0) CNT[16 + wave] = c;
        __syncthreads();
        int tot = 0;
#pragma unroll
        for (int w = 0; w < 8; ++w) tot += CNT[16 + w];
        need_ties = 256 - tot;
    }
    if (wave == 0) {
        int pos = 0, ties = 0;
        const unsigned long long lt = (1ull << lane) - 1ull;
        for (int c0 = 0; c0 < n; c0 += 64) {
            const int s = c0 + lane; const bool valid = s < n; const unsigned k = valid ? KEY[s] : 0u;
            const bool gt = valid && (all || k > thr), eq = valid && !all && (k == thr);
            const unsigned long long beq = __ballot(eq); const int tr = ties + __popcll(beq & lt);
            const bool sel = gt || (eq && tr < need_ties);
            const unsigned long long bs = __ballot(sel); const int p = pos + __popcll(bs & lt);
            if (sel) LIST[p] = s;
            if (MASKo && lane == 0) MASKo[((size_t)b * 64 + (c0 >> 6)) * SEQ + t] = bs;
            pos += __popcll(bs); ties += __popcll(beq);
        }
        if (lane == 0) CNT[32] = pos;
    }
    __syncthreads();
    if (!O) return;
    const int nsel = CNT[32];
    const int g = wave >> 1, h0 = 4 * g + 2 * (wave & 1);
    const bf16* Q = WSP(bf16, WS_Q0); const bf16* Kp = WSP(bf16, WS_K0); const bf16* Vp = WSP(bf16, WS_V0);
    u32x4 q0[8], q1[8];
#pragma unroll
    for (int c = 0; c < 8; ++c) { q0[c] = ((const u32x4*)(Q + (size_t)m * 1024 + h0 * 64))[c]; q1[c] = ((const u32x4*)(Q + (size_t)m * 1024 + (h0 + 1) * 64))[c]; }
    float s0[4], s1[4]; float mx0 = -INFINITY, mx1 = -INFINITY;
#pragma unroll
    for (int i = 0; i < 4; ++i) { const int j = lane + 64 * i; s0[i] = -INFINITY; s1[i] = -INFINITY;
        if (j < nsel) { const int s = LIST[j]; const u32x4* kp = (const u32x4*)(Kp + (size_t)(b * SEQ + s) * 256 + g * 64); float d0 = 0.f, d1 = 0.f;
#pragma unroll
            for (int c = 0; c < 8; ++c) { const u32x4 kk = kp[c]; d0 = dot8(kk, q0[c], d0); d1 = dot8(kk, q1[c], d1); }
            s0[i] = d0; s1[i] = d1; }
        mx0 = fmaxf(mx0, s0[i]); mx1 = fmaxf(mx1, s1[i]); }
    mx0 = wave_max(mx0); mx1 = wave_max(mx1);
    float l0 = 0.f, l1 = 0.f;
    LAS float* P0 = PL + (wave * 2 + 0) * 256; LAS float* P1 = PL + (wave * 2 + 1) * 256;
#pragma unroll
    for (int i = 0; i < 4; ++i) { const int j = lane + 64 * i; const float p0 = (j < nsel) ? __builtin_amdgcn_exp2f(s0[i] - mx0) : 0.f, p1 = (j < nsel) ? __builtin_amdgcn_exp2f(s1[i] - mx1) : 0.f;
        l0 += p0; l1 += p1; P0[j] = bfround(p0); P1[j] = bfround(p1); }
    l0 = wave_sum(l0); l1 = wave_sum(l1);
    float a0 = 0.f, a1 = 0.f;
    for (int j = 0; j < nsel; ++j) { const int s = LIST[j]; const float v = bf2f(Vp[(size_t)(b * SEQ + s) * 256 + g * 64 + lane]); a0 += P0[j] * v; a1 += P1[j] * v; }
    O[(size_t)m * 1024 + h0 * 64 + lane] = (bf16)f2bf(a0 / l0); O[(size_t)m * 1024 + (h0 + 1) * 64 + lane] = (bf16)f2bf(a1 / l1);
    __syncthreads();
}

__device__ __forceinline__ void nsa_naive_item(Frame& F, int m, bf16* O  , bf16* OCG  , unsigned long long* SELo  ) {
    const int lane = F.lane, wave = F.wave;
    const int b = m >> 12, t = m & 4095, jt = t >> 6;
    const int g = wave >> 1, h0 = 4 * g + 2 * (wave & 1);
    LAS float* PC = (LAS float*)(F.lds);
    LAS float* SC0 = (LAS float*)(F.lds + 16384) + (wave * 2 + 0) * 1024;
    LAS float* SC1 = SC0 + 1024;
    LAS unsigned long long* SEL = (LAS unsigned long long*)(F.lds + 16384 + 65536);
    const bf16* Q = WSP(bf16, WS_Q1);
    u32x4 q0[8], q1[8];
#pragma unroll
    for (int c = 0; c < 8; ++c) { q0[c] = ((const u32x4*)(Q + (size_t)m * 1024 + h0 * 64))[c]; q1[c] = ((const u32x4*)(Q + (size_t)m * 1024 + (h0 + 1) * 64))[c]; }
    const int nv = t >= 31 ? min(255, (t - 31) / 16 + 1) : 0;
    const bf16* KC = WSP(bf16, SM_KC) + (size_t)(b * 4 + g) * 256 * 64; const bf16* VC = WSP(bf16, SM_VC) + (size_t)(b * 4 + g) * 256 * 64;
    float oc0 = 0.f, oc1 = 0.f;
    {
        float s0[4], s1[4]; float mx0 = -INFINITY, mx1 = -INFINITY;
#pragma unroll
        for (int i = 0; i < 4; ++i) { const int n = lane + 64 * i; s0[i] = -INFINITY; s1[i] = -INFINITY;
            if (n < nv) { const u32x4* kp = (const u32x4*)(KC + (size_t)n * 64); float d0 = 0.f, d1 = 0.f;
#pragma unroll
                for (int c = 0; c < 8; ++c) { const u32x4 kk = kp[c]; d0 = dot8(kk, q0[c], d0); d1 = dot8(kk, q1[c], d1); }
                s0[i] = d0; s1[i] = d1; }
            mx0 = fmaxf(mx0, s0[i]); mx1 = fmaxf(mx1, s1[i]); }
        mx0 = wave_max(mx0); mx1 = wave_max(mx1);
        float p0[4], p1[4], l0 = 0.f, l1 = 0.f;
#pragma unroll
        for (int i = 0; i < 4; ++i) { const int n = lane + 64 * i; p0[i] = (n < nv) ? __builtin_amdgcn_exp2f(s0[i] - mx0) : 0.f; p1[i] = (n < nv) ? __builtin_amdgcn_exp2f(s1[i] - mx1) : 0.f; l0 += p0[i]; l1 += p1[i]; }
        l0 = wave_sum(l0); l1 = wave_sum(l1);
        const float r0 = nv > 0 ? 1.0f / l0 : 0.f, r1 = nv > 0 ? 1.0f / l1 : 0.f;
#pragma unroll
        for (int i = 0; i < 4; ++i) { const int n = lane + 64 * i; PC[h0 * 256 + n] = p0[i] * r0; PC[(h0 + 1) * 256 + n] = p1[i] * r1; SC0[n] = bfround(p0[i]); SC1[n] = bfround(p1[i]); }
        for (int n = 0; n < nv; ++n) { const float v = bf2f(VC[(size_t)n * 64 + lane]); oc0 += SC0[n] * v; oc1 += SC1[n] * v; }
        oc0 *= r0; oc1 *= r1;
    }
    __syncthreads();
    if ((wave & 1) == 0) {
        const int j = lane;
        auto P4 = [&](int n) -> float { return (PC[(4 * g) * 256 + n] + PC[(4 * g + 1) * 256 + n]) + (PC[(4 * g + 2) * 256 + n] + PC[(4 * g + 3) * 256 + n]); };
        float imp = P4(4 * j) + P4(4 * j + 1) + P4(4 * j + 2) + 0.5f * P4(4 * j + 3);
        if (j > 0) imp += 0.5f * P4(4 * j - 1);
        const bool valid = j <= jt, forced = (j == 0) || (j == jt) || (j + 1 == jt);
        const float val = valid ? (forced ? 1e30f : imp) : -1e30f;
        int rank = 0;
        for (int jj = 0; jj < 64; ++jj) { const float vj = __shfl(val, jj); rank += ((vj > val) || (vj == val && jj < j)) ? 1 : 0; }
        const unsigned long long mk = __ballot(rank < 16);
        if (lane == 0) { SEL[g] = mk; if (SELo) SELo[((size_t)b * 4 + g) * SEQ + t] = mk; }
    }
    __syncthreads();
    const float* gt = WSP(float, SM_GATES) + (size_t)m * 48;
    if (OCG) { OCG[(size_t)m * 1024 + h0 * 64 + lane] = (bf16)f2bf(gt[h0 * 3] * oc0); OCG[(size_t)m * 1024 + (h0 + 1) * 64 + lane] = (bf16)f2bf(gt[h0 * 3 + 3] * oc1); }
    if (!O) return;
    float os0 = 0.f, os1 = 0.f;
    {
        unsigned long long mk = SEL[g]; if (jt < 63) mk &= ((1ull << (jt + 1)) - 1ull);
        const bf16* Ks = WSP(bf16, WS_KSLC); const bf16* Vs = WSP(bf16, WS_VSLC);
        int cnt = 0; float mx0 = -INFINITY, mx1 = -INFINITY;
        for (unsigned long long r = mk; r; r &= r - 1ull) { const int j = __builtin_ctzll(r); const int tok = 64 * j + lane;
            float d0 = -INFINITY, d1 = -INFINITY;
            if (tok <= t) { const u32x4* kp = (const u32x4*)(Ks + (size_t)(b * SEQ + tok) * 256 + g * 64); d0 = 0.f; d1 = 0.f;
#pragma unroll
                for (int c = 0; c < 8; ++c) { const u32x4 kk = kp[c]; d0 = dot8(kk, q0[c], d0); d1 = dot8(kk, q1[c], d1); } }
            SC0[cnt * 64 + lane] = d0; SC1[cnt * 64 + lane] = d1; mx0 = fmaxf(mx0, d0); mx1 = fmaxf(mx1, d1); ++cnt; }
        mx0 = wave_max(mx0); mx1 = wave_max(mx1);
        float l0 = 0.f, l1 = 0.f;
        for (int i = lane; i < cnt * 64; i += 64) { const float p0 = __builtin_amdgcn_exp2f(SC0[i] - mx0), p1 = __builtin_amdgcn_exp2f(SC1[i] - mx1); l0 += p0; l1 += p1; SC0[i] = bfround(p0); SC1[i] = bfround(p1); }
        l0 = wave_sum(l0); l1 = wave_sum(l1);
        cnt = 0;
        for (unsigned long long r = mk; r; r &= r - 1ull) { const int j = __builtin_ctzll(r);
            const int kmax = min(64, t - 64 * j + 1);
            for (int kk = 0; kk < kmax; ++kk) { const float v = bf2f(Vs[(size_t)(b * SEQ + 64 * j + kk) * 256 + g * 64 + lane]); os0 += SC0[cnt * 64 + kk] * v; os1 += SC1[cnt * 64 + kk] * v; }
            ++cnt; }
        os0 /= l0; os1 /= l1;
    }
    float ow0 = 0.f, ow1 = 0.f;
    {
        const bf16* Kw = WSP(bf16, WS_KWIN); const bf16* Vw = WSP(bf16, WS_VWIN);
        const int slo = max(0, t - 511), nw = t - slo + 1;
        float mx0 = -INFINITY, mx1 = -INFINITY;
        for (int i = lane; i < nw; i += 64) { const u32x4* kp = (const u32x4*)(Kw + (size_t)(b * SEQ + slo + i) * 256 + g * 64); float d0 = 0.f, d1 = 0.f;
#pragma unroll
            for (int c = 0; c < 8; ++c) { const u32x4 kk = kp[c]; d0 = dot8(kk, q0[c], d0); d1 = dot8(kk, q1[c], d1); }
            SC0[i] = d0; SC1[i] = d1; mx0 = fmaxf(mx0, d0); mx1 = fmaxf(mx1, d1); }
        mx0 = wave_max(mx0); mx1 = wave_max(mx1);
        float l0 = 0.f, l1 = 0.f;
        for (int i = lane; i < nw; i += 64) { const float p0 = __builtin_amdgcn_exp2f(SC0[i] - mx0), p1 = __builtin_amdgcn_exp2f(SC1[i] - mx1); l0 += p0; l1 += p1; SC0[i] = bfround(p0); SC1[i] = bfround(p1); }
        l0 = wave_sum(l0); l1 = wave_sum(l1);
        for (int i = 0; i < nw; ++i) { const float v = bf2f(Vw[(size_t)(b * SEQ + slo + i) * 256 + g * 64 + lane]); ow0 += SC0[i] * v; ow1 += SC1[i] * v; }
        ow0 /= l0; ow1 /= l1;
    }
    O[(size_t)m * 1024 + h0 * 64 + lane] = (bf16)f2bf(gt[h0 * 3] * oc0 + gt[h0 * 3 + 1] * os0 + gt[h0 * 3 + 2] * ow0);
    O[(size_t)m * 1024 + (h0 + 1) * 64 + lane] = (bf16)f2bf(gt[h0 * 3 + 3] * oc1 + gt[h0 * 3 + 4] * os1 + gt[h0 * 3 + 5] * ow1);
    __syncthreads();
}

namespace ix {
__device__ __forceinline__ void unit(Frame& F, int b, int qb) {
    const int lane = F.lane, wid = F.wave, r32 = lane & 31, hh = lane >> 5;
    const int q0w = 32 * qb + 4 * wid;
    LAS unsigned char* lds = F.lds;
    bf16x8 af[4];
    { const int rho = r32, hsel = (rho >> 2) & 1, r = (rho & 3) + 4 * (rho >> 3), qq = q0w + 2 * hsel + (r >> 3), head = r & 7;
      const bf16* ap = WSP(bf16, WS_IQ) + ((size_t)b * SEQ + qq) * 512 + head * 64 + 8 * hh;
#pragma unroll
      for (int d0 = 0; d0 < 4; ++d0) af[d0] = *(const bf16x8*)(ap + 16 * d0); }
    float w[16];
    { const float* wp = WSP(float, SM_IW) + ((size_t)b * SEQ + q0w + 2 * hh) * 8;
#pragma unroll
      for (int i = 0; i < 4; ++i) { const f32x4 v = ((const f32x4*)wp)[i]; w[4 * i] = v.x; w[4 * i + 1] = v.y; w[4 * i + 2] = v.z; w[4 * i + 3] = v.w; } }
    const int NT = ((32 * qb + 31) >> 6) + 1;
    const bf16* IKb = WSP(bf16, WS_IK) + (size_t)b * SEQ * 64;
    float* SC = WSP(float, WS_SCORES) + ((size_t)b * SEQ + q0w + 2 * hh) * SEQ + r32;
#define IX_DMA(t, buf) __builtin_amdgcn_global_load_lds((const unsigned*)(IKb + (size_t)(64 * (t) + lane) * 64 + wid * 8), (LAS unsigned*)(lds + (buf) * 8192 + wid * 1024), 16, 0, 0)
    IX_DMA(0, 0);
    __syncthreads();
    for (int t = 0; t < NT; ++t) {
        if (t + 1 < NT) IX_DMA(t + 1, (t + 1) & 1);
        const LAS unsigned char* kb = lds + (t & 1) * 8192 + hh * 1024 + r32 * 16;
        f32x16 a0 = {}, a1 = {};
#pragma unroll
        for (int d0 = 0; d0 < 4; ++d0) {
            const bf16x8 b0 = *(const LAS bf16x8*)(kb + d0 * 2048), b1 = *(const LAS bf16x8*)(kb + d0 * 2048 + 512);
            a0 = __builtin_amdgcn_mfma_f32_32x32x16_bf16(af[d0], b0, a0, 0, 0, 0);
            a1 = __builtin_amdgcn_mfma_f32_32x32x16_bf16(af[d0], b1, a1, 0, 0, 0);
        }
        float sA0 = 0.f, sB0 = 0.f, sA1 = 0.f, sB1 = 0.f;
#pragma unroll
        for (int r = 0; r < 8; ++r) { sA0 += w[r] * fmaxf(a0[r], 0.f); sB0 += w[8 + r] * fmaxf(a0[8 + r], 0.f); sA1 += w[r] * fmaxf(a1[r], 0.f); sB1 += w[8 + r] * fmaxf(a1[8 + r], 0.f); }
        float* o = SC + 64 * t;
        o[0] = sA0; o[32] = sA1; o[SEQ] = sB0; o[SEQ + 32] = sB1;
        asm volatile("s_waitcnt vmcnt(4)" ::: "memory");
        __builtin_amdgcn_s_barrier();
    }
    asm volatile("s_waitcnt vmcnt(0)" ::: "memory");
#undef IX_DMA
}
__device__ __forceinline__ int cnt8(unsigned a0, unsigned a1, unsigned a2, unsigned a3, unsigned a4, unsigned a5, unsigned a6, unsigned a7, unsigned cand) {
    int c;
    asm("s_nop 1\n\tv_cmp_le_u32_e64 s[36:37], %9, %1\n\tv_cmp_le_u32_e64 s[38:39], %9, %2\n\tv_cmp_le_u32_e64 s[40:41], %9, %3\n\tv_cmp_le_u32_e64 s[42:43], %9, %4\n\t"
        "v_cmp_le_u32_e64 s[44:45], %9, %5\n\tv_cmp_le_u32_e64 s[46:47], %9, %6\n\tv_cmp_le_u32_e64 s[48:49], %9, %7\n\tv_cmp_le_u32_e64 s[50:51], %9, %8\n\t"
        "s_bcnt1_i32_b64 s36, s[36:37]\n\ts_bcnt1_i32_b64 s38, s[38:39]\n\ts_bcnt1_i32_b64 s40, s[40:41]\n\ts_bcnt1_i32_b64 s42, s[42:43]\n\t"
        "s_bcnt1_i32_b64 s44, s[44:45]\n\ts_bcnt1_i32_b64 s46, s[46:47]\n\ts_bcnt1_i32_b64 s48, s[48:49]\n\ts_bcnt1_i32_b64 s50, s[50:51]\n\t"
        "s_add_i32 s36, s36, s38\n\ts_add_i32 s40, s40, s42\n\ts_add_i32 s44, s44, s46\n\ts_add_i32 s48, s48, s50\n\ts_add_i32 s36, s36, s40\n\ts_add_i32 s44, s44, s48\n\ts_add_i32 %0, s36, s44"
        : "=s"(c) : "v"(a0), "v"(a1), "v"(a2), "v"(a3), "v"(a4), "v"(a5), "v"(a6), "v"(a7), "s"(cand)
        : "s36", "s37", "s38", "s39", "s40", "s41", "s42", "s43", "s44", "s45", "s46", "s47", "s48", "s49", "s50", "s51", "scc");
    return c;
}
template <int NJ>
__device__ __forceinline__ void select_row_t(Frame& F, int m) {
    const int lane = F.lane, b = m >> 12, t = m & 4095, n = t + 1;
    const float* row = WSP(float, WS_SCORES) + (size_t)m * SEQ + lane;
    unsigned k[NJ];
    {
        float v[NJ];
#pragma unroll
        for (int j = 0; j < NJ; ++j) v[j] = row[64 * j];
#pragma unroll
        for (int j = 0; j < NJ; ++j) k[j] = (64 * j + lane < n) ? okey(v[j]) : 0u;
    }
    unsigned thrg = 0u; int need = 0;
    if (n > 256) {
        unsigned prefix = 0u; bool exact = false;
        for (int bit = 31; bit >= 0; --bit) {
            const unsigned cand = prefix | (1u << bit);
            int c = 0;
#pragma unroll
            for (int j = 0; j < NJ; j += 8) c += cnt8(k[j], k[j + 1], k[j + 2], k[j + 3], k[j + 4], k[j + 5], k[j + 6], k[j + 7], cand);
            if (c >= 256) { prefix = cand; if (c == 256) { exact = true; break; } }
        }
        if (exact) { thrg = prefix - 1u; need = 0; }
        else { int cg = 0;
#pragma unroll
            for (int j = 0; j < NJ; j += 8) cg += cnt8(k[j], k[j + 1], k[j + 2], k[j + 3], k[j + 4], k[j + 5], k[j + 6], k[j + 7], prefix + 1u);
            thrg = prefix; need = 256 - cg; }
    }
    const unsigned long long lt = (1ull << lane) - 1ull;
    unsigned mlo = 0u, mhi = 0u;
    if (need == 0) {
#pragma unroll
        for (int j = 0; j < NJ; j += 8)
            asm("s_nop 1\n\tv_cmp_lt_u32_e64 s[36:37], %10, %2\n\tv_cmp_lt_u32_e64 s[38:39], %10, %3\n\tv_cmp_lt_u32_e64 s[40:41], %10, %4\n\tv_cmp_lt_u32_e64 s[42:43], %10, %5\n\t"
                "v_cmp_lt_u32_e64 s[44:45], %10, %6\n\tv_cmp_lt_u32_e64 s[46:47], %10, %7\n\tv_cmp_lt_u32_e64 s[48:49], %10, %8\n\tv_cmp_lt_u32_e64 s[50:51], %10, %9\n\ts_nop 3\n\t"
                "v_writelane_b32 %0, s36, %11\n\tv_writelane_b32 %1, s37, %11\n\tv_writelane_b32 %0, s38, %12\n\tv_writelane_b32 %1, s39, %12\n\t"
                "v_writelane_b32 %0, s40, %13\n\tv_writelane_b32 %1, s41, %13\n\tv_writelane_b32 %0, s42, %14\n\tv_writelane_b32 %1, s43, %14\n\t"
                "v_writelane_b32 %0, s44, %15\n\tv_writelane_b32 %1, s45, %15\n\tv_writelane_b32 %0, s46, %16\n\tv_writelane_b32 %1, s47, %16\n\t"
                "v_writelane_b32 %0, s48, %17\n\tv_writelane_b32 %1, s49, %17\n\tv_writelane_b32 %0, s50, %18\n\tv_writelane_b32 %1, s51, %18"
                : "+v"(mlo), "+v"(mhi) : "v"(k[j]), "v"(k[j + 1]), "v"(k[j + 2]), "v"(k[j + 3]), "v"(k[j + 4]), "v"(k[j + 5]), "v"(k[j + 6]), "v"(k[j + 7]), "s"(thrg),
                  "i"(j), "i"(j + 1), "i"(j + 2), "i"(j + 3), "i"(j + 4), "i"(j + 5), "i"(j + 6), "i"(j + 7)
                : "s36", "s37", "s38", "s39", "s40", "s41", "s42", "s43", "s44", "s45", "s46", "s47", "s48", "s49", "s50", "s51");
    } else {
        unsigned long long myw = 0ull; int ties = 0;
#pragma unroll
        for (int j = 0; j < NJ; ++j) {
            const bool gt = (k[j] > thrg), eq = (k[j] == thrg) && ((64 * j + lane) < n);
            const unsigned long long beq = __ballot(eq);
            const bool sel = gt || (eq && (ties + __popcll(beq & lt) < need)); ties += __popcll(beq);
            const unsigned long long bs = __ballot(sel);
            if (lane == j) myw = bs;
        }
        mlo = (unsigned)myw; mhi = (unsigned)(myw >> 32);
    }
    if (lane <= (t >> 6)) WSP(unsigned long long, WS_MASK)[((size_t)b * 64 + lane) * SEQ + t] = ((unsigned long long)mhi << 32) | mlo;
}
__device__ __forceinline__ void select_row(Frame& F, int m) {
    const int n = (m & 4095) + 1;
    if (n <= 1024) select_row_t<16>(F, m); else if (n <= 2048) select_row_t<32>(F, m); else if (n <= 3072) select_row_t<48>(F, m); else select_row_t<64>(F, m);
}
}

namespace fa {
typedef short s16x4 __attribute__((ext_vector_type(4)));
typedef short v4i16_t __attribute__((ext_vector_type(4)));
constexpr int KOFF = 0, VOFF = 16384, XOFF = 32768, OSTOFF = 36864, TOTOFF = 69632;
constexpr float THR = 8.0f;
__device__ __forceinline__ int crow(int r, int hi) { return (r & 3) + 8 * (r >> 2) + 4 * hi; }
typedef float f32x2_t __attribute__((ext_vector_type(2))); typedef __bf16 bf16x2_t __attribute__((ext_vector_type(2)));
__device__ __forceinline__ unsigned cvtpk(float lo, float hi) { f32x2_t v = {lo, hi}; bf16x2_t b = __builtin_convertvector(v, bf16x2_t); return __builtin_bit_cast(unsigned, b); }
struct Ctx { LAS unsigned char* lds; int lane, wid, r32, hi; };

__device__ __forceinline__ void dma_tile(const Ctx& c, const bf16* Kg, const bf16* Vg, int pitch, int t, int buf) {
    const bf16* ks = Kg + (size_t)(64 * t + c.lane) * pitch + c.wid * 8;
    __builtin_amdgcn_global_load_lds((const unsigned*)ks, (LAS unsigned*)(c.lds + KOFF + buf * 8192 + c.wid * 1024), 16, 0, 0);
    const bf16* vs = Vg + (size_t)(64 * t + 16 * (c.wid & 3) + (c.lane >> 2)) * pitch + (c.wid >> 2) * 32 + (c.lane & 3) * 8;
    __builtin_amdgcn_global_load_lds((const unsigned*)vs, (LAS unsigned*)(c.lds + VOFF + buf * 8192 + c.wid * 1024), 16, 0, 0);
}
__device__ __forceinline__ void qk(const Ctx& c, int buf, const f32x16& ci, f32x16& p0, f32x16& p1) {
    const LAS unsigned char* kb = c.lds + KOFF + buf * 8192 + c.hi * 1024 + c.r32 * 16;
    const LAS bf16x8* qs = (const LAS bf16x8*)(c.lds + OSTOFF + c.wid * 4096) + c.lane;
    p0 = ci; p1 = ci;
#pragma unroll
    for (int d0 = 0; d0 < 4; ++d0) {
        const bf16x8 b0 = *(const LAS bf16x8*)(kb + d0 * 2048), b1 = *(const LAS bf16x8*)(kb + d0 * 2048 + 512), q = qs[d0 * 64];
        p0 = __builtin_amdgcn_mfma_f32_32x32x16_bf16(b0, q, p0, 0, 0, 0);
        p1 = __builtin_amdgcn_mfma_f32_32x32x16_bf16(b1, q, p1, 0, 0, 0);
    }
}
__device__ __forceinline__ void park_q(const Ctx& c, const bf16* Qrow  ) {
    LAS bf16x8* qs = (LAS bf16x8*)(c.lds + OSTOFF + c.wid * 4096) + c.lane;
#pragma unroll
    for (int d0 = 0; d0 < 4; ++d0) qs[d0 * 64] = *(const bf16x8*)(Qrow + d0 * 16 + c.hi * 8);
}
__device__ __forceinline__ s16x4 vtr(const LAS unsigned char* p) { return __builtin_bit_cast(s16x4, __builtin_amdgcn_ds_read_tr16_b64_v4i16((LAS v4i16_t*)p)); }
__device__ __forceinline__ void pv(const Ctx& c, int buf, f32x16 (&o)[2], f32x16& lacc, const u32x4 (&pw)[4]) {
    const bf16x8 ones = {(short)0x3F80, (short)0x3F80, (short)0x3F80, (short)0x3F80, (short)0x3F80, (short)0x3F80, (short)0x3F80, (short)0x3F80};
    const LAS unsigned char* vp = c.lds + VOFF + buf * 8192 + ((c.lane >> 4) & 1) * 32 + (c.lane & 3) * 8 + (4 * c.hi + ((c.lane & 15) >> 2)) * 64;
#pragma unroll
    for (int d0 = 0; d0 < 2; ++d0) {
        s16x4 lo[4], hi[4];
#pragma unroll
        for (int ks = 0; ks < 4; ++ks) { lo[ks] = vtr(vp + d0 * 4096 + ks * 1024); hi[ks] = vtr(vp + d0 * 4096 + ks * 1024 + 512); }
#pragma unroll
        for (int ks = 0; ks < 4; ++ks) {
            const bf16x8 vf = {lo[ks][0], lo[ks][1], lo[ks][2], lo[ks][3], hi[ks][0], hi[ks][1], hi[ks][2], hi[ks][3]};
            o[d0] = __builtin_amdgcn_mfma_f32_32x32x16_bf16(__builtin_bit_cast(bf16x8, pw[ks]), vf, o[d0], 0, 0, 0);
        }
        }
#pragma unroll
    for (int ks = 0; ks < 4; ++ks) lacc = __builtin_amdgcn_mfma_f32_32x32x16_bf16(__builtin_bit_cast(bf16x8, pw[ks]), ones, lacc, 0, 0, 0);
}
struct State { f32x16 o[2]; f32x16 lacc; f32x16 negm; float m; };
__device__ __forceinline__ void reset(State& s) { s.o[0] = f32x16{}; s.o[1] = f32x16{}; s.lacc = f32x16{}; s.negm = f32x16{}; s.m = 0.f; }
__device__ __forceinline__ float rowmax(const f32x16& p0, const f32x16& p1) {
    float a = fmaxf(fmaxf(p0[0], p0[1]), p1[0]), b = fmaxf(fmaxf(p0[2], p0[3]), p1[1]); a = fmaxf(fmaxf(a, p1[2]), p1[3]);
#pragma unroll
    for (int r = 4; r < 16; r += 4) { a = fmaxf(fmaxf(a, p0[r]), p0[r + 1]); b = fmaxf(fmaxf(b, p0[r + 2]), p0[r + 3]); a = fmaxf(fmaxf(a, p1[r]), p1[r + 1]); b = fmaxf(fmaxf(b, p1[r + 2]), p1[r + 3]); }
    const float m = fmaxf(a, b);
    auto rr = __builtin_amdgcn_permlane32_swap(__builtin_bit_cast(unsigned, m), __builtin_bit_cast(unsigned, m), false, false);
    return fmaxf(__builtin_bit_cast(float, rr[0]), __builtin_bit_cast(float, rr[1]));
}
template <bool BITS>
__device__ __forceinline__ void tile_step(const Ctx& c, int buf, State& s, const f32x16& ci, bool first, unsigned w0, unsigned w1) {
    f32x16 p0, p1;
    qk(c, buf, ci, p0, p1);
    const float rm = rowmax(p0, p1);
    bool doit; float dl;
    if (first) { doit = true; dl = rm; } else { doit = __any(rm > THR); dl = fmaxf(rm, 0.f); }
    if (doit) {
        s.m += dl;
#pragma unroll
        for (int r = 0; r < 16; ++r) { p0[r] -= dl; p1[r] -= dl; s.negm[r] = -s.m; }
        if (!first) {
            const float f = __builtin_amdgcn_exp2f(-dl);
            LAS float* xs = (LAS float*)(c.lds + XOFF) + c.wid * 64;
            if (c.hi == 0) xs[c.r32] = f;
#pragma unroll
            for (int r = 0; r < 16; ++r) { const float fr = xs[crow(r, c.hi)]; s.o[0][r] *= fr; s.o[1][r] *= fr; s.lacc[r] *= fr; }
        }
    }
    if (BITS) { w0 >>= 4 * c.hi; w1 >>= 4 * c.hi; }
#pragma unroll
    for (int r = 0; r < 16; ++r) {
        float e0 = __builtin_amdgcn_exp2f(p0[r]), e1 = __builtin_amdgcn_exp2f(p1[r]);
        if (BITS) { const int sh = (r & 3) + 8 * (r >> 2);
            int m0_, m1_;
            asm("v_bfe_i32 %0, %1, %2, 1" : "=v"(m0_) : "v"(w0), "s"(sh)); asm("v_bfe_i32 %0, %1, %2, 1" : "=v"(m1_) : "v"(w1), "s"(sh));
            e0 = __builtin_bit_cast(float, __builtin_bit_cast(unsigned, e0) & (unsigned)m0_);
            e1 = __builtin_bit_cast(float, __builtin_bit_cast(unsigned, e1) & (unsigned)m1_); }
        p0[r] = e0; p1[r] = e1;
    }
    u32x4 pw[4];
    pw[0] = (u32x4){cvtpk(p0[0], p0[1]), cvtpk(p0[2], p0[3]), cvtpk(p0[4], p0[5]), cvtpk(p0[6], p0[7])};
    pw[1] = (u32x4){cvtpk(p0[8], p0[9]), cvtpk(p0[10], p0[11]), cvtpk(p0[12], p0[13]), cvtpk(p0[14], p0[15])};
    pw[2] = (u32x4){cvtpk(p1[0], p1[1]), cvtpk(p1[2], p1[3]), cvtpk(p1[4], p1[5]), cvtpk(p1[6], p1[7])};
    pw[3] = (u32x4){cvtpk(p1[8], p1[9]), cvtpk(p1[10], p1[11]), cvtpk(p1[12], p1[13]), cvtpk(p1[14], p1[15])};
    pv(c, buf, s.o, s.lacc, pw);
}
__device__ __forceinline__ void normalise(const Ctx& c, State& s, const LAS float* gl) {
#pragma unroll
    for (int r = 0; r < 16; ++r) { const float gq = gl ? gl[crow(r, c.hi)] : 1.0f; const float fr = s.lacc[r] > 0.f ? gq / s.lacc[r] : 0.f; s.o[0][r] *= fr; s.o[1][r] *= fr; }
}
__device__ __forceinline__ void causal_words(int qi, unsigned& w0, unsigned& w1) { const unsigned long long w = (qi >= 63) ? ~0ull : ((2ull << qi) - 1ull); w0 = (unsigned)w; w1 = (unsigned)(w >> 32); }
__device__ __forceinline__ void store_o(const Ctx& c, const f32x16 (&val)[2], unsigned char* Ow  ) {
    LAS float* stg = (LAS float*)(c.lds + OSTOFF + c.wid * 4096);
    LAS bf16* sb = (LAS bf16*)stg;
#pragma unroll
    for (int r = 0; r < 16; ++r) { const int orow = crow(r, c.hi);
#pragma unroll
        for (int d0 = 0; d0 < 2; ++d0) sb[orow * 64 + d0 * 32 + c.r32] = (bf16)f2bf(val[d0][r] * OS); }
    const int row = c.lane >> 1, hf = c.lane & 1;
    const u32x4 a = *(const LAS u32x4*)(sb + row * 64 + hf * 32), b = *(const LAS u32x4*)(sb + row * 64 + hf * 32 + 8), cq = *(const LAS u32x4*)(sb + row * 64 + hf * 32 + 16), dq = *(const LAS u32x4*)(sb + row * 64 + hf * 32 + 24);
    u32x4 o0, o1;
    o0.x = pk4_fp8(bflo(a.x), bfhi(a.x), bflo(a.y), bfhi(a.y)); o0.y = pk4_fp8(bflo(a.z), bfhi(a.z), bflo(a.w), bfhi(a.w)); o0.z = pk4_fp8(bflo(b.x), bfhi(b.x), bflo(b.y), bfhi(b.y)); o0.w = pk4_fp8(bflo(b.z), bfhi(b.z), bflo(b.w), bfhi(b.w));
    o1.x = pk4_fp8(bflo(cq.x), bfhi(cq.x), bflo(cq.y), bfhi(cq.y)); o1.y = pk4_fp8(bflo(cq.z), bfhi(cq.z), bflo(cq.w), bfhi(cq.w)); o1.z = pk4_fp8(bflo(dq.x), bfhi(dq.x), bflo(dq.y), bfhi(dq.y)); o1.w = pk4_fp8(bflo(dq.z), bfhi(dq.z), bflo(dq.w), bfhi(dq.w));
    *(u32x4*)(Ow + (size_t)row * 1024 + hf * 32) = o0; *(u32x4*)(Ow + (size_t)row * 1024 + hf * 32 + 16) = o1;
}
__device__ __forceinline__ void store_o_bf16(const Ctx& c, const f32x16 (&val)[2], bf16* Ow) {
    LAS bf16* stg = (LAS bf16*)(c.lds + OSTOFF) + c.wid * 2048;
#pragma unroll
    for (int r = 0; r < 16; ++r) { const int orow = crow(r, c.hi);
#pragma unroll
        for (int d0 = 0; d0 < 2; ++d0) stg[orow * 64 + d0 * 32 + c.r32] = (bf16)f2bf(val[d0][r]); }
#pragma unroll
    for (int i = 0; i < 4; ++i) { const int row = i * 8 + (c.lane >> 3), ch = c.lane & 7; const u32x4 v = *(const LAS u32x4*)(stg + row * 64 + ch * 8); *(u32x4*)(Ow + (size_t)row * 1024 + ch * 8) = v; }
}

__device__ __forceinline__ void dsa_unit(Frame& F, int b, int g, int qt) {
    Ctx c; c.lds = F.lds; c.lane = F.lane; c.wid = F.wave; c.r32 = F.lane & 31; c.hi = F.lane >> 5;
    const int h = 4 * g + (c.wid >> 1), qw = 64 * qt + 32 * (c.wid & 1);
    const size_t mrow = (size_t)b * SEQ + qw;
    const bf16* Q = LWSP(bf16, WS_Q0) + (mrow + c.r32) * 1024 + h * 64;
    park_q(c, Q);
    const bf16* Kg = LWSP(bf16, WS_K0) + (size_t)b * SEQ * 256 + g * 64; const bf16* Vg = LWSP(bf16, WS_V0) + (size_t)b * SEQ * 256 + g * 64;
    typedef __attribute__((address_space(1))) const u32x2* gmask_t;
    const gmask_t MK = (gmask_t)(const u32x2*)(LWSP(unsigned long long, WS_MASK) + (size_t)b * 64 * SEQ + qw + c.r32);
    State s; reset(s);
    const int NT = qt + 1;
    dma_tile(c, Kg, Vg, 256, 0, 0);
    u32x2 mk_next = MK[0];
    __syncthreads();
    for (int t = 0; t < NT; ++t) {
        const u32x2 mk = mk_next;
        if (t + 1 < NT) { dma_tile(c, Kg, Vg, 256, t + 1, (t + 1) & 1); mk_next = MK[(size_t)(t + 1) * SEQ]; }
        tile_step<true>(c, t & 1, s, s.negm, t == 0, mk.x, mk.y);
        __syncthreads();
    }
    normalise(c, s, nullptr);
    store_o(c, s.o, LWSP(unsigned char, WS_O0) + mrow * 1024 + h * 64);
}

__device__ __forceinline__ void nsa_unit(Frame& F, int b, int g, int qt) {
    Ctx c; c.lds = F.lds; c.lane = F.lane; c.wid = F.wave; c.r32 = F.lane & 31; c.hi = F.lane >> 5;
    const int h = 4 * g + (c.wid >> 1), qw = 64 * qt + 32 * (c.wid & 1), qi = 32 * (c.wid & 1) + c.r32;
    const size_t mrow = (size_t)b * SEQ + qw;
    park_q(c, LWSP(bf16, WS_Q1) + (mrow + c.r32) * 1024 + h * 64);
    const unsigned long long sel = LWSP(unsigned long long, WS_SEL)[((size_t)b * 4 + g) * SEQ + qw + c.r32];
    LAS float* gx = (LAS float*)(c.lds + XOFF + 2048) + c.wid * 64;
    gx[c.lane] = LWSP(float, SM_GATES)[(mrow + c.r32) * 48 + h * 3 + 1 + c.hi];
    LAS float* totw = (LAS float*)(c.lds + TOTOFF) + c.wid * 2048;
    LAS float* totl = totw + c.r32;
    State s;
    {
        const bf16* Kg = LWSP(bf16, WS_KSLC) + (size_t)b * SEQ * 256 + g * 64; const bf16* Vg = LWSP(bf16, WS_VSLC) + (size_t)b * SEQ * 256 + g * 64;
        reset(s);
        dma_tile(c, Kg, Vg, 256, 0, 0);
        __syncthreads();
        for (int t = 0; t <= qt; ++t) {
            if (t < qt) dma_tile(c, Kg, Vg, 256, t + 1, (t + 1) & 1);
            const bool on = (sel >> t) & 1ull;
            if (!on) {
#pragma unroll
                for (int r = 0; r < 16; ++r) s.negm[r] = -INFINITY; }
            if (t == qt) { unsigned w0, w1; causal_words(qi, w0, w1); tile_step<true>(c, t & 1, s, s.negm, t == 0, w0, w1); }
            else tile_step<false>(c, t & 1, s, s.negm, t == 0, 0u, 0u);
#pragma unroll
            for (int r = 0; r < 16; ++r) s.negm[r] = -s.m;
            __syncthreads();
        }
        normalise(c, s, gx);
#pragma unroll
        for (int r = 0; r < 16; ++r) { totl[crow(r, c.hi) * 64] = s.o[0][r]; totl[crow(r, c.hi) * 64 + 32] = s.o[1][r]; }
    }
    {
        const bf16* Kg = LWSP(bf16, WS_KWIN) + (size_t)b * SEQ * 256 + g * 64; const bf16* Vg = LWSP(bf16, WS_VWIN) + (size_t)b * SEQ * 256 + g * 64;
        reset(s);
        const int tlo = qt >= 8 ? qt - 8 : 0;
        dma_tile(c, Kg, Vg, 256, tlo, tlo & 1);
        __syncthreads();
        for (int t = tlo; t <= qt; ++t) {
            if (t < qt) dma_tile(c, Kg, Vg, 256, t + 1, (t + 1) & 1);
            if (t == qt) { unsigned w0, w1; causal_words(qi, w0, w1); tile_step<true>(c, t & 1, s, s.negm, t == tlo, w0, w1); }
            else if (t == qt - 8) { unsigned w0, w1; causal_words(qi, w0, w1); tile_step<true>(c, t & 1, s, s.negm, t == tlo, ~w0, ~w1); }
            else tile_step<false>(c, t & 1, s, s.negm, t == tlo, 0u, 0u);
            __syncthreads();
        }
        normalise(c, s, gx + 32);
#pragma unroll
        for (int r = 0; r < 16; ++r) { totl[crow(r, c.hi) * 64] += s.o[0][r]; totl[crow(r, c.hi) * 64 + 32] += s.o[1][r]; }
    }
    const bf16* OCG = LWSP(bf16, WS_OCG) + mrow * 1024 + h * 64; unsigned char* O = LWSP(unsigned char, WS_O1) + mrow * 1024 + h * 64;
#pragma unroll
    for (int i = 0; i < 8; ++i) { const int row = i * 4 + (c.lane >> 4), ch = c.lane & 15;
        const u32x2 oc = *(const u32x2*)(OCG + (size_t)row * 1024 + 4 * ch);
        const f32x4 v = (*(const LAS f32x4*)(totw + row * 64 + 4 * ch) + (f32x4){bflo(oc.x), bfhi(oc.x), bflo(oc.y), bfhi(oc.y)}) * OS;
        *(unsigned*)(O + (size_t)row * 1024 + 4 * ch) = pk4_fp8(v.x, v.y, v.z, v.w); }
}
__device__ __forceinline__ void unit_of(int v, int i, int& b, int& g, int& qt) { const int bg = v >> 4, p = v & 15; b = bg >> 2; g = bg & 3; qt = (i == 0) ? p : (i == 1) ? 63 - p : (i == 2) ? 31 - p : 32 + p; }
}

namespace fp {
using fa::Ctx; using fa::crow; using fa::cvtpk; using fa::vtr; using fa::s16x4; using fa::causal_words;
constexpr int SLOTB = 8192, LK = 0, LV = 3 * SLOTB, LX = 6 * SLOTB, LOST = LX + 4096, LQ = LOST + 8 * 4096;
constexpr float THR = 8.0f;
enum { SW_DSA = 0, SW_SLC = 1, SW_WIN = 2 };
#define FP_SBAR() __builtin_amdgcn_sched_barrier(0)
#define FP_PIN(x) asm volatile("" : "+v"(x))
#define FP_MFMA(a, b, c) __builtin_amdgcn_mfma_f32_32x32x16_bf16(a, b, c, 0, 0, 0)
#define FP_WAIT_BAR(N) asm volatile("s_waitcnt vmcnt(" #N ") lgkmcnt(0)\n\ts_barrier" ::: "memory")
#define FP_MX3(a, b, c) __builtin_fmaxf(__builtin_fmaxf((a), (b)), (c))
typedef const LAS char* lds_cptr;
__device__ __forceinline__ void glds16s(const char* base  , unsigned off, LAS unsigned char* l  ) {
    const unsigned a = __builtin_amdgcn_readfirstlane((unsigned)(unsigned long)l);
    asm volatile("s_nop 4\n\ts_mov_b32 m0, %2\n\ts_nop 0\n\tglobal_load_lds_dwordx4 %0, %1" :: "v"(off), "s"(base), "s"(a) : "memory", "m0");
}
__device__ __forceinline__ float rowmax(const f32x16& p0, const f32x16& p1) {
    float a = FP_MX3(p0[0], p0[1], p1[0]), b = FP_MX3(p0[2], p0[3], p1[1]); a = FP_MX3(a, p1[2], p1[3]);
#pragma unroll
    for (int r = 4; r < 16; r += 4) { a = FP_MX3(a, p0[r], p0[r + 1]); b = FP_MX3(b, p0[r + 2], p0[r + 3]); a = FP_MX3(a, p1[r], p1[r + 1]); b = FP_MX3(b, p1[r + 2], p1[r + 3]); }
    const float m = __builtin_fmaxf(a, b); auto rr = __builtin_amdgcn_permlane32_swap(__builtin_bit_cast(unsigned, m), __builtin_bit_cast(unsigned, m), false, false);
    return __builtin_bit_cast(float, rr[0]); }
__device__ __forceinline__ float pair_sum(float v) { return v + __shfl_xor(v, 32); }
__device__ __forceinline__ void kload2(bf16x8* kf, lds_cptr kp, int d0) { kf[2 * d0] = *(const LAS bf16x8*)(kp + d0 * 2048); kf[2 * d0 + 1] = *(const LAS bf16x8*)(kp + d0 * 2048 + 512); }
#define FP_MBIT(e, w, SH) ({ int m_; asm("v_bfe_i32 %0, %1, %2, 1" : "=v"(m_) : "v"(w), "n"(SH)); __builtin_bit_cast(float, __builtin_bit_cast(unsigned, (e)) & (unsigned)m_); })
template <int SW>
__device__ __forceinline__ void sweep(const Ctx& c, const bf16* Kg, const bf16* Vg, const int NT, const u32x2* MK, const unsigned long long sel, const int qi, f32x16 (&o)[2], float& l_out) {
    const int lane = c.lane, r32 = c.r32, hi = c.hi, wid = c.wid;
    LAS float* wsf = (LAS float*)(c.lds + LX) + wid * 64;
    const unsigned koff = (unsigned)(lane * 256 + wid * 8) * 2u;
    const unsigned voff = (unsigned)((16 * (wid & 3) + (lane >> 2)) * 256 + (wid >> 2) * 32 + (lane & 3) * 8) * 2u;
    LAS unsigned char* kdst = c.lds + LK + wid * 1024; LAS unsigned char* vdst = c.lds + LV + wid * 1024;
#define FP_DMA_K(t, slot) glds16s((const char*)Kg + (size_t)(t) * (64 * 256 * 2), koff, kdst + (slot))
#define FP_DMA_V(t, slot) glds16s((const char*)Vg + (size_t)(t) * (64 * 256 * 2), voff, vdst + (slot))
    const lds_cptr vp0 = (lds_cptr)c.lds + LV + ((lane >> 4) & 1) * 32 + (lane & 3) * 8 + (4 * hi + ((lane & 15) >> 2)) * 64;
    const lds_cptr kp0 = (lds_cptr)c.lds + LK + hi * 1024 + r32 * 16;
    const LAS bf16x8* qs = (const LAS bf16x8*)(c.lds + LQ + wid * 4096) + lane;
#define FP_Q(d0) qs[(d0) * 64]
    bf16x8 qa, qb;
    constexpr int KS = (SW == SW_DSA) ? 1 : (SW == SW_SLC) ? 2 : 0;
    u32x2 mkN = {0u, 0u}; unsigned w0s = 0u, w1s = 0u; bool onv = true; (void)onv; (void)mkN;
    auto words = [&](int j, unsigned& a0, unsigned& a1) {
        unsigned x0 = ~0u, x1 = ~0u;
        if (SW == SW_DSA) { u32x2 m_ = mkN; asm volatile("" : "+v"(m_.x), "+v"(m_.y)); x0 = m_.x; x1 = m_.y; }
        else { if (j == NT - 1) causal_words(qi, x0, x1); else if (SW == SW_WIN && j == 0 && NT == 9) { causal_words(qi, x0, x1); x0 = ~x0; x1 = ~x1; }
               if (SW == SW_SLC && !((sel >> j) & 1ull)) { x0 = 0u; x1 = 0u; } }
        a0 = x0 >> (4 * hi); a1 = x1 >> (4 * hi); };
    typedef __attribute__((address_space(1))) const u32x2* gmask_t; const gmask_t MKG = (gmask_t)MK;
    if (SW == SW_DSA) mkN = MKG[0];
    FP_DMA_K(0, 0); FP_DMA_V(0, 0); if (NT > 1) FP_DMA_K(1, SLOTB); if (NT > 2) FP_DMA_K(2, 2 * SLOTB);
    float mhat = 0.f, l_reg = 0.f; o[0] = f32x16{}; o[1] = f32x16{};
    f32x16 negm;
    { float z_ = 0.f; asm volatile("" : "+v"(z_));
#pragma unroll
      for (int r = 0; r < 16; ++r) negm[r] = z_; }
    bool resc = false;
    f32x16 pA0, pA1, pB0, pB1; bf16x8 kf[8]; s16x4 vlo[8], vhi[8]; u32x4 pw0, pw1, pw2, pw3;
    int sl_prev = 0, sl_cur = 0, sl_next = SLOTB;
#define FP_ROT() do { sl_prev = sl_cur; sl_cur = sl_next; sl_next = (sl_next == 2 * SLOTB) ? 0 : sl_next + SLOTB; } while (0)
#define FP_RESC() do { if (resc) { _Pragma("unroll") for (int d_ = 0; d_ < 2; ++d_) _Pragma("unroll") for (int r = 0; r < 16; ++r) o[d_][r] *= wsf[crow(r, hi)]; } } while (0)
    if (NT > 2) FP_WAIT_BAR(3); else if (NT > 1) FP_WAIT_BAR(2); else FP_WAIT_BAR(1);
    _Pragma("unroll") for (int d0 = 0; d0 < 4; ++d0) kload2(kf, kp0, d0);
    qa = FP_Q(0); qb = FP_Q(1);
    pA0 = FP_MFMA(kf[0], qa, negm); pA1 = FP_MFMA(kf[1], qa, negm); pA0 = FP_MFMA(kf[2], qb, pA0); pA1 = FP_MFMA(kf[3], qb, pA1);
    qa = FP_Q(2); qb = FP_Q(3);
    pA0 = FP_MFMA(kf[4], qa, pA0); pA1 = FP_MFMA(kf[5], qa, pA1); pA0 = FP_MFMA(kf[6], qb, pA0); pA1 = FP_MFMA(kf[7], qb, pA1);
    qa = FP_Q(0);
    { words(0, w0s, w1s);
      const float rm = rowmax(pA0, pA1); mhat = rm;
#pragma unroll
      for (int r = 0; r < 16; ++r) { const int sh = (r & 3) + 8 * (r >> 2);
          const float e0 = __builtin_amdgcn_exp2f(pA0[r] - rm), e1 = __builtin_amdgcn_exp2f(pA1[r] - rm);
          pA0[r] = ((w0s >> sh) & 1u) ? e0 : 0.f; pA1[r] = ((w1s >> sh) & 1u) ? e1 : 0.f; negm[r] = -rm; } }
    FP_WAIT_BAR(0);
    if (SW == SW_DSA && NT > 1) mkN = MKG[SEQ];
    if (NT > 3) FP_DMA_K(3, 0); if (NT > 1) { FP_DMA_V(1, SLOTB); FP_ROT(); }
    if (NT > 1) { _Pragma("unroll") for (int d0 = 0; d0 < 4; ++d0) kload2(kf, kp0 + sl_cur, d0); }
    if (NT > 3) FP_WAIT_BAR(2); else if (NT == 3) FP_WAIT_BAR(1); else FP_WAIT_BAR(0);
#define FP_PKW(P, i) cvtpk(P[i], P[i + 1])
#define FP_PAF(k) __builtin_bit_cast(bf16x8, pw##k)
#define FP_VFR(i) (bf16x8){vlo[i][0], vlo[i][1], vlo[i][2], vlo[i][3], vhi[i][0], vhi[i][1], vhi[i][2], vhi[i][3]}
#define FP_VRD(i) do { vlo[i] = vtr((const LAS unsigned char*)(vp_ + (((i) >> 2) * 4096 + ((i) & 3) * 1024))); vhi[i] = vtr((const LAS unsigned char*)(vp_ + (((i) >> 2) * 4096 + ((i) & 3) * 1024 + 512))); } while (0)
#define FP_KRD(G, d0) do { if (G) { kload2(kf, kp0 + sl_next, d0); FP_SBAR(); } } while (0)
#define FP_GAPA(MF, a0, a1, a2, a3, W0, W1, PW) do { MF; sacc += a0; sacc += a1; sacc += a2; sacc += a3; W0; W1; FP_PIN(PW); FP_PIN(sacc); FP_SBAR(); } while (0)
#define FP_EXM(KIND, X, W, k, SHB) X[k] = ((KIND) == 1) ? FP_MBIT(__builtin_amdgcn_exp2f(X[k]), W, (SHB)) : ((KIND) == 2) ? (onv ? __builtin_amdgcn_exp2f(X[k]) : 0.f) : __builtin_amdgcn_exp2f(X[k])
#define FP_GAPB(MF, KIND, X, W, i) do { MF; FP_EXM(KIND, X, W, i, 2 * (i)); FP_EXM(KIND, X, W, (i) + 1, 2 * (i) + 1); FP_EXM(KIND, X, W, (i) + 2, 2 * (i) + 2); FP_EXM(KIND, X, W, (i) + 3, 2 * (i) + 3); FP_PIN(X); FP_SBAR(); } while (0)
#define FP_STEP(C0, C1, P0, P1, t, KIND, MSET, GK, GVL) do { FP_SBAR(); \
    const lds_cptr vp_ = vp0 + sl_prev; \
    FP_VRD(0); qb = FP_Q(1); FP_SBAR(); float sacc = P0[0] + P0[1]; \
                       FP_GAPA(C0 = FP_MFMA(kf[0], qa, negm), P0[2], P0[3], P0[4], P0[5],     pw0[0] = FP_PKW(P0, 0),  pw0[1] = FP_PKW(P0, 2),  pw0); \
    FP_VRD(4); FP_SBAR(); FP_GAPA(C1 = FP_MFMA(kf[1], qa, negm), P0[6], P0[7], P0[8], P0[9],     pw0[2] = FP_PKW(P0, 4),  pw0[3] = FP_PKW(P0, 6),  pw0); \
    FP_VRD(1); qa = FP_Q(2); FP_SBAR(); FP_GAPA(C0 = FP_MFMA(kf[2], qb, C0),   P0[10], P0[11], P0[12], P0[13], pw1[0] = FP_PKW(P0, 8),  pw1[1] = FP_PKW(P0, 10), pw1); \
    FP_VRD(5); FP_SBAR(); FP_GAPA(C1 = FP_MFMA(kf[3], qb, C1),   P0[14], P0[15], P1[0], P1[1],   pw1[2] = FP_PKW(P0, 12), pw1[3] = FP_PKW(P0, 14), pw1); \
    FP_VRD(2); qb = FP_Q(3); FP_SBAR(); FP_GAPA(C0 = FP_MFMA(kf[4], qa, C0),   P1[2], P1[3], P1[4], P1[5],     pw2[0] = FP_PKW(P1, 0),  pw2[1] = FP_PKW(P1, 2),  pw2); \
    FP_VRD(6); FP_SBAR(); FP_GAPA(C1 = FP_MFMA(kf[5], qa, C1),   P1[6], P1[7], P1[8], P1[9],     pw2[2] = FP_PKW(P1, 4),  pw2[3] = FP_PKW(P1, 6),  pw2); \
    FP_VRD(3); FP_SBAR(); FP_GAPA(C0 = FP_MFMA(kf[6], qb, C0),   P1[10], P1[11], P1[12], P1[13], pw3[0] = FP_PKW(P1, 8),  pw3[1] = FP_PKW(P1, 10), pw3); \
    FP_VRD(7); FP_SBAR(); FP_GAPA(C1 = FP_MFMA(kf[7], qb, C1),   P1[14], P1[15], 0.f, 0.f,       pw3[2] = FP_PKW(P1, 12), pw3[3] = FP_PKW(P1, 14), pw3); \
    l_reg += sacc; \
    MSET; \
    if (SW == SW_DSA && (GVL)) mkN = MKG[(size_t)((t) + 1) * SEQ];                                                          \
    if (GK) FP_DMA_K((t) + 3, sl_cur); if (GVL) FP_DMA_V((t) + 1, sl_next); \
    { const float rm = rowmax(C0, C1); resc = false;                                                                         \
      if (__builtin_expect(__any(rm > THR), 0)) { const float dl = __builtin_fmaxf(rm, 0.f); mhat += dl; \
          const float f = __builtin_amdgcn_exp2f(-dl); l_reg *= f; if (hi == 0) wsf[r32] = f; resc = true; \
          _Pragma("unroll") for (int r = 0; r < 16; ++r) { C0[r] -= dl; C1[r] -= dl; negm[r] = -mhat; } } } \
    FP_SBAR(); \
    FP_GAPB(o[0] = FP_MFMA(FP_PAF(0), FP_VFR(0), o[0]), KIND, C0, w0s, 0);  FP_GAPB(o[1] = FP_MFMA(FP_PAF(0), FP_VFR(4), o[1]), KIND, C0, w0s, 4);     \
    FP_GAPB(o[0] = FP_MFMA(FP_PAF(1), FP_VFR(1), o[0]), KIND, C0, w0s, 8);  FP_GAPB(o[1] = FP_MFMA(FP_PAF(1), FP_VFR(5), o[1]), KIND, C0, w0s, 12); \
    FP_KRD(GVL, 0); FP_GAPB(o[0] = FP_MFMA(FP_PAF(2), FP_VFR(2), o[0]), KIND, C1, w1s, 0);  FP_KRD(GVL, 1); FP_GAPB(o[1] = FP_MFMA(FP_PAF(2), FP_VFR(6), o[1]), KIND, C1, w1s, 4);           \
    FP_KRD(GVL, 2); FP_GAPB(o[0] = FP_MFMA(FP_PAF(3), FP_VFR(3), o[0]), KIND, C1, w1s, 8);  if (GVL) { kload2(kf, kp0 + sl_next, 3); qa = FP_Q(0); FP_SBAR(); }  FP_GAPB(o[1] = FP_MFMA(FP_PAF(3), FP_VFR(7), o[1]), KIND, C1, w1s, 12); \
    } while (0)
#define FP_ENDW(tt) do { if ((tt) + 3 < NT) { FP_WAIT_BAR(2); } else if ((tt) + 2 < NT) { FP_WAIT_BAR(1); } else { FP_WAIT_BAR(0); } } while (0)
#define FP_MSET_S(t) do { if (KS == 1) words((t), w0s, w1s); else if (KS == 2) onv = (sel >> (t)) & 1ull; } while (0)
#define FP_MSET_L(t) words((t), w0s, w1s)
#define FP_DRAIN(P0, P1) do { float sacc = P0[0] + P0[1]; \
      _Pragma("unroll") for (int r = 2; r < 16; ++r) sacc += P0[r]; \
      _Pragma("unroll") for (int r = 0; r < 16; ++r) sacc += P1[r]; \
      l_reg += sacc; \
      pw0 = (u32x4){FP_PKW(P0, 0), FP_PKW(P0, 2), FP_PKW(P0, 4), FP_PKW(P0, 6)}; pw1 = (u32x4){FP_PKW(P0, 8), FP_PKW(P0, 10), FP_PKW(P0, 12), FP_PKW(P0, 14)}; \
      pw2 = (u32x4){FP_PKW(P1, 0), FP_PKW(P1, 2), FP_PKW(P1, 4), FP_PKW(P1, 6)}; pw3 = (u32x4){FP_PKW(P1, 8), FP_PKW(P1, 10), FP_PKW(P1, 12), FP_PKW(P1, 14)}; \
      const lds_cptr vp_ = vp0 + sl_cur; _Pragma("unroll") for (int i = 0; i < 8; ++i) FP_VRD(i); \
      o[0] = FP_MFMA(FP_PAF(0), FP_VFR(0), o[0]); o[1] = FP_MFMA(FP_PAF(0), FP_VFR(4), o[1]); o[0] = FP_MFMA(FP_PAF(1), FP_VFR(1), o[0]); o[1] = FP_MFMA(FP_PAF(1), FP_VFR(5), o[1]); \
      o[0] = FP_MFMA(FP_PAF(2), FP_VFR(2), o[0]); o[1] = FP_MFMA(FP_PAF(2), FP_VFR(6), o[1]); o[0] = FP_MFMA(FP_PAF(3), FP_VFR(3), o[0]); o[1] = FP_MFMA(FP_PAF(3), FP_VFR(7), o[1]); } while (0)
    const int S = NT - 1; int t = 1;
    if (S >= 1) {
        if (!(S & 1)) {
            FP_STEP(pB0, pB1, pA0, pA1, 1, KS, FP_MSET_S(1), (4 < NT), true); FP_ENDW(1); FP_RESC(); FP_ROT();
            pA0 = pB0; pA1 = pB1; t = 2;
        }
        for (; t < S; t += 2) {
            FP_STEP(pB0, pB1, pA0, pA1, t, KS, FP_MSET_S(t), (t + 3 < NT), true);         FP_ENDW(t);     FP_RESC(); FP_ROT();
            FP_STEP(pA0, pA1, pB0, pB1, t + 1, KS, FP_MSET_S(t + 1), (t + 4 < NT), true); FP_ENDW(t + 1); FP_RESC(); FP_ROT();
        }
        FP_STEP(pB0, pB1, pA0, pA1, S, 1, FP_MSET_L(S), false, false); FP_RESC();
    } else { pB0 = pA0; pB1 = pA1; }
    FP_DRAIN(pB0, pB1);
    l_out = l_reg;
    asm volatile("s_waitcnt lgkmcnt(0)\n\ts_barrier" ::: "memory");
#undef FP_Q
#undef FP_DMA_K
#undef FP_DMA_V
#undef FP_ROT
#undef FP_RESC
#undef FP_PKW
#undef FP_PAF
#undef FP_VFR
#undef FP_VRD
#undef FP_KRD
#undef FP_GAPA
#undef FP_EXM
#undef FP_GAPB
#undef FP_STEP
#undef FP_ENDW
#undef FP_MSET_S
#undef FP_MSET_L
#undef FP_DRAIN
}
__device__ __forceinline__ void park_qf(const Ctx& c, const bf16* Qrow) {
    LAS bf16x8* qs = (LAS bf16x8*)(c.lds + LQ + c.wid * 4096) + c.lane;
#pragma unroll
    for (int d0 = 0; d0 < 4; ++d0) qs[d0 * 64] = *(const bf16x8*)(Qrow + d0 * 16 + c.hi * 8);
}
__device__ __forceinline__ void scale_rows(const Ctx& c, f32x16 (&o)[2], float fac) {
    LAS float* wsf = (LAS float*)(c.lds + LX) + c.wid * 64;
    if (c.hi == 0) wsf[32 + c.r32] = fac;
#pragma unroll
    for (int r = 0; r < 16; ++r) { const float f = wsf[32 + crow(r, c.hi)]; o[0][r] *= f; o[1][r] *= f; }
}
__device__ __forceinline__ void dsa_unit(Frame& F, int b, int g, int qt) {
    int ln_ = F.lane; asm volatile("" : "+v"(ln_));
    Ctx c; c.lds = F.lds; c.lane = ln_; c.wid = F.wave; c.r32 = ln_ & 31; c.hi = ln_ >> 5;
    const int h = 4 * g + (c.wid >> 1), qw = 64 * qt + 32 * (c.wid & 1);
    const size_t mrow = (size_t)b * SEQ + qw;
    park_qf(c, LWSP(bf16, WS_Q0) + (mrow + c.r32) * 1024 + h * 64);
    const bf16* Kg = LWSP(bf16, WS_K0) + (size_t)b * SEQ * 256 + g * 64; const bf16* Vg = LWSP(bf16, WS_V0) + (size_t)b * SEQ * 256 + g * 64;
    const u32x2* MK = (const u32x2*)(LWSP(unsigned long long, WS_MASK) + (size_t)b * 64 * SEQ + qw + c.r32);
    f32x16 o[2]; float l;
    sweep<SW_DSA>(c, Kg, Vg, qt + 1, MK, 0ull, 0, o, l);
    l = pair_sum(l);
    scale_rows(c, o, l > 0.f ? 1.0f / l : 0.f);
    LAS bf16* sb = (LAS bf16*)(c.lds + LOST + c.wid * 4096);
#pragma unroll
    for (int r = 0; r < 16; ++r) { const int orow = crow(r, c.hi);
#pragma unroll
        for (int d0 = 0; d0 < 2; ++d0) sb[orow * 64 + d0 * 32 + c.r32] = (bf16)f2bf(o[d0][r] * OS); }
    unsigned char* Ow = LWSP(unsigned char, WS_O0) + mrow * 1024 + h * 64;
    const int row = c.lane >> 1, hf = c.lane & 1;
    const u32x4 a = *(const LAS u32x4*)(sb + row * 64 + hf * 32), bq = *(const LAS u32x4*)(sb + row * 64 + hf * 32 + 8), cq = *(const LAS u32x4*)(sb + row * 64 + hf * 32 + 16), dq = *(const LAS u32x4*)(sb + row * 64 + hf * 32 + 24);
    u32x4 o0, o1;
    o0.x = pk4_fp8(bflo(a.x), bfhi(a.x), bflo(a.y), bfhi(a.y)); o0.y = pk4_fp8(bflo(a.z), bfhi(a.z), bflo(a.w), bfhi(a.w)); o0.z = pk4_fp8(bflo(bq.x), bfhi(bq.x), bflo(bq.y), bfhi(bq.y)); o0.w = pk4_fp8(bflo(bq.z), bfhi(bq.z), bflo(bq.w), bfhi(bq.w));
    o1.x = pk4_fp8(bflo(cq.x), bfhi(cq.x), bflo(cq.y), bfhi(cq.y)); o1.y = pk4_fp8(bflo(cq.z), bfhi(cq.z), bflo(cq.w), bfhi(cq.w)); o1.z = pk4_fp8(bflo(dq.x), bfhi(dq.x), bflo(dq.y), bfhi(dq.y)); o1.w = pk4_fp8(bflo(dq.z), bfhi(dq.z), bflo(dq.w), bfhi(dq.w));
    *(u32x4*)(Ow + (size_t)row * 1024 + hf * 32) = o0; *(u32x4*)(Ow + (size_t)row * 1024 + hf * 32 + 16) = o1;
}
__device__ __forceinline__ void nsa_unit(Frame& F, int b, int g, int qt) {
    int ln_ = F.lane; asm volatile("" : "+v"(ln_));
    Ctx c; c.lds = F.lds; c.lane = ln_; c.wid = F.wave; c.r32 = ln_ & 31; c.hi = ln_ >> 5;
    const int h = 4 * g + (c.wid >> 1), qw = 64 * qt + 32 * (c.wid & 1), qi = 32 * (c.wid & 1) + c.r32;
    const size_t mrow = (size_t)b * SEQ + qw;
    park_qf(c, LWSP(bf16, WS_Q1) + (mrow + c.r32) * 1024 + h * 64);
    const unsigned long long sel = LWSP(unsigned long long, WS_SEL)[((size_t)b * 4 + g) * SEQ + qw + c.r32];
    LAS float* gx = (LAS float*)(c.lds + LX + 2048) + c.wid * 64;
    gx[c.lane] = LWSP(float, SM_GATES)[(mrow + c.r32) * 48 + h * 3 + 1 + c.hi];
    LAS bf16* stg = (LAS bf16*)(c.lds + LOST + c.wid * 4096);
    f32x16 o[2]; float l;
    {
        const bf16* Kg = LWSP(bf16, WS_KSLC) + (size_t)b * SEQ * 256 + g * 64; const bf16* Vg = LWSP(bf16, WS_VSLC) + (size_t)b * SEQ * 256 + g * 64;
        sweep<SW_SLC>(c, Kg, Vg, qt + 1, nullptr, sel, qi, o, l);
        l = pair_sum(l);
        scale_rows(c, o, l > 0.f ? gx[c.r32] / l : 0.f);
#pragma unroll
        for (int r = 0; r < 16; ++r) { const int orow = crow(r, c.hi);
#pragma unroll
            for (int d0 = 0; d0 < 2; ++d0) stg[orow * 64 + d0 * 32 + c.r32] = (bf16)f2bf(o[d0][r]); }
    }
    {
        const int tlo = qt >= 8 ? qt - 8 : 0;
        const bf16* Kg = LWSP(bf16, WS_KWIN) + ((size_t)b * SEQ + 64 * tlo) * 256 + g * 64; const bf16* Vg = LWSP(bf16, WS_VWIN) + ((size_t)b * SEQ + 64 * tlo) * 256 + g * 64;
        sweep<SW_WIN>(c, Kg, Vg, qt - tlo + 1, nullptr, 0ull, qi, o, l);
        l = pair_sum(l);
        scale_rows(c, o, l > 0.f ? gx[32 + c.r32] / l : 0.f);
#pragma unroll
        for (int r = 0; r < 16; ++r) { const int orow = crow(r, c.hi);
#pragma unroll
            for (int d0 = 0; d0 < 2; ++d0) { LAS bf16* p = stg + orow * 64 + d0 * 32 + c.r32; *p = (bf16)f2bf(o[d0][r] + bf2f((unsigned)*p)); } }
    }
    const bf16* OCG = LWSP(bf16, WS_OCG) + mrow * 1024 + h * 64; unsigned char* O = LWSP(unsigned char, WS_O1) + mrow * 1024 + h * 64;
#pragma unroll
    for (int i = 0; i < 4; ++i) { const int row = i * 8 + (c.lane >> 3), ch = c.lane & 7;
        const u32x4 oc = *(const u32x4*)(OCG + (size_t)row * 1024 + 8 * ch), sv = *(const LAS u32x4*)(stg + row * 64 + 8 * ch);
        u32x2 w; w.x = pk4_fp8((bflo(oc.x) + bflo(sv.x)) * OS, (bfhi(oc.x) + bfhi(sv.x)) * OS, (bflo(oc.y) + bflo(sv.y)) * OS, (bfhi(oc.y) + bfhi(sv.y)) * OS);
        w.y = pk4_fp8((bflo(oc.z) + bflo(sv.z)) * OS, (bfhi(oc.z) + bfhi(sv.z)) * OS, (bflo(oc.w) + bflo(sv.w)) * OS, (bfhi(oc.w) + bfhi(sv.w)) * OS);
        *(u32x2*)(O + (size_t)row * 1024 + 8 * ch) = w; }
}
#undef FP_SBAR
#undef FP_PIN
#undef FP_MFMA
#undef FP_WAIT_BAR
#undef FP_MX3
#undef FP_MBIT
}

namespace cm {
using namespace fa;
constexpr int IMPOFF = 69632;
__device__ __forceinline__ void unit(Frame& F, int b, int g, int qt) {
    Ctx c; c.lds = F.lds; c.lane = F.lane; c.wid = F.wave; c.r32 = F.lane & 31; c.hi = F.lane >> 5;
    const int hr = c.wid >> 1, h = 4 * g + hr, qw = 64 * qt + 32 * (c.wid & 1), qi = 32 * (c.wid & 1) + c.r32;
    const size_t mrow = (size_t)b * SEQ + qw;
    park_q(c, LWSP(bf16, WS_Q1) + (mrow + c.r32) * 1024 + h * 64);
    LAS float* gx = (LAS float*)(c.lds + XOFF + 2048) + c.wid * 64;
    if (c.hi == 0) gx[c.r32] = LWSP(float, SM_GATES)[(mrow + c.r32) * 48 + h * 3];
    const int t = qw + c.r32, nv = t >= 31 ? min(255, (t - 31) / 16 + 1) : 0;
    const bf16* Kg = LWSP(bf16, SM_KC) + (size_t)(b * 4 + g) * 256 * 64; const bf16* Vg = LWSP(bf16, SM_VC) + (size_t)(b * 4 + g) * 256 * 64;
    const int NTc = (qt >> 4) + 1;
    f32x16 o[2]; o[0] = f32x16{}; o[1] = f32x16{};
    f32x16 zero = {};
    float m = 0.f, l = 0.f, carry = 0.f;
    float bsum[4][8];
#pragma unroll
    for (int T_ = 0; T_ < 4; ++T_)
#pragma unroll
        for (int i = 0; i < 8; ++i) bsum[T_][i] = 0.f;
    dma_tile(c, Kg, Vg, 64, 0, 0);
    __syncthreads();
#pragma unroll
    for (int T_ = 0; T_ < 4; ++T_) {
        if (T_ < NTc) {
            if (T_ + 1 < NTc) dma_tile(c, Kg, Vg, 64, T_ + 1, (T_ + 1) & 1);
            f32x16 p0, p1;
            qk(c, T_ & 1, zero, p0, p1);
            __builtin_amdgcn_sched_barrier(0);
            const float rm = rowmax(p0, p1) - m;
            bool doit; float dl;
            if (T_ == 0) { doit = true; dl = rm; } else { doit = __any(rm > THR); dl = fmaxf(rm, 0.f); }
            if (doit) {
                m += dl;
                if (T_ > 0) {
                    const float f = __builtin_amdgcn_exp2f(-dl);
                    l *= f; carry *= f;
#pragma unroll
                    for (int u = 0; u < 4; ++u)
#pragma unroll
                        for (int i = 0; i < 8; ++i) bsum[u][i] *= f;
                    LAS float* xs = (LAS float*)(c.lds + XOFF) + c.wid * 64;
                    if (c.hi == 0) xs[c.r32] = f;
#pragma unroll
                    for (int r = 0; r < 16; ++r) { const float fr = xs[crow(r, c.hi)]; o[0][r] *= fr; o[1][r] *= fr; }
                }
            }
            const int cnt = nv - 64 * T_;
            const unsigned long long wm = cnt >= 64 ? ~0ull : (cnt <= 0 ? 0ull : ((1ull << cnt) - 1ull));
            const unsigned w0 = (unsigned)wm >> (4 * c.hi), w1 = (unsigned)(wm >> 32) >> (4 * c.hi);
            float ls = 0.f;
#pragma unroll
            for (int r = 0; r < 16; ++r) { const int sh = (r & 3) + 8 * (r >> 2);
                float e0 = __builtin_amdgcn_exp2f(p0[r] - m), e1 = __builtin_amdgcn_exp2f(p1[r] - m);
                e0 = __builtin_bit_cast(float, __builtin_bit_cast(unsigned, e0) & (unsigned)__builtin_amdgcn_sbfe((int)w0, sh, 1));
                e1 = __builtin_bit_cast(float, __builtin_bit_cast(unsigned, e1) & (unsigned)__builtin_amdgcn_sbfe((int)w1, sh, 1));
                p0[r] = e0; p1[r] = e1; ls += e0 + e1; }
            l += ls;
            float mn0[4], mn1[4], rc0[4], rc1[4];
#pragma unroll
            for (int i = 0; i < 4; ++i) { const float s0 = 0.5f * p0[4 * i + 3], s1 = 0.5f * p1[4 * i + 3];
                mn0[i] = (p0[4 * i] + p0[4 * i + 1]) + (p0[4 * i + 2] + s0); mn1[i] = (p1[4 * i] + p1[4 * i + 1]) + (p1[4 * i + 2] + s1);
                rc0[i] = __shfl_xor(s0, 32); rc1[i] = __shfl_xor(s1, 32); }
            if (c.hi) {
#pragma unroll
                for (int i = 0; i < 4; ++i) { bsum[T_][i] = mn0[i] + rc0[i]; bsum[T_][4 + i] = mn1[i] + rc1[i]; }
            } else {
                bsum[T_][0] = mn0[0] + carry; bsum[T_][4] = mn1[0] + rc0[3];
#pragma unroll
                for (int i = 1; i < 4; ++i) { bsum[T_][i] = mn0[i] + rc0[i - 1]; bsum[T_][4 + i] = mn1[i] + rc1[i - 1]; }
                carry = rc1[3];
            }
            u32x4 pw[4];
            pw[0] = (u32x4){cvtpk(p0[0], p0[1]), cvtpk(p0[2], p0[3]), cvtpk(p0[4], p0[5]), cvtpk(p0[6], p0[7])};
            pw[1] = (u32x4){cvtpk(p0[8], p0[9]), cvtpk(p0[10], p0[11]), cvtpk(p0[12], p0[13]), cvtpk(p0[14], p0[15])};
            pw[2] = (u32x4){cvtpk(p1[0], p1[1]), cvtpk(p1[2], p1[3]), cvtpk(p1[4], p1[5]), cvtpk(p1[6], p1[7])};
            pw[3] = (u32x4){cvtpk(p1[8], p1[9]), cvtpk(p1[10], p1[11]), cvtpk(p1[12], p1[13]), cvtpk(p1[14], p1[15])};
            __builtin_amdgcn_sched_barrier(0);
            {
                const LAS unsigned char* vp = c.lds + VOFF + (T_ & 1) * 8192 + ((c.lane >> 4) & 1) * 32 + (c.lane & 3) * 8 + (4 * c.hi + ((c.lane & 15) >> 2)) * 64;
#pragma unroll
                for (int d0 = 0; d0 < 2; ++d0) {
                    s16x4 lo[4], hi4[4];
#pragma unroll
                    for (int ks = 0; ks < 4; ++ks) { lo[ks] = vtr(vp + d0 * 4096 + ks * 1024); hi4[ks] = vtr(vp + d0 * 4096 + ks * 1024 + 512); }
#pragma unroll
                    for (int ks = 0; ks < 4; ++ks) { const bf16x8 vf = {lo[ks][0], lo[ks][1], lo[ks][2], lo[ks][3], hi4[ks][0], hi4[ks][1], hi4[ks][2], hi4[ks][3]};
                        o[d0] = __builtin_amdgcn_mfma_f32_32x32x16_bf16(__builtin_bit_cast(bf16x8, pw[ks]), vf, o[d0], 0, 0, 0); }
                    __builtin_amdgcn_sched_barrier(0);
                }
            }
            __syncthreads();
        }
    }
    l += __shfl_xor(l, 32);
    const float inv = l > 0.f ? 1.0f / l : 0.f;
    LAS float* imp = (LAS float*)(c.lds + IMPOFF) + (hr * 64 + qi) * 64;
#pragma unroll
    for (int T_ = 0; T_ < 4; ++T_)
#pragma unroll
        for (int i = 0; i < 4; ++i) { imp[16 * T_ + 2 * i + c.hi] = bsum[T_][i] * inv; imp[16 * T_ + 8 + 2 * i + c.hi] = bsum[T_][4 + i] * inv; }
    {
        LAS float* xs = (LAS float*)(c.lds + XOFF) + c.wid * 64;
        if (c.hi == 0) xs[c.r32] = inv * gx[c.r32];
#pragma unroll
        for (int r = 0; r < 16; ++r) { const float fr = xs[crow(r, c.hi)]; o[0][r] *= fr; o[1][r] *= fr; }
        store_o_bf16(c, o, LWSP(bf16, WS_OCG) + mrow * 1024 + h * 64);
    }
    __syncthreads();
    {
        const LAS float* I0 = (const LAS float*)(c.lds + IMPOFF);
        const int j = c.lane;
        for (int qq = 8 * c.wid; qq < 8 * c.wid + 8; ++qq) {
            const float iv = (I0[(0 * 64 + qq) * 64 + j] + I0[(1 * 64 + qq) * 64 + j]) + (I0[(2 * 64 + qq) * 64 + j] + I0[(3 * 64 + qq) * 64 + j]);
            const bool valid = j <= qt, forced = valid && ((j == 0) || (j == qt) || (j + 1 == qt)), cnd = valid && !forced;
            const unsigned long long bf = __ballot(forced), bc = __ballot(cnd);
            const int K = 16 - __popcll(bf);
            unsigned long long bsel = bc;
            if (__popcll(bc) > K) {
                const unsigned key = cnd ? okey(iv) : 0u;
                unsigned prefix = 0u; bool exact = false;
                for (int bit = 31; bit >= 0; --bit) { const unsigned cand = prefix | (1u << bit); const int cn = __popcll(__ballot(key >= cand)); if (cn >= K) { prefix = cand; if (cn == K) { exact = true; break; } } }
                if (exact) bsel = __ballot(key >= prefix);
                else { const unsigned long long bg = __ballot(key > prefix), be = __ballot(key == prefix); const int need = K - __popcll(bg);
                    const bool tk = (key == prefix) && (__popcll(be & ((1ull << j) - 1ull)) < need); bsel = bg | __ballot(tk); }
            }
            const unsigned long long mk = bf | bsel;
            if (j == 0) LWSP(unsigned long long, WS_SEL)[((size_t)b * 4 + g) * SEQ + 64 * qt + qq] = mk;
        }
    }
    __syncthreads();
}
}


#if DBG_CHECK
__device__ __forceinline__ void dbg_compare(Frame& F, const bf16* A, const bf16* R, int slot) {
    float sd = 0.f, sr = 0.f;
    for (size_t i = (size_t)F.gw * 64 + F.lane; i < (size_t)T * D / 2; i += (size_t)F.NGW * 64) { const unsigned a = ((const unsigned*)A)[i], r = ((const unsigned*)R)[i];
        const float d0 = bflo(a) - bflo(r), d1 = bfhi(a) - bfhi(r); sd += d0 * d0 + d1 * d1; sr += bflo(r) * bflo(r) + bfhi(r) * bfhi(r); }
    sd = wave_sum(sd); sr = wave_sum(sr);
    if (F.lane == 0) { atomicAdd((float*)(F.ctl + CW_DBG + slot), sd); atomicAdd((float*)(F.ctl + CW_DBG + slot + 1), sr); }
}
#endif
__device__ __forceinline__ f32x4 yrow(const bf16* Y, const bf16* Yp, int slot, int i) {
    if (slot < 128 * 256) { const u32x2 v = ((const u32x2*)(Y + (size_t)slot * D))[i]; return (f32x4){bflo(v.x), bfhi(v.x), bflo(v.y), bfhi(v.y)}; }
    f32x4 a = {0.f, 0.f, 0.f, 0.f};
#pragma unroll
    for (int q = 0; q < 2; ++q) { const u32x2 v = ((const u32x2*)(Yp + (size_t)q * NE * 256 * D + (size_t)(slot - 128 * 256) * D))[i]; a += (f32x4){bflo(v.x), bfhi(v.x), bflo(v.y), bfhi(v.y)}; }
    return a;
}
constexpr int NPHASE = 22;
struct Args { const void* in[29]; float* out; unsigned char* ws; int ph_lo, ph_hi, li, pad; };
__global__ void __launch_bounds__(NWAVES * 64, 2) trunk_fwd(Args args) {
    extern __shared__ __attribute__((aligned(16))) unsigned char lds[];
const int wave_s = __builtin_amdgcn_readfirstlane((int)threadIdx.x >> 6);
#define MKFRAME() Frame F; F.lds = (LAS unsigned char*)lds; F.MISC = (volatile LAS unsigned*)(F.lds + MISC_OFF); F.wave = wave_s; F.lane = lane_id(); F.tid = wave_s * 64 + F.lane; F.G = gridDim.x; F.gw = blockIdx.x * NWAVES + F.wave; F.NGW = F.G * NWAVES; F.ws = args.ws; F.ctl = (unsigned*)(args.ws + WS_CTL); F.x = (const float*)args.in[0]; F.c = (const float*)args.in[1]; F.pos = (const int*)args.in[2]; F.attn_gain = (const float*)args.in[3]; F.ffn_gain = (const float*)args.in[4]; F.w_ada = (const float*)args.in[5]; F.b_ada = (const float*)args.in[6]; F.a_w_in = (const float*)args.in[7]; F.a_w_out = (const float*)args.in[8]; F.b_w_q = (const float*)args.in[9]; F.b_w_out = (const float*)args.in[10]; F.kv_gain = (const float*)args.in[11]; F.w_kv_ada = (const float*)args.in[12]; F.b_kv_ada = (const float*)args.in[13]; F.w_kv = (const float*)args.in[14]; F.pe_k = (const float*)args.in[15]; F.w1_k = (const float*)args.in[16]; F.w2_k = (const float*)args.in[17]; F.pe_v = (const float*)args.in[18]; F.w1_v = (const float*)args.in[19]; F.w2_v = (const float*)args.in[20]; F.ffn_wg = (const float*)args.in[21]; F.ffn_wu = (const float*)args.in[22]; F.ffn_wd = (const float*)args.in[23]; F.w_router = (const float*)args.in[24]; F.moe_wg = (const float*)args.in[25]; F.moe_wu = (const float*)args.in[26]; F.moe_wd = (const float*)args.in[27]; F.final_gain = (const float*)args.in[28]; F.out = args.out; F.outw = args.pad ? (float*)(args.ws + WS_DRY) : args.out;
    { MKFRAME();
    for (int u = F.tid; u < (LDS_BYTES - LDSCTL_OFF) / 4; u += NWAVES * 64) ((LAS unsigned*)(F.lds + LDSCTL_OFF))[u] = 0u;
    __syncthreads(); }
    XcdBarrier bar; bar.bar = (unsigned*)(args.ws + WS_CTL) + CW_BAR + args.li * XCD_BAR_WORDS; bar.x = 0; bar.st = nullptr;
    if (!MK_PER_PHASE) bar = xcd_barrier_post((unsigned*)(args.ws + WS_CTL) + CW_BAR + args.li * XCD_BAR_WORDS, (volatile LAS unsigned*)((LAS unsigned char*)lds + MISC_OFF) + 8, wave_s == 0 && lane_id() == 0);
#define GRID_BAR() do { if (!MK_PER_PHASE) xcd_barrier(bar, wave_s == 0 && lane_id() == 0); } while (0)
#define GRID_BAR_ALWAYS() do { static_assert(!MK_PER_PHASE, "a seam inside a phase needs the one-launch build"); xcd_barrier(bar, wave_s == 0 && lane_id() == 0); } while (0)
    const int lo = args.ph_lo, hi = args.ph_hi;
#if DBG_TIME
    volatile LAS unsigned long long* tsl = (volatile LAS unsigned long long*)(F.lds + LDSCTL_OFF + 1024);
#define IN(k) ((lo <= (k) && (k) < hi) && (((blockIdx.x == 0 && F.tid == 0) ? (void)(tsl[(k)] = __builtin_amdgcn_s_memrealtime()) : (void)0), true))
#else
#define IN(k) (lo <= (k) && (k) < hi)
#endif
#define BOTH(k) (IN(k) && IN((k) + 1))
#define MOD0 WSP(float, SM_MOD0)
#define MOD1 WSP(float, SM_MOD1)
#define KVMOD WSP(float, SM_KVMOD)
#define CS WSP(float, SM_COS)
#define SN WSP(float, SM_SIN)

    if (IN(0)) { MKFRAME(); p0_prologue(F); if (BOTH(0)) GRID_BAR(); }
    if (IN(1)) { MKFRAME(); norm_phase(F, F.x, F.attn_gain, MOD0, 6144, 0, 1024, WSP(bf16, WS_U)); if (BOTH(1)) GRID_BAR(); }
    if (IN(2)) { MKFRAME();
        pg8::Gemm g{WSP(bf16, WS_U), WSP(bf16, WB_IN), D, D, D}; pg8::StaticOrder S; S.init(T, 2048, F.G, (int)blockIdx.x);
        EpiIn E{WSP(bf16, WS_Q0), WSP(bf16, WS_K0), WSP(bf16, WS_V0), WSP(bf16, WS_IQ), WSP(bf16, WS_IK), WSP(float, SM_IW), CS, SN};
        pg8::gemm_phase(F.lds, g, S, E, F.wave);
        for (int it0 = 2 * blockIdx.x; it0 < T / 32; it0 += 2 * F.G) {
            const int lane = F.lane, half = F.wave >> 2, wq = F.wave & 3, row0 = 32 * (it0 + half), kw = 256 * wq;
            const bf16* ap = WSP(bf16, WS_U) + (size_t)(row0 + (lane & 31)) * D + 8 * (lane >> 5) + kw;
            const bf16* bp = WSP(bf16, WB_IKW) + (size_t)(lane & 31) * D + 8 * (lane >> 5) + kw;
            f32x16 a1 = {}, a2 = {}, a3 = {};
#pragma unroll
            for (int k = 0; k < 256; k += 16) { const bf16x8 a = *(const bf16x8*)(ap + k);
                a1 = __builtin_amdgcn_mfma_f32_32x32x16_bf16(a, *(const bf16x8*)(bp + k), a1, 0, 0, 0);
                a2 = __builtin_amdgcn_mfma_f32_32x32x16_bf16(a, *(const bf16x8*)(bp + 32 * D + k), a2, 0, 0, 0);
                a3 = __builtin_amdgcn_mfma_f32_32x32x16_bf16(a, *(const bf16x8*)(bp + 64 * D + k), a3, 0, 0, 0); }
            LAS float* red = (LAS float*)F.lds + F.wave * 3072 + lane;
#pragma unroll
            for (int r = 0; r < 16; ++r) { red[r * 64] = a1[r]; red[1024 + r * 64] = a2[r]; red[2048 + r * 64] = a3[r]; }
            __syncthreads();
            const int d = lane & 31; bf16* IKo = WSP(bf16, WS_IK); float* IWo = WSP(float, SM_IW);
#pragma unroll
            for (int rr = 0; rr < 4; ++rr) { const int r = 4 * wq + rr; float x1 = 0.f, x2 = 0.f, x3 = 0.f;
#pragma unroll
                for (int w = 0; w < 4; ++w) { const LAS float* q = (const LAS float*)F.lds + (4 * half + w) * 3072 + r * 64 + lane; x1 += q[0]; x2 += q[1024]; x3 += q[2048]; }
                const int row = row0 + (r & 3) + 8 * (r >> 2) + 4 * (lane >> 5);
                const float c = CS[(size_t)row * 32 + d], sn = SN[(size_t)row * 32 + d];
                IKo[(size_t)row * 64 + d] = (bf16)f2bf(x1 * c - x2 * sn); IKo[(size_t)row * 64 + 32 + d] = (bf16)f2bf(x2 * c + x1 * sn);
                if (d < 8) IWo[(size_t)row * 8 + d] = x3 * IWS; }
            __syncthreads();
        }
        if (BOTH(2)) GRID_BAR();
    }
    if (IN(3)) { MKFRAME();
        for (int p = blockIdx.x; p < 256; p += F.G) { const int b = p >> 6, q = p & 63;
#pragma unroll 1
            for (int u = 0; u < 2; ++u) ix::unit(F, b, u ? 127 - q : q);
#pragma unroll 1
            for (int i = 0; i < 8; ++i) ix::select_row(F, b * SEQ + 32 * ((i & 1) ? 127 - q : q) + 4 * F.wave + (i >> 1)); }
        if (BOTH(3)) GRID_BAR(); }
    if (IN(4)) { MKFRAME(); }
    if (IN(5)) { MKFRAME();
        const int v = (F.G == 256) ? ((int)(blockIdx.x & 7) * 32 + (int)(blockIdx.x >> 3)) : (int)blockIdx.x;
        for (int vv = v; vv < 256; vv += F.G) for (int i = 0; i < 4; ++i) { int b, g, qt; fa::unit_of(vv, i, b, g, qt); fp::dsa_unit(F, b, g, qt); }
#if DBG_CHECK
        for (int m = blockIdx.x; m < T; m += F.G) dsa_naive_item(F, m, WSP(bf16, WS_DBG_O0), nullptr);
        GRID_BAR_ALWAYS(); dbg_compare(F, WSP(bf16, WS_O0), WSP(bf16, WS_DBG_O0), 0);
#endif
        if (BOTH(5)) GRID_BAR(); }
    if (IN(6)) { MKFRAME();
        pg8::Gemm g{WSP(bf16, WS_O0), WSP(bf16, WB_O0), D / 2, D / 2, D / 2}; pg8::StaticOrder S; S.init(T, D, F.G, (int)blockIdx.x);
        EpiRes E{F.x, F.out, MOD0 + 2048, 6144, 1.0f / (SW_GU * OS)};
        pg8::gemm_phase<EpiRes, pg8::StaticOrder, true>(F.lds, g, S, E, F.wave);
        if (BOTH(6)) GRID_BAR();
    }
    if (IN(7)) { MKFRAME();
        norm_phase(F, F.out, F.ffn_gain, MOD0, 6144, 3072, 4096, WSP(bf16, WS_U), true);
        { LAS float* scr = (LAS float*)(F.lds + F.wave * 16896); for (int it = F.gw; it < NCONV_B; it += F.NGW) conv_item_b(F, it, scr); }
        if (BOTH(7)) GRID_BAR();
    }
    if (IN(8)) { MKFRAME();
        pg8::Gemm g{WSP(bf16, WS_U), WSP(bf16, WB_GU0), D / 2, D / 2, D / 2}; pg8::StaticOrder S; S.init(T, 2 * FF0, F.G, (int)blockIdx.x);
        EpiSwiglu E{WSP(unsigned char, WS_HID), FF0, 2 * FF0 / 256};
        pg8::gemm_phase<EpiSwiglu, pg8::StaticOrder, true>(F.lds, g, S, E, F.wave);
        if (BOTH(8)) GRID_BAR();
    }
    if (IN(9)) { MKFRAME();
        pg8::Gemm g{WSP(bf16, WS_HID), WSP(bf16, WB_D0), FF0 / 2, FF0 / 2, FF0 / 2}; pg8::StaticOrder S; S.init(T, D, F.G, (int)blockIdx.x);
        EpiRes E{F.out, F.outw, MOD0 + 5120, 6144, 1.0f / (SW_DN * HS)};
        pg8::gemm_phase<EpiRes, pg8::StaticOrder, true>(F.lds, g, S, E, F.wave);
        if (BOTH(9)) GRID_BAR();
    }
    if (IN(10)) { MKFRAME();
        for (int m = F.gw; m < T; m += F.NGW) {
            f32x4 v[4], u[4]; load_row(F.out + (size_t)m * D, F.lane, v);
            const float r = row_rs(v); const int b = m >> 12;
            modulate_row(v, r, F.kv_gain, KVMOD + (size_t)b * 2048, KVMOD + (size_t)b * 2048 + 1024, F.lane, u);
            store_row_fp8(WSP(unsigned char, WS_U) + (size_t)m * D, F.lane, u);
            modulate_row(v, r, F.attn_gain + D, MOD1 + (size_t)b * 6144, MOD1 + (size_t)b * 6144 + 1024, F.lane, u);
            store_row_fp8(WSP(unsigned char, WS_U) + (size_t)(T + m) * D, F.lane, u);
        }
        if (BOTH(10)) GRID_BAR();
    }
    if (IN(11)) { MKFRAME();
        pg8::Gemm g{WSP(bf16, WS_U), WSP(bf16, WB_KVQ), D / 2, D / 2, D / 2}; KvqOrder S; S.S.init(T, 11 * 256, F.G, (int)blockIdx.x);
        EpiKVQ E{WSP(bf16, WS_KCMP), WSP(bf16, WS_VCMP), WSP(bf16, WS_KSLC), WSP(bf16, WS_VSLC), WSP(bf16, WS_KWIN), WSP(bf16, WS_VWIN), WSP(bf16, WS_Q1), WSP(float, SM_GATES), CS, SN};
        pg8::gemm_phase<EpiKVQ, KvqOrder, true>(F.lds, g, S, E, F.wave);
        if (BOTH(11)) GRID_BAR();
    }
    if (IN(12)) { MKFRAME();
        const float* cb = WSP(float, SM_CBIAS);
        LAS bf16* HL = (LAS bf16*)F.lds;
        for (int rt = blockIdx.x; rt < 256; rt += F.G) {
            const int kv = rt >> 7, lane = F.lane;
            const bf16* A = kv ? WSP(bf16, WS_VCMP) : WSP(bf16, WS_KCMP);
            const f32x16 acc = sgemm_tile(A, 1024, WSP(bf16, WB_C1) + (size_t)kv * 256 * 2048, 2048, 2048, (rt & 127) * 32, F.wave * 32, lane);
            const int col = F.wave * 32 + (lane & 31); const float bias = cb[kv * 256 + col];
#pragma unroll
            for (int r = 0; r < 16; ++r) { const int row = (r & 3) + 8 * (r >> 2) + 4 * (lane >> 5); HL[row * 264 + col] = (bf16)f2bf(gelu_tanh(acc[r] + bias)); }
            __syncthreads();
            if (F.wave < 2) {
                f32x16 o = {};
                const LAS bf16* ap = HL + (lane & 31) * 264 + 8 * (lane >> 5);
                const bf16* bp = WSP(bf16, WB_C2) + (size_t)kv * 64 * 256 + (size_t)(F.wave * 32 + (lane & 31)) * 256 + 8 * (lane >> 5);
#pragma unroll
                for (int k = 0; k < 256; k += 16) o = __builtin_amdgcn_mfma_f32_32x32x16_bf16(*(const LAS bf16x8*)(ap + k), *(const bf16x8*)(bp + k), o, 0, 0, 0);
                bf16* dst = kv ? WSP(bf16, SM_VC) : WSP(bf16, SM_KC);
                const int oc = F.wave * 32 + (lane & 31);
#pragma unroll
                for (int r = 0; r < 16; ++r) { const int row = (rt & 127) * 32 + (r & 3) + 8 * (r >> 2) + 4 * (lane >> 5); dst[(size_t)row * 64 + oc] = ((row & 255) == 255) ? (bf16)0 : (bf16)f2bf(o[r]); }
            }
            __syncthreads();
        }
        if (BOTH(12)) GRID_BAR();
    }
    if (IN(13)) { }
    if (IN(14)) { MKFRAME();
        const int v = (F.G == 256) ? ((int)(blockIdx.x & 7) * 32 + (int)(blockIdx.x >> 3)) : (int)blockIdx.x;
        for (int vv = v; vv < 256; vv += F.G) for (int i = 0; i < 4; ++i) { int b, g, qt; fa::unit_of(vv, i, b, g, qt); cm::unit(F, b, g, qt); }
        if (BOTH(14)) GRID_BAR(); }
    if (IN(15)) { MKFRAME();
        const int v = (F.G == 256) ? ((int)(blockIdx.x & 7) * 32 + (int)(blockIdx.x >> 3)) : (int)blockIdx.x;
        for (int vv = v; vv < 256; vv += F.G) for (int i = 0; i < 4; ++i) { int b, g, qt; fa::unit_of(vv, i, b, g, qt); fp::nsa_unit(F, b, g, qt); }
#if DBG_CHECK
        GRID_BAR_ALWAYS();
        for (int m = blockIdx.x; m < T; m += F.G) nsa_naive_item(F, m, WSP(bf16, WS_DBG_O1), nullptr, nullptr);
        GRID_BAR_ALWAYS(); dbg_compare(F, WSP(bf16, WS_O1), WSP(bf16, WS_DBG_O1), 2);
#endif
        if (BOTH(15)) GRID_BAR(); }
    if (IN(16)) { MKFRAME();
        pg8::Gemm g{WSP(bf16, WS_O1), WSP(bf16, WB_O1), D / 2, D / 2, D / 2}; pg8::StaticOrder S; S.init(T, D, F.G, (int)blockIdx.x);
        EpiRes E{F.out, F.outw, MOD1 + 2048, 6144, 1.0f / (SW_GU * OS)};
        pg8::gemm_phase<EpiRes, pg8::StaticOrder, true>(F.lds, g, S, E, F.wave);
        if (BOTH(16)) GRID_BAR();
    }
    if (IN(17)) { MKFRAME();
        LAS int* lcnt = (LAS int*)(F.lds);
        if (F.tid < NE) lcnt[F.tid] = 0;
        __syncthreads();
        int* toke = WSP(int, SM_TOKE); float* tokw = WSP(float, SM_TOKW);
        for (int m = F.gw; m < T; m += F.NGW) {
            f32x4 v[4], u[4]; load_row(F.out + (size_t)m * D, F.lane, v);
            const float r = row_rs(v); const int b = m >> 12;
            modulate_row(v, r, F.ffn_gain + D, MOD1 + (size_t)b * 6144 + 3072, MOD1 + (size_t)b * 6144 + 4096, F.lane, u);
            store_row_fp8(WSP(unsigned char, WS_UM) + (size_t)m * D, F.lane, u);
            float lg[NE];
#pragma unroll
            for (int e = 0; e < NE; ++e) lg[e] = 0.f;
#pragma unroll
            for (int j = 0; j < 4; ++j) {
                const float uu[4] = {u[j].x, u[j].y, u[j].z, u[j].w};
#pragma unroll
                for (int q = 0; q < 4; ++q) { const float* wr = F.w_router + (size_t)(4 * F.lane + 256 * j + q) * NE; const f32x4 w0 = *(const f32x4*)wr, w1 = *(const f32x4*)(wr + 4);
                    lg[0] += uu[q] * w0.x; lg[1] += uu[q] * w0.y; lg[2] += uu[q] * w0.z; lg[3] += uu[q] * w0.w; lg[4] += uu[q] * w1.x; lg[5] += uu[q] * w1.y; lg[6] += uu[q] * w1.z; lg[7] += uu[q] * w1.w; }
            }
#pragma unroll
            for (int e = 0; e < NE; ++e) lg[e] = wave_sum(lg[e]);
            int e1 = 0; float v1 = lg[0];
#pragma unroll
            for (int e = 1; e < NE; ++e) if (lg[e] > v1) { v1 = lg[e]; e1 = e; }
            int e2 = -1; float v2 = -INFINITY;
#pragma unroll
            for (int e = 0; e < NE; ++e) if (e != e1 && lg[e] > v2) { v2 = lg[e]; e2 = e; }
            if (F.lane == 0) {
                const float ex = __expf(v2 - v1), w1 = 1.0f / (1.0f + ex);
                toke[2 * m] = e1; toke[2 * m + 1] = e2; tokw[2 * m] = w1; tokw[2 * m + 1] = ex * w1;
                lds_add(&lcnt[e1], 1); lds_add(&lcnt[e2], 1);
            }
        }
        __syncthreads();
        if (F.tid < NE) atomicAdd(F.ctl + CW_CNT + F.tid, (unsigned)lcnt[F.tid]);
        if (BOTH(17)) GRID_BAR();
    }
    if (IN(18)) { MKFRAME();
        LAS int* lcnt = (LAS int*)(F.lds); LAS int* lbase = lcnt + 8; LAS int* lfill = lcnt + 16;
        const int* toke = WSP(int, SM_TOKE); int* slot = WSP(int, SM_SLOT);
        const int rows_per = T / F.G, r0 = blockIdx.x * rows_per;
        if (F.tid < NE) { lcnt[F.tid] = 0; lfill[F.tid] = 0; }
        __syncthreads();
        for (int i = F.tid; i < 2 * rows_per; i += 512) lds_add(&lcnt[toke[2 * r0 + i]], 1);
        __syncthreads();
        if (F.tid < NE) {
            int off = 0; for (int e = 0; e < F.tid; ++e) off += (int)((ld_u32(F.ctl + CW_CNT + e) + 255u) >> 8) * 256;
            lbase[F.tid] = off + (int)atomicAdd(F.ctl + CW_FILL + F.tid, (unsigned)lcnt[F.tid]);
        }
        __syncthreads();
        const unsigned char* UM = WSP(unsigned char, WS_UM); unsigned char* AG = WSP(unsigned char, WS_AG);
        LAS int* SL = lcnt + 32;
        for (int i = F.tid; i < 2 * rows_per; i += 512) { const int e = toke[2 * r0 + i]; const int sl = lbase[e] + lds_add(&lfill[e], 1); SL[i] = sl; slot[2 * r0 + i] = sl; }
        __syncthreads();
        if (rows_per == 8 * NWAVES) {
            u32x4 v[8];
#pragma unroll
            for (int j = 0; j < 8; ++j) v[j] = ((const u32x4*)(UM + (size_t)(r0 + F.wave + NWAVES * j) * D))[F.lane];
#pragma unroll
            for (int j = 0; j < 8; ++j) { const int rr = F.wave + NWAVES * j; const int s0 = SL[2 * rr], s1 = SL[2 * rr + 1];
                ((u32x4*)(AG + (size_t)s0 * D))[F.lane] = v[j]; ((u32x4*)(AG + (size_t)s1 * D))[F.lane] = v[j]; }
        } else {
            for (int rr = F.wave; rr < rows_per; rr += NWAVES) { const u32x4 v = ((const u32x4*)(UM + (size_t)(r0 + rr) * D))[F.lane];
                ((u32x4*)(AG + (size_t)SL[2 * rr] * D))[F.lane] = v; ((u32x4*)(AG + (size_t)SL[2 * rr + 1] * D))[F.lane] = v; }
        }
        if (BOTH(18)) GRID_BAR();
    }
    if (IN(19)) { MKFRAME();
        pg8::Gemm g{WSP(bf16, WS_AG), WSP(bf16, WS_WGU1), D / 2, D / 2, D / 2}; MoeOrder S; S.init(F.ctl + CW_CNT, 2 * FFE / 256, F.G, (int)blockIdx.x);
        EpiSwiglu E{WSP(unsigned char, WS_HID2), FFE, 2 * FFE / 256};
        pg8::gemm_phase<EpiSwiglu, MoeOrder, true>(F.lds, g, S, E, F.wave);
        if (BOTH(19)) GRID_BAR();
    }
    if (IN(20)) { MKFRAME();
        {
            pg8::Gemm g{WSP(bf16, WS_HID2), WSP(bf16, WS_WD1), FFE / 2, FFE / 2, FFE / 2}; MoeOrder S; S.init(F.ctl + CW_CNT, D / 256, F.G, (int)blockIdx.x, 1, 0, 0, 128);
            EpiY E{WSP(bf16, WS_Y)};
            pg8::gemm_phase<EpiY, MoeOrder, true>(F.lds, g, S, E, F.wave); }
        {
            pg8::Gemm g{WSP(bf16, WS_HID2), WSP(bf16, WS_WD1), FFE / 4, FFE / 2, FFE / 2}; MoeOrder S; S.init(F.ctl + CW_CNT, D / 256, F.G, (int)blockIdx.x, 2, FFE / 2, 128);
            EpiYp E{WSP(bf16, WS_Y2)};
            pg8::gemm_phase<EpiYp, MoeOrder, true>(F.lds, g, S, E, F.wave); }
        if (BOTH(20)) GRID_BAR();
    }
    if (IN(21)) { MKFRAME();
        const int* slot = WSP(int, SM_SLOT); const float* tokw = WSP(float, SM_TOKW); const bf16* Y = WSP(bf16, WS_Y); const bf16* Yp = WSP(bf16, WS_Y2);
        for (int m = F.gw; m < T; m += F.NGW) {
            f32x4 v[4]; load_row(F.out + (size_t)m * D, F.lane, v);
            const int b = m >> 12; const int s1 = slot[2 * m], s2 = slot[2 * m + 1]; const float w1 = tokw[2 * m], w2 = tokw[2 * m + 1];
            const float* fg = MOD1 + (size_t)b * 6144 + 5120;
#pragma unroll
            for (int j = 0; j < 4; ++j) {
                const f32x4 ya = yrow(Y, Yp, s1, F.lane + 64 * j), yb = yrow(Y, Yp, s2, F.lane + 64 * j);
                const f32x4 gq = ((const f32x4*)fg)[F.lane + 64 * j];
                const f32x4 y = ya * w1 + yb * w2;
                v[j] = v[j] + gq * y;
            }
            const float r = row_rs(v);
#pragma unroll
            for (int j = 0; j < 4; ++j) { const f32x4 gn = ((const f32x4*)F.final_gain)[F.lane + 64 * j]; ((f32x4*)(F.outw + (size_t)m * D))[F.lane + 64 * j] = v[j] * r * gn; }
        }
#if DBG_TIME
        {
            if (blockIdx.x == 0 && F.tid == 0) { tsl[NPHASE] = __builtin_amdgcn_s_memrealtime();
                const float ua = 0.01f * (float)(tsl[DBG_TA + 1] - tsl[DBG_TA]), ub = 0.01f * (float)(tsl[DBG_TB + 1] - tsl[DBG_TB]);
                const float cc = sqrtf(10.0f * ua);
                __hip_atomic_store(F.ctl + CW_DBG + 8, __builtin_bit_cast(unsigned, cc), RLX_AGENT); __hip_atomic_store(F.ctl + CW_DBG + 9, __builtin_bit_cast(unsigned, cc * (1.0f + ub * 0.05f)), RLX_AGENT); }
            GRID_BAR_ALWAYS();
            const float cc = __builtin_bit_cast(float, ld_u32(F.ctl + CW_DBG + 8)), c0 = __builtin_bit_cast(float, ld_u32(F.ctl + CW_DBG + 9));
            for (int m = F.gw; m < T; m += F.NGW) for (int j = 0; j < 4; ++j) ((f32x4*)(F.out + (size_t)m * D))[F.lane + 64 * j] = (f32x4){cc, cc, cc, cc};
            GRID_BAR_ALWAYS();
            if (blockIdx.x == 0 && F.tid == 0) F.out[0] = c0;
        }
#endif
#if DBG_CHECK
        {
            const float sd0 = __builtin_bit_cast(float, ld_u32(F.ctl + CW_DBG)), sr0 = __builtin_bit_cast(float, ld_u32(F.ctl + CW_DBG + 1));
            const float sd1 = __builtin_bit_cast(float, ld_u32(F.ctl + CW_DBG + 2)), sr1 = __builtin_bit_cast(float, ld_u32(F.ctl + CW_DBG + 3));
            const float e0 = sqrtf(sd0 / sr0), e1 = sqrtf(sd1 / sr1);
            const float cc = sqrtf(1e6f * e0);
            __syncthreads();
            for (int m = F.gw; m < T; m += F.NGW) for (int j = 0; j < 4; ++j) ((f32x4*)(F.out + (size_t)m * D))[F.lane + 64 * j] = (f32x4){cc, cc, cc, cc};
            GRID_BAR_ALWAYS();
            if (blockIdx.x == 0 && F.tid == 0) F.out[0] = cc * (1.0f + 1000.0f * e1);
        }
#endif
    }
#undef IN
#undef BOTH
}

extern "C" void kernel_launch(void* const* d_in, const int* in_sizes, int n_in, void* d_out, int out_size, void* d_ws, size_t ws_size, hipStream_t stream) {
    static int grid = 0;
    if (grid == 0) {
        if (n_in != 29 || out_size != T * D || ws_size < WS_END) { fprintf(stderr, "kernel_launch: unexpected problem (n_in %d, out %d, ws %zu)\n", n_in, out_size, ws_size); grid = -1; return; }
        int dev = 0, cus = 0, per_cu = 0;
        if (hipGetDevice(&dev) != hipSuccess || hipDeviceGetAttribute(&cus, hipDeviceAttributeMultiprocessorCount, dev) != hipSuccess) { grid = -1; return; }
        if (hipFuncSetAttribute((const void*)trunk_fwd, hipFuncAttributeMaxDynamicSharedMemorySize, LDS_BYTES) != hipSuccess) { fprintf(stderr, "kernel_launch: hipFuncSetAttribute failed\n"); grid = -1; return; }
        if (hipOccupancyMaxActiveBlocksPerMultiprocessor(&per_cu, (const void*)trunk_fwd, NWAVES * 64, LDS_BYTES) != hipSuccess || per_cu < 1) { fprintf(stderr, "kernel_launch: occupancy query says %d\n", per_cu); }
        (void)hipGetLastError();
        grid = cus;
        if (T % grid != 0) { fprintf(stderr, "kernel_launch: grid %d does not divide the token count\n", grid); grid = -1; return; }
    }
    if (grid < 0) return;
    if (hipMemsetAsync((char*)d_ws + WS_CTL, 0, CTL_ZERO_BYTES, stream) != hipSuccess) return;
    Args a{};
    for (int i = 0; i < 29; ++i) a.in[i] = d_in[i];
    a.out = (float*)d_out; a.ws = (unsigned char*)d_ws;
#if MK_PER_PHASE
    for (int p = 0; p < NPHASE; ++p) { a.ph_lo = p; a.ph_hi = p + 1; a.li = p; hipLaunchKernelGGL(trunk_fwd, dim3(grid), dim3(NWAVES * 64), LDS_BYTES, stream, a); }
#elif defined(PROBE_LO)
#ifndef PROBE_DRY
#define PROBE_DRY 0
#endif
    { const int cuts[4] = {0, PROBE_HI, PROBE_LO, PROBE_HI};
      a.ph_lo = 0; a.ph_hi = PROBE_HI; a.li = 0; hipLaunchKernelGGL(trunk_fwd, dim3(grid), dim3(NWAVES * 64), LDS_BYTES, stream, a);
      a.ph_lo = PROBE_LO; a.ph_hi = PROBE_HI; a.li = 1; a.pad = PROBE_DRY; hipLaunchKernelGGL(trunk_fwd, dim3(grid), dim3(NWAVES * 64), LDS_BYTES, stream, a);
      a.pad = 0; if (PROBE_HI < NPHASE) { a.ph_lo = PROBE_HI; a.ph_hi = NPHASE; a.li = 2; hipLaunchKernelGGL(trunk_fwd, dim3(grid), dim3(NWAVES * 64), LDS_BYTES, stream, a); } (void)cuts; }
#else
    a.ph_lo = 0; a.ph_hi = NPHASE; a.li = 0;
    hipLaunchKernelGGL(trunk_fwd, dim3(grid), dim3(NWAVES * 64), LDS_BYTES, stream, a);
#endif
    const hipError_t le = hipPeekAtLastError();
    if (le != hipSuccess) fprintf(stderr, "kernel_launch: launch failed: %s\n", hipGetErrorName(le));
}
```

```cpp
#include <hip/hip_runtime.h>
#include <cstdio>
#include <cstdint>

#ifndef MK_PER_PHASE
#define MK_PER_PHASE 0
#endif

#ifndef DBG_CHECK
#define DBG_CHECK 0
#endif
#ifndef DBG_TIME
#define DBG_TIME 0
#endif
#ifndef DBG_TA
#define DBG_TA 3
#endif
#ifndef DBG_TB
#define DBG_TB 4
#endif
#define GAS __attribute__((address_space(1)))
#define LAS __attribute__((address_space(3)))
typedef unsigned short bf16;
typedef short bf16x8 __attribute__((ext_vector_type(8)));
typedef float f32x4 __attribute__((ext_vector_type(4)));
typedef float f32x16 __attribute__((ext_vector_type(16)));
typedef unsigned u32x4 __attribute__((ext_vector_type(4)));
typedef unsigned u32x2 __attribute__((ext_vector_type(2)));
typedef GAS unsigned gu32;
typedef int v8i_t __attribute__((ext_vector_type(8)));
typedef int v4i_t __attribute__((ext_vector_type(4)));

constexpr int NB = 4, SEQ = 4096, T = NB * SEQ, D = 1024, NH = 16, HD = 64, NG = 4;
constexpr int A_IN = 2120, A_INP = 2304, FF0 = 2816, FFE = 3584, NE = 8;
constexpr int KVW = 1536, BQ = 1072, BQP = 1280;
constexpr float C2 = 0.125f * 1.4426950408889634f;
constexpr float IWS = 0.04419417382415922f;
constexpr float RMS_EPS = 1e-6f;
constexpr int MPAD = 2 * T + NE * 256;
constexpr float SW_GU = 32.f, SW_DN = 64.f, HS = 4.f, OS = 16.f;

constexpr size_t MiB = 1u << 20;
constexpr size_t WS_CTL = 0, CTL_ZERO_BYTES = 1 * MiB;
constexpr size_t WS_SMALL = 1 * MiB;
constexpr size_t SM_MOD0 = WS_SMALL, SM_MOD1 = SM_MOD0 + 4 * 6144 * 4, SM_KVMOD = SM_MOD1 + 4 * 6144 * 4, SM_CBIAS = SM_KVMOD + 4 * 2048 * 4;
constexpr size_t SM_COS = 2 * MiB, SM_SIN = 4 * MiB, SM_IW = 6 * MiB, SM_GATES = 7 * MiB, SM_TOKE = 10 * MiB, SM_TOKW = SM_TOKE + 131072, SM_SLOT = SM_TOKW + 131072;
constexpr size_t SM_KC = 11 * MiB, SM_VC = SM_KC + 524288 + 4096;
static_assert(SM_CBIAS + 2048 <= SM_COS && SM_SLOT + 131072 <= SM_KC && SM_VC + 524288 + 4096 <= 16 * MiB, "small map");
constexpr size_t WB_IN = 16 * MiB;
constexpr size_t WB_O0 = WB_IN + (size_t)A_INP * D * 2;
constexpr size_t WB_GU0 = WB_O0 + (size_t)D * D * 2;
constexpr size_t WB_D0 = WB_GU0 + (size_t)2 * FF0 * D * 2;
constexpr size_t WB_KVQ = WB_D0 + (size_t)D * FF0 * 2;
constexpr size_t WB_O1 = WB_KVQ + (size_t)(KVW + BQP) * D * 2;
constexpr size_t WB_C1 = WB_O1 + (size_t)D * D * 2;
constexpr size_t WB_C2 = WB_C1 + (size_t)512 * 2048 * 2;
constexpr size_t WB_IKW = WB_C2 + 128 * 256 * 2;
static_assert(WB_IKW + 96 * 1024 * 2 <= 50 * MiB, "weight map");
constexpr size_t WS_U = 50 * MiB, WS_U2 = 82 * MiB;
constexpr size_t WS_Q0 = 114 * MiB, WS_K0 = 146 * MiB, WS_V0 = 154 * MiB, WS_IQ = 162 * MiB, WS_IK = 178 * MiB, WS_O0 = 180 * MiB, WS_MASK = 212 * MiB, WS_SCORES = 220 * MiB;
constexpr size_t WS_HID = 220 * MiB;
constexpr size_t WS_KCMP = 114 * MiB, WS_VCMP = 122 * MiB, WS_KSLC = 130 * MiB, WS_VSLC = 138 * MiB, WS_KWIN = 146 * MiB, WS_VWIN = 154 * MiB;
constexpr size_t WS_Q1 = 162 * MiB, WS_O1 = 194 * MiB, WS_CH = 226 * MiB;
constexpr size_t WS_OCG = 50 * MiB;
constexpr size_t WS_SEL = 230 * MiB;
constexpr size_t WS_UM = 300 * MiB;
constexpr size_t WS_AG = 16 * MiB;
constexpr size_t WS_Y = 16 * MiB;
constexpr size_t WS_DRY = 130 * MiB;
constexpr size_t WS_Y2 = 351 * MiB;
constexpr size_t WS_HID2 = 84 * MiB;
constexpr size_t WS_WGU1 = 351 * MiB, WS_WD1 = 463 * MiB, WS_END = 519 * MiB;
static_assert(WS_AG + (size_t)MPAD * D * 2 <= WS_HID2 && WS_HID2 + (size_t)MPAD * FFE * 2 <= WS_WGU1 && WS_WGU1 + (size_t)NE * 2 * FFE * D * 2 == WS_WD1 && WS_WD1 + (size_t)NE * D * FFE * 2 == WS_END, "moe map");
static_assert(WS_HID + (size_t)T * FF0 * 2 <= WS_WGU1 && WS_UM + (size_t)T * D * 2 <= WS_WGU1 && WS_SCORES + (size_t)NB * SEQ * SEQ * 4 <= 476 * MiB, "map");
constexpr int CW_TMO = 0, CW_BAR = 4096  , CW_CNT = 20480, CW_FILL = 20544, CW_DBG = 20608;
constexpr size_t WS_DBG_O0 = 480 * MiB, WS_DBG_O1 = 240 * MiB;
#define XCD_BAR_WORDS 3456

constexpr int RING_BYTES = 131072, LDSCTL_OFF = 139264, MISC_OFF = LDSCTL_OFF + 320, LDS_BYTES = 147456;
constexpr int NWAVES = 8;

#define RLX_AGENT __ATOMIC_RELAXED, __HIP_MEMORY_SCOPE_AGENT
#define LDS_WAIT() asm volatile("s_waitcnt lgkmcnt(0)" ::: "memory")
#define VM_WAIT() asm volatile("s_waitcnt vmcnt(0)" ::: "memory")
__device__ __forceinline__ unsigned f2bf(float f) { unsigned u = __builtin_bit_cast(unsigned, f); return (u + 0x7fffu + ((u >> 16) & 1u)) >> 16; }
__device__ __forceinline__ unsigned pk2(float lo, float hi) { return f2bf(lo) | (f2bf(hi) << 16); }
__device__ __forceinline__ unsigned pk4_fp8(float a, float b, float c, float d) { int r = 0; r = __builtin_amdgcn_cvt_pk_fp8_f32(a, b, r, false); r = __builtin_amdgcn_cvt_pk_fp8_f32(c, d, r, true); return (unsigned)r; }
__device__ __forceinline__ float bf2f(unsigned v) { return __builtin_bit_cast(float, v << 16); }
__device__ __forceinline__ float bflo(unsigned w) { return __builtin_bit_cast(float, w << 16); }
__device__ __forceinline__ float bfhi(unsigned w) { return __builtin_bit_cast(float, w & 0xffff0000u); }
__device__ __forceinline__ float bfround(float f) { return bf2f(f2bf(f)); }
__device__ __forceinline__ int lane_id() { return (int)__builtin_amdgcn_mbcnt_hi(~0u, __builtin_amdgcn_mbcnt_lo(~0u, 0u)); }
__device__ __forceinline__ float wave_sum(float v) {
#pragma unroll
    for (int o = 1; o < 64; o <<= 1) v += __shfl_xor(v, o);
    return v;
}
__device__ __forceinline__ float wave_max(float v) {
#pragma unroll
    for (int o = 1; o < 64; o <<= 1) v = fmaxf(v, __shfl_xor(v, o));
    return v;
}
__device__ __forceinline__ int wave_sum_i(int v) {
#pragma unroll
    for (int o = 1; o < 64; o <<= 1) v += __shfl_xor(v, o);
    return v;
}
__device__ __forceinline__ int lds_add(LAS int* p, int v) { return __hip_atomic_fetch_add(p, v, __ATOMIC_RELAXED, __HIP_MEMORY_SCOPE_WORKGROUP); }
__device__ __forceinline__ unsigned ld_u32(const unsigned* p) { return __hip_atomic_load(p, RLX_AGENT); }
__device__ __forceinline__ float dot8(u32x4 a, u32x4 b, float acc) {
    acc += bflo(a.x) * bflo(b.x); acc += bfhi(a.x) * bfhi(b.x); acc += bflo(a.y) * bflo(b.y); acc += bfhi(a.y) * bfhi(b.y);
    acc += bflo(a.z) * bflo(b.z); acc += bfhi(a.z) * bfhi(b.z); acc += bflo(a.w) * bflo(b.w); acc += bfhi(a.w) * bfhi(b.w);
    return acc;
}

namespace pg8 {
constexpr int BM = 256, BK = 64, HALF = 128, HTB = HALF * BK * 2, STAGE_BYTES = 8 * HTB, NXCD = 8, WGM = 8;
__host__ __device__ __forceinline__ int lds_byte(int r, int c) { const int st = (r >> 4) * 2 + (c >> 5), rr = r & 15, cc = c & 31, ob = rr * 64 + cc * 2; return st * 1024 + (ob ^ (((ob >> 9) & 1) << 5)); }
__host__ __device__ __forceinline__ void stage_rc(int b, int& R, int& C) { const int st = b / 1024, sb = b % 1024, swz = sb ^ (((sb >> 9) & 1) << 5); R = (st >> 1) * 16 + swz / 64; C = (st & 1) * 32 + (swz % 64) / 2; }
__host__ __device__ __forceinline__ int perm32(int rho) { const int n = rho >> 4, i = rho & 15; return 8 * (i >> 2) + 4 * n + (i & 3); }
struct Unit { int pm, pn, ko; };
struct Gemm { const bf16* A; const bf16* Bt; int K, lda, ldb; };

struct StaticOrder {
    int nM, nN, nwg, G, c;
    __device__ void init(int M, int N, int G_, int c_) { nM = M / BM; nN = N / BM; nwg = nM * nN; G = G_; c = c_; }
    __device__ bool next(int i, Unit& u) const {
        const long L = (long)i * G + c; if (L >= nwg) return false;
        int wgid = (int)L; { const int q = nwg / NXCD, r = nwg % NXCD, xcd = wgid % NXCD, off = wgid / NXCD; wgid = (xcd < r ? xcd * (q + 1) : r * (q + 1) + (xcd - r) * q) + off; }
        const int nig = WGM * nN, gid = wgid / nig, fm = gid * WGM, gsz = (nM - fm) < WGM ? (nM - fm) : WGM;
        u.pm = fm + ((wgid % nig) % gsz); u.pn = (wgid % nig) / gsz; u.ko = 0; return true;
    }
};

template <class Epi, class Sched, bool F8 = false>
__device__ __forceinline__ void gemm_phase(LAS unsigned char* lds, const Gemm g, const Sched& S, const Epi& E, int wid  ) {
    const int lane = lane_id(), tid = wid * 64 + lane, wr = wid >> 2, wc = wid & 3, fr = lane & 15, fq = lane >> 4;
    const int K = g.K, nt = K / BK;
    unsigned voffA[2], voffB[2];
#pragma unroll
    for (int i = 0; i < 2; ++i) { int R, C; stage_rc(tid * 16 + i * 8192, R, C); const int Rb = (R & ~31) + perm32(R & 31);
        voffA[i] = (unsigned)(R * g.lda + C) * 2u; voffB[i] = (unsigned)(Rb * g.ldb + C) * 2u; }
    const size_t kstep = (size_t)(BK * 2);
    const size_t hA = (size_t)HALF * g.lda * 2, hB = (size_t)HALF * g.ldb * 2;
    const size_t tA = 2 * hA, tB = 2 * hB;
    const unsigned ldsw = (unsigned)wid * 1024u;
    const int aoff = lds_byte(wr * 64 + fr, fq * 8), boff = lds_byte(wc * 32 + fr, fq * 8);
#define PG8_SA(b, h) (((b) * 2 + (h)) * HTB)
#define PG8_SB(b, h) ((4 + (b) * 2 + (h)) * HTB)
#define PG8_STAGE(bufoff, gbase, voff) do { _Pragma("unroll") for (int _i = 0; _i < 2; ++_i) \
        __builtin_amdgcn_global_load_lds((const unsigned*)((const char*)(gbase) + (voff)[_i]), (LAS unsigned*)(lds + (bufoff) + ldsw + _i * 8192), 16, 0, 0); } while (0)
#define PG8_LDA(dst, b, h) do { if constexpr (F8) { _Pragma("unroll") for (int m = 0; m < 4; ++m) { dst##8[m].lo = *(const LAS v4i_t*)(lds + PG8_SA(b, h) + aoff + m * 2048); dst##8[m].hi = *(const LAS v4i_t*)(lds + PG8_SA(b, h) + aoff + m * 2048 + 1024); } } \
        else { _Pragma("unroll") for (int m = 0; m < 4; ++m) _Pragma("unroll") for (int k = 0; k < 2; ++k) dst[m][k] = *(const LAS bf16x8*)(lds + PG8_SA(b, h) + aoff + m * 2048 + k * 1024); } } while (0)
#define PG8_LDB(dst, b, h) do { if constexpr (F8) { _Pragma("unroll") for (int n = 0; n < 2; ++n) { dst##8[n].lo = *(const LAS v4i_t*)(lds + PG8_SB(b, h) + boff + n * 2048); dst##8[n].hi = *(const LAS v4i_t*)(lds + PG8_SB(b, h) + boff + n * 2048 + 1024); } } \
        else { _Pragma("unroll") for (int n = 0; n < 2; ++n) _Pragma("unroll") for (int k = 0; k < 2; ++k) dst[n][k] = *(const LAS bf16x8*)(lds + PG8_SB(b, h) + boff + n * 2048 + k * 1024); } } while (0)
#define PG8_MMA(ai, bj, At, Bt) do { if constexpr (F8) __builtin_amdgcn_sched_barrier(0); __builtin_amdgcn_s_setprio(1); _Pragma("unroll") for (int m = 0; m < 4; ++m) _Pragma("unroll") for (int n = 0; n < 2; ++n) { \
        if constexpr (F8)   \
            asm volatile("v_mfma_scale_f32_16x16x128_f8f6f4 %0, %1, %2, %0, %3, %3 op_sel_hi:[0,0,0]" : "+v"(acc[ai][bj][m][n]) : "v"(Bt##8[n]), "v"(At##8[m]), "v"(one8));   \
        else { _Pragma("unroll") for (int k = 0; k < 2; ++k) acc[ai][bj][m][n] = __builtin_amdgcn_mfma_f32_16x16x32_bf16(Bt[n][k], At[m][k], acc[ai][bj][m][n], 0, 0, 0); } } \
        __builtin_amdgcn_s_setprio(0); if constexpr (F8) __builtin_amdgcn_sched_barrier(0); } while (0)
#define PG8_WAIT_V(n) asm volatile("s_waitcnt vmcnt(" #n ")" ::: "memory")
#define PG8_WAIT_L(n) asm volatile("s_waitcnt lgkmcnt(" #n ")" ::: "memory")
#define PG8_BAR __builtin_amdgcn_s_barrier()
#define PG8_SCHED __builtin_amdgcn_sched_barrier(0)
    Unit cur, nxt; int ui = 0;
    if (!S.next(0, cur)) return;
    f32x4 acc[2][2][4][2];
#pragma unroll
    for (int a = 0; a < 2; ++a)
#pragma unroll
        for (int b = 0; b < 2; ++b)
#pragma unroll
            for (int m = 0; m < 4; ++m)
#pragma unroll
                for (int n = 0; n < 2; ++n) acc[a][b][m][n] = (f32x4){0.f, 0.f, 0.f, 0.f};
    bf16x8 At[4][2], B0[2][2], B1[2][2];
    v8i_t At8[4], B08[2], B18[2];
    (void)At; (void)B0; (void)B1; (void)At8; (void)B08; (void)B18;
    const int one8 = 0x7F7F7F7F;
    (void)one8;
    const char* cA = (const char*)g.A + (size_t)cur.pm * tA + cur.ko; const char* cB = (const char*)g.Bt + (size_t)cur.pn * tB + cur.ko;
    PG8_STAGE(PG8_SB(0, 0), cB, voffB); PG8_STAGE(PG8_SB(0, 1), cB + hB, voffB); PG8_STAGE(PG8_SA(0, 0), cA, voffA); PG8_STAGE(PG8_SA(0, 1), cA + hA, voffA);
    if (wr == 1) PG8_BAR;
    PG8_WAIT_V(2); PG8_BAR;
    PG8_STAGE(PG8_SB(1, 0), cB + kstep, voffB); PG8_STAGE(PG8_SA(1, 0), cA + kstep, voffA); PG8_STAGE(PG8_SB(1, 1), cB + hB + kstep, voffB);
    PG8_WAIT_V(6); PG8_BAR;
    for (;;) {
        const bool has_next = S.next(ui + 1, nxt);
        const char* nA = has_next ? (const char*)g.A + (size_t)nxt.pm * tA + nxt.ko : cA; const char* nB = has_next ? (const char*)g.Bt + (size_t)nxt.pn * tB + nxt.ko : cB;
        for (int t = 0; t < nt; t += 2) {
            const bool last = (t == nt - 2);
            const char* a1 = cA + (size_t)(t + 1) * kstep;
            const char* a2 = last ? nA : cA + (size_t)(t + 2) * kstep; const char* b2 = last ? nB : cB + (size_t)(t + 2) * kstep;
            const char* a3 = a2 + kstep; const char* b3 = b2 + kstep;
            PG8_LDB(B0, 0, 0); PG8_LDB(B1, 0, 1); PG8_SCHED; PG8_LDA(At, 0, 0); PG8_STAGE(PG8_SA(1, 1), a1 + hA, voffA);
            PG8_WAIT_V(8); PG8_WAIT_L(0); PG8_BAR; PG8_MMA(0, 0, At, B0); PG8_MMA(0, 1, At, B1); PG8_BAR; PG8_SCHED;
            PG8_LDA(At, 0, 1); PG8_STAGE(PG8_SB(0, 0), b2, voffB); PG8_STAGE(PG8_SB(0, 1), b2 + hB, voffB); PG8_STAGE(PG8_SA(0, 0), a2, voffA);
            PG8_WAIT_V(8); PG8_WAIT_L(0); PG8_BAR; PG8_MMA(1, 0, At, B0); PG8_MMA(1, 1, At, B1); PG8_BAR; PG8_SCHED;
            PG8_LDB(B0, 1, 0); PG8_LDB(B1, 1, 1); PG8_SCHED; PG8_LDA(At, 1, 0); PG8_STAGE(PG8_SA(0, 1), a2 + hA, voffA);
            PG8_WAIT_V(8); PG8_WAIT_L(0); PG8_BAR; PG8_MMA(0, 0, At, B0); PG8_MMA(0, 1, At, B1); PG8_BAR; PG8_SCHED;
            PG8_LDA(At, 1, 1); PG8_STAGE(PG8_SB(1, 0), b3, voffB); PG8_STAGE(PG8_SB(1, 1), b3 + hB, voffB); PG8_STAGE(PG8_SA(1, 0), a3, voffA);
            PG8_WAIT_V(8); PG8_WAIT_L(0); PG8_BAR; PG8_MMA(1, 0, At, B0); PG8_MMA(1, 1, At, B1); PG8_BAR; PG8_SCHED;
        }
        if (wr == 0) PG8_BAR;
        if constexpr (F8) asm volatile("s_nop 15\n\ts_nop 7" ::: "memory");
        E(acc, cur, wr, wc, fr, fq);
        if (!has_next) break;
#pragma unroll
        for (int a = 0; a < 2; ++a)
#pragma unroll
            for (int b = 0; b < 2; ++b)
#pragma unroll
                for (int m = 0; m < 4; ++m)
#pragma unroll
                    for (int n = 0; n < 2; ++n) acc[a][b][m][n] = (f32x4){0.f, 0.f, 0.f, 0.f};
        cur = nxt; cA = nA; cB = nB; ++ui;
        if (wr == 1) PG8_BAR;
    }
    PG8_WAIT_V(0);
    PG8_BAR;
#undef PG8_SA
#undef PG8_SB
#undef PG8_STAGE
#undef PG8_LDA
#undef PG8_LDB
#undef PG8_MMA
#undef PG8_WAIT_V
#undef PG8_WAIT_L
#undef PG8_BAR
#undef PG8_SCHED
}
}

#define XB_TMO      128
#define XB_XCNT(j)  (256  + 64 * (j))
#define XB_XSUB(j)  (1280 + 64 * (j))
#define XB_XGEN(j)  (2304 + 64 * (j))
#define XB_TOP      3328
#define XB_TOPGEN   3392
#define XB_SPIN_CAP (1u << 18)
__device__ __forceinline__ unsigned xb_ld(unsigned* p)              { return __hip_atomic_load(p, __ATOMIC_RELAXED, __HIP_MEMORY_SCOPE_AGENT); }
__device__ __forceinline__ unsigned xb_add(unsigned* p, unsigned v) { return __hip_atomic_fetch_add(p, v, __ATOMIC_RELAXED, __HIP_MEMORY_SCOPE_AGENT); }
__device__ __forceinline__ unsigned xb_xcc_id() { return (unsigned)__builtin_amdgcn_s_getreg((3 << 11) | 20) & 0xFu; }
#define XB_SPIN(cond, bar) do { unsigned _sp = 0; while (cond) { __builtin_amdgcn_s_sleep(1); \
    if ((++_sp & 255u) == 0u) { if (xb_ld(&(bar)[XB_TMO])) break; if (_sp > XB_SPIN_CAP) { atomicAdd(&(bar)[XB_TMO], 1u); break; } } } } while (0)
struct XcdBarrier { unsigned* bar; unsigned x; volatile LAS unsigned* st; };
__device__ __forceinline__ XcdBarrier xcd_barrier_post(unsigned* bar, volatile LAS unsigned* st, bool t0) {
    XcdBarrier b; b.bar = bar; b.x = xb_xcc_id(); b.st = st;
    if (t0) (void)xb_add(&bar[XB_XCNT(b.x)], 1u);
    return b;
}
__device__ __forceinline__ void xcd_barrier_complete(unsigned* bar, unsigned x, unsigned& nloc, unsigned& nx) {
    const unsigned G = gridDim.x * gridDim.y * gridDim.z;
    unsigned sum, cnt, mine, sp = 0u;
    for (;;) {
        sum = 0u; cnt = 0u; mine = 0u;
#pragma unroll
        for (unsigned j = 0; j < 16; ++j) { const unsigned c = xb_ld(&bar[XB_XCNT(j)]); sum += c; cnt += (c > 0u) ? 1u : 0u; mine = (j == x) ? c : mine; }
        if (sum == G) break;
        __builtin_amdgcn_s_sleep(1);
        if ((++sp & 255u) == 0u) { if (xb_ld(&bar[XB_TMO])) break; if (sp > XB_SPIN_CAP) { atomicAdd(&bar[XB_TMO], 1u); break; } }
    }
    nloc = mine > 0u ? mine : 1u; nx = cnt > 0u ? cnt : 1u;
}
__device__ __forceinline__ void xcd_barrier(const XcdBarrier& b, bool t0  ) {
    asm volatile("s_waitcnt vmcnt(0)" ::: "memory");
    __syncthreads();
    if (t0) {
        unsigned* bar = b.bar;
        __builtin_amdgcn_s_waitcnt(0);
        unsigned nloc = b.st[0], nx = b.st[1];
        if (nloc == 0u) { xcd_barrier_complete(bar, b.x, nloc, nx); b.st[0] = nloc; b.st[1] = nx; }
        const unsigned old = xb_add(&bar[XB_XSUB(b.x)], 1u);
        const unsigned gen = old / nloc;
        if (old + 1u == (gen + 1u) * nloc) {
            __builtin_amdgcn_fence(__ATOMIC_RELEASE, "agent");
            asm volatile("s_waitcnt vmcnt(0)" ::: "memory");
            const unsigned og = xb_add(&bar[XB_TOP], 1u);
            const unsigned tg = og / nx;
            if (og + 1u == (tg + 1u) * nx) xb_add(&bar[XB_TOPGEN], 1u);
            else XB_SPIN(xb_ld(&bar[XB_TOPGEN]) == tg, bar);
            __builtin_amdgcn_fence(__ATOMIC_ACQUIRE, "agent");
            xb_add(&bar[XB_XGEN(b.x)], 1u);
            asm volatile("s_waitcnt vmcnt(0)" ::: "memory");
        } else {
            XB_SPIN(xb_ld(&bar[XB_XGEN(b.x)]) == gen, bar);
            __builtin_amdgcn_fence(__ATOMIC_ACQUIRE, "agent");
            asm volatile("s_waitcnt vmcnt(0)" ::: "memory");
        }
    }
    __syncthreads();
}

struct Frame {
    LAS unsigned char* lds;
    volatile LAS unsigned* MISC;
    unsigned* ctl;
    unsigned char* ws;
    int tid, lane, wave, G, gw, NGW;
    const float *x, *c; const int* pos;
    const float *attn_gain, *ffn_gain, *w_ada, *b_ada, *a_w_in, *a_w_out, *b_w_q, *b_w_out, *kv_gain, *w_kv_ada, *b_kv_ada, *w_kv;
    const float *pe_k, *w1_k, *w2_k, *pe_v, *w1_v, *w2_v, *ffn_wg, *ffn_wu, *ffn_wd, *w_router, *moe_wg, *moe_wu, *moe_wd, *final_gain;
    float* out; float* outw;
};
#define WSP(T_, off) ((T_*)(F.ws + (off)))
__device__ __forceinline__ unsigned char* launder(unsigned char* p) { asm volatile("" : "+s"(p)); return p; }
#define LWSP(T_, off) ((T_*)(launder(F.ws) + (off)))

__device__ __forceinline__ void tr_item(const float* W, int Nsrc, int ncol0, int K, int k0, bf16* WT, int drow0, LAS float* scr, int lane) {
    const int cc = ncol0 + (lane & 31); const bool ok = (ncol0 >= 0) && (cc < Nsrc);
    const float* wp = W + (size_t)(k0 + (lane >> 5)) * Nsrc + (ok ? cc : 0);
    float v[32];
#pragma unroll
    for (int i = 0; i < 32; ++i) v[i] = wp[(size_t)(2 * i) * Nsrc];
#pragma unroll
    for (int i = 0; i < 32; ++i) { const int kk = 2 * i + (lane >> 5); scr[kk * 33 + (lane & 31)] = ok ? v[i] : 0.f; }
    LDS_WAIT(); asm volatile("" ::: "memory");
    const int c = lane & 7;
#pragma unroll
    for (int j = 0; j < 4; ++j) { const int n = (lane >> 3) + 8 * j; const LAS float* s = scr + (8 * c) * 33 + n;
        u32x4 o; o.x = pk2(s[0 * 33], s[1 * 33]); o.y = pk2(s[2 * 33], s[3 * 33]); o.z = pk2(s[4 * 33], s[5 * 33]); o.w = pk2(s[6 * 33], s[7 * 33]);
        *(u32x4*)(WT + (size_t)(drow0 + n) * K + k0 + 8 * c) = o; }
    LDS_WAIT(); asm volatile("" ::: "memory");
}
__device__ __forceinline__ void tr_item8(const float* W, int Nsrc, int ncol0, int K, int k0, unsigned char* WT, int drow0, float scale, LAS float* scr, int lane) {
    const int cc = ncol0 + (lane & 31); const bool ok = cc < Nsrc;
    const float* wp = W + (size_t)(k0 + (lane >> 5)) * Nsrc + (ok ? cc : 0);
    float v[64];
#pragma unroll
    for (int i = 0; i < 64; ++i) v[i] = wp[(size_t)(2 * i) * Nsrc];
    const float sc_ = ok ? scale : 0.f;
#pragma unroll
    for (int i = 0; i < 64; ++i) scr[(2 * i + (lane >> 5)) * 33 + (lane & 31)] = v[i] * sc_;
    LDS_WAIT(); asm volatile("" ::: "memory");
    const int c = lane & 7;
#pragma unroll
    for (int j = 0; j < 4; ++j) { const int n = (lane >> 3) + 8 * j; const LAS float* q = scr + (16 * c) * 33 + n;
        u32x4 o; o.x = pk4_fp8(q[0], q[33], q[66], q[99]); o.y = pk4_fp8(q[132], q[165], q[198], q[231]); o.z = pk4_fp8(q[264], q[297], q[330], q[363]); o.w = pk4_fp8(q[396], q[429], q[462], q[495]);
        *(u32x4*)(WT + (size_t)(drow0 + n) * K + k0 + 16 * c) = o; }
    LDS_WAIT(); asm volatile("" ::: "memory");
}
__device__ __forceinline__ int rope_lb(int pb) { const int pn = pb >> 3, half = (pb >> 2) & 1, hl = pb & 3; return 8 * pn + 2 * hl + half; }

__device__ __forceinline__ void conv_item_a(Frame& F, int it, LAS float* scr) {
    const int lane = F.lane;
    int r = it;
    { constexpr int NBK = 2048 / 32, NI = 16 * NBK; if (r < NI) { const int kb = r / NBK, pb = r % NBK; tr_item(F.a_w_in, A_IN, 32 * rope_lb(pb), D, 64 * kb, WSP(bf16, WB_IN), 32 * pb, scr, lane); return; } r -= NI; }
    { constexpr int NBK = 3, NI = 16 * NBK; if (r < NI) { const int kb = r / NBK, pb = r % NBK; tr_item(F.a_w_in, A_IN, 2048 + 32 * pb, D, 64 * kb, WSP(bf16, WB_IKW), 32 * pb, scr, lane); return; } r -= NI; }
    { constexpr int NBK = D / 32, NI = 8 * NBK; if (r < NI) { const int kb = r / NBK, pb = r % NBK; tr_item8(F.a_w_out, D, 32 * pb, D, 128 * kb, WSP(unsigned char, WB_O0), 32 * pb, SW_GU, scr, lane); return; } r -= NI; }
    { constexpr int NBK = 2 * FF0 / 32, NI = 8 * NBK; if (r < NI) { const int kb = r / NBK, pb = r % NBK; const int pn = pb >> 3, half = (pb >> 2) & 1, q = pb & 3;
        tr_item8(half ? F.ffn_wu : F.ffn_wg, FF0, 32 * (4 * pn + q), D, 128 * kb, WSP(unsigned char, WB_GU0), 32 * pb, SW_GU, scr, lane); return; } r -= NI; }
    { constexpr int NBK = D / 32, NI = (FF0 / 128) * NBK; if (r < NI) { const int kb = r / NBK, pb = r % NBK; tr_item8(F.ffn_wd, D, 32 * pb, FF0, 128 * kb, WSP(unsigned char, WB_D0), 32 * pb, SW_DN, scr, lane); return; } r -= NI; }
    { constexpr int NBK = KVW / 32, NI = 8 * NBK; if (r < NI) { const int kb = r / NBK, pb = r % NBK; tr_item8(F.w_kv, KVW, 32 * rope_lb(pb), D, 128 * kb, WSP(unsigned char, WB_KVQ), 32 * pb, SW_GU, scr, lane); return; } r -= NI; }
    { constexpr int NBK = BQP / 32, NI = 8 * NBK; if (r < NI) { const int kb = r / NBK, pb = r % NBK; tr_item8(F.b_w_q, BQ, 32 * rope_lb(pb), D, 128 * kb, WSP(unsigned char, WB_KVQ) + (size_t)KVW * D, 32 * pb, SW_GU, scr, lane); return; } r -= NI; }
    { constexpr int NBK = D / 32, NI = 8 * NBK; if (r < NI) { const int kb = r / NBK, pb = r % NBK; tr_item8(F.b_w_out, D, 32 * pb, D, 128 * kb, WSP(unsigned char, WB_O1), 32 * pb, SW_GU, scr, lane); return; } r -= NI; }
    { constexpr int NBK = 8, NI = 32 * NBK; if (r < NI) { const int kb = r / NBK, pb = r % NBK; tr_item(F.w1_k, 256, 32 * pb, 2048, 64 * kb, WSP(bf16, WB_C1), 32 * pb, scr, lane); return; } r -= NI;
                                       if (r < NI) { const int kb = r / NBK, pb = r % NBK; tr_item(F.w1_v, 256, 32 * pb, 2048, 64 * kb, WSP(bf16, WB_C1), 256 + 32 * pb, scr, lane); return; } r -= NI; }
    { constexpr int NBK = 2, NI = 4 * NBK; if (r < NI) { const int kb = r / NBK, pb = r % NBK; tr_item(F.w2_k, 64, 32 * pb, 256, 64 * kb, WSP(bf16, WB_C2), 32 * pb, scr, lane); return; } r -= NI;
                                       if (r < NI) { const int kb = r / NBK, pb = r % NBK; tr_item(F.w2_v, 64, 32 * pb, 256, 64 * kb, WSP(bf16, WB_C2), 64 + 32 * pb, scr, lane); return; } r -= NI; }
}
constexpr int NCONV_A = 16 * (2048 / 32) + 16 * 3 + 8 * 32 + 8 * (2 * FF0 / 32) + (FF0 / 128) * 32 + 8 * (KVW / 32) + 8 * (BQP / 32) + 8 * 32 + 2 * 32 * 8 + 2 * 4 * 2;
__device__ __forceinline__ void conv_item_b(Frame& F, int it, LAS float* scr) {
    const int lane = F.lane;
    constexpr int NBK1 = 2 * FFE / 32, NI1 = 8 * NBK1;
    constexpr int NBK2 = D / 32, NI2 = (FFE / 128) * NBK2;
    int r = it;
    if (r < NE * NI1) { const int e = r / NI1; r -= e * NI1; const int kb = r / NBK1, pb = r % NBK1; const int pn = pb >> 3, half = (pb >> 2) & 1, q = pb & 3;
        tr_item8((half ? F.moe_wu : F.moe_wg) + (size_t)e * D * FFE, FFE, 32 * (4 * pn + q), D, 128 * kb, WSP(unsigned char, WS_WGU1) + (size_t)e * 2 * FFE * D, 32 * pb, SW_GU, scr, lane); return; }
    r -= NE * NI1;
    { const int e = r / NI2; r -= e * NI2; const int kb = r / NBK2, pb = r % NBK2;
        tr_item8(F.moe_wd + (size_t)e * FFE * D, D, 32 * pb, FFE, 128 * kb, WSP(unsigned char, WS_WD1) + (size_t)e * D * FFE, 32 * pb, SW_DN, scr, lane); }
}
constexpr int NCONV_B = NE * (8 * (2 * FFE / 32) + (FFE / 128) * 32);

template <int NBAT>
__device__ __forceinline__ void gemv_item(Frame& F, const LAS float* act, const float* W, int K, int N, int n0, const float* bias, float* out, int ldo, LAS float* red) {
    const int kper = K / 8, k0 = F.wave * kper;
    float a[NBAT];
#pragma unroll
    for (int b = 0; b < NBAT; ++b) a[b] = 0.f;
    const float* wp = W + (size_t)k0 * N + n0 + F.lane;
#pragma unroll 8
    for (int k = 0; k < kper; ++k) { const float w = wp[(size_t)k * N];
#pragma unroll
        for (int b = 0; b < NBAT; ++b) a[b] += act[b * K + k0 + k] * w; }
#pragma unroll
    for (int b = 0; b < NBAT; ++b) red[(F.wave * 4 + b) * 64 + F.lane] = a[b];
    __syncthreads();
    if (F.tid < 64 * NBAT) { const int b = F.tid >> 6, l = F.tid & 63; float s = 0.f;
#pragma unroll
        for (int w = 0; w < 8; ++w) s += red[(w * 4 + b) * 64 + l];
        out[(size_t)b * ldo + n0 + l] = s + (bias ? bias[n0 + l] : 0.f); }
    __syncthreads();
}

__device__ __forceinline__ void p0_prologue(Frame& F) {
    {
        LAS float* act = (LAS float*)(F.lds);
        LAS float* red = (LAS float*)(F.lds + 16384);
        constexpr int NI_MOD = 6144 / 64, NI_KV = 2048 / 64, NITEMS = 2 * NI_MOD + NI_KV + 8;
        for (int it = blockIdx.x; it < NITEMS; it += F.G) {
            if (it < 2 * NI_MOD + NI_KV) {
                for (int i = F.tid; i < 4096; i += 512) { const float v = F.c[i]; act[i] = v / (1.f + __expf(-v)); }
                __syncthreads();
                if (it < NI_MOD) gemv_item<4>(F, act, F.w_ada, D, 6144, 64 * it, F.b_ada, WSP(float, SM_MOD0), 6144, red);
                else if (it < 2 * NI_MOD) gemv_item<4>(F, act, F.w_ada + (size_t)D * 6144, D, 6144, 64 * (it - NI_MOD), F.b_ada + 6144, WSP(float, SM_MOD1), 6144, red);
                else gemv_item<4>(F, act, F.w_kv_ada, D, 2048, 64 * (it - 2 * NI_MOD), F.b_kv_ada, WSP(float, SM_KVMOD), 2048, red);
            } else {
                const int j = it - (2 * NI_MOD + NI_KV), kv = j >> 2;
                const float* pe = kv ? F.pe_v : F.pe_k;
                for (int i = F.tid; i < 2048; i += 512) act[i] = pe[i];
                __syncthreads();
                gemv_item<1>(F, act, kv ? F.w1_v : F.w1_k, 2048, 256, 64 * (j & 3), nullptr, WSP(float, SM_CBIAS) + 256 * kv, 256, red);
            }
        }
        __syncthreads();
    }
    {
        LAS float* scr = (LAS float*)(F.lds + F.wave * 16896);
        for (int it = F.gw; it < NCONV_A; it += F.NGW) conv_item_a(F, it, scr);
    }
    {
        float* cs = WSP(float, SM_COS); float* sn = WSP(float, SM_SIN);
        for (int i = F.gw * 64 + F.lane; i < T * 32; i += F.NGW * 64) {
            const int m = i >> 5, d = i & 31;
            const float inv = 1.0f / powf(10000.0f, (float)d * (1.0f / 32.0f));
            const float ang = (float)F.pos[m] * inv;
            cs[i] = cosf(ang); sn[i] = sinf(ang);
        }
    }
}

__device__ __forceinline__ void load_row(const float* row, int lane, f32x4 (&v)[4]) {
#pragma unroll
    for (int j = 0; j < 4; ++j) v[j] = ((const f32x4*)row)[lane + 64 * j];
}
__device__ __forceinline__ float row_rs(const f32x4 (&v)[4]) {
    float s = 0.f;
#pragma unroll
    for (int j = 0; j < 4; ++j) s += (v[j].x * v[j].x + v[j].y * v[j].y) + (v[j].z * v[j].z + v[j].w * v[j].w);
    return 1.0f / sqrtf(wave_sum(s) * (1.f / D) + RMS_EPS);
}
__device__ __forceinline__ void modulate_row(const f32x4 (&v)[4], float r, const float* gain, const float* shift, const float* scale, int lane, f32x4 (&u)[4]) {
#pragma unroll
    for (int j = 0; j < 4; ++j) { const f32x4 g = ((const f32x4*)gain)[lane + 64 * j], sh = ((const f32x4*)shift)[lane + 64 * j], sc = ((const f32x4*)scale)[lane + 64 * j];
        u[j] = v[j] * r * g * (sc + 1.0f) + sh; }
}
__device__ __forceinline__ void store_row_bf16(bf16* orow, int lane, const f32x4 (&u)[4]) {
#pragma unroll
    for (int j = 0; j < 4; ++j) { u32x2 o; o.x = pk2(u[j].x, u[j].y); o.y = pk2(u[j].z, u[j].w); ((u32x2*)orow)[lane + 64 * j] = o; }
}
__device__ __forceinline__ void store_row_fp8(unsigned char* orow, int lane, const f32x4 (&u)[4]) {
#pragma unroll
    for (int j = 0; j < 4; ++j) ((unsigned*)orow)[lane + 64 * j] = pk4_fp8(u[j].x, u[j].y, u[j].z, u[j].w);
}
__device__ __forceinline__ void norm_phase(Frame& F, const float* src, const float* gain, const float* mod  , int ldm, int shift_off, int scale_off, bf16* dst, bool f8 = false) {
    for (int m = F.gw; m < T; m += F.NGW) {
        f32x4 v[4], u[4]; load_row(src + (size_t)m * D, F.lane, v);
        const float r = row_rs(v); const int b = m >> 12;
        modulate_row(v, r, gain, mod + (size_t)b * ldm + shift_off, mod + (size_t)b * ldm + scale_off, F.lane, u);
        if (f8) store_row_fp8((unsigned char*)dst + (size_t)m * D, F.lane, u); else store_row_bf16(dst + (size_t)m * D, F.lane, u);
    }
}

__device__ __forceinline__ void store8(bf16* p, const float (&y)[8]) { u32x4 w; w.x = pk2(y[0], y[1]); w.y = pk2(y[2], y[3]); w.z = pk2(y[4], y[5]); w.w = pk2(y[6], y[7]); *(u32x4*)p = w; }
__device__ __forceinline__ void get8(const f32x4 (&a)[2], float (&x)[8]) { x[0] = a[0].x; x[1] = a[0].y; x[2] = a[0].z; x[3] = a[0].w; x[4] = a[1].x; x[5] = a[1].y; x[6] = a[1].z; x[7] = a[1].w; }
__device__ __forceinline__ void rope8(const float* cs, const float* sn, int row, int fq, const float (&x1)[8], const float (&x2)[8], float sc, float (&y1)[8], float (&y2)[8]) {
    const f32x4 c0 = *(const f32x4*)(cs + (size_t)row * 32 + 8 * fq), c1 = *(const f32x4*)(cs + (size_t)row * 32 + 8 * fq + 4);
    const f32x4 s0 = *(const f32x4*)(sn + (size_t)row * 32 + 8 * fq), s1 = *(const f32x4*)(sn + (size_t)row * 32 + 8 * fq + 4);
    const float c[8] = {c0.x, c0.y, c0.z, c0.w, c1.x, c1.y, c1.z, c1.w}, s[8] = {s0.x, s0.y, s0.z, s0.w, s1.x, s1.y, s1.z, s1.w};
#pragma unroll
    for (int j = 0; j < 8; ++j) { y1[j] = (x1[j] * c[j] - x2[j] * s[j]) * sc; y2[j] = (x2[j] * c[j] + x1[j] * s[j]) * sc; }
}
struct EpiIn {
    bf16 *Q, *K, *V, *IQ, *IK; float* IW; const float *cs, *sn;
    __device__ __forceinline__ void operator()(const f32x4 (&acc)[2][2][4][2], const pg8::Unit& u, int wr, int wc, int fr, int fq) const {
        const int pn = u.pn;
        if (pn == 8 && wc >= 2) return;
#pragma unroll
        for (int ai = 0; ai < 2; ++ai)
#pragma unroll
            for (int m = 0; m < 4; ++m) {
                const int row = u.pm * 256 + ai * 128 + wr * 64 + m * 16 + fr;
                float x1[8], x2[8]; get8(acc[ai][0][m], x1); get8(acc[ai][1][m], x2);
                if (pn == 5) { bf16* d = V + (size_t)row * 256 + wc * 64 + 8 * fq; store8(d, x1); store8(d + 32, x2); }
                else if (pn == 8 && wc == 1) { if (fq == 0) { f32x4 a = {x1[0] * IWS, x1[1] * IWS, x1[2] * IWS, x1[3] * IWS}, b = {x1[4] * IWS, x1[5] * IWS, x1[6] * IWS, x1[7] * IWS};
                        *(f32x4*)(IW + (size_t)row * 8) = a; *(f32x4*)(IW + (size_t)row * 8 + 4) = b; } }
                else {
                    float y1[8], y2[8]; rope8(cs, sn, row, fq, x1, x2, pn < 4 ? C2 : 1.0f, y1, y2);
                    bf16* d;
                    if (pn < 4) d = Q + (size_t)row * 1024 + (4 * pn + wc) * 64;
                    else if (pn == 4) d = K + (size_t)row * 256 + wc * 64;
                    else if (pn < 8) d = IQ + (size_t)row * 512 + (4 * (pn - 6) + wc) * 64;
                    else d = IK + (size_t)row * 64;
                    store8(d + 8 * fq, y1); store8(d + 32 + 8 * fq, y2);
                }
            }
    }
};
struct EpiRes {
    const float* base; float* out; const float* gate; int ldg; float sc;
    __device__ __forceinline__ void operator()(const f32x4 (&acc)[2][2][4][2], const pg8::Unit& u, int wr, int wc, int fr, int fq) const {
        const float* gv = gate + (size_t)((u.pm * 256) >> 12) * ldg;
#pragma unroll
        for (int bj = 0; bj < 2; ++bj) {
            const int col = u.pn * 256 + bj * 128 + wc * 32 + 8 * fq;
            const f32x4 g0 = *(const f32x4*)(gv + col) * sc, g1 = *(const f32x4*)(gv + col + 4) * sc;
#pragma unroll
            for (int ai = 0; ai < 2; ++ai)
#pragma unroll
                for (int m = 0; m < 4; ++m) {
                    const size_t o = (size_t)(u.pm * 256 + ai * 128 + wr * 64 + m * 16 + fr) * D + col;
                    const f32x4 b0 = *(const f32x4*)(base + o), b1 = *(const f32x4*)(base + o + 4);
                    *(f32x4*)(out + o) = b0 + g0 * acc[ai][bj][m][0]; *(f32x4*)(out + o + 4) = b1 + g1 * acc[ai][bj][m][1];
                }
        }
    }
};
__device__ __forceinline__ float silu_f(float g) { return g * __builtin_amdgcn_rcpf(1.0f + __builtin_amdgcn_exp2f(-1.4426950408889634f * g)); }
struct EpiSwiglu {
    unsigned char* H; int ldh, npn;
    __device__ __forceinline__ void operator()(const f32x4 (&acc)[2][2][4][2], const pg8::Unit& u, int wr, int wc, int fr, int fq) const {
        const int col = (u.pn % npn) * 128 + wc * 32 + 8 * fq;
#pragma unroll
        for (int ai = 0; ai < 2; ++ai)
#pragma unroll
            for (int m = 0; m < 4; ++m) {
                const int row = u.pm * 256 + ai * 128 + wr * 64 + m * 16 + fr;
                float g[8], up[8], h[8]; get8(acc[ai][0][m], g); get8(acc[ai][1][m], up);
#pragma unroll
                for (int j = 0; j < 8; ++j) h[j] = silu_f(g[j] * (1.0f / SW_GU)) * up[j] * (HS / SW_GU);
                u32x2 w; w.x = pk4_fp8(h[0], h[1], h[2], h[3]); w.y = pk4_fp8(h[4], h[5], h[6], h[7]);
                *(u32x2*)(H + (size_t)row * ldh + col) = w;
            }
    }
};
struct EpiKVQ {
    bf16 *KCMP, *VCMP, *KSLC, *VSLC, *KWIN, *VWIN, *Q; float* GATES; const float *cs, *sn;
    __device__ __forceinline__ void operator()(const f32x4 (&acc)[2][2][4][2], const pg8::Unit& u, int wr, int wc, int fr, int fq) const {
        const int pn = u.pn;
        if (pn == 10 && wc >= 1) return;
#pragma unroll
        for (int ai = 0; ai < 2; ++ai)
#pragma unroll
            for (int m = 0; m < 4; ++m) {
                const int row = (u.pm & 63) * 256 + ai * 128 + wr * 64 + m * 16 + fr;
                float x1[8], x2[8]; get8(acc[ai][0][m], x1); get8(acc[ai][1][m], x2);
#pragma unroll
                for (int j = 0; j < 8; ++j) { x1[j] *= 1.0f / SW_GU; x2[j] *= 1.0f / SW_GU; }
                if (pn < 6) {
                    if ((pn & 1) == 0) { float y1[8], y2[8]; rope8(cs, sn, row, fq, x1, x2, 1.0f, y1, y2);
#pragma unroll
                        for (int j = 0; j < 8; ++j) { x1[j] = y1[j]; x2[j] = y2[j]; } }
                    bf16* d;
                    if (pn < 2) d = (pn == 0 ? KCMP : VCMP) + ((size_t)((row >> 12) * 4 + wc) * SEQ + (row & 4095)) * 64;
                    else d = (pn == 2 ? KSLC : pn == 3 ? VSLC : pn == 4 ? KWIN : VWIN) + (size_t)row * 256 + wc * 64;
                    store8(d + 8 * fq, x1); store8(d + 32 + 8 * fq, x2);
                } else if (pn < 10) {
                    float y1[8], y2[8]; rope8(cs, sn, row, fq, x1, x2, C2, y1, y2);
                    bf16* d = Q + (size_t)row * 1024 + (4 * (pn - 6) + wc) * 64;
                    store8(d + 8 * fq, y1); store8(d + 32 + 8 * fq, y2);
                } else {
                    float* gp = GATES + (size_t)row * 48;
#pragma unroll
                    for (int j = 0; j < 8; ++j) gp[8 * fq + j] = 1.0f / (1.0f + __expf(-x1[j]));
                    if (fq < 2) {
#pragma unroll
                        for (int j = 0; j < 8; ++j) gp[32 + 8 * fq + j] = 1.0f / (1.0f + __expf(-x2[j])); }
                }
            }
    }
};
struct EpiY {
    bf16* Y;
    __device__ __forceinline__ void operator()(const f32x4 (&acc)[2][2][4][2], const pg8::Unit& u, int wr, int wc, int fr, int fq) const {
#pragma unroll
        for (int ai = 0; ai < 2; ++ai)
#pragma unroll
            for (int m = 0; m < 4; ++m) {
                const int row = u.pm * 256 + ai * 128 + wr * 64 + m * 16 + fr;
#pragma unroll
                for (int bj = 0; bj < 2; ++bj) { float x[8]; get8(acc[ai][bj][m], x);
#pragma unroll
                    for (int j = 0; j < 8; ++j) x[j] *= 1.0f / (SW_DN * HS);
                    store8(Y + (size_t)row * D + (u.pn & 3) * 256 + bj * 128 + wc * 32 + 8 * fq, x); }
            }
    }
};
struct EpiYp {
    bf16* Yp;
    __device__ __forceinline__ void operator()(const f32x4 (&acc)[2][2][4][2], const pg8::Unit& u, int wr, int wc, int fr, int fq) const {
        bf16* base = Yp + (size_t)((u.ko * 586) >> 20) * ((size_t)NE * 256 * D) + (size_t)(u.pm - 128) * 256 * D + (u.pn & 3) * 256 + wc * 32 + 8 * fq;
#pragma unroll
        for (int ai = 0; ai < 2; ++ai)
#pragma unroll
            for (int m = 0; m < 4; ++m) {
                const int row = ai * 128 + wr * 64 + m * 16 + fr;
#pragma unroll
                for (int bj = 0; bj < 2; ++bj) { float x[8]; get8(acc[ai][bj][m], x);
#pragma unroll
                    for (int j = 0; j < 8; ++j) x[j] *= 1.0f / (SW_DN * HS);
                    store8(base + (size_t)row * D + bj * 128, x); }
            }
    }
};
struct KvqOrder {
    pg8::StaticOrder S;
    __device__ bool next(int i, pg8::Unit& u) const { if (!S.next(i, u)) return false; if (u.pn >= 6) u.pm += 64; return true; }
};
struct MoeOrder {
    int tend[NE]; int npn, ksplit, kbytes, mtlo, nmt, j, per8;
    __device__ void init(const unsigned* cnt, int npn_, int G_, int c_, int ksplit_ = 1, int kbytes_ = 0, int mt0_ = 0, int mt1_ = 1 << 30) {
        int acc = 0; for (int e = 0; e < NE; ++e) { acc += (int)((ld_u32(cnt + e) + 255u) >> 8); tend[e] = acc; }
        npn = npn_; ksplit = ksplit_; kbytes = kbytes_;
        const int mt0 = mt0_ < acc ? mt0_ : acc, mt1 = mt1_ < acc ? mt1_ : acc, n = mt1 - mt0;
        const int nx = (G_ % 8 == 0) ? 8 : 1, x = (nx == 8) ? (c_ & 7) : 0;
        mtlo = mt0 + (int)((long)n * x / nx); nmt = mt0 + (int)((long)n * (x + 1) / nx) - mtlo;
        j = (nx == 8) ? (c_ >> 3) : c_; per8 = G_ / nx;
    }
    __device__ bool next(int i, pg8::Unit& u) const {
        const int idx = i * per8 + j;
        const int cw = (npn < 4 ? npn : 4), upc = nmt * cw * ksplit;
        if (nmt <= 0 || idx >= nmt * npn * ksplit) return false;
        const int q = idx / upc, w = idx % upc, mt = mtlo + w / (cw * ksplit), r = w % (cw * ksplit), pn = q * cw + r / ksplit, kh = r % ksplit; int e = 0;
#pragma unroll
        for (int k = 0; k < NE - 1; ++k) e += (mt >= tend[k]) ? 1 : 0;
        u.pm = mt; u.pn = e * npn + pn; u.ko = kh * kbytes; return true;
    }
};

__device__ __forceinline__ f32x16 sgemm_tile(const bf16* A, int lda, const bf16* Bt, int ldb, int K, int row0, int col0, int lane) {
    f32x16 acc = {};
    const bf16* ap = A + (size_t)(row0 + (lane & 31)) * lda + 8 * (lane >> 5);
    const bf16* bp = Bt + (size_t)(col0 + (lane & 31)) * ldb + 8 * (lane >> 5);
#pragma unroll 8
    for (int k = 0; k < K; k += 16) { const bf16x8 a = *(const bf16x8*)(ap + k), b = *(const bf16x8*)(bp + k); acc = __builtin_amdgcn_mfma_f32_32x32x16_bf16(a, b, acc, 0, 0, 0); }
    return acc;
}
__device__ __forceinline__ float gelu_tanh(float x) { const float t = tanhf(0.7978845608028654f * (x + 0.044715f * x * x * x)); return 0.5f * x * (1.0f + t); }

__device__ __forceinline__ unsigned okey(float f) { const unsigned u = __builtin_bit_cast(unsigned, f); return (u & 0x80000000u) ? ~u : (u | 0x80000000u); }
__device__ __forceinline__ void dsa_naive_item(Frame& F, int m, bf16* O  , unsigned long long* MASKo  ) {
    const int tid = F.tid, lane = F.lane, wave = F.wave;
    const int b = m >> 12, t = m & 4095, n = t + 1;
    LAS unsigned* KEY = (LAS unsigned*)(F.lds);
    LAS u32x4* IQL = (LAS u32x4*)(F.lds + 16384);
    LAS float* IWL = (LAS float*)(F.lds + 16384 + 1024);
    LAS int* LIST = (LAS int*)(F.lds + 20480);
    LAS int* CNT = (LAS int*)(F.lds + 20480 + 1024);
    LAS float* PL = (LAS float*)(F.lds + 24576);
    const bf16* IQ = WSP(bf16, WS_IQ); const bf16* IK = WSP(bf16, WS_IK); const float* IW = WSP(float, SM_IW);
    if (tid < 64) IQL[tid] = ((const u32x4*)(IQ + (size_t)m * 512))[tid];
    if (tid < 8) IWL[tid] = IW[(size_t)m * 8 + tid];
    __syncthreads();
    for (int s = tid; s < n; s += 512) {
        const u32x4* kp = (const u32x4*)(IK + (size_t)(b * SEQ + s) * 64);
        u32x4 kv[8];
#pragma unroll
        for (int c = 0; c < 8; ++c) kv[c] = kp[c];
        float sc = 0.f;
#pragma unroll
        for (int h = 0; h < 8; ++h) { float d = 0.f;
#pragma unroll
            for (int c = 0; c < 8; ++c) d = dot8(kv[c], IQL[h * 8 + c], d);
            sc += IWL[h] * fmaxf(d, 0.f); }
        KEY[s] = okey(sc);
    }
    __syncthreads();
    const bool all = (n <= 256);
    unsigned thr = 0u; int need_ties = 0;
    if (!all) {
        unsigned myk[8];
#pragma unroll
        for (int i = 0; i < 8; ++i) { const int s = tid + 512 * i; myk[i] = s < n ? KEY[s] : 0u; }
        unsigned prefix = 0u;
        for (int bit = 31; bit >= 0; --bit) {
            const unsigned cand = prefix | (1u << bit);
            int c = 0;
#pragma unroll
            for (int i = 0; i < 8; ++i) c += (myk[i] >= cand) ? 1 : 0;
            c = wave_sum_i(c);
            if (lane == 0) CNT[(bit & 1) * 8 + wave] = c;
            __syncthreads();
            int tot = 0;
#pragma unroll
            for (int w = 0; w < 8; ++w) tot += CNT[(bit & 1) * 8 + w];
            if (tot >= 256) prefix = cand;
        }
        thr = prefix;
        int c = 0;
#pragma unroll
        for (int i = 0; i < 8; ++i) c += (myk[i] > thr) ? 1 : 0;
        c = wave_sum_i(c);
        if (lane == 0) CNT[16 + wave] = c;
        __syncthreads();
        int tot = 0;
#pragma unroll
        for (int w = 0; w < 8; ++w) tot += CNT[16 + w];
        need_ties = 256 - tot;
    }
    if (wave == 0) {
        int pos = 0, ties = 0;
        const unsigned long long lt = (1ull << lane) - 1ull;
        for (int c0 = 0; c0 < n; c0 += 64) {
            const int s = c0 + lane; const bool valid = s < n; const unsigned k = valid ? KEY[s] : 0u;
            const bool gt = valid && (all || k > thr), eq = valid && !all && (k == thr);
            const unsigned long long beq = __ballot(eq); const int tr = ties + __popcll(beq & lt);
            const bool sel = gt || (eq && tr < need_ties);
            const unsigned long long bs = __ballot(sel); const int p = pos + __popcll(bs & lt);
            if (sel) LIST[p] = s;
            if (MASKo && lane == 0) MASKo[((size_t)b * 64 + (c0 >> 6)) * SEQ + t] = bs;
            pos += __popcll(bs); ties += __popcll(beq);
        }
        if (lane == 0) CNT[32] = pos;
    }
    __syncthreads();
    if (!O) return;
    const int nsel = CNT[32];
    const int g = wave >> 1, h0 = 4 * g + 2 * (wave & 1);
    const bf16* Q = WSP(bf16, WS_Q0); const bf16* Kp = WSP(bf16, WS_K0); const bf16* Vp = WSP(bf16, WS_V0);
    u32x4 q0[8], q1[8];
#pragma unroll
    for (int c = 0; c < 8; ++c) { q0[c] = ((const u32x4*)(Q + (size_t)m * 1024 + h0 * 64))[c]; q1[c] = ((const u32x4*)(Q + (size_t)m * 1024 + (h0 + 1) * 64))[c]; }
    float s0[4], s1[4]; float mx0 = -INFINITY, mx1 = -INFINITY;
#pragma unroll
    for (int i = 0; i < 4; ++i) { const int j = lane + 64 * i; s0[i] = -INFINITY; s1[i] = -INFINITY;
        if (j < nsel) { const int s = LIST[j]; const u32x4* kp = (const u32x4*)(Kp + (size_t)(b * SEQ + s) * 256 + g * 64); float d0 = 0.f, d1 = 0.f;
#pragma unroll
            for (int c = 0; c < 8; ++c) { const u32x4 kk = kp[c]; d0 = dot8(kk, q0[c], d0); d1 = dot8(kk, q1[c], d1); }
            s0[i] = d0; s1[i] = d1; }
        mx0 = fmaxf(mx0, s0[i]); mx1 = fmaxf(mx1, s1[i]); }
    mx0 = wave_max(mx0); mx1 = wave_max(mx1);
    float l0 = 0.f, l1 = 0.f;
    LAS float* P0 = PL + (wave * 2 + 0) * 256; LAS float* P1 = PL + (wave * 2 + 1) * 256;
#pragma unroll
    for (int i = 0; i < 4; ++i) { const int j = lane + 64 * i; const float p0 = (j < nsel) ? __builtin_amdgcn_exp2f(s0[i] - mx0) : 0.f, p1 = (j < nsel) ? __builtin_amdgcn_exp2f(s1[i] - mx1) : 0.f;
        l0 += p0; l1 += p1; P0[j] = bfround(p0); P1[j] = bfround(p1); }
    l0 = wave_sum(l0); l1 = wave_sum(l1);
    float a0 = 0.f, a1 = 0.f;
    for (int j = 0; j < nsel; ++j) { const int s = LIST[j]; const float v = bf2f(Vp[(size_t)(b * SEQ + s) * 256 + g * 64 + lane]); a0 += P0[j] * v; a1 += P1[j] * v; }
    O[(size_t)m * 1024 + h0 * 64 + lane] = (bf16)f2bf(a0 / l0); O[(size_t)m * 1024 + (h0 + 1) * 64 + lane] = (bf16)f2bf(a1 / l1);
    __syncthreads();
}

__device__ __forceinline__ void nsa_naive_item(Frame& F, int m, bf16* O  , bf16* OCG  , unsigned long long* SELo  ) {
    const int lane = F.lane, wave = F.wave;
    const int b = m >> 12, t = m & 4095, jt = t >> 6;
    const int g = wave >> 1, h0 = 4 * g + 2 * (wave & 1);
    LAS float* PC = (LAS float*)(F.lds);
    LAS float* SC0 = (LAS float*)(F.lds + 16384) + (wave * 2 + 0) * 1024;
    LAS float* SC1 = SC0 + 1024;
    LAS unsigned long long* SEL = (LAS unsigned long long*)(F.lds + 16384 + 65536);
    const bf16* Q = WSP(bf16, WS_Q1);
    u32x4 q0[8], q1[8];
#pragma unroll
    for (int c = 0; c < 8; ++c) { q0[c] = ((const u32x4*)(Q + (size_t)m * 1024 + h0 * 64))[c]; q1[c] = ((const u32x4*)(Q + (size_t)m * 1024 + (h0 + 1) * 64))[c]; }
    const int nv = t >= 31 ? min(255, (t - 31) / 16 + 1) : 0;
    const bf16* KC = WSP(bf16, SM_KC) + (size_t)(b * 4 + g) * 256 * 64; const bf16* VC = WSP(bf16, SM_VC) + (size_t)(b * 4 + g) * 256 * 64;
    float oc0 = 0.f, oc1 = 0.f;
    {
        float s0[4], s1[4]; float mx0 = -INFINITY, mx1 = -INFINITY;
#pragma unroll
        for (int i = 0; i < 4; ++i) { const int n = lane + 64 * i; s0[i] = -INFINITY; s1[i] = -INFINITY;
            if (n < nv) { const u32x4* kp = (const u32x4*)(KC + (size_t)n * 64); float d0 = 0.f, d1 = 0.f;
#pragma unroll
                for (int c = 0; c < 8; ++c) { const u32x4 kk = kp[c]; d0 = dot8(kk, q0[c], d0); d1 = dot8(kk, q1[c], d1); }
                s0[i] = d0; s1[i] = d1; }
            mx0 = fmaxf(mx0, s0[i]); mx1 = fmaxf(mx1, s1[i]); }
        mx0 = wave_max(mx0); mx1 = wave_max(mx1);
        float p0[4], p1[4], l0 = 0.f, l1 = 0.f;
#pragma unroll
        for (int i = 0; i < 4; ++i) { const int n = lane + 64 * i; p0[i] = (n < nv) ? __builtin_amdgcn_exp2f(s0[i] - mx0) : 0.f; p1[i] = (n < nv) ? __builtin_amdgcn_exp2f(s1[i] - mx1) : 0.f; l0 += p0[i]; l1 += p1[i]; }
        l0 = wave_sum(l0); l1 = wave_sum(l1);
        const float r0 = nv > 0 ? 1.0f / l0 : 0.f, r1 = nv > 0 ? 1.0f / l1 : 0.f;
#pragma unroll
        for (int i = 0; i < 4; ++i) { const int n = lane + 64 * i; PC[h0 * 256 + n] = p0[i] * r0; PC[(h0 + 1) * 256 + n] = p1[i] * r1; SC0[n] = bfround(p0[i]); SC1[n] = bfround(p1[i]); }
        for (int n = 0; n < nv; ++n) { const float v = bf2f(VC[(size_t)n * 64 + lane]); oc0 += SC0[n] * v; oc1 += SC1[n] * v; }
        oc0 *= r0; oc1 *= r1;
    }
    __syncthreads();
    if ((wave & 1) == 0) {
        const int j = lane;
        auto P4 = [&](int n) -> float { return (PC[(4 * g) * 256 + n] + PC[(4 * g + 1) * 256 + n]) + (PC[(4 * g + 2) * 256 + n] + PC[(4 * g + 3) * 256 + n]); };
        float imp = P4(4 * j) + P4(4 * j + 1) + P4(4 * j + 2) + 0.5f * P4(4 * j + 3);
        if (j > 0) imp += 0.5f * P4(4 * j - 1);
        const bool valid = j <= jt, forced = (j == 0) || (j == jt) || (j + 1 == jt);
        const float val = valid ? (forced ? 1e30f : imp) : -1e30f;
        int rank = 0;
        for (int jj = 0; jj < 64; ++jj) { const float vj = __shfl(val, jj); rank += ((vj > val) || (vj == val && jj < j)) ? 1 : 0; }
        const unsigned long long mk = __ballot(rank < 16);
        if (lane == 0) { SEL[g] = mk; if (SELo) SELo[((size_t)b * 4 + g) * SEQ + t] = mk; }
    }
    __syncthreads();
    const float* gt = WSP(float, SM_GATES) + (size_t)m * 48;
    if (OCG) { OCG[(size_t)m * 1024 + h0 * 64 + lane] = (bf16)f2bf(gt[h0 * 3] * oc0); OCG[(size_t)m * 1024 + (h0 + 1) * 64 + lane] = (bf16)f2bf(gt[h0 * 3 + 3] * oc1); }
    if (!O) return;
    float os0 = 0.f, os1 = 0.f;
    {
        unsigned long long mk = SEL[g]; if (jt < 63) mk &= ((1ull << (jt + 1)) - 1ull);
        const bf16* Ks = WSP(bf16, WS_KSLC); const bf16* Vs = WSP(bf16, WS_VSLC);
        int cnt = 0; float mx0 = -INFINITY, mx1 = -INFINITY;
        for (unsigned long long r = mk; r; r &= r - 1ull) { const int j = __builtin_ctzll(r); const int tok = 64 * j + lane;
            float d0 = -INFINITY, d1 = -INFINITY;
            if (tok <= t) { const u32x4* kp = (const u32x4*)(Ks + (size_t)(b * SEQ + tok) * 256 + g * 64); d0 = 0.f; d1 = 0.f;
#pragma unroll
                for (int c = 0; c < 8; ++c) { const u32x4 kk = kp[c]; d0 = dot8(kk, q0[c], d0); d1 = dot8(kk, q1[c], d1); } }
            SC0[cnt * 64 + lane] = d0; SC1[cnt * 64 + lane] = d1; mx0 = fmaxf(mx0, d0); mx1 = fmaxf(mx1, d1); ++cnt; }
        mx0 = wave_max(mx0); mx1 = wave_max(mx1);
        float l0 = 0.f, l1 = 0.f;
        for (int i = lane; i < cnt * 64; i += 64) { const float p0 = __builtin_amdgcn_exp2f(SC0[i] - mx0), p1 = __builtin_amdgcn_exp2f(SC1[i] - mx1); l0 += p0; l1 += p1; SC0[i] = bfround(p0); SC1[i] = bfround(p1); }
        l0 = wave_sum(l0); l1 = wave_sum(l1);
        cnt = 0;
        for (unsigned long long r = mk; r; r &= r - 1ull) { const int j = __builtin_ctzll(r);
            const int kmax = min(64, t - 64 * j + 1);
            for (int kk = 0; kk < kmax; ++kk) { const float v = bf2f(Vs[(size_t)(b * SEQ + 64 * j + kk) * 256 + g * 64 + lane]); os0 += SC0[cnt * 64 + kk] * v; os1 += SC1[cnt * 64 + kk] * v; }
            ++cnt; }
        os0 /= l0; os1 /= l1;
    }
    float ow0 = 0.f, ow1 = 0.f;
    {
        const bf16* Kw = WSP(bf16, WS_KWIN); const bf16* Vw = WSP(bf16, WS_VWIN);
        const int slo = max(0, t - 511), nw = t - slo + 1;
        float mx0 = -INFINITY, mx1 = -INFINITY;
        for (int i = lane; i < nw; i += 64) { const u32x4* kp = (const u32x4*)(Kw + (size_t)(b * SEQ + slo + i) * 256 + g * 64); float d0 = 0.f, d1 = 0.f;
#pragma unroll
            for (int c = 0; c < 8; ++c) { const u32x4 kk = kp[c]; d0 = dot8(kk, q0[c], d0); d1 = dot8(kk, q1[c], d1); }
            SC0[i] = d0; SC1[i] = d1; mx0 = fmaxf(mx0, d0); mx1 = fmaxf(mx1, d1); }
        mx0 = wave_max(mx0); mx1 = wave_max(mx1);
        float l0 = 0.f, l1 = 0.f;
        for (int i = lane; i < nw; i += 64) { const float p0 = __builtin_amdgcn_exp2f(SC0[i] - mx0), p1 = __builtin_amdgcn_exp2f(SC1[i] - mx1); l0 += p0; l1 += p1; SC0[i] = bfround(p0); SC1[i] = bfround(p1); }
        l0 = wave_sum(l0); l1 = wave_sum(l1);
        for (int i = 0; i < nw; ++i) { const float v = bf2f(Vw[(size_t)(b * SEQ + slo + i) * 256 + g * 64 + lane]); ow0 += SC0[i] * v; ow1 += SC1[i] * v; }
        ow0 /= l0; ow1 /= l1;
    }
    O[(size_t)m * 1024 + h0 * 64 + lane] = (bf16)f2bf(gt[h0 * 3] * oc0 + gt[h0 * 3 + 1] * os0 + gt[h0 * 3 + 2] * ow0);
    O[(size_t)m * 1024 + (h0 + 1) * 64 + lane] = (bf16)f2bf(gt[h0 * 3 + 3] * oc1 + gt[h0 * 3 + 4] * os1 + gt[h0 * 3 + 5] * ow1);
    __syncthreads();
}

namespace ix {
__device__ __forceinline__ void unit(Frame& F, int b, int qb) {
    const int lane = F.lane, wid = F.wave, r32 = lane & 31, hh = lane >> 5;
    const int q0w = 32 * qb + 4 * wid;
    LAS unsigned char* lds = F.lds;
    bf16x8 af[4];
    { const int rho = r32, hsel = (rho >> 2) & 1, r = (rho & 3) + 4 * (rho >> 3), qq = q0w + 2 * hsel + (r >> 3), head = r & 7;
      const bf16* ap = WSP(bf16, WS_IQ) + ((size_t)b * SEQ + qq) * 512 + head * 64 + 8 * hh;
#pragma unroll
      for (int d0 = 0; d0 < 4; ++d0) af[d0] = *(const bf16x8*)(ap + 16 * d0); }
    float w[16];
    { const float* wp = WSP(float, SM_IW) + ((size_t)b * SEQ + q0w + 2 * hh) * 8;
#pragma unroll
      for (int i = 0; i < 4; ++i) { const f32x4 v = ((const f32x4*)wp)[i]; w[4 * i] = v.x; w[4 * i + 1] = v.y; w[4 * i + 2] = v.z; w[4 * i + 3] = v.w; } }
    const int NT = ((32 * qb + 31) >> 6) + 1;
    const bf16* IKb = WSP(bf16, WS_IK) + (size_t)b * SEQ * 64;
    float* SC = WSP(float, WS_SCORES) + ((size_t)b * SEQ + q0w + 2 * hh) * SEQ + r32;
#define IX_DMA(t, buf) __builtin_amdgcn_global_load_lds((const unsigned*)(IKb + (size_t)(64 * (t) + lane) * 64 + wid * 8), (LAS unsigned*)(lds + (buf) * 8192 + wid * 1024), 16, 0, 0)
    IX_DMA(0, 0);
    __syncthreads();
    for (int t = 0; t < NT; ++t) {
        if (t + 1 < NT) IX_DMA(t + 1, (t + 1) & 1);
        const LAS unsigned char* kb = lds + (t & 1) * 8192 + hh * 1024 + r32 * 16;
        f32x16 a0 = {}, a1 = {};
#pragma unroll
        for (int d0 = 0; d0 < 4; ++d0) {
            const bf16x8 b0 = *(const LAS bf16x8*)(kb + d0 * 2048), b1 = *(const LAS bf16x8*)(kb + d0 * 2048 + 512);
            a0 = __builtin_amdgcn_mfma_f32_32x32x16_bf16(af[d0], b0, a0, 0, 0, 0);
            a1 = __builtin_amdgcn_mfma_f32_32x32x16_bf16(af[d0], b1, a1, 0, 0, 0);
        }
        float sA0 = 0.f, sB0 = 0.f, sA1 = 0.f, sB1 = 0.f;
#pragma unroll
        for (int r = 0; r < 8; ++r) { sA0 += w[r] * fmaxf(a0[r], 0.f); sB0 += w[8 + r] * fmaxf(a0[8 + r], 0.f); sA1 += w[r] * fmaxf(a1[r], 0.f); sB1 += w[8 + r] * fmaxf(a1[8 + r], 0.f); }
        float* o = SC + 64 * t;
        o[0] = sA0; o[32] = sA1; o[SEQ] = sB0; o[SEQ + 32] = sB1;
        asm volatile("s_waitcnt vmcnt(4)" ::: "memory");
        __builtin_amdgcn_s_barrier();
    }
    asm volatile("s_waitcnt vmcnt(0)" ::: "memory");
#undef IX_DMA
}
__device__ __forceinline__ int cnt8(unsigned a0, unsigned a1, unsigned a2, unsigned a3, unsigned a4, unsigned a5, unsigned a6, unsigned a7, unsigned cand) {
    int c;
    asm("s_nop 1\n\tv_cmp_le_u32_e64 s[36:37], %9, %1\n\tv_cmp_le_u32_e64 s[38:39], %9, %2\n\tv_cmp_le_u32_e64 s[40:41], %9, %3\n\tv_cmp_le_u32_e64 s[42:43], %9, %4\n\t"
        "v_cmp_le_u32_e64 s[44:45], %9, %5\n\tv_cmp_le_u32_e64 s[46:47], %9, %6\n\tv_cmp_le_u32_e64 s[48:49], %9, %7\n\tv_cmp_le_u32_e64 s[50:51], %9, %8\n\t"
        "s_bcnt1_i32_b64 s36, s[36:37]\n\ts_bcnt1_i32_b64 s38, s[38:39]\n\ts_bcnt1_i32_b64 s40, s[40:41]\n\ts_bcnt1_i32_b64 s42, s[42:43]\n\t"
        "s_bcnt1_i32_b64 s44, s[44:45]\n\ts_bcnt1_i32_b64 s46, s[46:47]\n\ts_bcnt1_i32_b64 s48, s[48:49]\n\ts_bcnt1_i32_b64 s50, s[50:51]\n\t"
        "s_add_i32 s36, s36, s38\n\ts_add_i32 s40, s40, s42\n\ts_add_i32 s44, s44, s46\n\ts_add_i32 s48, s48, s50\n\ts_add_i32 s36, s36, s40\n\ts_add_i32 s44, s44, s48\n\ts_add_i32 %0, s36, s44"
        : "=s"(c) : "v"(a0), "v"(a1), "v"(a2), "v"(a3), "v"(a4), "v"(a5), "v"(a6), "v"(a7), "s"(cand)
        : "s36", "s37", "s38", "s39", "s40", "s41", "s42", "s43", "s44", "s45", "s46", "s47", "s48", "s49", "s50", "s51", "scc");
    return c;
}
template <int NJ>
__device__ __forceinline__ void select_row_t(Frame& F, int m) {
    const int lane = F.lane, b = m >> 12, t = m & 4095, n = t + 1;
    const float* row = WSP(float, WS_SCORES) + (size_t)m * SEQ + lane;
    unsigned k[NJ];
    {
        float v[NJ];
#pragma unroll
        for (int j = 0; j < NJ; ++j) v[j] = row[64 * j];
#pragma unroll
        for (int j = 0; j < NJ; ++j) k[j] = (64 * j + lane < n) ? okey(v[j]) : 0u;
    }
    unsigned thrg = 0u; int need = 0;
    if (n > 256) {
        unsigned prefix = 0u; bool exact = false;
        for (int bit = 31; bit >= 0; --bit) {
            const unsigned cand = prefix | (1u << bit);
            int c = 0;
#pragma unroll
            for (int j = 0; j < NJ; j += 8) c += cnt8(k[j], k[j + 1], k[j + 2], k[j + 3], k[j + 4], k[j + 5], k[j + 6], k[j + 7], cand);
            if (c >= 256) { prefix = cand; if (c == 256) { exact = true; break; } }
        }
        if (exact) { thrg = prefix - 1u; need = 0; }
        else { int cg = 0;
#pragma unroll
            for (int j = 0; j < NJ; j += 8) cg += cnt8(k[j], k[j + 1], k[j + 2], k[j + 3], k[j + 4], k[j + 5], k[j + 6], k[j + 7], prefix + 1u);
            thrg = prefix; need = 256 - cg; }
    }
    const unsigned long long lt = (1ull << lane) - 1ull;
    unsigned mlo = 0u, mhi = 0u;
    if (need == 0) {
#pragma unroll
        for (int j = 0; j < NJ; j += 8)
            asm("s_nop 1\n\tv_cmp_lt_u32_e64 s[36:37], %10, %2\n\tv_cmp_lt_u32_e64 s[38:39], %10, %3\n\tv_cmp_lt_u32_e64 s[40:41], %10, %4\n\tv_cmp_lt_u32_e64 s[42:43], %10, %5\n\t"
                "v_cmp_lt_u32_e64 s[44:45], %10, %6\n\tv_cmp_lt_u32_e64 s[46:47], %10, %7\n\tv_cmp_lt_u32_e64 s[48:49], %10, %8\n\tv_cmp_lt_u32_e64 s[50:51], %10, %9\n\ts_nop 3\n\t"
                "v_writelane_b32 %0, s36, %11\n\tv_writelane_b32 %1, s37, %11\n\tv_writelane_b32 %0, s38, %12\n\tv_writelane_b32 %1, s39, %12\n\t"
                "v_writelane_b32 %0, s40, %13\n\tv_writelane_b32 %1, s41, %13\n\tv_writelane_b32 %0, s42, %14\n\tv_writelane_b32 %1, s43, %14\n\t"
                "v_writelane_b32 %0, s44, %15\n\tv_writelane_b32 %1, s45, %15\n\tv_writelane_b32 %0, s46, %16\n\tv_writelane_b32 %1, s47, %16\n\t"
                "v_writelane_b32 %0, s48, %17\n\tv_writelane_b32 %1, s49, %17\n\tv_writelane_b32 %0, s50, %18\n\tv_writelane_b32 %1, s51, %18"
                : "+v"(mlo), "+v"(mhi) : "v"(k[j]), "v"(k[j + 1]), "v"(k[j + 2]), "v"(k[j + 3]), "v"(k[j + 4]), "v"(k[j + 5]), "v"(k[j + 6]), "v"(k[j + 7]), "s"(thrg),
                  "i"(j), "i"(j + 1), "i"(j + 2), "i"(j + 3), "i"(j + 4), "i"(j + 5), "i"(j + 6), "i"(j + 7)
                : "s36", "s37", "s38", "s39", "s40", "s41", "s42", "s43", "s44", "s45", "s46", "s47", "s48", "s49", "s50", "s51");
    } else {
        unsigned long long myw = 0ull; int ties = 0;
#pragma unroll
        for (int j = 0; j < NJ; ++j) {
            const bool gt = (k[j] > thrg), eq = (k[j] == thrg) && ((64 * j + lane) < n);
            const unsigned long long beq = __ballot(eq);
            const bool sel = gt || (eq && (ties + __popcll(beq & lt) < need)); ties += __popcll(beq);
            const unsigned long long bs = __ballot(sel);
            if (lane == j) myw = bs;
        }
        mlo = (unsigned)myw; mhi = (unsigned)(myw >> 32);
    }
    if (lane <= (t >> 6)) WSP(unsigned long long, WS_MASK)[((size_t)b * 64 + lane) * SEQ + t] = ((unsigned long long)mhi << 32) | mlo;
}
__device__ __forceinline__ void select_row(Frame& F, int m) {
    const int n = (m & 4095) + 1;
    if (n <= 1024) select_row_t<16>(F, m); else if (n <= 2048) select_row_t<32>(F, m); else if (n <= 3072) select_row_t<48>(F, m); else select_row_t<64>(F, m);
}
}

namespace fa {
typedef short s16x4 __attribute__((ext_vector_type(4)));
typedef short v4i16_t __attribute__((ext_vector_type(4)));
constexpr int KOFF = 0, VOFF = 16384, XOFF = 32768, OSTOFF = 36864, TOTOFF = 69632;
constexpr float THR = 8.0f;
__device__ __forceinline__ int crow(int r, int hi) { return (r & 3) + 8 * (r >> 2) + 4 * hi; }
typedef float f32x2_t __attribute__((ext_vector_type(2))); typedef __bf16 bf16x2_t __attribute__((ext_vector_type(2)));
__device__ __forceinline__ unsigned cvtpk(float lo, float hi) { f32x2_t v = {lo, hi}; bf16x2_t b = __builtin_convertvector(v, bf16x2_t); return __builtin_bit_cast(unsigned, b); }
struct Ctx { LAS unsigned char* lds; int lane, wid, r32, hi; };

__device__ __forceinline__ void dma_tile(const Ctx& c, const bf16* Kg, const bf16* Vg, int pitch, int t, int buf) {
    const bf16* ks = Kg + (size_t)(64 * t + c.lane) * pitch + c.wid * 8;
    __builtin_amdgcn_global_load_lds((const unsigned*)ks, (LAS unsigned*)(c.lds + KOFF + buf * 8192 + c.wid * 1024), 16, 0, 0);
    const bf16* vs = Vg + (size_t)(64 * t + 16 * (c.wid & 3) + (c.lane >> 2)) * pitch + (c.wid >> 2) * 32 + (c.lane & 3) * 8;
    __builtin_amdgcn_global_load_lds((const unsigned*)vs, (LAS unsigned*)(c.lds + VOFF + buf * 8192 + c.wid * 1024), 16, 0, 0);
}
__device__ __forceinline__ void qk(const Ctx& c, int buf, const f32x16& ci, f32x16& p0, f32x16& p1) {
    const LAS unsigned char* kb = c.lds + KOFF + buf * 8192 + c.hi * 1024 + c.r32 * 16;
    const LAS bf16x8* qs = (const LAS bf16x8*)(c.lds + OSTOFF + c.wid * 4096) + c.lane;
    p0 = ci; p1 = ci;
#pragma unroll
    for (int d0 = 0; d0 < 4; ++d0) {
        const bf16x8 b0 = *(const LAS bf16x8*)(kb + d0 * 2048), b1 = *(const LAS bf16x8*)(kb + d0 * 2048 + 512), q = qs[d0 * 64];
        p0 = __builtin_amdgcn_mfma_f32_32x32x16_bf16(b0, q, p0, 0, 0, 0);
        p1 = __builtin_amdgcn_mfma_f32_32x32x16_bf16(b1, q, p1, 0, 0, 0);
    }
}
__device__ __forceinline__ void park_q(const Ctx& c, const bf16* Qrow  ) {
    LAS bf16x8* qs = (LAS bf16x8*)(c.lds + OSTOFF + c.wid * 4096) + c.lane;
#pragma unroll
    for (int d0 = 0; d0 < 4; ++d0) qs[d0 * 64] = *(const bf16x8*)(Qrow + d0 * 16 + c.hi * 8);
}
__device__ __forceinline__ s16x4 vtr(const LAS unsigned char* p) { return __builtin_bit_cast(s16x4, __builtin_amdgcn_ds_read_tr16_b64_v4i16((LAS v4i16_t*)p)); }
__device__ __forceinline__ void pv(const Ctx& c, int buf, f32x16 (&o)[2], f32x16& lacc, const u32x4 (&pw)[4]) {
    const bf16x8 ones = {(short)0x3F80, (short)0x3F80, (short)0x3F80, (short)0x3F80, (short)0x3F80, (short)0x3F80, (short)0x3F80, (short)0x3F80};
    const LAS unsigned char* vp = c.lds + VOFF + buf * 8192 + ((c.lane >> 4) & 1) * 32 + (c.lane & 3) * 8 + (4 * c.hi + ((c.lane & 15) >> 2)) * 64;
#pragma unroll
    for (int d0 = 0; d0 < 2; ++d0) {
        s16x4 lo[4], hi[4];
#pragma unroll
        for (int ks = 0; ks < 4; ++ks) { lo[ks] = vtr(vp + d0 * 4096 + ks * 1024); hi[ks] = vtr(vp + d0 * 4096 + ks * 1024 + 512); }
#pragma unroll
        for (int ks = 0; ks < 4; ++ks) {
            const bf16x8 vf = {lo[ks][0], lo[ks][1], lo[ks][2], lo[ks][3], hi[ks][0], hi[ks][1], hi[ks][2], hi[ks][3]};
            o[d0] = __builtin_amdgcn_mfma_f32_32x32x16_bf16(__builtin_bit_cast(bf16x8, pw[ks]), vf, o[d0], 0, 0, 0);
        }
        }
#pragma unroll
    for (int ks = 0; ks < 4; ++ks) lacc = __builtin_amdgcn_mfma_f32_32x32x16_bf16(__builtin_bit_cast(bf16x8, pw[ks]), ones, lacc, 0, 0, 0);
}
struct State { f32x16 o[2]; f32x16 lacc; f32x16 negm; float m; };
__device__ __forceinline__ void reset(State& s) { s.o[0] = f32x16{}; s.o[1] = f32x16{}; s.lacc = f32x16{}; s.negm = f32x16{}; s.m = 0.f; }
__device__ __forceinline__ float rowmax(const f32x16& p0, const f32x16& p1) {
    float a = fmaxf(fmaxf(p0[0], p0[1]), p1[0]), b = fmaxf(fmaxf(p0[2], p0[3]), p1[1]); a = fmaxf(fmaxf(a, p1[2]), p1[3]);
#pragma unroll
    for (int r = 4; r < 16; r += 4) { a = fmaxf(fmaxf(a, p0[r]), p0[r + 1]); b = fmaxf(fmaxf(b, p0[r + 2]), p0[r + 3]); a = fmaxf(fmaxf(a, p1[r]), p1[r + 1]); b = fmaxf(fmaxf(b, p1[r + 2]), p1[r + 3]); }
    const float m = fmaxf(a, b);
    auto rr = __builtin_amdgcn_permlane32_swap(__builtin_bit_cast(unsigned, m), __builtin_bit_cast(unsigned, m), false, false);
    return fmaxf(__builtin_bit_cast(float, rr[0]), __builtin_bit_cast(float, rr[1]));
}
template <bool BITS>
__device__ __forceinline__ void tile_step(const Ctx& c, int buf, State& s, const f32x16& ci, bool first, unsigned w0, unsigned w1) {
    f32x16 p0, p1;
    qk(c, buf, ci, p0, p1);
    const float rm = rowmax(p0, p1);
    bool doit; float dl;
    if (first) { doit = true; dl = rm; } else { doit = __any(rm > THR); dl = fmaxf(rm, 0.f); }
    if (doit) {
        s.m += dl;
#pragma unroll
        for (int r = 0; r < 16; ++r) { p0[r] -= dl; p1[r] -= dl; s.negm[r] = -s.m; }
        if (!first) {
            const float f = __builtin_amdgcn_exp2f(-dl);
            LAS float* xs = (LAS float*)(c.lds + XOFF) + c.wid * 64;
            if (c.hi == 0) xs[c.r32] = f;
#pragma unroll
            for (int r = 0; r < 16; ++r) { const float fr = xs[crow(r, c.hi)]; s.o[0][r] *= fr; s.o[1][r] *= fr; s.lacc[r] *= fr; }
        }
    }
    if (BITS) { w0 >>= 4 * c.hi; w1 >>= 4 * c.hi; }
#pragma unroll
    for (int r = 0; r < 16; ++r) {
        float e0 = __builtin_amdgcn_exp2f(p0[r]), e1 = __builtin_amdgcn_exp2f(p1[r]);
        if (BITS) { const int sh = (r & 3) + 8 * (r >> 2);
            int m0_, m1_;
            asm("v_bfe_i32 %0, %1, %2, 1" : "=v"(m0_) : "v"(w0), "s"(sh)); asm("v_bfe_i32 %0, %1, %2, 1" : "=v"(m1_) : "v"(w1), "s"(sh));
            e0 = __builtin_bit_cast(float, __builtin_bit_cast(unsigned, e0) & (unsigned)m0_);
            e1 = __builtin_bit_cast(float, __builtin_bit_cast(unsigned, e1) & (unsigned)m1_); }
        p0[r] = e0; p1[r] = e1;
    }
    u32x4 pw[4];
    pw[0] = (u32x4){cvtpk(p0[0], p0[1]), cvtpk(p0[2], p0[3]), cvtpk(p0[4], p0[5]), cvtpk(p0[6], p0[7])};
    pw[1] = (u32x4){cvtpk(p0[8], p0[9]), cvtpk(p0[10], p0[11]), cvtpk(p0[12], p0[13]), cvtpk(p0[14], p0[15])};
    pw[2] = (u32x4){cvtpk(p1[0], p1[1]), cvtpk(p1[2], p1[3]), cvtpk(p1[4], p1[5]), cvtpk(p1[6], p1[7])};
    pw[3] = (u32x4){cvtpk(p1[8], p1[9]), cvtpk(p1[10], p1[11]), cvtpk(p1[12], p1[13]), cvtpk(p1[14], p1[15])};
    pv(c, buf, s.o, s.lacc, pw);
}
__device__ __forceinline__ void normalise(const Ctx& c, State& s, const LAS float* gl) {
#pragma unroll
    for (int r = 0; r < 16; ++r) { const float gq = gl ? gl[crow(r, c.hi)] : 1.0f; const float fr = s.lacc[r] > 0.f ? gq / s.lacc[r] : 0.f; s.o[0][r] *= fr; s.o[1][r] *= fr; }
}
__device__ __forceinline__ void causal_words(int qi, unsigned& w0, unsigned& w1) { const unsigned long long w = (qi >= 63) ? ~0ull : ((2ull << qi) - 1ull); w0 = (unsigned)w; w1 = (unsigned)(w >> 32); }
__device__ __forceinline__ void store_o(const Ctx& c, const f32x16 (&val)[2], unsigned char* Ow  ) {
    LAS float* stg = (LAS float*)(c.lds + OSTOFF + c.wid * 4096);
    LAS bf16* sb = (LAS bf16*)stg;
#pragma unroll
    for (int r = 0; r < 16; ++r) { const int orow = crow(r, c.hi);
#pragma unroll
        for (int d0 = 0; d0 < 2; ++d0) sb[orow * 64 + d0 * 32 + c.r32] = (bf16)f2bf(val[d0][r] * OS); }
    const int row = c.lane >> 1, hf = c.lane & 1;
    const u32x4 a = *(const LAS u32x4*)(sb + row * 64 + hf * 32), b = *(const LAS u32x4*)(sb + row * 64 + hf * 32 + 8), cq = *(const LAS u32x4*)(sb + row * 64 + hf * 32 + 16), dq = *(const LAS u32x4*)(sb + row * 64 + hf * 32 + 24);
    u32x4 o0, o1;
    o0.x = pk4_fp8(bflo(a.x), bfhi(a.x), bflo(a.y), bfhi(a.y)); o0.y = pk4_fp8(bflo(a.z), bfhi(a.z), bflo(a.w), bfhi(a.w)); o0.z = pk4_fp8(bflo(b.x), bfhi(b.x), bflo(b.y), bfhi(b.y)); o0.w = pk4_fp8(bflo(b.z), bfhi(b.z), bflo(b.w), bfhi(b.w));
    o1.x = pk4_fp8(bflo(cq.x), bfhi(cq.x), bflo(cq.y), bfhi(cq.y)); o1.y = pk4_fp8(bflo(cq.z), bfhi(cq.z), bflo(cq.w), bfhi(cq.w)); o1.z = pk4_fp8(bflo(dq.x), bfhi(dq.x), bflo(dq.y), bfhi(dq.y)); o1.w = pk4_fp8(bflo(dq.z), bfhi(dq.z), bflo(dq.w), bfhi(dq.w));
    *(u32x4*)(Ow + (size_t)row * 1024 + hf * 32) = o0; *(u32x4*)(Ow + (size_t)row * 1024 + hf * 32 + 16) = o1;
}
__device__ __forceinline__ void store_o_bf16(const Ctx& c, const f32x16 (&val)[2], bf16* Ow) {
    LAS bf16* stg = (LAS bf16*)(c.lds + OSTOFF) + c.wid * 2048;
#pragma unroll
    for (int r = 0; r < 16; ++r) { const int orow = crow(r, c.hi);
#pragma unroll
        for (int d0 = 0; d0 < 2; ++d0) stg[orow * 64 + d0 * 32 + c.r32] = (bf16)f2bf(val[d0][r]); }
#pragma unroll
    for (int i = 0; i < 4; ++i) { const int row = i * 8 + (c.lane >> 3), ch = c.lane & 7; const u32x4 v = *(const LAS u32x4*)(stg + row * 64 + ch * 8); *(u32x4*)(Ow + (size_t)row * 1024 + ch * 8) = v; }
}

__device__ __forceinline__ void dsa_unit(Frame& F, int b, int g, int qt) {
    Ctx c; c.lds = F.lds; c.lane = F.lane; c.wid = F.wave; c.r32 = F.lane & 31; c.hi = F.lane >> 5;
    const int h = 4 * g + (c.wid >> 1), qw = 64 * qt + 32 * (c.wid & 1);
    const size_t mrow = (size_t)b * SEQ + qw;
    const bf16* Q = LWSP(bf16, WS_Q0) + (mrow + c.r32) * 1024 + h * 64;
    park_q(c, Q);
    const bf16* Kg = LWSP(bf16, WS_K0) + (size_t)b * SEQ * 256 + g * 64; const bf16* Vg = LWSP(bf16, WS_V0) + (size_t)b * SEQ * 256 + g * 64;
    typedef __attribute__((address_space(1))) const u32x2* gmask_t;
    const gmask_t MK = (gmask_t)(const u32x2*)(LWSP(unsigned long long, WS_MASK) + (size_t)b * 64 * SEQ + qw + c.r32);
    State s; reset(s);
    const int NT = qt + 1;
    dma_tile(c, Kg, Vg, 256, 0, 0);
    u32x2 mk_next = MK[0];
    __syncthreads();
    for (int t = 0; t < NT; ++t) {
        const u32x2 mk = mk_next;
        if (t + 1 < NT) { dma_tile(c, Kg, Vg, 256, t + 1, (t + 1) & 1); mk_next = MK[(size_t)(t + 1) * SEQ]; }
        tile_step<true>(c, t & 1, s, s.negm, t == 0, mk.x, mk.y);
        __syncthreads();
    }
    normalise(c, s, nullptr);
    store_o(c, s.o, LWSP(unsigned char, WS_O0) + mrow * 1024 + h * 64);
}

__device__ __forceinline__ void nsa_unit(Frame& F, int b, int g, int qt) {
    Ctx c; c.lds = F.lds; c.lane = F.lane; c.wid = F.wave; c.r32 = F.lane & 31; c.hi = F.lane >> 5;
    const int h = 4 * g + (c.wid >> 1), qw = 64 * qt + 32 * (c.wid & 1), qi = 32 * (c.wid & 1) + c.r32;
    const size_t mrow = (size_t)b * SEQ + qw;
    park_q(c, LWSP(bf16, WS_Q1) + (mrow + c.r32) * 1024 + h * 64);
    const unsigned long long sel = LWSP(unsigned long long, WS_SEL)[((size_t)b * 4 + g) * SEQ + qw + c.r32];
    LAS float* gx = (LAS float*)(c.lds + XOFF + 2048) + c.wid * 64;
    gx[c.lane] = LWSP(float, SM_GATES)[(mrow + c.r32) * 48 + h * 3 + 1 + c.hi];
    LAS float* totw = (LAS float*)(c.lds + TOTOFF) + c.wid * 2048;
    LAS float* totl = totw + c.r32;
    State s;
    {
        const bf16* Kg = LWSP(bf16, WS_KSLC) + (size_t)b * SEQ * 256 + g * 64; const bf16* Vg = LWSP(bf16, WS_VSLC) + (size_t)b * SEQ * 256 + g * 64;
        reset(s);
        dma_tile(c, Kg, Vg, 256, 0, 0);
        __syncthreads();
        for (int t = 0; t <= qt; ++t) {
            if (t < qt) dma_tile(c, Kg, Vg, 256, t + 1, (t + 1) & 1);
            const bool on = (sel >> t) & 1ull;
            if (!on) {
#pragma unroll
                for (int r = 0; r < 16; ++r) s.negm[r] = -INFINITY; }
            if (t == qt) { unsigned w0, w1; causal_words(qi, w0, w1); tile_step<true>(c, t & 1, s, s.negm, t == 0, w0, w1); }
            else tile_step<false>(c, t & 1, s, s.negm, t == 0, 0u, 0u);
#pragma unroll
            for (int r = 0; r < 16; ++r) s.negm[r] = -s.m;
            __syncthreads();
        }
        normalise(c, s, gx);
#pragma unroll
        for (int r = 0; r < 16; ++r) { totl[crow(r, c.hi) * 64] = s.o[0][r]; totl[crow(r, c.hi) * 64 + 32] = s.o[1][r]; }
    }
    {
        const bf16* Kg = LWSP(bf16, WS_KWIN) + (size_t)b * SEQ * 256 + g * 64; const bf16* Vg = LWSP(bf16, WS_VWIN) + (size_t)b * SEQ * 256 + g * 64;
        reset(s);
        const int tlo = qt >= 8 ? qt - 8 : 0;
        dma_tile(c, Kg, Vg, 256, tlo, tlo & 1);
        __syncthreads();
        for (int t = tlo; t <= qt; ++t) {
            if (t < qt) dma_tile(c, Kg, Vg, 256, t + 1, (t + 1) & 1);
            if (t == qt) { unsigned w0, w1; causal_words(qi, w0, w1); tile_step<true>(c, t & 1, s, s.negm, t == tlo, w0, w1); }
            else if (t == qt - 8) { unsigned w0, w1; causal_words(qi, w0, w1); tile_step<true>(c, t & 1, s, s.negm, t == tlo, ~w0, ~w1); }
            else tile_step<false>(c, t & 1, s, s.negm, t == tlo, 0u, 0u);
            __syncthreads();
        }
        normalise(c, s, gx + 32);
#pragma unroll
        for (int r = 0; r < 16; ++r) { totl[crow(r, c.hi) * 64] += s.o[0][r]; totl[crow(r, c.hi) * 64 + 32] += s.o[1][r]; }
    }
    const bf16* OCG = LWSP(bf16, WS_OCG) + mrow * 1024 + h * 64; unsigned char* O = LWSP(unsigned char, WS_O1) + mrow * 1024 + h * 64;
#pragma unroll
    for (int i = 0; i < 8; ++i) { const int row = i * 4 + (c.lane >> 4), ch = c.lane & 15;
        const u32x2 oc = *(const u32x2*)(OCG + (size_t)row * 1024 + 4 * ch);
        const f32x4 v = (*(const LAS f32x4*)(totw + row * 64 + 4 * ch) + (f32x4){bflo(oc.x), bfhi(oc.x), bflo(oc.y), bfhi(oc.y)}) * OS;
        *(unsigned*)(O + (size_t)row * 1024 + 4 * ch) = pk4_fp8(v.x, v.y, v.z, v.w); }
}
__device__ __forceinline__ void unit_of(int v, int i, int& b, int& g, int& qt) { const int bg = v >> 4, p = v & 15; b = bg >> 2; g = bg & 3; qt = (i == 0) ? p : (i == 1) ? 63 - p : (i == 2) ? 31 - p : 32 + p; }
}

namespace fp {
using fa::Ctx; using fa::crow; using fa::cvtpk; using fa::vtr; using fa::s16x4; using fa::causal_words;
constexpr int SLOTB = 8192, LK = 0, LV = 3 * SLOTB, LX = 6 * SLOTB, LOST = LX + 4096, LQ = LOST + 8 * 4096;
constexpr float THR = 8.0f;
enum { SW_DSA = 0, SW_SLC = 1, SW_WIN = 2 };
#define FP_SBAR() __builtin_amdgcn_sched_barrier(0)
#define FP_PIN(x) asm volatile("" : "+v"(x))
#define FP_MFMA(a, b, c) __builtin_amdgcn_mfma_f32_32x32x16_bf16(a, b, c, 0, 0, 0)
#define FP_WAIT_BAR(N) asm volatile("s_waitcnt vmcnt(" #N ") lgkmcnt(0)\n\ts_barrier" ::: "memory")
#define FP_MX3(a, b, c) __builtin_fmaxf(__builtin_fmaxf((a), (b)), (c))
typedef const LAS char* lds_cptr;
__device__ __forceinline__ void glds16s(const char* base  , unsigned off, LAS unsigned char* l  ) {
    const unsigned a = __builtin_amdgcn_readfirstlane((unsigned)(unsigned long)l);
    asm volatile("s_nop 4\n\ts_mov_b32 m0, %2\n\ts_nop 0\n\tglobal_load_lds_dwordx4 %0, %1" :: "v"(off), "s"(base), "s"(a) : "memory", "m0");
}
__device__ __forceinline__ float rowmax(const f32x16& p0, const f32x16& p1) {
    float a = FP_MX3(p0[0], p0[1], p1[0]), b = FP_MX3(p0[2], p0[3], p1[1]); a = FP_MX3(a, p1[2], p1[3]);
#pragma unroll
    for (int r = 4; r < 16; r += 4) { a = FP_MX3(a, p0[r], p0[r + 1]); b = FP_MX3(b, p0[r + 2], p0[r + 3]); a = FP_MX3(a, p1[r], p1[r + 1]); b = FP_MX3(b, p1[r + 2], p1[r + 3]); }
    const float m = __builtin_fmaxf(a, b); auto rr = __builtin_amdgcn_permlane32_swap(__builtin_bit_cast(unsigned, m), __builtin_bit_cast(unsigned, m), false, false);
    return __builtin_bit_cast(float, rr[0]); }
__device__ __forceinline__ float pair_sum(float v) { return v + __shfl_xor(v, 32); }
__device__ __forceinline__ void kload2(bf16x8* kf, lds_cptr kp, int d0) { kf[2 * d0] = *(const LAS bf16x8*)(kp + d0 * 2048); kf[2 * d0 + 1] = *(const LAS bf16x8*)(kp + d0 * 2048 + 512); }
#define FP_MBIT(e, w, SH) ({ int m_; asm("v_bfe_i32 %0, %1, %2, 1" : "=v"(m_) : "v"(w), "n"(SH)); __builtin_bit_cast(float, __builtin_bit_cast(unsigned, (e)) & (unsigned)m_); })
template <int SW>
__device__ __forceinline__ void sweep(const Ctx& c, const bf16* Kg, const bf16* Vg, const int NT, const u32x2* MK, const unsigned long long sel, const int qi, f32x16 (&o)[2], float& l_out) {
    const int lane = c.lane, r32 = c.r32, hi = c.hi, wid = c.wid;
    LAS float* wsf = (LAS float*)(c.lds + LX) + wid * 64;
    const unsigned koff = (unsigned)(lane * 256 + wid * 8) * 2u;
    const unsigned voff = (unsigned)((16 * (wid & 3) + (lane >> 2)) * 256 + (wid >> 2) * 32 + (lane & 3) * 8) * 2u;
    LAS unsigned char* kdst = c.lds + LK + wid * 1024; LAS unsigned char* vdst = c.lds + LV + wid * 1024;
#define FP_DMA_K(t, slot) glds16s((const char*)Kg + (size_t)(t) * (64 * 256 * 2), koff, kdst + (slot))
#define FP_DMA_V(t, slot) glds16s((const char*)Vg + (size_t)(t) * (64 * 256 * 2), voff, vdst + (slot))
    const lds_cptr vp0 = (lds_cptr)c.lds + LV + ((lane >> 4) & 1) * 32 + (lane & 3) * 8 + (4 * hi + ((lane & 15) >> 2)) * 64;
    const lds_cptr kp0 = (lds_cptr)c.lds + LK + hi * 1024 + r32 * 16;
    const LAS bf16x8* qs = (const LAS bf16x8*)(c.lds + LQ + wid * 4096) + lane;
    bf16x8 qr_[4];
#pragma unroll
    for (int d0 = 0; d0 < 4; ++d0) qr_[d0] = qs[d0 * 64];
#define FP_Q(d0) qr_[(d0)]
    bf16x8 qa, qb;
    constexpr int KS = (SW == SW_DSA) ? 1 : (SW == SW_SLC) ? 2 : 0;
    u32x2 mkN = {0u, 0u}; unsigned w0s = 0u, w1s = 0u; bool onv = true; (void)onv; (void)mkN;
    auto words = [&](int j, unsigned& a0, unsigned& a1) {
        unsigned x0 = ~0u, x1 = ~0u;
        if (SW == SW_DSA) { u32x2 m_ = mkN; asm volatile("" : "+v"(m_.x), "+v"(m_.y)); x0 = m_.x; x1 = m_.y; }
        else { if (j == NT - 1) causal_words(qi, x0, x1); else if (SW == SW_WIN && j == 0 && NT == 9) { causal_words(qi, x0, x1); x0 = ~x0; x1 = ~x1; }
               if (SW == SW_SLC && !((sel >> j) & 1ull)) { x0 = 0u; x1 = 0u; } }
        a0 = x0 >> (4 * hi); a1 = x1 >> (4 * hi); };
    typedef __attribute__((address_space(1))) const u32x2* gmask_t; const gmask_t MKG = (gmask_t)MK;
    if (SW == SW_DSA) mkN = MKG[0];
    FP_DMA_K(0, 0); FP_DMA_V(0, 0); if (NT > 1) FP_DMA_K(1, SLOTB); if (NT > 2) FP_DMA_K(2, 2 * SLOTB);
    float mhat = 0.f, l_reg = 0.f; o[0] = f32x16{}; o[1] = f32x16{};
    f32x16 negm;
    { float z_ = 0.f; asm volatile("" : "+v"(z_));
#pragma unroll
      for (int r = 0; r < 16; ++r) negm[r] = z_; }
    bool resc = false;
    f32x16 pA0, pA1, pB0, pB1; bf16x8 kf[8]; s16x4 vlo[8], vhi[8]; u32x4 pw0, pw1, pw2, pw3;
    int sl_prev = 0, sl_cur = 0, sl_next = SLOTB;
#define FP_ROT() do { sl_prev = sl_cur; sl_cur = sl_next; sl_next = (sl_next == 2 * SLOTB) ? 0 : sl_next + SLOTB; } while (0)
#define FP_RESC() do { if (resc) { _Pragma("unroll") for (int d_ = 0; d_ < 2; ++d_) _Pragma("unroll") for (int r = 0; r < 16; ++r) o[d_][r] *= wsf[crow(r, hi)]; } } while (0)
    if (NT > 2) FP_WAIT_BAR(3); else if (NT > 1) FP_WAIT_BAR(2); else FP_WAIT_BAR(1);
    _Pragma("unroll") for (int d0 = 0; d0 < 4; ++d0) kload2(kf, kp0, d0);
    qa = FP_Q(0); qb = FP_Q(1);
    pA0 = FP_MFMA(kf[0], qa, negm); pA1 = FP_MFMA(kf[1], qa, negm); pA0 = FP_MFMA(kf[2], qb, pA0); pA1 = FP_MFMA(kf[3], qb, pA1);
    qa = FP_Q(2); qb = FP_Q(3);
    pA0 = FP_MFMA(kf[4], qa, pA0); pA1 = FP_MFMA(kf[5], qa, pA1); pA0 = FP_MFMA(kf[6], qb, pA0); pA1 = FP_MFMA(kf[7], qb, pA1);
    qa = FP_Q(0);
    { words(0, w0s, w1s);
      const float rm = rowmax(pA0, pA1); mhat = rm;
#pragma unroll
      for (int r = 0; r < 16; ++r) { const int sh = (r & 3) + 8 * (r >> 2);
          const float e0 = __builtin_amdgcn_exp2f(pA0[r] - rm), e1 = __builtin_amdgcn_exp2f(pA1[r] - rm);
          pA0[r] = ((w0s >> sh) & 1u) ? e0 : 0.f; pA1[r] = ((w1s >> sh) & 1u) ? e1 : 0.f; negm[r] = -rm; } }
    FP_WAIT_BAR(0);
    if (SW == SW_DSA && NT > 1) mkN = MKG[SEQ];
    if (NT > 3) FP_DMA_K(3, 0); if (NT > 1) { FP_DMA_V(1, SLOTB); FP_ROT(); }
    if (NT > 1) { _Pragma("unroll") for (int d0 = 0; d0 < 4; ++d0) kload2(kf, kp0 + sl_cur, d0); }
    if (NT > 3) FP_WAIT_BAR(2); else if (NT == 3) FP_WAIT_BAR(1); else FP_WAIT_BAR(0);
#define FP_PKW(P, i) cvtpk(P[i], P[i + 1])
#define FP_PAF(k) __builtin_bit_cast(bf16x8, pw##k)
#define FP_VFR(i) (bf16x8){vlo[i][0], vlo[i][1], vlo[i][2], vlo[i][3], vhi[i][0], vhi[i][1], vhi[i][2], vhi[i][3]}
#define FP_VRD(i) do { vlo[i] = vtr((const LAS unsigned char*)(vp_ + (((i) >> 2) * 4096 + ((i) & 3) * 1024))); vhi[i] = vtr((const LAS unsigned char*)(vp_ + (((i) >> 2) * 4096 + ((i) & 3) * 1024 + 512))); } while (0)
#define FP_KRD(G, d0) do { if (G) { kload2(kf, kp0 + sl_next, d0); FP_SBAR(); } } while (0)
#define FP_GAPA(MF, a0, a1, a2, a3, W0, W1, PW) do { MF; sacc += a0; sacc += a1; sacc += a2; sacc += a3; W0; W1; FP_PIN(PW); FP_PIN(sacc); FP_SBAR(); } while (0)
#define FP_EXM(KIND, X, W, k, SHB) X[k] = ((KIND) == 1) ? FP_MBIT(__builtin_amdgcn_exp2f(X[k]), W, (SHB)) : ((KIND) == 2) ? (onv ? __builtin_amdgcn_exp2f(X[k]) : 0.f) : __builtin_amdgcn_exp2f(X[k])
#define FP_GAPB(MF, KIND, X, W, i) do { MF; FP_EXM(KIND, X, W, i, 2 * (i)); FP_EXM(KIND, X, W, (i) + 1, 2 * (i) + 1); FP_EXM(KIND, X, W, (i) + 2, 2 * (i) + 2); FP_EXM(KIND, X, W, (i) + 3, 2 * (i) + 3); FP_PIN(X); FP_SBAR(); } while (0)
#define FP_STEP(C0, C1, P0, P1, t, KIND, MSET, GK, GVL) do { FP_SBAR(); \
    const lds_cptr vp_ = vp0 + sl_prev; \
    FP_VRD(0); qb = FP_Q(1); FP_SBAR(); float sacc = P0[0] + P0[1]; \
                       FP_GAPA(C0 = FP_MFMA(kf[0], qa, negm), P0[2], P0[3], P0[4], P0[5],     pw0[0] = FP_PKW(P0, 0),  pw0[1] = FP_PKW(P0, 2),  pw0); \
    FP_VRD(4); FP_SBAR(); FP_GAPA(C1 = FP_MFMA(kf[1], qa, negm), P0[6], P0[7], P0[8], P0[9],     pw0[2] = FP_PKW(P0, 4),  pw0[3] = FP_PKW(P0, 6),  pw0); \
    FP_VRD(1); qa = FP_Q(2); FP_SBAR(); FP_GAPA(C0 = FP_MFMA(kf[2], qb, C0),   P0[10], P0[11], P0[12], P0[13], pw1[0] = FP_PKW(P0, 8),  pw1[1] = FP_PKW(P0, 10), pw1); \
    FP_VRD(5); FP_SBAR(); FP_GAPA(C1 = FP_MFMA(kf[3], qb, C1),   P0[14], P0[15], P1[0], P1[1],   pw1[2] = FP_PKW(P0, 12), pw1[3] = FP_PKW(P0, 14), pw1); \
    qb = FP_Q(3); FP_SBAR(); FP_GAPA(C0 = FP_MFMA(kf[4], qa, C0),   P1[2], P1[3], P1[4], P1[5],     pw2[0] = FP_PKW(P1, 0),  pw2[1] = FP_PKW(P1, 2),  pw2); \
    FP_GAPA(C1 = FP_MFMA(kf[5], qa, C1),   P1[6], P1[7], P1[8], P1[9],     pw2[2] = FP_PKW(P1, 4),  pw2[3] = FP_PKW(P1, 6),  pw2); \
    FP_GAPA(C0 = FP_MFMA(kf[6], qb, C0),   P1[10], P1[11], P1[12], P1[13], pw3[0] = FP_PKW(P1, 8),  pw3[1] = FP_PKW(P1, 10), pw3); \
    FP_GAPA(C1 = FP_MFMA(kf[7], qb, C1),   P1[14], P1[15], 0.f, 0.f,       pw3[2] = FP_PKW(P1, 12), pw3[3] = FP_PKW(P1, 14), pw3); \
    l_reg += sacc; \
    MSET; \
    if (SW == SW_DSA && (GVL)) mkN = MKG[(size_t)((t) + 1) * SEQ];                                                          \
    if (GK) FP_DMA_K((t) + 3, sl_cur); if (GVL) FP_DMA_V((t) + 1, sl_next); \
    { const float rm = rowmax(C0, C1); resc = false;                                                                         \
      if (__builtin_expect(__any(rm > THR), 0)) { const float dl = __builtin_fmaxf(rm, 0.f); mhat += dl; \
          const float f = __builtin_amdgcn_exp2f(-dl); l_reg *= f; if (hi == 0) wsf[r32] = f; resc = true; \
          _Pragma("unroll") for (int r = 0; r < 16; ++r) { C0[r] -= dl; C1[r] -= dl; negm[r] = -mhat; } } } \
    FP_SBAR(); \
    FP_VRD(2); FP_SBAR(); FP_GAPB(o[0] = FP_MFMA(FP_PAF(0), FP_VFR(0), o[0]), KIND, C0, w0s, 0);  FP_VRD(6); FP_SBAR(); FP_GAPB(o[1] = FP_MFMA(FP_PAF(0), FP_VFR(4), o[1]), KIND, C0, w0s, 4);     \
    FP_VRD(3); FP_SBAR(); FP_GAPB(o[0] = FP_MFMA(FP_PAF(1), FP_VFR(1), o[0]), KIND, C0, w0s, 8);  FP_VRD(7); FP_SBAR(); FP_GAPB(o[1] = FP_MFMA(FP_PAF(1), FP_VFR(5), o[1]), KIND, C0, w0s, 12); \
    FP_KRD(GVL, 0); FP_GAPB(o[0] = FP_MFMA(FP_PAF(2), FP_VFR(2), o[0]), KIND, C1, w1s, 0);  FP_KRD(GVL, 1); FP_GAPB(o[1] = FP_MFMA(FP_PAF(2), FP_VFR(6), o[1]), KIND, C1, w1s, 4);           \
    FP_KRD(GVL, 2); FP_GAPB(o[0] = FP_MFMA(FP_PAF(3), FP_VFR(3), o[0]), KIND, C1, w1s, 8);  if (GVL) { kload2(kf, kp0 + sl_next, 3); qa = FP_Q(0); FP_SBAR(); }  FP_GAPB(o[1] = FP_MFMA(FP_PAF(3), FP_VFR(7), o[1]), KIND, C1, w1s, 12); \
    } while (0)
#define FP_ENDW(tt) do { if ((tt) + 3 < NT) { FP_WAIT_BAR(2); } else if ((tt) + 2 < NT) { FP_WAIT_BAR(1); } else { FP_WAIT_BAR(0); } } while (0)
#define FP_MSET_S(t) do { if (KS == 1) words((t), w0s, w1s); else if (KS == 2) onv = (sel >> (t)) & 1ull; } while (0)
#define FP_MSET_L(t) words((t), w0s, w1s)
#define FP_DRAIN(P0, P1) do { float sacc = P0[0] + P0[1]; \
      _Pragma("unroll") for (int r = 2; r < 16; ++r) sacc += P0[r]; \
      _Pragma("unroll") for (int r = 0; r < 16; ++r) sacc += P1[r]; \
      l_reg += sacc; \
      pw0 = (u32x4){FP_PKW(P0, 0), FP_PKW(P0, 2), FP_PKW(P0, 4), FP_PKW(P0, 6)}; pw1 = (u32x4){FP_PKW(P0, 8), FP_PKW(P0, 10), FP_PKW(P0, 12), FP_PKW(P0, 14)}; \
      pw2 = (u32x4){FP_PKW(P1, 0), FP_PKW(P1, 2), FP_PKW(P1, 4), FP_PKW(P1, 6)}; pw3 = (u32x4){FP_PKW(P1, 8), FP_PKW(P1, 10), FP_PKW(P1, 12), FP_PKW(P1, 14)}; \
      const lds_cptr vp_ = vp0 + sl_cur; _Pragma("unroll") for (int i = 0; i < 8; ++i) FP_VRD(i); \
      o[0] = FP_MFMA(FP_PAF(0), FP_VFR(0), o[0]); o[1] = FP_MFMA(FP_PAF(0), FP_VFR(4), o[1]); o[0] = FP_MFMA(FP_PAF(1), FP_VFR(1), o[0]); o[1] = FP_MFMA(FP_PAF(1), FP_VFR(5), o[1]); \
      o[0] = FP_MFMA(FP_PAF(2), FP_VFR(2), o[0]); o[1] = FP_MFMA(FP_PAF(2), FP_VFR(6), o[1]); o[0] = FP_MFMA(FP_PAF(3), FP_VFR(3), o[0]); o[1] = FP_MFMA(FP_PAF(3), FP_VFR(7), o[1]); } while (0)
    const int S = NT - 1; int t = 1;
    if (S >= 1) {
        if (!(S & 1)) {
            FP_STEP(pB0, pB1, pA0, pA1, 1, KS, FP_MSET_S(1), (4 < NT), true); FP_ENDW(1); FP_RESC(); FP_ROT();
            pA0 = pB0; pA1 = pB1; t = 2;
        }
        for (; t < S; t += 2) {
            FP_STEP(pB0, pB1, pA0, pA1, t, KS, FP_MSET_S(t), (t + 3 < NT), true);         FP_ENDW(t);     FP_RESC(); FP_ROT();
            FP_STEP(pA0, pA1, pB0, pB1, t + 1, KS, FP_MSET_S(t + 1), (t + 4 < NT), true); FP_ENDW(t + 1); FP_RESC(); FP_ROT();
        }
        FP_STEP(pB0, pB1, pA0, pA1, S, 1, FP_MSET_L(S), false, false); FP_RESC();
    } else { pB0 = pA0; pB1 = pA1; }
    FP_DRAIN(pB0, pB1);
    l_out = l_reg;
    asm volatile("s_waitcnt lgkmcnt(0)\n\ts_barrier" ::: "memory");
#undef FP_Q
#undef FP_DMA_K
#undef FP_DMA_V
#undef FP_ROT
#undef FP_RESC
#undef FP_PKW
#undef FP_PAF
#undef FP_VFR
#undef FP_VRD
#undef FP_KRD
#undef FP_GAPA
#undef FP_EXM
#undef FP_GAPB
#undef FP_STEP
#undef FP_ENDW
#undef FP_MSET_S
#undef FP_MSET_L
#undef FP_DRAIN
}
__device__ __forceinline__ void park_qf(const Ctx& c, const bf16* Qrow) {
    LAS bf16x8* qs = (LAS bf16x8*)(c.lds + LQ + c.wid * 4096) + c.lane;
#pragma unroll
    for (int d0 = 0; d0 < 4; ++d0) qs[d0 * 64] = *(const bf16x8*)(Qrow + d0 * 16 + c.hi * 8);
}
__device__ __forceinline__ void scale_rows(const Ctx& c, f32x16 (&o)[2], float fac) {
    LAS float* wsf = (LAS float*)(c.lds + LX) + c.wid * 64;
    if (c.hi == 0) wsf[32 + c.r32] = fac;
#pragma unroll
    for (int r = 0; r < 16; ++r) { const float f = wsf[32 + crow(r, c.hi)]; o[0][r] *= f; o[1][r] *= f; }
}
__device__ __forceinline__ void dsa_unit(Frame& F, int b, int g, int qt) {
    int ln_ = F.lane; asm volatile("" : "+v"(ln_));
    Ctx c; c.lds = F.lds; c.lane = ln_; c.wid = F.wave; c.r32 = ln_ & 31; c.hi = ln_ >> 5;
    const int h = 4 * g + (c.wid >> 1), qw = 64 * qt + 32 * (c.wid & 1);
    const size_t mrow = (size_t)b * SEQ + qw;
    park_qf(c, LWSP(bf16, WS_Q0) + (mrow + c.r32) * 1024 + h * 64);
    const bf16* Kg = LWSP(bf16, WS_K0) + (size_t)b * SEQ * 256 + g * 64; const bf16* Vg = LWSP(bf16, WS_V0) + (size_t)b * SEQ * 256 + g * 64;
    const u32x2* MK = (const u32x2*)(LWSP(unsigned long long, WS_MASK) + (size_t)b * 64 * SEQ + qw + c.r32);
    f32x16 o[2]; float l;
    sweep<SW_DSA>(c, Kg, Vg, qt + 1, MK, 0ull, 0, o, l);
    l = pair_sum(l);
    scale_rows(c, o, l > 0.f ? 1.0f / l : 0.f);
    LAS bf16* sb = (LAS bf16*)(c.lds + LOST + c.wid * 4096);
#pragma unroll
    for (int r = 0; r < 16; ++r) { const int orow = crow(r, c.hi);
#pragma unroll
        for (int d0 = 0; d0 < 2; ++d0) sb[orow * 64 + d0 * 32 + c.r32] = (bf16)f2bf(o[d0][r] * OS); }
    unsigned char* Ow = LWSP(unsigned char, WS_O0) + mrow * 1024 + h * 64;
    const int row = c.lane >> 1, hf = c.lane & 1;
    const u32x4 a = *(const LAS u32x4*)(sb + row * 64 + hf * 32), bq = *(const LAS u32x4*)(sb + row * 64 + hf * 32 + 8), cq = *(const LAS u32x4*)(sb + row * 64 + hf * 32 + 16), dq = *(const LAS u32x4*)(sb + row * 64 + hf * 32 + 24);
    u32x4 o0, o1;
    o0.x = pk4_fp8(bflo(a.x), bfhi(a.x), bflo(a.y), bfhi(a.y)); o0.y = pk4_fp8(bflo(a.z), bfhi(a.z), bflo(a.w), bfhi(a.w)); o0.z = pk4_fp8(bflo(bq.x), bfhi(bq.x), bflo(bq.y), bfhi(bq.y)); o0.w = pk4_fp8(bflo(bq.z), bfhi(bq.z), bflo(bq.w), bfhi(bq.w));
    o1.x = pk4_fp8(bflo(cq.x), bfhi(cq.x), bflo(cq.y), bfhi(cq.y)); o1.y = pk4_fp8(bflo(cq.z), bfhi(cq.z), bflo(cq.w), bfhi(cq.w)); o1.z = pk4_fp8(bflo(dq.x), bfhi(dq.x), bflo(dq.y), bfhi(dq.y)); o1.w = pk4_fp8(bflo(dq.z), bfhi(dq.z), bflo(dq.w), bfhi(dq.w));
    *(u32x4*)(Ow + (size_t)row * 1024 + hf * 32) = o0; *(u32x4*)(Ow + (size_t)row * 1024 + hf * 32 + 16) = o1;
}
__device__ __forceinline__ void nsa_unit(Frame& F, int b, int g, int qt) {
    int ln_ = F.lane; asm volatile("" : "+v"(ln_));
    Ctx c; c.lds = F.lds; c.lane = ln_; c.wid = F.wave; c.r32 = ln_ & 31; c.hi = ln_ >> 5;
    const int h = 4 * g + (c.wid >> 1), qw = 64 * qt + 32 * (c.wid & 1), qi = 32 * (c.wid & 1) + c.r32;
    const size_t mrow = (size_t)b * SEQ + qw;
    park_qf(c, LWSP(bf16, WS_Q1) + (mrow + c.r32) * 1024 + h * 64);
    const unsigned long long sel = LWSP(unsigned long long, WS_SEL)[((size_t)b * 4 + g) * SEQ + qw + c.r32];
    LAS float* gx = (LAS float*)(c.lds + LX + 2048) + c.wid * 64;
    gx[c.lane] = LWSP(float, SM_GATES)[(mrow + c.r32) * 48 + h * 3 + 1 + c.hi];
    LAS bf16* stg = (LAS bf16*)(c.lds + LOST + c.wid * 4096);
    f32x16 o[2]; float l;
    {
        const bf16* Kg = LWSP(bf16, WS_KSLC) + (size_t)b * SEQ * 256 + g * 64; const bf16* Vg = LWSP(bf16, WS_VSLC) + (size_t)b * SEQ * 256 + g * 64;
        sweep<SW_SLC>(c, Kg, Vg, qt + 1, nullptr, sel, qi, o, l);
        l = pair_sum(l);
        scale_rows(c, o, l > 0.f ? gx[c.r32] / l : 0.f);
#pragma unroll
        for (int r = 0; r < 16; ++r) { const int orow = crow(r, c.hi);
#pragma unroll
            for (int d0 = 0; d0 < 2; ++d0) stg[orow * 64 + d0 * 32 + c.r32] = (bf16)f2bf(o[d0][r]); }
    }
    {
        const int tlo = qt >= 8 ? qt - 8 : 0;
        const bf16* Kg = LWSP(bf16, WS_KWIN) + ((size_t)b * SEQ + 64 * tlo) * 256 + g * 64; const bf16* Vg = LWSP(bf16, WS_VWIN) + ((size_t)b * SEQ + 64 * tlo) * 256 + g * 64;
        sweep<SW_WIN>(c, Kg, Vg, qt - tlo + 1, nullptr, 0ull, qi, o, l);
        l = pair_sum(l);
        scale_rows(c, o, l > 0.f ? gx[32 + c.r32] / l : 0.f);
#pragma unroll
        for (int r = 0; r < 16; ++r) { const int orow = crow(r, c.hi);
#pragma unroll
            for (int d0 = 0; d0 < 2; ++d0) { LAS bf16* p = stg + orow * 64 + d0 * 32 + c.r32; *p = (bf16)f2bf(o[d0][r] + bf2f((unsigned)*p)); } }
    }
    const bf16* OCG = LWSP(bf16, WS_OCG) + mrow * 1024 + h * 64; unsigned char* O = LWSP(unsigned char, WS_O1) + mrow * 1024 + h * 64;
#pragma unroll
    for (int i = 0; i < 4; ++i) { const int row = i * 8 + (c.lane >> 3), ch = c.lane & 7;
        const u32x4 oc = *(const u32x4*)(OCG + (size_t)row * 1024 + 8 * ch), sv = *(const LAS u32x4*)(stg + row * 64 + 8 * ch);
        u32x2 w; w.x = pk4_fp8((bflo(oc.x) + bflo(sv.x)) * OS, (bfhi(oc.x) + bfhi(sv.x)) * OS, (bflo(oc.y) + bflo(sv.y)) * OS, (bfhi(oc.y) + bfhi(sv.y)) * OS);
        w.y = pk4_fp8((bflo(oc.z) + bflo(sv.z)) * OS, (bfhi(oc.z) + bfhi(sv.z)) * OS, (bflo(oc.w) + bflo(sv.w)) * OS, (bfhi(oc.w) + bfhi(sv.w)) * OS);
        *(u32x2*)(O + (size_t)row * 1024 + 8 * ch) = w; }
}
#undef FP_SBAR
#undef FP_PIN
#undef FP_MFMA
#undef FP_WAIT_BAR
#undef FP_MX3
#undef FP_MBIT
}

namespace cm {
using namespace fa;
constexpr int IMPOFF = 69632;
__device__ __forceinline__ void unit(Frame& F, int b, int g, int qt) {
    Ctx c; c.lds = F.lds; c.lane = F.lane; c.wid = F.wave; c.r32 = F.lane & 31; c.hi = F.lane >> 5;
    const int hr = c.wid >> 1, h = 4 * g + hr, qw = 64 * qt + 32 * (c.wid & 1), qi = 32 * (c.wid & 1) + c.r32;
    const size_t mrow = (size_t)b * SEQ + qw;
    park_q(c, LWSP(bf16, WS_Q1) + (mrow + c.r32) * 1024 + h * 64);
    LAS float* gx = (LAS float*)(c.lds + XOFF + 2048) + c.wid * 64;
    if (c.hi == 0) gx[c.r32] = LWSP(float, SM_GATES)[(mrow + c.r32) * 48 + h * 3];
    const int t = qw + c.r32, nv = t >= 31 ? min(255, (t - 31) / 16 + 1) : 0;
    const bf16* Kg = LWSP(bf16, SM_KC) + (size_t)(b * 4 + g) * 256 * 64; const bf16* Vg = LWSP(bf16, SM_VC) + (size_t)(b * 4 + g) * 256 * 64;
    const int NTc = (qt >> 4) + 1;
    f32x16 o[2]; o[0] = f32x16{}; o[1] = f32x16{};
    f32x16 zero = {};
    float m = 0.f, l = 0.f, carry = 0.f;
    float bsum[4][8];
#pragma unroll
    for (int T_ = 0; T_ < 4; ++T_)
#pragma unroll
        for (int i = 0; i < 8; ++i) bsum[T_][i] = 0.f;
    dma_tile(c, Kg, Vg, 64, 0, 0);
    __syncthreads();
#pragma unroll
    for (int T_ = 0; T_ < 4; ++T_) {
        if (T_ < NTc) {
            if (T_ + 1 < NTc) dma_tile(c, Kg, Vg, 64, T_ + 1, (T_ + 1) & 1);
            f32x16 p0, p1;
            qk(c, T_ & 1, zero, p0, p1);
            __builtin_amdgcn_sched_barrier(0);
            const float rm = rowmax(p0, p1) - m;
            bool doit; float dl;
            if (T_ == 0) { doit = true; dl = rm; } else { doit = __any(rm > THR); dl = fmaxf(rm, 0.f); }
            if (doit) {
                m += dl;
                if (T_ > 0) {
                    const float f = __builtin_amdgcn_exp2f(-dl);
                    l *= f; carry *= f;
#pragma unroll
                    for (int u = 0; u < 4; ++u)
#pragma unroll
                        for (int i = 0; i < 8; ++i) bsum[u][i] *= f;
                    LAS float* xs = (LAS float*)(c.lds + XOFF) + c.wid * 64;
                    if (c.hi == 0) xs[c.r32] = f;
#pragma unroll
                    for (int r = 0; r < 16; ++r) { const float fr = xs[crow(r, c.hi)]; o[0][r] *= fr; o[1][r] *= fr; }
                }
            }
            const int cnt = nv - 64 * T_;
            const unsigned long long wm = cnt >= 64 ? ~0ull : (cnt <= 0 ? 0ull : ((1ull << cnt) - 1ull));
            const unsigned w0 = (unsigned)wm >> (4 * c.hi), w1 = (unsigned)(wm >> 32) >> (4 * c.hi);
            float ls = 0.f;
#pragma unroll
            for (int r = 0; r < 16; ++r) { const int sh = (r & 3) + 8 * (r >> 2);
                float e0 = __builtin_amdgcn_exp2f(p0[r] - m), e1 = __builtin_amdgcn_exp2f(p1[r] - m);
                e0 = __builtin_bit_cast(float, __builtin_bit_cast(unsigned, e0) & (unsigned)__builtin_amdgcn_sbfe((int)w0, sh, 1));
                e1 = __builtin_bit_cast(float, __builtin_bit_cast(unsigned, e1) & (unsigned)__builtin_amdgcn_sbfe((int)w1, sh, 1));
                p0[r] = e0; p1[r] = e1; ls += e0 + e1; }
            l += ls;
            float mn0[4], mn1[4], rc0[4], rc1[4];
#pragma unroll
            for (int i = 0; i < 4; ++i) { const float s0 = 0.5f * p0[4 * i + 3], s1 = 0.5f * p1[4 * i + 3];
                mn0[i] = (p0[4 * i] + p0[4 * i + 1]) + (p0[4 * i + 2] + s0); mn1[i] = (p1[4 * i] + p1[4 * i + 1]) + (p1[4 * i + 2] + s1);
                rc0[i] = __shfl_xor(s0, 32); rc1[i] = __shfl_xor(s1, 32); }
            if (c.hi) {
#pragma unroll
                for (int i = 0; i < 4; ++i) { bsum[T_][i] = mn0[i] + rc0[i]; bsum[T_][4 + i] = mn1[i] + rc1[i]; }
            } else {
                bsum[T_][0] = mn0[0] + carry; bsum[T_][4] = mn1[0] + rc0[3];
#pragma unroll
                for (int i = 1; i < 4; ++i) { bsum[T_][i] = mn0[i] + rc0[i - 1]; bsum[T_][4 + i] = mn1[i] + rc1[i - 1]; }
                carry = rc1[3];
            }
            u32x4 pw[4];
            pw[0] = (u32x4){cvtpk(p0[0], p0[1]), cvtpk(p0[2], p0[3]), cvtpk(p0[4], p0[5]), cvtpk(p0[6], p0[7])};
            pw[1] = (u32x4){cvtpk(p0[8], p0[9]), cvtpk(p0[10], p0[11]), cvtpk(p0[12], p0[13]), cvtpk(p0[14], p0[15])};
            pw[2] = (u32x4){cvtpk(p1[0], p1[1]), cvtpk(p1[2], p1[3]), cvtpk(p1[4], p1[5]), cvtpk(p1[6], p1[7])};
            pw[3] = (u32x4){cvtpk(p1[8], p1[9]), cvtpk(p1[10], p1[11]), cvtpk(p1[12], p1[13]), cvtpk(p1[14], p1[15])};
            __builtin_amdgcn_sched_barrier(0);
            {
                const LAS unsigned char* vp = c.lds + VOFF + (T_ & 1) * 8192 + ((c.lane >> 4) & 1) * 32 + (c.lane & 3) * 8 + (4 * c.hi + ((c.lane & 15) >> 2)) * 64;
#pragma unroll
                for (int d0 = 0; d0 < 2; ++d0) {
                    s16x4 lo[4], hi4[4];
#pragma unroll
                    for (int ks = 0; ks < 4; ++ks) { lo[ks] = vtr(vp + d0 * 4096 + ks * 1024); hi4[ks] = vtr(vp + d0 * 4096 + ks * 1024 + 512); }
#pragma unroll
                    for (int ks = 0; ks < 4; ++ks) { const bf16x8 vf = {lo[ks][0], lo[ks][1], lo[ks][2], lo[ks][3], hi4[ks][0], hi4[ks][1], hi4[ks][2], hi4[ks][3]};
                        o[d0] = __builtin_amdgcn_mfma_f32_32x32x16_bf16(__builtin_bit_cast(bf16x8, pw[ks]), vf, o[d0], 0, 0, 0); }
                    __builtin_amdgcn_sched_barrier(0);
                }
            }
            __syncthreads();
        }
    }
    l += __shfl_xor(l, 32);
    const float inv = l > 0.f ? 1.0f / l : 0.f;
    LAS float* imp = (LAS float*)(c.lds + IMPOFF) + (hr * 64 + qi) * 64;
#pragma unroll
    for (int T_ = 0; T_ < 4; ++T_)
#pragma unroll
        for (int i = 0; i < 4; ++i) { imp[16 * T_ + 2 * i + c.hi] = bsum[T_][i] * inv; imp[16 * T_ + 8 + 2 * i + c.hi] = bsum[T_][4 + i] * inv; }
    {
        LAS float* xs = (LAS float*)(c.lds + XOFF) + c.wid * 64;
        if (c.hi == 0) xs[c.r32] = inv * gx[c.r32];
#pragma unroll
        for (int r = 0; r < 16; ++r) { const float fr = xs[crow(r, c.hi)]; o[0][r] *= fr; o[1][r] *= fr; }
        store_o_bf16(c, o, LWSP(bf16, WS_OCG) + mrow * 1024 + h * 64);
    }
    __syncthreads();
    {
        const LAS float* I0 = (const LAS float*)(c.lds + IMPOFF);
        const int j = c.lane;
        for (int qq = 8 * c.wid; qq < 8 * c.wid + 8; ++qq) {
            const float iv = (I0[(0 * 64 + qq) * 64 + j] + I0[(1 * 64 + qq) * 64 + j]) + (I0[(2 * 64 + qq) * 64 + j] + I0[(3 * 64 + qq) * 64 + j]);
            const bool valid = j <= qt, forced = valid && ((j == 0) || (j == qt) || (j + 1 == qt)), cnd = valid && !forced;
            const unsigned long long bf = __ballot(forced), bc = __ballot(cnd);
            const int K = 16 - __popcll(bf);
            unsigned long long bsel = bc;
            if (__popcll(bc) > K) {
                const unsigned key = cnd ? okey(iv) : 0u;
                unsigned prefix = 0u; bool exact = false;
                for (int bit = 31; bit >= 0; --bit) { const unsigned cand = prefix | (1u << bit); const int cn = __popcll(__ballot(key >= cand)); if (cn >= K) { prefix = cand; if (cn == K) { exact = true; break; } } }
                if (exact) bsel = __ballot(key >= prefix);
                else { const unsigned long long bg = __ballot(key > prefix), be = __ballot(key == prefix); const int need = K - __popcll(bg);
                    const bool tk = (key == prefix) && (__popcll(be & ((1ull << j) - 1ull)) < need); bsel = bg | __ballot(tk); }
            }
            const unsigned long long mk = bf | bsel;
            if (j == 0) LWSP(unsigned long long, WS_SEL)[((size_t)b * 4 + g) * SEQ + 64 * qt + qq] = mk;
        }
    }
    __syncthreads();
}
}


#if DBG_CHECK
__device__ __forceinline__ void dbg_compare(Frame& F, const bf16* A, const bf16* R, int slot) {
    float sd = 0.f, sr = 0.f;
    for (size_t i = (size_t)F.gw * 64 + F.lane; i < (size_t)T * D / 2; i += (size_t)F.NGW * 64) { const unsigned a = ((const unsigned*)A)[i], r = ((const unsigned*)R)[i];
        const float d0 = bflo(a) - bflo(r), d1 = bfhi(a) - bfhi(r); sd += d0 * d0 + d1 * d1; sr += bflo(r) * bflo(r) + bfhi(r) * bfhi(r); }
    sd = wave_sum(sd); sr = wave_sum(sr);
    if (F.lane == 0) { atomicAdd((float*)(F.ctl + CW_DBG + slot), sd); atomicAdd((float*)(F.ctl + CW_DBG + slot + 1), sr); }
}
#endif
__device__ __forceinline__ f32x4 yrow(const bf16* Y, const bf16* Yp, int slot, int i) {
    if (slot < 128 * 256) { const u32x2 v = ((const u32x2*)(Y + (size_t)slot * D))[i]; return (f32x4){bflo(v.x), bfhi(v.x), bflo(v.y), bfhi(v.y)}; }
    f32x4 a = {0.f, 0.f, 0.f, 0.f};
#pragma unroll
    for (int q = 0; q < 2; ++q) { const u32x2 v = ((const u32x2*)(Yp + (size_t)q * NE * 256 * D + (size_t)(slot - 128 * 256) * D))[i]; a += (f32x4){bflo(v.x), bfhi(v.x), bflo(v.y), bfhi(v.y)}; }
    return a;
}
constexpr int NPHASE = 22;
struct Args { const void* in[29]; float* out; unsigned char* ws; int ph_lo, ph_hi, li, pad; };
__global__ void __launch_bounds__(NWAVES * 64, 2) trunk_fwd(Args args) {
    extern __shared__ __attribute__((aligned(16))) unsigned char lds[];
const int wave_s = __builtin_amdgcn_readfirstlane((int)threadIdx.x >> 6);
#define MKFRAME() Frame F; F.lds = (LAS unsigned char*)lds; F.MISC = (volatile LAS unsigned*)(F.lds + MISC_OFF); F.wave = wave_s; F.lane = lane_id(); F.tid = wave_s * 64 + F.lane; F.G = gridDim.x; F.gw = blockIdx.x * NWAVES + F.wave; F.NGW = F.G * NWAVES; F.ws = args.ws; F.ctl = (unsigned*)(args.ws + WS_CTL); F.x = (const float*)args.in[0]; F.c = (const float*)args.in[1]; F.pos = (const int*)args.in[2]; F.attn_gain = (const float*)args.in[3]; F.ffn_gain = (const float*)args.in[4]; F.w_ada = (const float*)args.in[5]; F.b_ada = (const float*)args.in[6]; F.a_w_in = (const float*)args.in[7]; F.a_w_out = (const float*)args.in[8]; F.b_w_q = (const float*)args.in[9]; F.b_w_out = (const float*)args.in[10]; F.kv_gain = (const float*)args.in[11]; F.w_kv_ada = (const float*)args.in[12]; F.b_kv_ada = (const float*)args.in[13]; F.w_kv = (const float*)args.in[14]; F.pe_k = (const float*)args.in[15]; F.w1_k = (const float*)args.in[16]; F.w2_k = (const float*)args.in[17]; F.pe_v = (const float*)args.in[18]; F.w1_v = (const float*)args.in[19]; F.w2_v = (const float*)args.in[20]; F.ffn_wg = (const float*)args.in[21]; F.ffn_wu = (const float*)args.in[22]; F.ffn_wd = (const float*)args.in[23]; F.w_router = (const float*)args.in[24]; F.moe_wg = (const float*)args.in[25]; F.moe_wu = (const float*)args.in[26]; F.moe_wd = (const float*)args.in[27]; F.final_gain = (const float*)args.in[28]; F.out = args.out; F.outw = args.pad ? (float*)(args.ws + WS_DRY) : args.out;
    { MKFRAME();
    for (int u = F.tid; u < (LDS_BYTES - LDSCTL_OFF) / 4; u += NWAVES * 64) ((LAS unsigned*)(F.lds + LDSCTL_OFF))[u] = 0u;
    __syncthreads(); }
    XcdBarrier bar; bar.bar = (unsigned*)(args.ws + WS_CTL) + CW_BAR + args.li * XCD_BAR_WORDS; bar.x = 0; bar.st = nullptr;
    if (!MK_PER_PHASE) bar = xcd_barrier_post((unsigned*)(args.ws + WS_CTL) + CW_BAR + args.li * XCD_BAR_WORDS, (volatile LAS unsigned*)((LAS unsigned char*)lds + MISC_OFF) + 8, wave_s == 0 && lane_id() == 0);
#define GRID_BAR() do { if (!MK_PER_PHASE) xcd_barrier(bar, wave_s == 0 && lane_id() == 0); } while (0)
#define GRID_BAR_ALWAYS() do { static_assert(!MK_PER_PHASE, "a seam inside a phase needs the one-launch build"); xcd_barrier(bar, wave_s == 0 && lane_id() == 0); } while (0)
    const int lo = args.ph_lo, hi = args.ph_hi;
#if DBG_TIME
    volatile LAS unsigned long long* tsl = (volatile LAS unsigned long long*)(F.lds + LDSCTL_OFF + 1024);
#define IN(k) ((lo <= (k) && (k) < hi) && (((blockIdx.x == 0 && F.tid == 0) ? (void)(tsl[(k)] = __builtin_amdgcn_s_memrealtime()) : (void)0), true))
#else
#define IN(k) (lo <= (k) && (k) < hi)
#endif
#define BOTH(k) (IN(k) && IN((k) + 1))
#define MOD0 WSP(float, SM_MOD0)
#define MOD1 WSP(float, SM_MOD1)
#define KVMOD WSP(float, SM_KVMOD)
#define CS WSP(float, SM_COS)
#define SN WSP(float, SM_SIN)

    if (IN(0)) { MKFRAME(); p0_prologue(F); if (BOTH(0)) GRID_BAR(); }
    if (IN(1)) { MKFRAME(); norm_phase(F, F.x, F.attn_gain, MOD0, 6144, 0, 1024, WSP(bf16, WS_U)); if (BOTH(1)) GRID_BAR(); }
    if (IN(2)) { MKFRAME();
        pg8::Gemm g{WSP(bf16, WS_U), WSP(bf16, WB_IN), D, D, D}; pg8::StaticOrder S; S.init(T, 2048, F.G, (int)blockIdx.x);
        EpiIn E{WSP(bf16, WS_Q0), WSP(bf16, WS_K0), WSP(bf16, WS_V0), WSP(bf16, WS_IQ), WSP(bf16, WS_IK), WSP(float, SM_IW), CS, SN};
        pg8::gemm_phase(F.lds, g, S, E, F.wave);
        for (int it0 = 2 * blockIdx.x; it0 < T / 32; it0 += 2 * F.G) {
            const int lane = F.lane, half = F.wave >> 2, wq = F.wave & 3, row0 = 32 * (it0 + half), kw = 256 * wq;
            const bf16* ap = WSP(bf16, WS_U) + (size_t)(row0 + (lane & 31)) * D + 8 * (lane >> 5) + kw;
            const bf16* bp = WSP(bf16, WB_IKW) + (size_t)(lane & 31) * D + 8 * (lane >> 5) + kw;
            f32x16 a1 = {}, a2 = {}, a3 = {};
#pragma unroll
            for (int k = 0; k < 256; k += 16) { const bf16x8 a = *(const bf16x8*)(ap + k);
                a1 = __builtin_amdgcn_mfma_f32_32x32x16_bf16(a, *(const bf16x8*)(bp + k), a1, 0, 0, 0);
                a2 = __builtin_amdgcn_mfma_f32_32x32x16_bf16(a, *(const bf16x8*)(bp + 32 * D + k), a2, 0, 0, 0);
                a3 = __builtin_amdgcn_mfma_f32_32x32x16_bf16(a, *(const bf16x8*)(bp + 64 * D + k), a3, 0, 0, 0); }
            LAS float* red = (LAS float*)F.lds + F.wave * 3072 + lane;
#pragma unroll
            for (int r = 0; r < 16; ++r) { red[r * 64] = a1[r]; red[1024 + r * 64] = a2[r]; red[2048 + r * 64] = a3[r]; }
            __syncthreads();
            const int d = lane & 31; bf16* IKo = WSP(bf16, WS_IK); float* IWo = WSP(float, SM_IW);
#pragma unroll
            for (int rr = 0; rr < 4; ++rr) { const int r = 4 * wq + rr; float x1 = 0.f, x2 = 0.f, x3 = 0.f;
#pragma unroll
                for (int w = 0; w < 4; ++w) { const LAS float* q = (const LAS float*)F.lds + (4 * half + w) * 3072 + r * 64 + lane; x1 += q[0]; x2 += q[1024]; x3 += q[2048]; }
                const int row = row0 + (r & 3) + 8 * (r >> 2) + 4 * (lane >> 5);
                const float c = CS[(size_t)row * 32 + d], sn = SN[(size_t)row * 32 + d];
                IKo[(size_t)row * 64 + d] = (bf16)f2bf(x1 * c - x2 * sn); IKo[(size_t)row * 64 + 32 + d] = (bf16)f2bf(x2 * c + x1 * sn);
                if (d < 8) IWo[(size_t)row * 8 + d] = x3 * IWS; }
            __syncthreads();
        }
        if (BOTH(2)) GRID_BAR();
    }
    if (IN(3)) { MKFRAME();
        for (int p = blockIdx.x; p < 256; p += F.G) { const int b = p >> 6, q = p & 63;
#pragma unroll 1
            for (int u = 0; u < 2; ++u) ix::unit(F, b, u ? 127 - q : q);
#pragma unroll 1
            for (int i = 0; i < 8; ++i) ix::select_row(F, b * SEQ + 32 * ((i & 1) ? 127 - q : q) + 4 * F.wave + (i >> 1)); }
        if (BOTH(3)) GRID_BAR(); }
    if (IN(4)) { MKFRAME(); }
    if (IN(5)) { MKFRAME();
        const int v = (F.G == 256) ? ((int)(blockIdx.x & 7) * 32 + (int)(blockIdx.x >> 3)) : (int)blockIdx.x;
        for (int vv = v; vv < 256; vv += F.G) for (int i = 0; i < 4; ++i) { int b, g, qt; fa::unit_of(vv, i, b, g, qt); fp::dsa_unit(F, b, g, qt); }
#if DBG_CHECK
        for (int m = blockIdx.x; m < T; m += F.G) dsa_naive_item(F, m, WSP(bf16, WS_DBG_O0), nullptr);
        GRID_BAR_ALWAYS(); dbg_compare(F, WSP(bf16, WS_O0), WSP(bf16, WS_DBG_O0), 0);
#endif
        if (BOTH(5)) GRID_BAR(); }
    if (IN(6)) { MKFRAME();
        pg8::Gemm g{WSP(bf16, WS_O0), WSP(bf16, WB_O0), D / 2, D / 2, D / 2}; pg8::StaticOrder S; S.init(T, D, F.G, (int)blockIdx.x);
        EpiRes E{F.x, F.out, MOD0 + 2048, 6144, 1.0f / (SW_GU * OS)};
        pg8::gemm_phase<EpiRes, pg8::StaticOrder, true>(F.lds, g, S, E, F.wave);
        if (BOTH(6)) GRID_BAR();
    }
    if (IN(7)) { MKFRAME();
        norm_phase(F, F.out, F.ffn_gain, MOD0, 6144, 3072, 4096, WSP(bf16, WS_U), true);
        { LAS float* scr = (LAS float*)(F.lds + F.wave * 16896); for (int it = F.gw; it < NCONV_B; it += F.NGW) conv_item_b(F, it, scr); }
        if (BOTH(7)) GRID_BAR();
    }
    if (IN(8)) { MKFRAME();
        pg8::Gemm g{WSP(bf16, WS_U), WSP(bf16, WB_GU0), D / 2, D / 2, D / 2}; pg8::StaticOrder S; S.init(T, 2 * FF0, F.G, (int)blockIdx.x);
        EpiSwiglu E{WSP(unsigned char, WS_HID), FF0, 2 * FF0 / 256};
        pg8::gemm_phase<EpiSwiglu, pg8::StaticOrder, true>(F.lds, g, S, E, F.wave);
        if (BOTH(8)) GRID_BAR();
    }
    if (IN(9)) { MKFRAME();
        pg8::Gemm g{WSP(bf16, WS_HID), WSP(bf16, WB_D0), FF0 / 2, FF0 / 2, FF0 / 2}; pg8::StaticOrder S; S.init(T, D, F.G, (int)blockIdx.x);
        EpiRes E{F.out, F.outw, MOD0 + 5120, 6144, 1.0f / (SW_DN * HS)};
        pg8::gemm_phase<EpiRes, pg8::StaticOrder, true>(F.lds, g, S, E, F.wave);
        if (BOTH(9)) GRID_BAR();
    }
    if (IN(10)) { MKFRAME();
        for (int m = F.gw; m < T; m += F.NGW) {
            f32x4 v[4], u[4]; load_row(F.out + (size_t)m * D, F.lane, v);
            const float r = row_rs(v); const int b = m >> 12;
            modulate_row(v, r, F.kv_gain, KVMOD + (size_t)b * 2048, KVMOD + (size_t)b * 2048 + 1024, F.lane, u);
            store_row_fp8(WSP(unsigned char, WS_U) + (size_t)m * D, F.lane, u);
            modulate_row(v, r, F.attn_gain + D, MOD1 + (size_t)b * 6144, MOD1 + (size_t)b * 6144 + 1024, F.lane, u);
            store_row_fp8(WSP(unsigned char, WS_U) + (size_t)(T + m) * D, F.lane, u);
        }
        if (BOTH(10)) GRID_BAR();
    }
    if (IN(11)) { MKFRAME();
        pg8::Gemm g{WSP(bf16, WS_U), WSP(bf16, WB_KVQ), D / 2, D / 2, D / 2}; KvqOrder S; S.S.init(T, 11 * 256, F.G, (int)blockIdx.x);
        EpiKVQ E{WSP(bf16, WS_KCMP), WSP(bf16, WS_VCMP), WSP(bf16, WS_KSLC), WSP(bf16, WS_VSLC), WSP(bf16, WS_KWIN), WSP(bf16, WS_VWIN), WSP(bf16, WS_Q1), WSP(float, SM_GATES), CS, SN};
        pg8::gemm_phase<EpiKVQ, KvqOrder, true>(F.lds, g, S, E, F.wave);
        if (BOTH(11)) GRID_BAR();
    }
    if (IN(12)) { MKFRAME();
        const float* cb = WSP(float, SM_CBIAS);
        LAS bf16* HL = (LAS bf16*)F.lds;
        for (int rt = blockIdx.x; rt < 256; rt += F.G) {
            const int kv = rt >> 7, lane = F.lane;
            const bf16* A = kv ? WSP(bf16, WS_VCMP) : WSP(bf16, WS_KCMP);
            const f32x16 acc = sgemm_tile(A, 1024, WSP(bf16, WB_C1) + (size_t)kv * 256 * 2048, 2048, 2048, (rt & 127) * 32, F.wave * 32, lane);
            const int col = F.wave * 32 + (lane & 31); const float bias = cb[kv * 256 + col];
#pragma unroll
            for (int r = 0; r < 16; ++r) { const int row = (r & 3) + 8 * (r >> 2) + 4 * (lane >> 5); HL[row * 264 + col] = (bf16)f2bf(gelu_tanh(acc[r] + bias)); }
            __syncthreads();
            if (F.wave < 2) {
                f32x16 o = {};
                const LAS bf16* ap = HL + (lane & 31) * 264 + 8 * (lane >> 5);
                const bf16* bp = WSP(bf16, WB_C2) + (size_t)kv * 64 * 256 + (size_t)(F.wave * 32 + (lane & 31)) * 256 + 8 * (lane >> 5);
#pragma unroll
                for (int k = 0; k < 256; k += 16) o = __builtin_amdgcn_mfma_f32_32x32x16_bf16(*(const LAS bf16x8*)(ap + k), *(const bf16x8*)(bp + k), o, 0, 0, 0);
                bf16* dst = kv ? WSP(bf16, SM_VC) : WSP(bf16, SM_KC);
                const int oc = F.wave * 32 + (lane & 31);
#pragma unroll
                for (int r = 0; r < 16; ++r) { const int row = (rt & 127) * 32 + (r & 3) + 8 * (r >> 2) + 4 * (lane >> 5); dst[(size_t)row * 64 + oc] = ((row & 255) == 255) ? (bf16)0 : (bf16)f2bf(o[r]); }
            }
            __syncthreads();
        }
        if (BOTH(12)) GRID_BAR();
    }
    if (IN(13)) { }
    if (IN(14)) { MKFRAME();
        const int v = (F.G == 256) ? ((int)(blockIdx.x & 7) * 32 + (int)(blockIdx.x >> 3)) : (int)blockIdx.x;
        for (int vv = v; vv < 256; vv += F.G) for (int i = 0; i < 4; ++i) { int b, g, qt; fa::unit_of(vv, i, b, g, qt); cm::unit(F, b, g, qt); }
        if (BOTH(14)) GRID_BAR(); }
    if (IN(15)) { MKFRAME();
        const int v = (F.G == 256) ? ((int)(blockIdx.x & 7) * 32 + (int)(blockIdx.x >> 3)) : (int)blockIdx.x;
        for (int vv = v; vv < 256; vv += F.G) for (int i = 0; i < 4; ++i) { int b, g, qt; fa::unit_of(vv, i, b, g, qt); fp::nsa_unit(F, b, g, qt); }
#if DBG_CHECK
        GRID_BAR_ALWAYS();
        for (int m = blockIdx.x; m < T; m += F.G) nsa_naive_item(F, m, WSP(bf16, WS_DBG_O1), nullptr, nullptr);
        GRID_BAR_ALWAYS(); dbg_compare(F, WSP(bf16, WS_O1), WSP(bf16, WS_DBG_O1), 2);
#endif
        if (BOTH(15)) GRID_BAR(); }
    if (IN(16)) { MKFRAME();
        pg8::Gemm g{WSP(bf16, WS_O1), WSP(bf16, WB_O1), D / 2, D / 2, D / 2}; pg8::StaticOrder S; S.init(T, D, F.G, (int)blockIdx.x);
        EpiRes E{F.out, F.outw, MOD1 + 2048, 6144, 1.0f / (SW_GU * OS)};
        pg8::gemm_phase<EpiRes, pg8::StaticOrder, true>(F.lds, g, S, E, F.wave);
        if (BOTH(16)) GRID_BAR();
    }
    if (IN(17)) { MKFRAME();
        LAS int* lcnt = (LAS int*)(F.lds);
        if (F.tid < NE) lcnt[F.tid] = 0;
        __syncthreads();
        int* toke = WSP(int, SM_TOKE); float* tokw = WSP(float, SM_TOKW);
        for (int m = F.gw; m < T; m += F.NGW) {
            f32x4 v[4], u[4]; load_row(F.out + (size_t)m * D, F.lane, v);
            const float r = row_rs(v); const int b = m >> 12;
            modulate_row(v, r, F.ffn_gain + D, MOD1 + (size_t)b * 6144 + 3072, MOD1 + (size_t)b * 6144 + 4096, F.lane, u);
            store_row_fp8(WSP(unsigned char, WS_UM) + (size_t)m * D, F.lane, u);
            float lg[NE];
#pragma unroll
            for (int e = 0; e < NE; ++e) lg[e] = 0.f;
#pragma unroll
            for (int j = 0; j < 4; ++j) {
                const float uu[4] = {u[j].x, u[j].y, u[j].z, u[j].w};
#pragma unroll
                for (int q = 0; q < 4; ++q) { const float* wr = F.w_router + (size_t)(4 * F.lane + 256 * j + q) * NE; const f32x4 w0 = *(const f32x4*)wr, w1 = *(const f32x4*)(wr + 4);
                    lg[0] += uu[q] * w0.x; lg[1] += uu[q] * w0.y; lg[2] += uu[q] * w0.z; lg[3] += uu[q] * w0.w; lg[4] += uu[q] * w1.x; lg[5] += uu[q] * w1.y; lg[6] += uu[q] * w1.z; lg[7] += uu[q] * w1.w; }
            }
#pragma unroll
            for (int e = 0; e < NE; ++e) lg[e] = wave_sum(lg[e]);
            int e1 = 0; float v1 = lg[0];
#pragma unroll
            for (int e = 1; e < NE; ++e) if (lg[e] > v1) { v1 = lg[e]; e1 = e; }
            int e2 = -1; float v2 = -INFINITY;
#pragma unroll
            for (int e = 0; e < NE; ++e) if (e != e1 && lg[e] > v2) { v2 = lg[e]; e2 = e; }
            if (F.lane == 0) {
                const float ex = __expf(v2 - v1), w1 = 1.0f / (1.0f + ex);
                toke[2 * m] = e1; toke[2 * m + 1] = e2; tokw[2 * m] = w1; tokw[2 * m + 1] = ex * w1;
                lds_add(&lcnt[e1], 1); lds_add(&lcnt[e2], 1);
            }
        }
        __syncthreads();
        if (F.tid < NE) atomicAdd(F.ctl + CW_CNT + F.tid, (unsigned)lcnt[F.tid]);
        if (BOTH(17)) GRID_BAR();
    }
    if (IN(18)) { MKFRAME();
        LAS int* lcnt = (LAS int*)(F.lds); LAS int* lbase = lcnt + 8; LAS int* lfill = lcnt + 16;
        const int* toke = WSP(int, SM_TOKE); int* slot = WSP(int, SM_SLOT);
        const int rows_per = T / F.G, r0 = blockIdx.x * rows_per;
        if (F.tid < NE) { lcnt[F.tid] = 0; lfill[F.tid] = 0; }
        __syncthreads();
        for (int i = F.tid; i < 2 * rows_per; i += 512) lds_add(&lcnt[toke[2 * r0 + i]], 1);
        __syncthreads();
        if (F.tid < NE) {
            int off = 0; for (int e = 0; e < F.tid; ++e) off += (int)((ld_u32(F.ctl + CW_CNT + e) + 255u) >> 8) * 256;
            lbase[F.tid] = off + (int)atomicAdd(F.ctl + CW_FILL + F.tid, (unsigned)lcnt[F.tid]);
        }
        __syncthreads();
        const unsigned char* UM = WSP(unsigned char, WS_UM); unsigned char* AG = WSP(unsigned char, WS_AG);
        LAS int* SL = lcnt + 32;
        for (int i = F.tid; i < 2 * rows_per; i += 512) { const int e = toke[2 * r0 + i]; const int sl = lbase[e] + lds_add(&lfill[e], 1); SL[i] = sl; slot[2 * r0 + i] = sl; }
        __syncthreads();
        if (rows_per == 8 * NWAVES) {
            u32x4 v[8];
#pragma unroll
            for (int j = 0; j < 8; ++j) v[j] = ((const u32x4*)(UM + (size_t)(r0 + F.wave + NWAVES * j) * D))[F.lane];
#pragma unroll
            for (int j = 0; j < 8; ++j) { const int rr = F.wave + NWAVES * j; const int s0 = SL[2 * rr], s1 = SL[2 * rr + 1];
                ((u32x4*)(AG + (size_t)s0 * D))[F.lane] = v[j]; ((u32x4*)(AG + (size_t)s1 * D))[F.lane] = v[j]; }
        } else {
            for (int rr = F.wave; rr < rows_per; rr += NWAVES) { const u32x4 v = ((const u32x4*)(UM + (size_t)(r0 + rr) * D))[F.lane];
                ((u32x4*)(AG + (size_t)SL[2 * rr] * D))[F.lane] = v; ((u32x4*)(AG + (size_t)SL[2 * rr + 1] * D))[F.lane] = v; }
        }
        if (BOTH(18)) GRID_BAR();
    }
    if (IN(19)) { MKFRAME();
        pg8::Gemm g{WSP(bf16, WS_AG), WSP(bf16, WS_WGU1), D / 2, D / 2, D / 2}; MoeOrder S; S.init(F.ctl + CW_CNT, 2 * FFE / 256, F.G, (int)blockIdx.x);
        EpiSwiglu E{WSP(unsigned char, WS_HID2), FFE, 2 * FFE / 256};
        pg8::gemm_phase<EpiSwiglu, MoeOrder, true>(F.lds, g, S, E, F.wave);
        if (BOTH(19)) GRID_BAR();
    }
    if (IN(20)) { MKFRAME();
        {
            pg8::Gemm g{WSP(bf16, WS_HID2), WSP(bf16, WS_WD1), FFE / 2, FFE / 2, FFE / 2}; MoeOrder S; S.init(F.ctl + CW_CNT, D / 256, F.G, (int)blockIdx.x, 1, 0, 0, 128);
            EpiY E{WSP(bf16, WS_Y)};
            pg8::gemm_phase<EpiY, MoeOrder, true>(F.lds, g, S, E, F.wave); }
        {
            pg8::Gemm g{WSP(bf16, WS_HID2), WSP(bf16, WS_WD1), FFE / 4, FFE / 2, FFE / 2}; MoeOrder S; S.init(F.ctl + CW_CNT, D / 256, F.G, (int)blockIdx.x, 2, FFE / 2, 128);
            EpiYp E{WSP(bf16, WS_Y2)};
            pg8::gemm_phase<EpiYp, MoeOrder, true>(F.lds, g, S, E, F.wave); }
        if (BOTH(20)) GRID_BAR();
    }
    if (IN(21)) { MKFRAME();
        const int* slot = WSP(int, SM_SLOT); const float* tokw = WSP(float, SM_TOKW); const bf16* Y = WSP(bf16, WS_Y); const bf16* Yp = WSP(bf16, WS_Y2);
        for (int m = F.gw; m < T; m += F.NGW) {
            f32x4 v[4]; load_row(F.out + (size_t)m * D, F.lane, v);
            const int b = m >> 12; const int s1 = slot[2 * m], s2 = slot[2 * m + 1]; const float w1 = tokw[2 * m], w2 = tokw[2 * m + 1];
            const float* fg = MOD1 + (size_t)b * 6144 + 5120;
#pragma unroll
            for (int j = 0; j < 4; ++j) {
                const f32x4 ya = yrow(Y, Yp, s1, F.lane + 64 * j), yb = yrow(Y, Yp, s2, F.lane + 64 * j);
                const f32x4 gq = ((const f32x4*)fg)[F.lane + 64 * j];
                const f32x4 y = ya * w1 + yb * w2;
                v[j] = v[j] + gq * y;
            }
            const float r = row_rs(v);
#pragma unroll
            for (int j = 0; j < 4; ++j) { const f32x4 gn = ((const f32x4*)F.final_gain)[F.lane + 64 * j]; ((f32x4*)(F.outw + (size_t)m * D))[F.lane + 64 * j] = v[j] * r * gn; }
        }
#if DBG_TIME
        {
            if (blockIdx.x == 0 && F.tid == 0) { tsl[NPHASE] = __builtin_amdgcn_s_memrealtime();
                const float ua = 0.01f * (float)(tsl[DBG_TA + 1] - tsl[DBG_TA]), ub = 0.01f * (float)(tsl[DBG_TB + 1] - tsl[DBG_TB]);
                const float cc = sqrtf(10.0f * ua);
                __hip_atomic_store(F.ctl + CW_DBG + 8, __builtin_bit_cast(unsigned, cc), RLX_AGENT); __hip_atomic_store(F.ctl + CW_DBG + 9, __builtin_bit_cast(unsigned, cc * (1.0f + ub * 0.05f)), RLX_AGENT); }
            GRID_BAR_ALWAYS();
            const float cc = __builtin_bit_cast(float, ld_u32(F.ctl + CW_DBG + 8)), c0 = __builtin_bit_cast(float, ld_u32(F.ctl + CW_DBG + 9));
            for (int m = F.gw; m < T; m += F.NGW) for (int j = 0; j < 4; ++j) ((f32x4*)(F.out + (size_t)m * D))[F.lane + 64 * j] = (f32x4){cc, cc, cc, cc};
            GRID_BAR_ALWAYS();
            if (blockIdx.x == 0 && F.tid == 0) F.out[0] = c0;
        }
#endif
#if DBG_CHECK
        {
            const float sd0 = __builtin_bit_cast(float, ld_u32(F.ctl + CW_DBG)), sr0 = __builtin_bit_cast(float, ld_u32(F.ctl + CW_DBG + 1));
            const float sd1 = __builtin_bit_cast(float, ld_u32(F.ctl + CW_DBG + 2)), sr1 = __builtin_bit_cast(float, ld_u32(F.ctl + CW_DBG + 3));
            const float e0 = sqrtf(sd0 / sr0), e1 = sqrtf(sd1 / sr1);
            const float cc = sqrtf(1e6f * e0);
            __syncthreads();
            for (int m = F.gw; m < T; m += F.NGW) for (int j = 0; j < 4; ++j) ((f32x4*)(F.out + (size_t)m * D))[F.lane + 64 * j] = (f32x4){cc, cc, cc, cc};
            GRID_BAR_ALWAYS();
            if (blockIdx.x == 0 && F.tid == 0) F.out[0] = cc * (1.0f + 1000.0f * e1);
        }
#endif
    }
#undef IN
#undef BOTH
}

extern "C" void kernel_launch(void* const* d_in, const int* in_sizes, int n_in, void* d_out, int out_size, void* d_ws, size_t ws_size, hipStream_t stream) {
    static int grid = 0;
    if (grid == 0) {
        if (n_in != 29 || out_size != T * D || ws_size < WS_END) { fprintf(stderr, "kernel_launch: unexpected problem (n_in %d, out %d, ws %zu)\n", n_in, out_size, ws_size); grid = -1; return; }
        int dev = 0, cus = 0, per_cu = 0;
        if (hipGetDevice(&dev) != hipSuccess || hipDeviceGetAttribute(&cus, hipDeviceAttributeMultiprocessorCount, dev) != hipSuccess) { grid = -1; return; }
        if (hipFuncSetAttribute((const void*)trunk_fwd, hipFuncAttributeMaxDynamicSharedMemorySize, LDS_BYTES) != hipSuccess) { fprintf(stderr, "kernel_launch: hipFuncSetAttribute failed\n"); grid = -1; return; }
        if (hipOccupancyMaxActiveBlocksPerMultiprocessor(&per_cu, (const void*)trunk_fwd, NWAVES * 64, LDS_BYTES) != hipSuccess || per_cu < 1) { fprintf(stderr, "kernel_launch: occupancy query says %d\n", per_cu); }
        (void)hipGetLastError();
        grid = cus;
        if (T % grid != 0) { fprintf(stderr, "kernel_launch: grid %d does not divide the token count\n", grid); grid = -1; return; }
    }
    if (grid < 0) return;
    if (hipMemsetAsync((char*)d_ws + WS_CTL, 0, CTL_ZERO_BYTES, stream) != hipSuccess) return;
    Args a{};
    for (int i = 0; i < 29; ++i) a.in[i] = d_in[i];
    a.out = (float*)d_out; a.ws = (unsigned char*)d_ws;
#if MK_PER_PHASE
    for (int p = 0; p < NPHASE; ++p) { a.ph_lo = p; a.ph_hi = p + 1; a.li = p; hipLaunchKernelGGL(trunk_fwd, dim3(grid), dim3(NWAVES * 64), LDS_BYTES, stream, a); }
#elif defined(PROBE_LO)
#ifndef PROBE_DRY
#define PROBE_DRY 0
#endif
    { const int cuts[4] = {0, PROBE_HI, PROBE_LO, PROBE_HI};
      a.ph_lo = 0; a.ph_hi = PROBE_HI; a.li = 0; hipLaunchKernelGGL(trunk_fwd, dim3(grid), dim3(NWAVES * 64), LDS_BYTES, stream, a);
      a.ph_lo = PROBE_LO; a.ph_hi = PROBE_HI; a.li = 1; a.pad = PROBE_DRY; hipLaunchKernelGGL(trunk_fwd, dim3(grid), dim3(NWAVES * 64), LDS_BYTES, stream, a);
      a.pad = 0; if (PROBE_HI < NPHASE) { a.ph_lo = PROBE_HI; a.ph_hi = NPHASE; a.li = 2; hipLaunchKernelGGL(trunk_fwd, dim3(grid), dim3(NWAVES * 64), LDS_BYTES, stream, a); } (void)cuts; }
#else
    a.ph_lo = 0; a.ph_hi = NPHASE; a.li = 0;
    hipLaunchKernelGGL(trunk_fwd, dim3(grid), dim3(NWAVES * 64), LDS_BYTES, stream, a);
#endif
    const hipError_t le = hipPeekAtLastError();
    if (le != hipSuccess) fprintf(stderr, "kernel_launch: launch failed: %s\n", hipGetErrorName(le));
}
```

```cpp
#include <hip/hip_runtime.h>
#include <cstdio>
#include <cstdint>

#ifndef MK_PER_PHASE
#define MK_PER_PHASE 0
#endif

#ifndef DBG_CHECK
#define DBG_CHECK 0
#endif
#ifndef DBG_TIME
#define DBG_TIME 0
#endif
#ifndef DBG_TA
#define DBG_TA 3
#endif
#ifndef DBG_TB
#define DBG_TB 4
#endif
#define GAS __attribute__((address_space(1)))
#define LAS __attribute__((address_space(3)))
typedef unsigned short bf16;
typedef short bf16x8 __attribute__((ext_vector_type(8)));
typedef float f32x4 __attribute__((ext_vector_type(4)));
typedef float f32x16 __attribute__((ext_vector_type(16)));
typedef unsigned u32x4 __attribute__((ext_vector_type(4)));
typedef unsigned u32x2 __attribute__((ext_vector_type(2)));
typedef GAS unsigned gu32;
typedef int v8i_t __attribute__((ext_vector_type(8)));
typedef int v4i_t __attribute__((ext_vector_type(4)));

constexpr int NB = 4, SEQ = 4096, T = NB * SEQ, D = 1024, NH = 16, HD = 64, NG = 4;
constexpr int A_IN = 2120, A_INP = 2304, FF0 = 2816, FFE = 3584, NE = 8;
constexpr int KVW = 1536, BQ = 1072, BQP = 1280;
constexpr float C2 = 0.125f * 1.4426950408889634f;
constexpr float IWS = 0.04419417382415922f;
constexpr float RMS_EPS = 1e-6f;
constexpr int MPAD = 2 * T + NE * 256;
constexpr float SW_GU = 32.f, SW_DN = 64.f, HS = 4.f, OS = 16.f;

constexpr size_t MiB = 1u << 20;
constexpr size_t WS_CTL = 0, CTL_ZERO_BYTES = 1 * MiB;
constexpr size_t WS_SMALL = 1 * MiB;
constexpr size_t SM_MOD0 = WS_SMALL, SM_MOD1 = SM_MOD0 + 4 * 6144 * 4, SM_KVMOD = SM_MOD1 + 4 * 6144 * 4, SM_CBIAS = SM_KVMOD + 4 * 2048 * 4;
constexpr size_t SM_COS = 2 * MiB, SM_SIN = 4 * MiB, SM_IW = 6 * MiB, SM_GATES = 7 * MiB, SM_TOKE = 10 * MiB, SM_TOKW = SM_TOKE + 131072, SM_SLOT = SM_TOKW + 131072;
constexpr size_t SM_KC = 11 * MiB, SM_VC = SM_KC + 524288 + 4096;
static_assert(SM_CBIAS + 2048 <= SM_COS && SM_SLOT + 131072 <= SM_KC && SM_VC + 524288 + 4096 <= 16 * MiB, "small map");
constexpr size_t WB_IN = 16 * MiB;
constexpr size_t WB_O0 = WB_IN + (size_t)A_INP * D * 2;
constexpr size_t WB_GU0 = WB_O0 + (size_t)D * D * 2;
constexpr size_t WB_D0 = WB_GU0 + (size_t)2 * FF0 * D * 2;
constexpr size_t WB_KVQ = WB_D0 + (size_t)D * FF0 * 2;
constexpr size_t WB_O1 = WB_KVQ + (size_t)(KVW + BQP) * D * 2;
constexpr size_t WB_C1 = WB_O1 + (size_t)D * D * 2;
constexpr size_t WB_C2 = WB_C1 + (size_t)512 * 2048 * 2;
constexpr size_t WB_IKW = WB_C2 + 128 * 256 * 2;
static_assert(WB_IKW + 96 * 1024 * 2 <= 50 * MiB, "weight map");
constexpr size_t WS_U = 50 * MiB, WS_U2 = 82 * MiB;
constexpr size_t WS_Q0 = 114 * MiB, WS_K0 = 146 * MiB, WS_V0 = 154 * MiB, WS_IQ = 162 * MiB, WS_IK = 178 * MiB, WS_O0 = 180 * MiB, WS_MASK = 212 * MiB, WS_SCORES = 220 * MiB;
constexpr size_t WS_HID = 220 * MiB;
constexpr size_t WS_KCMP = 114 * MiB, WS_VCMP = 122 * MiB, WS_KSLC = 130 * MiB, WS_VSLC = 138 * MiB, WS_KWIN = 146 * MiB, WS_VWIN = 154 * MiB;
constexpr size_t WS_Q1 = 162 * MiB, WS_O1 = 194 * MiB, WS_CH = 226 * MiB;
constexpr size_t WS_OCG = 50 * MiB;
constexpr size_t WS_SEL = 230 * MiB;
constexpr size_t WS_XR = 318 * MiB;
constexpr size_t WS_UM = 300 * MiB;
constexpr size_t WS_AG = 16 * MiB;
constexpr size_t WS_Y = 16 * MiB;
constexpr size_t WS_DRY = 130 * MiB;
constexpr size_t WS_Y2 = 351 * MiB;
constexpr size_t WS_HID2 = 84 * MiB;
constexpr size_t WS_WGU1 = 351 * MiB, WS_WD1 = 463 * MiB, WS_END = 519 * MiB;
static_assert(WS_AG + (size_t)MPAD * D * 2 <= WS_HID2 && WS_HID2 + (size_t)MPAD * FFE * 2 <= WS_WGU1 && WS_WGU1 + (size_t)NE * 2 * FFE * D * 2 == WS_WD1 && WS_WD1 + (size_t)NE * D * FFE * 2 == WS_END, "moe map");
static_assert(WS_HID + (size_t)T * FF0 * 2 <= WS_WGU1 && WS_UM + (size_t)T * D * 2 <= WS_WGU1 && WS_SCORES + (size_t)NB * SEQ * SEQ * 4 <= 476 * MiB, "map");
constexpr int CW_TMO = 0, CW_BAR = 4096  , CW_CNT = 20480, CW_FILL = 20544, CW_DBG = 20608;
constexpr size_t WS_DBG_O0 = 480 * MiB, WS_DBG_O1 = 240 * MiB;
#define XCD_BAR_WORDS 3456

constexpr int RING_BYTES = 131072, LDSCTL_OFF = 139264, MISC_OFF = LDSCTL_OFF + 320, LDS_BYTES = 147456;
constexpr int NWAVES = 8;

#define RLX_AGENT __ATOMIC_RELAXED, __HIP_MEMORY_SCOPE_AGENT
#define LDS_WAIT() asm volatile("s_waitcnt lgkmcnt(0)" ::: "memory")
#define VM_WAIT() asm volatile("s_waitcnt vmcnt(0)" ::: "memory")
__device__ __forceinline__ unsigned f2bf(float f) { unsigned u = __builtin_bit_cast(unsigned, f); return (u + 0x7fffu + ((u >> 16) & 1u)) >> 16; }
__device__ __forceinline__ unsigned pk2(float lo, float hi) { return f2bf(lo) | (f2bf(hi) << 16); }
__device__ __forceinline__ unsigned pk4_fp8(float a, float b, float c, float d) { int r = 0; r = __builtin_amdgcn_cvt_pk_fp8_f32(a, b, r, false); r = __builtin_amdgcn_cvt_pk_fp8_f32(c, d, r, true); return (unsigned)r; }
__device__ __forceinline__ float bf2f(unsigned v) { return __builtin_bit_cast(float, v << 16); }
__device__ __forceinline__ float bflo(unsigned w) { return __builtin_bit_cast(float, w << 16); }
__device__ __forceinline__ float bfhi(unsigned w) { return __builtin_bit_cast(float, w & 0xffff0000u); }
__device__ __forceinline__ float bfround(float f) { return bf2f(f2bf(f)); }
__device__ __forceinline__ int lane_id() { return (int)__builtin_amdgcn_mbcnt_hi(~0u, __builtin_amdgcn_mbcnt_lo(~0u, 0u)); }
__device__ __forceinline__ float wave_sum(float v) {
#pragma unroll
    for (int o = 1; o < 64; o <<= 1) v += __shfl_xor(v, o);
    return v;
}
__device__ __forceinline__ float wave_max(float v) {
#pragma unroll
    for (int o = 1; o < 64; o <<= 1) v = fmaxf(v, __shfl_xor(v, o));
    return v;
}
__device__ __forceinline__ int wave_sum_i(int v) {
#pragma unroll
    for (int o = 1; o < 64; o <<= 1) v += __shfl_xor(v, o);
    return v;
}
__device__ __forceinline__ int lds_add(LAS int* p, int v) { return __hip_atomic_fetch_add(p, v, __ATOMIC_RELAXED, __HIP_MEMORY_SCOPE_WORKGROUP); }
__device__ __forceinline__ unsigned ld_u32(const unsigned* p) { return __hip_atomic_load(p, RLX_AGENT); }
__device__ __forceinline__ float dot8(u32x4 a, u32x4 b, float acc) {
    acc += bflo(a.x) * bflo(b.x); acc += bfhi(a.x) * bfhi(b.x); acc += bflo(a.y) * bflo(b.y); acc += bfhi(a.y) * bfhi(b.y);
    acc += bflo(a.z) * bflo(b.z); acc += bfhi(a.z) * bfhi(b.z); acc += bflo(a.w) * bflo(b.w); acc += bfhi(a.w) * bfhi(b.w);
    return acc;
}

namespace pg8 {
constexpr int BM = 256, BK = 64, HALF = 128, HTB = HALF * BK * 2, STAGE_BYTES = 8 * HTB, NXCD = 8, WGM = 8;
__host__ __device__ __forceinline__ int lds_byte(int r, int c) { const int st = (r >> 4) * 2 + (c >> 5), rr = r & 15, cc = c & 31, ob = rr * 64 + cc * 2; return st * 1024 + (ob ^ (((ob >> 9) & 1) << 5)); }
__host__ __device__ __forceinline__ void stage_rc(int b, int& R, int& C) { const int st = b / 1024, sb = b % 1024, swz = sb ^ (((sb >> 9) & 1) << 5); R = (st >> 1) * 16 + swz / 64; C = (st & 1) * 32 + (swz % 64) / 2; }
__host__ __device__ __forceinline__ int perm32(int rho) { const int n = rho >> 4, i = rho & 15; return 8 * (i >> 2) + 4 * n + (i & 3); }
struct Unit { int pm, pn, ko; };
struct Gemm { const bf16* A; const bf16* Bt; int K, lda, ldb; };

struct StaticOrder {
    int nM, nN, nwg, G, c;
    __device__ void init(int M, int N, int G_, int c_) { nM = M / BM; nN = N / BM; nwg = nM * nN; G = G_; c = c_; }
    __device__ bool next(int i, Unit& u) const {
        const long L = (long)i * G + c; if (L >= nwg) return false;
        int wgid = (int)L; { const int q = nwg / NXCD, r = nwg % NXCD, xcd = wgid % NXCD, off = wgid / NXCD; wgid = (xcd < r ? xcd * (q + 1) : r * (q + 1) + (xcd - r) * q) + off; }
        const int nig = WGM * nN, gid = wgid / nig, fm = gid * WGM, gsz = (nM - fm) < WGM ? (nM - fm) : WGM;
        u.pm = fm + ((wgid % nig) % gsz); u.pn = (wgid % nig) / gsz; u.ko = 0; return true;
    }
};

template <class Epi, class Sched, bool F8 = false>
__device__ __forceinline__ void gemm_phase(LAS unsigned char* lds, const Gemm g, const Sched& S, const Epi& E, int wid  ) {
    const int lane = lane_id(), tid = wid * 64 + lane, wr = wid >> 2, wc = wid & 3, fr = lane & 15, fq = lane >> 4;
    const int K = g.K, nt = K / BK;
    unsigned voffA[2], voffB[2];
#pragma unroll
    for (int i = 0; i < 2; ++i) { int R, C; stage_rc(tid * 16 + i * 8192, R, C); const int Rb = (R & ~31) + perm32(R & 31);
        voffA[i] = (unsigned)(R * g.lda + C) * 2u; voffB[i] = (unsigned)(Rb * g.ldb + C) * 2u; }
    const size_t kstep = (size_t)(BK * 2);
    const size_t hA = (size_t)HALF * g.lda * 2, hB = (size_t)HALF * g.ldb * 2;
    const size_t tA = 2 * hA, tB = 2 * hB;
    const unsigned ldsw = (unsigned)wid * 1024u;
    const int aoff = lds_byte(wr * 64 + fr, fq * 8), boff = lds_byte(wc * 32 + fr, fq * 8);
#define PG8_SA(b, h) (((b) * 2 + (h)) * HTB)
#define PG8_SB(b, h) ((4 + (b) * 2 + (h)) * HTB)
#define PG8_STAGE(bufoff, gbase, voff) do { _Pragma("unroll") for (int _i = 0; _i < 2; ++_i) \
        __builtin_amdgcn_global_load_lds((const unsigned*)((const char*)(gbase) + (voff)[_i]), (LAS unsigned*)(lds + (bufoff) + ldsw + _i * 8192), 16, 0, 0); } while (0)
#define PG8_LDA(dst, b, h) do { if constexpr (F8) { _Pragma("unroll") for (int m = 0; m < 4; ++m) { dst##8[m].lo = *(const LAS v4i_t*)(lds + PG8_SA(b, h) + aoff + m * 2048); dst##8[m].hi = *(const LAS v4i_t*)(lds + PG8_SA(b, h) + aoff + m * 2048 + 1024); } } \
        else { _Pragma("unroll") for (int m = 0; m < 4; ++m) _Pragma("unroll") for (int k = 0; k < 2; ++k) dst[m][k] = *(const LAS bf16x8*)(lds + PG8_SA(b, h) + aoff + m * 2048 + k * 1024); } } while (0)
#define PG8_LDB(dst, b, h) do { if constexpr (F8) { _Pragma("unroll") for (int n = 0; n < 2; ++n) { dst##8[n].lo = *(const LAS v4i_t*)(lds + PG8_SB(b, h) + boff + n * 2048); dst##8[n].hi = *(const LAS v4i_t*)(lds + PG8_SB(b, h) + boff + n * 2048 + 1024); } } \
        else { _Pragma("unroll") for (int n = 0; n < 2; ++n) _Pragma("unroll") for (int k = 0; k < 2; ++k) dst[n][k] = *(const LAS bf16x8*)(lds + PG8_SB(b, h) + boff + n * 2048 + k * 1024); } } while (0)
#define PG8_MMA(ai, bj, At, Bt) do { if constexpr (F8) __builtin_amdgcn_sched_barrier(0); __builtin_amdgcn_s_setprio(1); _Pragma("unroll") for (int m = 0; m < 4; ++m) _Pragma("unroll") for (int n = 0; n < 2; ++n) { \
        if constexpr (F8)   \
            asm volatile("v_mfma_scale_f32_16x16x128_f8f6f4 %0, %1, %2, %0, %3, %3 op_sel_hi:[0,0,0]" : "+v"(acc[ai][bj][m][n]) : "v"(Bt##8[n]), "v"(At##8[m]), "v"(one8));   \
        else { _Pragma("unroll") for (int k = 0; k < 2; ++k) acc[ai][bj][m][n] = __builtin_amdgcn_mfma_f32_16x16x32_bf16(Bt[n][k], At[m][k], acc[ai][bj][m][n], 0, 0, 0); } } \
        __builtin_amdgcn_s_setprio(0); if constexpr (F8) __builtin_amdgcn_sched_barrier(0); } while (0)
#define PG8_WAIT_V(n) asm volatile("s_waitcnt vmcnt(" #n ")" ::: "memory")
#define PG8_WAIT_L(n) asm volatile("s_waitcnt lgkmcnt(" #n ")" ::: "memory")
#define PG8_BAR __builtin_amdgcn_s_barrier()
#define PG8_SCHED __builtin_amdgcn_sched_barrier(0)
    Unit cur, nxt; int ui = 0;
    if (!S.next(0, cur)) return;
    f32x4 acc[2][2][4][2];
#pragma unroll
    for (int a = 0; a < 2; ++a)
#pragma unroll
        for (int b = 0; b < 2; ++b)
#pragma unroll
            for (int m = 0; m < 4; ++m)
#pragma unroll
                for (int n = 0; n < 2; ++n) acc[a][b][m][n] = (f32x4){0.f, 0.f, 0.f, 0.f};
    bf16x8 At[4][2], B0[2][2], B1[2][2];
    v8i_t At8[4], B08[2], B18[2];
    (void)At; (void)B0; (void)B1; (void)At8; (void)B08; (void)B18;
    const int one8 = 0x7F7F7F7F;
    (void)one8;
    const char* cA = (const char*)g.A + (size_t)cur.pm * tA + cur.ko; const char* cB = (const char*)g.Bt + (size_t)cur.pn * tB + cur.ko;
    PG8_STAGE(PG8_SB(0, 0), cB, voffB); PG8_STAGE(PG8_SB(0, 1), cB + hB, voffB); PG8_STAGE(PG8_SA(0, 0), cA, voffA); PG8_STAGE(PG8_SA(0, 1), cA + hA, voffA);
    if (wr == 1) PG8_BAR;
    PG8_WAIT_V(2); PG8_BAR;
    PG8_STAGE(PG8_SB(1, 0), cB + kstep, voffB); PG8_STAGE(PG8_SA(1, 0), cA + kstep, voffA); PG8_STAGE(PG8_SB(1, 1), cB + hB + kstep, voffB);
    PG8_WAIT_V(6); PG8_BAR;
    for (;;) {
        const bool has_next = S.next(ui + 1, nxt);
        const char* nA = has_next ? (const char*)g.A + (size_t)nxt.pm * tA + nxt.ko : cA; const char* nB = has_next ? (const char*)g.Bt + (size_t)nxt.pn * tB + nxt.ko : cB;
        for (int t = 0; t < nt; t += 2) {
            const bool last = (t == nt - 2);
            const char* a1 = cA + (size_t)(t + 1) * kstep;
            const char* a2 = last ? nA : cA + (size_t)(t + 2) * kstep; const char* b2 = last ? nB : cB + (size_t)(t + 2) * kstep;
            const char* a3 = a2 + kstep; const char* b3 = b2 + kstep;
            PG8_LDB(B0, 0, 0); PG8_LDB(B1, 0, 1); PG8_SCHED; PG8_LDA(At, 0, 0); PG8_STAGE(PG8_SA(1, 1), a1 + hA, voffA);
            PG8_WAIT_V(8); PG8_WAIT_L(0); PG8_BAR; PG8_MMA(0, 0, At, B0); PG8_MMA(0, 1, At, B1); PG8_BAR; PG8_SCHED;
            PG8_LDA(At, 0, 1); PG8_STAGE(PG8_SB(0, 0), b2, voffB); PG8_STAGE(PG8_SB(0, 1), b2 + hB, voffB); PG8_STAGE(PG8_SA(0, 0), a2, voffA);
            PG8_WAIT_V(8); PG8_WAIT_L(0); PG8_BAR; PG8_MMA(1, 0, At, B0); PG8_MMA(1, 1, At, B1); PG8_BAR; PG8_SCHED;
            PG8_LDB(B0, 1, 0); PG8_LDB(B1, 1, 1); PG8_SCHED; PG8_LDA(At, 1, 0); PG8_STAGE(PG8_SA(0, 1), a2 + hA, voffA);
            PG8_WAIT_V(8); PG8_WAIT_L(0); PG8_BAR; PG8_MMA(0, 0, At, B0); PG8_MMA(0, 1, At, B1); PG8_BAR; PG8_SCHED;
            PG8_LDA(At, 1, 1); PG8_STAGE(PG8_SB(1, 0), b3, voffB); PG8_STAGE(PG8_SB(1, 1), b3 + hB, voffB); PG8_STAGE(PG8_SA(1, 0), a3, voffA);
            PG8_WAIT_V(8); PG8_WAIT_L(0); PG8_BAR; PG8_MMA(1, 0, At, B0); PG8_MMA(1, 1, At, B1); PG8_BAR; PG8_SCHED;
        }
        if (wr == 0) PG8_BAR;
        if constexpr (F8) asm volatile("s_nop 15\n\ts_nop 7" ::: "memory");
        E(acc, cur, wr, wc, fr, fq);
        if (!has_next) break;
#pragma unroll
        for (int a = 0; a < 2; ++a)
#pragma unroll
            for (int b = 0; b < 2; ++b)
#pragma unroll
                for (int m = 0; m < 4; ++m)
#pragma unroll
                    for (int n = 0; n < 2; ++n) acc[a][b][m][n] = (f32x4){0.f, 0.f, 0.f, 0.f};
        cur = nxt; cA = nA; cB = nB; ++ui;
        if (wr == 1) PG8_BAR;
    }
    PG8_WAIT_V(0);
    PG8_BAR;
#undef PG8_SA
#undef PG8_SB
#undef PG8_STAGE
#undef PG8_LDA
#undef PG8_LDB
#undef PG8_MMA
#undef PG8_WAIT_V
#undef PG8_WAIT_L
#undef PG8_BAR
#undef PG8_SCHED
}
}

#define XB_TMO      128
#define XB_XCNT(j)  (256  + 64 * (j))
#define XB_XSUB(j)  (1280 + 64 * (j))
#define XB_XGEN(j)  (2304 + 64 * (j))
#define XB_TOP      3328
#define XB_TOPGEN   3392
#define XB_SPIN_CAP (1u << 18)
__device__ __forceinline__ unsigned xb_ld(unsigned* p)              { return __hip_atomic_load(p, __ATOMIC_RELAXED, __HIP_MEMORY_SCOPE_AGENT); }
__device__ __forceinline__ unsigned xb_add(unsigned* p, unsigned v) { return __hip_atomic_fetch_add(p, v, __ATOMIC_RELAXED, __HIP_MEMORY_SCOPE_AGENT); }
__device__ __forceinline__ unsigned xb_xcc_id() { return (unsigned)__builtin_amdgcn_s_getreg((3 << 11) | 20) & 0xFu; }
#define XB_SPIN(cond, bar) do { unsigned _sp = 0; while (cond) { __builtin_amdgcn_s_sleep(1); \
    if ((++_sp & 255u) == 0u) { if (xb_ld(&(bar)[XB_TMO])) break; if (_sp > XB_SPIN_CAP) { atomicAdd(&(bar)[XB_TMO], 1u); break; } } } } while (0)
struct XcdBarrier { unsigned* bar; unsigned x; volatile LAS unsigned* st; };
__device__ __forceinline__ XcdBarrier xcd_barrier_post(unsigned* bar, volatile LAS unsigned* st, bool t0) {
    XcdBarrier b; b.bar = bar; b.x = xb_xcc_id(); b.st = st;
    if (t0) (void)xb_add(&bar[XB_XCNT(b.x)], 1u);
    return b;
}
__device__ __forceinline__ void xcd_barrier_complete(unsigned* bar, unsigned x, unsigned& nloc, unsigned& nx) {
    const unsigned G = gridDim.x * gridDim.y * gridDim.z;
    unsigned sum, cnt, mine, sp = 0u;
    for (;;) {
        sum = 0u; cnt = 0u; mine = 0u;
#pragma unroll
        for (unsigned j = 0; j < 16; ++j) { const unsigned c = xb_ld(&bar[XB_XCNT(j)]); sum += c; cnt += (c > 0u) ? 1u : 0u; mine = (j == x) ? c : mine; }
        if (sum == G) break;
        __builtin_amdgcn_s_sleep(1);
        if ((++sp & 255u) == 0u) { if (xb_ld(&bar[XB_TMO])) break; if (sp > XB_SPIN_CAP) { atomicAdd(&bar[XB_TMO], 1u); break; } }
    }
    nloc = mine > 0u ? mine : 1u; nx = cnt > 0u ? cnt : 1u;
}
__device__ __forceinline__ void xcd_barrier(const XcdBarrier& b, bool t0  ) {
    asm volatile("s_waitcnt vmcnt(0)" ::: "memory");
    __syncthreads();
    if (t0) {
        unsigned* bar = b.bar;
        __builtin_amdgcn_s_waitcnt(0);
        unsigned nloc = b.st[0], nx = b.st[1];
        if (nloc == 0u) { xcd_barrier_complete(bar, b.x, nloc, nx); b.st[0] = nloc; b.st[1] = nx; }
        const unsigned old = xb_add(&bar[XB_XSUB(b.x)], 1u);
        const unsigned gen = old / nloc;
        if (old + 1u == (gen + 1u) * nloc) {
            __builtin_amdgcn_fence(__ATOMIC_RELEASE, "agent");
            asm volatile("s_waitcnt vmcnt(0)" ::: "memory");
            const unsigned og = xb_add(&bar[XB_TOP], 1u);
            const unsigned tg = og / nx;
            if (og + 1u == (tg + 1u) * nx) xb_add(&bar[XB_TOPGEN], 1u);
            else XB_SPIN(xb_ld(&bar[XB_TOPGEN]) == tg, bar);
            __builtin_amdgcn_fence(__ATOMIC_ACQUIRE, "agent");
            xb_add(&bar[XB_XGEN(b.x)], 1u);
            asm volatile("s_waitcnt vmcnt(0)" ::: "memory");
        } else {
            XB_SPIN(xb_ld(&bar[XB_XGEN(b.x)]) == gen, bar);
            __builtin_amdgcn_fence(__ATOMIC_ACQUIRE, "agent");
            asm volatile("s_waitcnt vmcnt(0)" ::: "memory");
        }
    }
    __syncthreads();
}

struct Frame {
    LAS unsigned char* lds;
    volatile LAS unsigned* MISC;
    unsigned* ctl;
    unsigned char* ws;
    int tid, lane, wave, G, gw, NGW;
    const float *x, *c; const int* pos;
    const float *attn_gain, *ffn_gain, *w_ada, *b_ada, *a_w_in, *a_w_out, *b_w_q, *b_w_out, *kv_gain, *w_kv_ada, *b_kv_ada, *w_kv;
    const float *pe_k, *w1_k, *w2_k, *pe_v, *w1_v, *w2_v, *ffn_wg, *ffn_wu, *ffn_wd, *w_router, *moe_wg, *moe_wu, *moe_wd, *final_gain;
    float* out; float* outw;
};
#define WSP(T_, off) ((T_*)(F.ws + (off)))
__device__ __forceinline__ unsigned char* launder(unsigned char* p) { asm volatile("" : "+s"(p)); return p; }
#define LWSP(T_, off) ((T_*)(launder(F.ws) + (off)))

__device__ __forceinline__ void tr_item(const float* W, int Nsrc, int ncol0, int K, int k0, bf16* WT, int drow0, LAS float* scr, int lane) {
    const int cc = ncol0 + (lane & 31); const bool ok = (ncol0 >= 0) && (cc < Nsrc);
    const float* wp = W + (size_t)(k0 + (lane >> 5)) * Nsrc + (ok ? cc : 0);
    float v[32];
#pragma unroll
    for (int i = 0; i < 32; ++i) v[i] = wp[(size_t)(2 * i) * Nsrc];
#pragma unroll
    for (int i = 0; i < 32; ++i) { const int kk = 2 * i + (lane >> 5); scr[kk * 33 + (lane & 31)] = ok ? v[i] : 0.f; }
    LDS_WAIT(); asm volatile("" ::: "memory");
    const int c = lane & 7;
#pragma unroll
    for (int j = 0; j < 4; ++j) { const int n = (lane >> 3) + 8 * j; const LAS float* s = scr + (8 * c) * 33 + n;
        u32x4 o; o.x = pk2(s[0 * 33], s[1 * 33]); o.y = pk2(s[2 * 33], s[3 * 33]); o.z = pk2(s[4 * 33], s[5 * 33]); o.w = pk2(s[6 * 33], s[7 * 33]);
        *(u32x4*)(WT + (size_t)(drow0 + n) * K + k0 + 8 * c) = o; }
    LDS_WAIT(); asm volatile("" ::: "memory");
}
__device__ __forceinline__ void tr_item8(const float* W, int Nsrc, int ncol0, int K, int k0, unsigned char* WT, int drow0, float scale, LAS float* scr, int lane) {
    const int cc = ncol0 + (lane & 31); const bool ok = cc < Nsrc;
    const float* wp = W + (size_t)(k0 + (lane >> 5)) * Nsrc + (ok ? cc : 0);
    float v[64];
#pragma unroll
    for (int i = 0; i < 64; ++i) v[i] = wp[(size_t)(2 * i) * Nsrc];
    const float sc_ = ok ? scale : 0.f;
#pragma unroll
    for (int i = 0; i < 64; ++i) scr[(2 * i + (lane >> 5)) * 33 + (lane & 31)] = v[i] * sc_;
    LDS_WAIT(); asm volatile("" ::: "memory");
    const int c = lane & 7;
#pragma unroll
    for (int j = 0; j < 4; ++j) { const int n = (lane >> 3) + 8 * j; const LAS float* q = scr + (16 * c) * 33 + n;
        u32x4 o; o.x = pk4_fp8(q[0], q[33], q[66], q[99]); o.y = pk4_fp8(q[132], q[165], q[198], q[231]); o.z = pk4_fp8(q[264], q[297], q[330], q[363]); o.w = pk4_fp8(q[396], q[429], q[462], q[495]);
        *(u32x4*)(WT + (size_t)(drow0 + n) * K + k0 + 16 * c) = o; }
    LDS_WAIT(); asm volatile("" ::: "memory");
}
__device__ __forceinline__ int rope_lb(int pb) { const int pn = pb >> 3, half = (pb >> 2) & 1, hl = pb & 3; return 8 * pn + 2 * hl + half; }

__device__ __forceinline__ void conv_item_a(Frame& F, int it, LAS float* scr) {
    const int lane = F.lane;
    int r = it;
    { constexpr int NBK = 2048 / 32, NI = 16 * NBK; if (r < NI) { const int kb = r / NBK, pb = r % NBK; tr_item(F.a_w_in, A_IN, 32 * rope_lb(pb), D, 64 * kb, WSP(bf16, WB_IN), 32 * pb, scr, lane); return; } r -= NI; }
    { constexpr int NBK = 3, NI = 16 * NBK; if (r < NI) { const int kb = r / NBK, pb = r % NBK; tr_item(F.a_w_in, A_IN, 2048 + 32 * pb, D, 64 * kb, WSP(bf16, WB_IKW), 32 * pb, scr, lane); return; } r -= NI; }
    { constexpr int NBK = D / 32, NI = 8 * NBK; if (r < NI) { const int kb = r / NBK, pb = r % NBK; tr_item8(F.a_w_out, D, 32 * pb, D, 128 * kb, WSP(unsigned char, WB_O0), 32 * pb, SW_GU, scr, lane); return; } r -= NI; }
    { constexpr int NBK = 2 * FF0 / 32, NI = 8 * NBK; if (r < NI) { const int kb = r / NBK, pb = r % NBK; const int pn = pb >> 3, half = (pb >> 2) & 1, q = pb & 3;
        tr_item8(half ? F.ffn_wu : F.ffn_wg, FF0, 32 * (4 * pn + q), D, 128 * kb, WSP(unsigned char, WB_GU0), 32 * pb, SW_GU, scr, lane); return; } r -= NI; }
    { constexpr int NBK = D / 32, NI = (FF0 / 128) * NBK; if (r < NI) { const int kb = r / NBK, pb = r % NBK; tr_item8(F.ffn_wd, D, 32 * pb, FF0, 128 * kb, WSP(unsigned char, WB_D0), 32 * pb, SW_DN, scr, lane); return; } r -= NI; }
    { constexpr int NBK = KVW / 32, NI = 8 * NBK; if (r < NI) { const int kb = r / NBK, pb = r % NBK; tr_item8(F.w_kv, KVW, 32 * rope_lb(pb), D, 128 * kb, WSP(unsigned char, WB_KVQ), 32 * pb, SW_GU, scr, lane); return; } r -= NI; }
    { constexpr int NBK = BQP / 32, NI = 8 * NBK; if (r < NI) { const int kb = r / NBK, pb = r % NBK; tr_item8(F.b_w_q, BQ, 32 * rope_lb(pb), D, 128 * kb, WSP(unsigned char, WB_KVQ) + (size_t)KVW * D, 32 * pb, SW_GU, scr, lane); return; } r -= NI; }
    { constexpr int NBK = D / 32, NI = 8 * NBK; if (r < NI) { const int kb = r / NBK, pb = r % NBK; tr_item8(F.b_w_out, D, 32 * pb, D, 128 * kb, WSP(unsigned char, WB_O1), 32 * pb, SW_GU, scr, lane); return; } r -= NI; }
    { constexpr int NBK = 8, NI = 32 * NBK; if (r < NI) { const int kb = r / NBK, pb = r % NBK; tr_item(F.w1_k, 256, 32 * pb, 2048, 64 * kb, WSP(bf16, WB_C1), 32 * pb, scr, lane); return; } r -= NI;
                                       if (r < NI) { const int kb = r / NBK, pb = r % NBK; tr_item(F.w1_v, 256, 32 * pb, 2048, 64 * kb, WSP(bf16, WB_C1), 256 + 32 * pb, scr, lane); return; } r -= NI; }
    { constexpr int NBK = 2, NI = 4 * NBK; if (r < NI) { const int kb = r / NBK, pb = r % NBK; tr_item(F.w2_k, 64, 32 * pb, 256, 64 * kb, WSP(bf16, WB_C2), 32 * pb, scr, lane); return; } r -= NI;
                                       if (r < NI) { const int kb = r / NBK, pb = r % NBK; tr_item(F.w2_v, 64, 32 * pb, 256, 64 * kb, WSP(bf16, WB_C2), 64 + 32 * pb, scr, lane); return; } r -= NI; }
}
constexpr int NCONV_A = 16 * (2048 / 32) + 16 * 3 + 8 * 32 + 8 * (2 * FF0 / 32) + (FF0 / 128) * 32 + 8 * (KVW / 32) + 8 * (BQP / 32) + 8 * 32 + 2 * 32 * 8 + 2 * 4 * 2;
__device__ __forceinline__ void conv_item_b(Frame& F, int it, LAS float* scr) {
    const int lane = F.lane;
    constexpr int NBK1 = 2 * FFE / 32, NI1 = 8 * NBK1;
    constexpr int NBK2 = D / 32, NI2 = (FFE / 128) * NBK2;
    int r = it;
    if (r < NE * NI1) { const int e = r / NI1; r -= e * NI1; const int kb = r / NBK1, pb = r % NBK1; const int pn = pb >> 3, half = (pb >> 2) & 1, q = pb & 3;
        tr_item8((half ? F.moe_wu : F.moe_wg) + (size_t)e * D * FFE, FFE, 32 * (4 * pn + q), D, 128 * kb, WSP(unsigned char, WS_WGU1) + (size_t)e * 2 * FFE * D, 32 * pb, SW_GU, scr, lane); return; }
    r -= NE * NI1;
    { const int e = r / NI2; r -= e * NI2; const int kb = r / NBK2, pb = r % NBK2;
        tr_item8(F.moe_wd + (size_t)e * FFE * D, D, 32 * pb, FFE, 128 * kb, WSP(unsigned char, WS_WD1) + (size_t)e * D * FFE, 32 * pb, SW_DN, scr, lane); }
}
constexpr int NCONV_B = NE * (8 * (2 * FFE / 32) + (FFE / 128) * 32);

template <int NBAT>
__device__ __forceinline__ void gemv_item(Frame& F, const LAS float* act, const float* W, int K, int N, int n0, const float* bias, float* out, int ldo, LAS float* red) {
    const int kper = K / 8, k0 = F.wave * kper;
    float a[NBAT];
#pragma unroll
    for (int b = 0; b < NBAT; ++b) a[b] = 0.f;
    const float* wp = W + (size_t)k0 * N + n0 + F.lane;
#pragma unroll 8
    for (int k = 0; k < kper; ++k) { const float w = wp[(size_t)k * N];
#pragma unroll
        for (int b = 0; b < NBAT; ++b) a[b] += act[b * K + k0 + k] * w; }
#pragma unroll
    for (int b = 0; b < NBAT; ++b) red[(F.wave * 4 + b) * 64 + F.lane] = a[b];
    __syncthreads();
    if (F.tid < 64 * NBAT) { const int b = F.tid >> 6, l = F.tid & 63; float s = 0.f;
#pragma unroll
        for (int w = 0; w < 8; ++w) s += red[(w * 4 + b) * 64 + l];
        out[(size_t)b * ldo + n0 + l] = s + (bias ? bias[n0 + l] : 0.f); }
    __syncthreads();
}

__device__ __forceinline__ void p0_prologue(Frame& F) {
    {
        LAS float* act = (LAS float*)(F.lds);
        LAS float* red = (LAS float*)(F.lds + 16384);
        constexpr int NI_MOD = 6144 / 64, NI_KV = 2048 / 64, NITEMS = 2 * NI_MOD + NI_KV + 8;
        for (int it = blockIdx.x; it < NITEMS; it += F.G) {
            if (it < 2 * NI_MOD + NI_KV) {
                for (int i = F.tid; i < 4096; i += 512) { const float v = F.c[i]; act[i] = v / (1.f + __expf(-v)); }
                __syncthreads();
                if (it < NI_MOD) gemv_item<4>(F, act, F.w_ada, D, 6144, 64 * it, F.b_ada, WSP(float, SM_MOD0), 6144, red);
                else if (it < 2 * NI_MOD) gemv_item<4>(F, act, F.w_ada + (size_t)D * 6144, D, 6144, 64 * (it - NI_MOD), F.b_ada + 6144, WSP(float, SM_MOD1), 6144, red);
                else gemv_item<4>(F, act, F.w_kv_ada, D, 2048, 64 * (it - 2 * NI_MOD), F.b_kv_ada, WSP(float, SM_KVMOD), 2048, red);
            } else {
                const int j = it - (2 * NI_MOD + NI_KV), kv = j >> 2;
                const float* pe = kv ? F.pe_v : F.pe_k;
                for (int i = F.tid; i < 2048; i += 512) act[i] = pe[i];
                __syncthreads();
                gemv_item<1>(F, act, kv ? F.w1_v : F.w1_k, 2048, 256, 64 * (j & 3), nullptr, WSP(float, SM_CBIAS) + 256 * kv, 256, red);
            }
        }
        __syncthreads();
    }
    {
        LAS float* scr = (LAS float*)(F.lds + F.wave * 16896);
        for (int it = F.gw; it < NCONV_A; it += F.NGW) conv_item_a(F, it, scr);
    }
    {
        float* cs = WSP(float, SM_COS); float* sn = WSP(float, SM_SIN);
        for (int i = F.gw * 64 + F.lane; i < T * 32; i += F.NGW * 64) {
            const int m = i >> 5, d = i & 31;
            const float inv = 1.0f / powf(10000.0f, (float)d * (1.0f / 32.0f));
            const float ang = (float)F.pos[m] * inv;
            cs[i] = cosf(ang); sn[i] = sinf(ang);
        }
    }
}

__device__ __forceinline__ void load_row(const float* row, int lane, f32x4 (&v)[4]) {
#pragma unroll
    for (int j = 0; j < 4; ++j) v[j] = ((const f32x4*)row)[lane + 64 * j];
}
__device__ __forceinline__ void load_row_h(const bf16* row, int lane, f32x4 (&v)[4]) {
#pragma unroll
    for (int j = 0; j < 4; ++j) { const u32x2 w = ((const u32x2*)row)[lane + 64 * j]; v[j] = (f32x4){bflo(w.x), bfhi(w.x), bflo(w.y), bfhi(w.y)}; }
}
__device__ __forceinline__ float row_rs(const f32x4 (&v)[4]) {
    float s = 0.f;
#pragma unroll
    for (int j = 0; j < 4; ++j) s += (v[j].x * v[j].x + v[j].y * v[j].y) + (v[j].z * v[j].z + v[j].w * v[j].w);
    return 1.0f / sqrtf(wave_sum(s) * (1.f / D) + RMS_EPS);
}
__device__ __forceinline__ void modulate_row(const f32x4 (&v)[4], float r, const float* gain, const float* shift, const float* scale, int lane, f32x4 (&u)[4]) {
#pragma unroll
    for (int j = 0; j < 4; ++j) { const f32x4 g = ((const f32x4*)gain)[lane + 64 * j], sh = ((const f32x4*)shift)[lane + 64 * j], sc = ((const f32x4*)scale)[lane + 64 * j];
        u[j] = v[j] * r * g * (sc + 1.0f) + sh; }
}
__device__ __forceinline__ void store_row_bf16(bf16* orow, int lane, const f32x4 (&u)[4]) {
#pragma unroll
    for (int j = 0; j < 4; ++j) { u32x2 o; o.x = pk2(u[j].x, u[j].y); o.y = pk2(u[j].z, u[j].w); ((u32x2*)orow)[lane + 64 * j] = o; }
}
__device__ __forceinline__ void store_row_fp8(unsigned char* orow, int lane, const f32x4 (&u)[4]) {
#pragma unroll
    for (int j = 0; j < 4; ++j) ((unsigned*)orow)[lane + 64 * j] = pk4_fp8(u[j].x, u[j].y, u[j].z, u[j].w);
}
__device__ __forceinline__ void norm_phase(Frame& F, const float* src, const float* gain, const float* mod  , int ldm, int shift_off, int scale_off, bf16* dst, bool f8 = false, const bf16* srch = nullptr) {
    for (int m = F.gw; m < T; m += F.NGW) {
        f32x4 v[4], u[4]; if (srch) load_row_h(srch + (size_t)m * D, F.lane, v); else load_row(src + (size_t)m * D, F.lane, v);
        const float r = row_rs(v); const int b = m >> 12;
        modulate_row(v, r, gain, mod + (size_t)b * ldm + shift_off, mod + (size_t)b * ldm + scale_off, F.lane, u);
        if (f8) store_row_fp8((unsigned char*)dst + (size_t)m * D, F.lane, u); else store_row_bf16(dst + (size_t)m * D, F.lane, u);
    }
}

__device__ __forceinline__ void store8(bf16* p, const float (&y)[8]) { u32x4 w; w.x = pk2(y[0], y[1]); w.y = pk2(y[2], y[3]); w.z = pk2(y[4], y[5]); w.w = pk2(y[6], y[7]); *(u32x4*)p = w; }
__device__ __forceinline__ void get8(const f32x4 (&a)[2], float (&x)[8]) { x[0] = a[0].x; x[1] = a[0].y; x[2] = a[0].z; x[3] = a[0].w; x[4] = a[1].x; x[5] = a[1].y; x[6] = a[1].z; x[7] = a[1].w; }
__device__ __forceinline__ void rope8(const float* cs, const float* sn, int row, int fq, const float (&x1)[8], const float (&x2)[8], float sc, float (&y1)[8], float (&y2)[8]) {
    const f32x4 c0 = *(const f32x4*)(cs + (size_t)row * 32 + 8 * fq), c1 = *(const f32x4*)(cs + (size_t)row * 32 + 8 * fq + 4);
    const f32x4 s0 = *(const f32x4*)(sn + (size_t)row * 32 + 8 * fq), s1 = *(const f32x4*)(sn + (size_t)row * 32 + 8 * fq + 4);
    const float c[8] = {c0.x, c0.y, c0.z, c0.w, c1.x, c1.y, c1.z, c1.w}, s[8] = {s0.x, s0.y, s0.z, s0.w, s1.x, s1.y, s1.z, s1.w};
#pragma unroll
    for (int j = 0; j < 8; ++j) { y1[j] = (x1[j] * c[j] - x2[j] * s[j]) * sc; y2[j] = (x2[j] * c[j] + x1[j] * s[j]) * sc; }
}
struct EpiIn {
    bf16 *Q, *K, *V, *IQ, *IK; float* IW; const float *cs, *sn;
    __device__ __forceinline__ void operator()(const f32x4 (&acc)[2][2][4][2], const pg8::Unit& u, int wr, int wc, int fr, int fq) const {
        const int pn = u.pn;
        if (pn == 8 && wc >= 2) return;
#pragma unroll
        for (int ai = 0; ai < 2; ++ai)
#pragma unroll
            for (int m = 0; m < 4; ++m) {
                const int row = u.pm * 256 + ai * 128 + wr * 64 + m * 16 + fr;
                float x1[8], x2[8]; get8(acc[ai][0][m], x1); get8(acc[ai][1][m], x2);
                if (pn == 5) { bf16* d = V + (size_t)row * 256 + wc * 64 + 8 * fq; store8(d, x1); store8(d + 32, x2); }
                else if (pn == 8 && wc == 1) { if (fq == 0) { f32x4 a = {x1[0] * IWS, x1[1] * IWS, x1[2] * IWS, x1[3] * IWS}, b = {x1[4] * IWS, x1[5] * IWS, x1[6] * IWS, x1[7] * IWS};
                        *(f32x4*)(IW + (size_t)row * 8) = a; *(f32x4*)(IW + (size_t)row * 8 + 4) = b; } }
                else {
                    float y1[8], y2[8]; rope8(cs, sn, row, fq, x1, x2, pn < 4 ? C2 : 1.0f, y1, y2);
                    bf16* d;
                    if (pn < 4) d = Q + (size_t)row * 1024 + (4 * pn + wc) * 64;
                    else if (pn == 4) d = K + (size_t)row * 256 + wc * 64;
                    else if (pn < 8) d = IQ + (size_t)row * 512 + (4 * (pn - 6) + wc) * 64;
                    else d = IK + (size_t)row * 64;
                    store8(d + 8 * fq, y1); store8(d + 32 + 8 * fq, y2);
                }
            }
    }
};
struct EpiRes {
    const float* basef; const bf16* baseh; bf16* out; const float* gate; int ldg; float sc;
    __device__ __forceinline__ void operator()(const f32x4 (&acc)[2][2][4][2], const pg8::Unit& u, int wr, int wc, int fr, int fq) const {
        const float* gv = gate + (size_t)((u.pm * 256) >> 12) * ldg;
#pragma unroll
        for (int bj = 0; bj < 2; ++bj) {
            const int col = u.pn * 256 + bj * 128 + wc * 32 + 8 * fq;
            const f32x4 g0 = *(const f32x4*)(gv + col) * sc, g1 = *(const f32x4*)(gv + col + 4) * sc;
#pragma unroll
            for (int ai = 0; ai < 2; ++ai)
#pragma unroll
                for (int m = 0; m < 4; ++m) {
                    const size_t o = (size_t)(u.pm * 256 + ai * 128 + wr * 64 + m * 16 + fr) * D + col;
                    f32x4 b0, b1;
                    if (basef) { b0 = *(const f32x4*)(basef + o); b1 = *(const f32x4*)(basef + o + 4); }
                    else { const u32x4 w = *(const u32x4*)(baseh + o); b0 = (f32x4){bflo(w.x), bfhi(w.x), bflo(w.y), bfhi(w.y)}; b1 = (f32x4){bflo(w.z), bfhi(w.z), bflo(w.w), bfhi(w.w)}; }
                    const f32x4 r0 = b0 + g0 * acc[ai][bj][m][0], r1 = b1 + g1 * acc[ai][bj][m][1];
                    u32x4 w; w.x = pk2(r0.x, r0.y); w.y = pk2(r0.z, r0.w); w.z = pk2(r1.x, r1.y); w.w = pk2(r1.z, r1.w);
                    *(u32x4*)(out + o) = w;
                }
        }
    }
};
__device__ __forceinline__ float silu_f(float g) { return g * __builtin_amdgcn_rcpf(1.0f + __builtin_amdgcn_exp2f(-1.4426950408889634f * g)); }
struct EpiSwiglu {
    unsigned char* H; int ldh, npn;
    __device__ __forceinline__ void operator()(const f32x4 (&acc)[2][2][4][2], const pg8::Unit& u, int wr, int wc, int fr, int fq) const {
        const int col = (u.pn % npn) * 128 + wc * 32 + 8 * fq;
#pragma unroll
        for (int ai = 0; ai < 2; ++ai)
#pragma unroll
            for (int m = 0; m < 4; ++m) {
                const int row = u.pm * 256 + ai * 128 + wr * 64 + m * 16 + fr;
                float g[8], up[8], h[8]; get8(acc[ai][0][m], g); get8(acc[ai][1][m], up);
#pragma unroll
                for (int j = 0; j < 8; ++j) h[j] = silu_f(g[j] * (1.0f / SW_GU)) * up[j] * (HS / SW_GU);
                u32x2 w; w.x = pk4_fp8(h[0], h[1], h[2], h[3]); w.y = pk4_fp8(h[4], h[5], h[6], h[7]);
                *(u32x2*)(H + (size_t)row * ldh + col) = w;
            }
    }
};
struct EpiKVQ {
    bf16 *KCMP, *VCMP, *KSLC, *VSLC, *KWIN, *VWIN, *Q; float* GATES; const float *cs, *sn;
    __device__ __forceinline__ void operator()(const f32x4 (&acc)[2][2][4][2], const pg8::Unit& u, int wr, int wc, int fr, int fq) const {
        const int pn = u.pn;
        if (pn == 10 && wc >= 1) return;
#pragma unroll
        for (int ai = 0; ai < 2; ++ai)
#pragma unroll
            for (int m = 0; m < 4; ++m) {
                const int row = (u.pm & 63) * 256 + ai * 128 + wr * 64 + m * 16 + fr;
                float x1[8], x2[8]; get8(acc[ai][0][m], x1); get8(acc[ai][1][m], x2);
#pragma unroll
                for (int j = 0; j < 8; ++j) { x1[j] *= 1.0f / SW_GU; x2[j] *= 1.0f / SW_GU; }
                if (pn < 6) {
                    if ((pn & 1) == 0) { float y1[8], y2[8]; rope8(cs, sn, row, fq, x1, x2, 1.0f, y1, y2);
#pragma unroll
                        for (int j = 0; j < 8; ++j) { x1[j] = y1[j]; x2[j] = y2[j]; } }
                    bf16* d;
                    if (pn < 2) d = (pn == 0 ? KCMP : VCMP) + ((size_t)((row >> 12) * 4 + wc) * SEQ + (row & 4095)) * 64;
                    else d = (pn == 2 ? KSLC : pn == 3 ? VSLC : pn == 4 ? KWIN : VWIN) + (size_t)row * 256 + wc * 64;
                    store8(d + 8 * fq, x1); store8(d + 32 + 8 * fq, x2);
                } else if (pn < 10) {
                    float y1[8], y2[8]; rope8(cs, sn, row, fq, x1, x2, C2, y1, y2);
                    bf16* d = Q + (size_t)row * 1024 + (4 * (pn - 6) + wc) * 64;
                    store8(d + 8 * fq, y1); store8(d + 32 + 8 * fq, y2);
                } else {
                    float* gp = GATES + (size_t)row * 48;
#pragma unroll
                    for (int j = 0; j < 8; ++j) gp[8 * fq + j] = 1.0f / (1.0f + __expf(-x1[j]));
                    if (fq < 2) {
#pragma unroll
                        for (int j = 0; j < 8; ++j) gp[32 + 8 * fq + j] = 1.0f / (1.0f + __expf(-x2[j])); }
                }
            }
    }
};
struct EpiY {
    bf16* Y;
    __device__ __forceinline__ void operator()(const f32x4 (&acc)[2][2][4][2], const pg8::Unit& u, int wr, int wc, int fr, int fq) const {
#pragma unroll
        for (int ai = 0; ai < 2; ++ai)
#pragma unroll
            for (int m = 0; m < 4; ++m) {
                const int row = u.pm * 256 + ai * 128 + wr * 64 + m * 16 + fr;
#pragma unroll
                for (int bj = 0; bj < 2; ++bj) { float x[8]; get8(acc[ai][bj][m], x);
#pragma unroll
                    for (int j = 0; j < 8; ++j) x[j] *= 1.0f / (SW_DN * HS);
                    store8(Y + (size_t)row * D + (u.pn & 3) * 256 + bj * 128 + wc * 32 + 8 * fq, x); }
            }
    }
};
struct EpiYp {
    bf16* Yp;
    __device__ __forceinline__ void operator()(const f32x4 (&acc)[2][2][4][2], const pg8::Unit& u, int wr, int wc, int fr, int fq) const {
        bf16* base = Yp + (size_t)((u.ko * 586) >> 20) * ((size_t)NE * 256 * D) + (size_t)(u.pm - 128) * 256 * D + (u.pn & 3) * 256 + wc * 32 + 8 * fq;
#pragma unroll
        for (int ai = 0; ai < 2; ++ai)
#pragma unroll
            for (int m = 0; m < 4; ++m) {
                const int row = ai * 128 + wr * 64 + m * 16 + fr;
#pragma unroll
                for (int bj = 0; bj < 2; ++bj) { float x[8]; get8(acc[ai][bj][m], x);
#pragma unroll
                    for (int j = 0; j < 8; ++j) x[j] *= 1.0f / (SW_DN * HS);
                    store8(base + (size_t)row * D + bj * 128, x); }
            }
    }
};
struct KvqOrder {
    pg8::StaticOrder S;
    __device__ bool next(int i, pg8::Unit& u) const { if (!S.next(i, u)) return false; if (u.pn >= 6) u.pm += 64; return true; }
};
struct MoeOrder {
    int tend[NE]; int npn, ksplit, kbytes, mtlo, nmt, j, per8;
    __device__ void init(const unsigned* cnt, int npn_, int G_, int c_, int ksplit_ = 1, int kbytes_ = 0, int mt0_ = 0, int mt1_ = 1 << 30) {
        int acc = 0; for (int e = 0; e < NE; ++e) { acc += (int)((ld_u32(cnt + e) + 255u) >> 8); tend[e] = acc; }
        npn = npn_; ksplit = ksplit_; kbytes = kbytes_;
        const int mt0 = mt0_ < acc ? mt0_ : acc, mt1 = mt1_ < acc ? mt1_ : acc, n = mt1 - mt0;
        const int nx = (G_ % 8 == 0) ? 8 : 1, x = (nx == 8) ? (c_ & 7) : 0;
        mtlo = mt0 + (int)((long)n * x / nx); nmt = mt0 + (int)((long)n * (x + 1) / nx) - mtlo;
        j = (nx == 8) ? (c_ >> 3) : c_; per8 = G_ / nx;
    }
    __device__ bool next(int i, pg8::Unit& u) const {
        const int idx = i * per8 + j;
        const int cw = (npn < 4 ? npn : 4), upc = nmt * cw * ksplit;
        if (nmt <= 0 || idx >= nmt * npn * ksplit) return false;
        const int q = idx / upc, w = idx % upc, mt = mtlo + w / (cw * ksplit), r = w % (cw * ksplit), pn = q * cw + r / ksplit, kh = r % ksplit; int e = 0;
#pragma unroll
        for (int k = 0; k < NE - 1; ++k) e += (mt >= tend[k]) ? 1 : 0;
        u.pm = mt; u.pn = e * npn + pn; u.ko = kh * kbytes; return true;
    }
};

__device__ __forceinline__ f32x16 sgemm_tile(const bf16* A, int lda, const bf16* Bt, int ldb, int K, int row0, int col0, int lane) {
    f32x16 acc = {};
    const bf16* ap = A + (size_t)(row0 + (lane & 31)) * lda + 8 * (lane >> 5);
    const bf16* bp = Bt + (size_t)(col0 + (lane & 31)) * ldb + 8 * (lane >> 5);
#pragma unroll 8
    for (int k = 0; k < K; k += 16) { const bf16x8 a = *(const bf16x8*)(ap + k), b = *(const bf16x8*)(bp + k); acc = __builtin_amdgcn_mfma_f32_32x32x16_bf16(a, b, acc, 0, 0, 0); }
    return acc;
}
__device__ __forceinline__ float gelu_tanh(float x) { const float t = tanhf(0.7978845608028654f * (x + 0.044715f * x * x * x)); return 0.5f * x * (1.0f + t); }

__device__ __forceinline__ unsigned okey(float f) { const unsigned u = __builtin_bit_cast(unsigned, f); return (u & 0x80000000u) ? ~u : (u | 0x80000000u); }
__device__ __forceinline__ void dsa_naive_item(Frame& F, int m, bf16* O  , unsigned long long* MASKo  ) {
    const int tid = F.tid, lane = F.lane, wave = F.wave;
    const int b = m >> 12, t = m & 4095, n = t + 1;
    LAS unsigned* KEY = (LAS unsigned*)(F.lds);
    LAS u32x4* IQL = (LAS u32x4*)(F.lds + 16384);
    LAS float* IWL = (LAS float*)(F.lds + 16384 + 1024);
    LAS int* LIST = (LAS int*)(F.lds + 20480);
    LAS int* CNT = (LAS int*)(F.lds + 20480 + 1024);
    LAS float* PL = (LAS float*)(F.lds + 24576);
    const bf16* IQ = WSP(bf16, WS_IQ); const bf16* IK = WSP(bf16, WS_IK); const float* IW = WSP(float, SM_IW);
    if (tid < 64) IQL[tid] = ((const u32x4*)(IQ + (size_t)m * 512))[tid];
    if (tid < 8) IWL[tid] = IW[(size_t)m * 8 + tid];
    __syncthreads();
    for (int s = tid; s < n; s += 512) {
        const u32x4* kp = (const u32x4*)(IK + (size_t)(b * SEQ + s) * 64);
        u32x4 kv[8];
#pragma unroll
        for (int c = 0; c < 8; ++c) kv[c] = kp[c];
        float sc = 0.f;
#pragma unroll
        for (int h = 0; h < 8; ++h) { float d = 0.f;
#pragma unroll
            for (int c = 0; c < 8; ++c) d = dot8(kv[c], IQL[h * 8 + c], d);
            sc += IWL[h] * fmaxf(d, 0.f); }
        KEY[s] = okey(sc);
    }
    __syncthreads();
    const bool all = (n <= 256);
    unsigned thr = 0u; int need_ties = 0;
    if (!all) {
        unsigned myk[8];
#pragma unroll
        for (int i = 0; i < 8; ++i) { const int s = tid + 512 * i; myk[i] = s < n ? KEY[s] : 0u; }
        unsigned prefix = 0u;
        for (int bit = 31; bit >= 0; --bit) {
            const unsigned cand = prefix | (1u << bit);
            int c = 0;
#pragma unroll
            for (int i = 0; i < 8; ++i) c += (myk[i] >= cand) ? 1 : 0;
            c = wave_sum_i(c);
            if (lane == 0) CNT[(bit & 1) * 8 + wave] = c;
            __syncthreads();
            int tot = 0;
#pragma unroll
            for (int w = 0; w < 8; ++w) tot += CNT[(bit & 1) * 8 + w];
            if (tot >= 256) prefix = cand;
        }
        thr = prefix;
        int c = 0;
#pragma unroll
        for (int i = 0; i < 8; ++i) c += (myk[i] > thr) ? 1 : 0;
        c = wave_sum_i(c);
        if (lane == 0) CNT[16 + wave] = c;
        __syncthreads();
        int tot = 0;
#pragma unroll
        for (int w = 0; w < 8; ++w) tot += CNT[16 + w];
        need_ties = 256 - tot;
    }
    if (wave == 0) {
        int pos = 0, ties = 0;
        const unsigned long long lt = (1ull << lane) - 1ull;
        for (int c0 = 0; c0 < n; c0 += 64) {
            const int s = c0 + lane; const bool valid = s < n; const unsigned k = valid ? KEY[s] : 0u;
            const bool gt = valid && (all || k > thr), eq = valid && !all && (k == thr);
            const unsigned long long beq = __ballot(eq); const int tr = ties + __popcll(beq & lt);
            const bool sel = gt || (eq && tr < need_ties);
            const unsigned long long bs = __ballot(sel); const int p = pos + __popcll(bs & lt);
            if (sel) LIST[p] = s;
            if (MASKo && lane == 0) MASKo[((size_t)b * 64 + (c0 >> 6)) * SEQ + t] = bs;
            pos += __popcll(bs); ties += __popcll(beq);
        }
        if (lane == 0) CNT[32] = pos;
    }
    __syncthreads();
    if (!O) return;
    const int nsel = CNT[32];
    const int g = wave >> 1, h0 = 4 * g + 2 * (wave & 1);
    const bf16* Q = WSP(bf16, WS_Q0); const bf16* Kp = WSP(bf16, WS_K0); const bf16* Vp = WSP(bf16, WS_V0);
    u32x4 q0[8], q1[8];
#pragma unroll
    for (int c = 0; c < 8; ++c) { q0[c] = ((const u32x4*)(Q + (size_t)m * 1024 + h0 * 64))[c]; q1[c] = ((const u32x4*)(Q + (size_t)m * 1024 + (h0 + 1) * 64))[c]; }
    float s0[4], s1[4]; float mx0 = -INFINITY, mx1 = -INFINITY;
#pragma unroll
    for (int i = 0; i < 4; ++i) { const int j = lane + 64 * i; s0[i] = -INFINITY; s1[i] = -INFINITY;
        if (j < nsel) { const int s = LIST[j]; const u32x4* kp = (const u32x4*)(Kp + (size_t)(b * SEQ + s) * 256 + g * 64); float d0 = 0.f, d1 = 0.f;
#pragma unroll
            for (int c = 0; c < 8; ++c) { const u32x4 kk = kp[c]; d0 = dot8(kk, q0[c], d0); d1 = dot8(kk, q1[c], d1); }
            s0[i] = d0; s1[i] = d1; }
        mx0 = fmaxf(mx0, s0[i]); mx1 = fmaxf(mx1, s1[i]); }
    mx0 = wave_max(mx0); mx1 = wave_max(mx1);
    float l0 = 0.f, l1 = 0.f;
    LAS float* P0 = PL + (wave * 2 + 0) * 256; LAS float* P1 = PL + (wave * 2 + 1) * 256;
#pragma unroll
    for (int i = 0; i < 4; ++i) { const int j = lane + 64 * i; const float p0 = (j < nsel) ? __builtin_amdgcn_exp2f(s0[i] - mx0) : 0.f, p1 = (j < nsel) ? __builtin_amdgcn_exp2f(s1[i] - mx1) : 0.f;
        l0 += p0; l1 += p1; P0[j] = bfround(p0); P1[j] = bfround(p1); }
    l0 = wave_sum(l0); l1 = wave_sum(l1);
    float a0 = 0.f, a1 = 0.f;
    for (int j = 0; j < nsel; ++j) { const int s = LIST[j]; const float v = bf2f(Vp[(size_t)(b * SEQ + s) * 256 + g * 64 + lane]); a0 += P0[j] * v; a1 += P1[j] * v; }
    O[(size_t)m * 1024 + h0 * 64 + lane] = (bf16)f2bf(a0 / l0); O[(size_t)m * 1024 + (h0 + 1) * 64 + lane] = (bf16)f2bf(a1 / l1);
    __syncthreads();
}

__device__ __forceinline__ void nsa_naive_item(Frame& F, int m, bf16* O  , bf16* OCG  , unsigned long long* SELo  ) {
    const int lane = F.lane, wave = F.wave;
    const int b = m >> 12, t = m & 4095, jt = t >> 6;
    const int g = wave >> 1, h0 = 4 * g + 2 * (wave & 1);
    LAS float* PC = (LAS float*)(F.lds);
    LAS float* SC0 = (LAS float*)(F.lds + 16384) + (wave * 2 + 0) * 1024;
    LAS float* SC1 = SC0 + 1024;
    LAS unsigned long long* SEL = (LAS unsigned long long*)(F.lds + 16384 + 65536);
    const bf16* Q = WSP(bf16, WS_Q1);
    u32x4 q0[8], q1[8];
#pragma unroll
    for (int c = 0; c < 8; ++c) { q0[c] = ((const u32x4*)(Q + (size_t)m * 1024 + h0 * 64))[c]; q1[c] = ((const u32x4*)(Q + (size_t)m * 1024 + (h0 + 1) * 64))[c]; }
    const int nv = t >= 31 ? min(255, (t - 31) / 16 + 1) : 0;
    const bf16* KC = WSP(bf16, SM_KC) + (size_t)(b * 4 + g) * 256 * 64; const bf16* VC = WSP(bf16, SM_VC) + (size_t)(b * 4 + g) * 256 * 64;
    float oc0 = 0.f, oc1 = 0.f;
    {
        float s0[4], s1[4]; float mx0 = -INFINITY, mx1 = -INFINITY;
#pragma unroll
        for (int i = 0; i < 4; ++i) { const int n = lane + 64 * i; s0[i] = -INFINITY; s1[i] = -INFINITY;
            if (n < nv) { const u32x4* kp = (const u32x4*)(KC + (size_t)n * 64); float d0 = 0.f, d1 = 0.f;
#pragma unroll
                for (int c = 0; c < 8; ++c) { const u32x4 kk = kp[c]; d0 = dot8(kk, q0[c], d0); d1 = dot8(kk, q1[c], d1); }
                s0[i] = d0; s1[i] = d1; }
            mx0 = fmaxf(mx0, s0[i]); mx1 = fmaxf(mx1, s1[i]); }
        mx0 = wave_max(mx0); mx1 = wave_max(mx1);
        float p0[4], p1[4], l0 = 0.f, l1 = 0.f;
#pragma unroll
        for (int i = 0; i < 4; ++i) { const int n = lane + 64 * i; p0[i] = (n < nv) ? __builtin_amdgcn_exp2f(s0[i] - mx0) : 0.f; p1[i] = (n < nv) ? __builtin_amdgcn_exp2f(s1[i] - mx1) : 0.f; l0 += p0[i]; l1 += p1[i]; }
        l0 = wave_sum(l0); l1 = wave_sum(l1);
        const float r0 = nv > 0 ? 1.0f / l0 : 0.f, r1 = nv > 0 ? 1.0f / l1 : 0.f;
#pragma unroll
        for (int i = 0; i < 4; ++i) { const int n = lane + 64 * i; PC[h0 * 256 + n] = p0[i] * r0; PC[(h0 + 1) * 256 + n] = p1[i] * r1; SC0[n] = bfround(p0[i]); SC1[n] = bfround(p1[i]); }
        for (int n = 0; n < nv; ++n) { const float v = bf2f(VC[(size_t)n * 64 + lane]); oc0 += SC0[n] * v; oc1 += SC1[n] * v; }
        oc0 *= r0; oc1 *= r1;
    }
    __syncthreads();
    if ((wave & 1) == 0) {
        const int j = lane;
        auto P4 = [&](int n) -> float { return (PC[(4 * g) * 256 + n] + PC[(4 * g + 1) * 256 + n]) + (PC[(4 * g + 2) * 256 + n] + PC[(4 * g + 3) * 256 + n]); };
        float imp = P4(4 * j) + P4(4 * j + 1) + P4(4 * j + 2) + 0.5f * P4(4 * j + 3);
        if (j > 0) imp += 0.5f * P4(4 * j - 1);
        const bool valid = j <= jt, forced = (j == 0) || (j == jt) || (j + 1 == jt);
        const float val = valid ? (forced ? 1e30f : imp) : -1e30f;
        int rank = 0;
        for (int jj = 0; jj < 64; ++jj) { const float vj = __shfl(val, jj); rank += ((vj > val) || (vj == val && jj < j)) ? 1 : 0; }
        const unsigned long long mk = __ballot(rank < 16);
        if (lane == 0) { SEL[g] = mk; if (SELo) SELo[((size_t)b * 4 + g) * SEQ + t] = mk; }
    }
    __syncthreads();
    const float* gt = WSP(float, SM_GATES) + (size_t)m * 48;
    if (OCG) { OCG[(size_t)m * 1024 + h0 * 64 + lane] = (bf16)f2bf(gt[h0 * 3] * oc0); OCG[(size_t)m * 1024 + (h0 + 1) * 64 + lane] = (bf16)f2bf(gt[h0 * 3 + 3] * oc1); }
    if (!O) return;
    float os0 = 0.f, os1 = 0.f;
    {
        unsigned long long mk = SEL[g]; if (jt < 63) mk &= ((1ull << (jt + 1)) - 1ull);
        const bf16* Ks = WSP(bf16, WS_KSLC); const bf16* Vs = WSP(bf16, WS_VSLC);
        int cnt = 0; float mx0 = -INFINITY, mx1 = -INFINITY;
        for (unsigned long long r = mk; r; r &= r - 1ull) { const int j = __builtin_ctzll(r); const int tok = 64 * j + lane;
            float d0 = -INFINITY, d1 = -INFINITY;
            if (tok <= t) { const u32x4* kp = (const u32x4*)(Ks + (size_t)(b * SEQ + tok) * 256 + g * 64); d0 = 0.f; d1 = 0.f;
#pragma unroll
                for (int c = 0; c < 8; ++c) { const u32x4 kk = kp[c]; d0 = dot8(kk, q0[c], d0); d1 = dot8(kk, q1[c], d1); } }
            SC0[cnt * 64 + lane] = d0; SC1[cnt * 64 + lane] = d1; mx0 = fmaxf(mx0, d0); mx1 = fmaxf(mx1, d1); ++cnt; }
        mx0 = wave_max(mx0); mx1 = wave_max(mx1);
        float l0 = 0.f, l1 = 0.f;
        for (int i = lane; i < cnt * 64; i += 64) { const float p0 = __builtin_amdgcn_exp2f(SC0[i] - mx0), p1 = __builtin_amdgcn_exp2f(SC1[i] - mx1); l0 += p0; l1 += p1; SC0[i] = bfround(p0); SC1[i] = bfround(p1); }
        l0 = wave_sum(l0); l1 = wave_sum(l1);
        cnt = 0;
        for (unsigned long long r = mk; r; r &= r - 1ull) { const int j = __builtin_ctzll(r);
            const int kmax = min(64, t - 64 * j + 1);
            for (int kk = 0; kk < kmax; ++kk) { const float v = bf2f(Vs[(size_t)(b * SEQ + 64 * j + kk) * 256 + g * 64 + lane]); os0 += SC0[cnt * 64 + kk] * v; os1 += SC1[cnt * 64 + kk] * v; }
            ++cnt; }
        os0 /= l0; os1 /= l1;
    }
    float ow0 = 0.f, ow1 = 0.f;
    {
        const bf16* Kw = WSP(bf16, WS_KWIN); const bf16* Vw = WSP(bf16, WS_VWIN);
        const int slo = max(0, t - 511), nw = t - slo + 1;
        float mx0 = -INFINITY, mx1 = -INFINITY;
        for (int i = lane; i < nw; i += 64) { const u32x4* kp = (const u32x4*)(Kw + (size_t)(b * SEQ + slo + i) * 256 + g * 64); float d0 = 0.f, d1 = 0.f;
#pragma unroll
            for (int c = 0; c < 8; ++c) { const u32x4 kk = kp[c]; d0 = dot8(kk, q0[c], d0); d1 = dot8(kk, q1[c], d1); }
            SC0[i] = d0; SC1[i] = d1; mx0 = fmaxf(mx0, d0); mx1 = fmaxf(mx1, d1); }
        mx0 = wave_max(mx0); mx1 = wave_max(mx1);
        float l0 = 0.f, l1 = 0.f;
        for (int i = lane; i < nw; i += 64) { const float p0 = __builtin_amdgcn_exp2f(SC0[i] - mx0), p1 = __builtin_amdgcn_exp2f(SC1[i] - mx1); l0 += p0; l1 += p1; SC0[i] = bfround(p0); SC1[i] = bfround(p1); }
        l0 = wave_sum(l0); l1 = wave_sum(l1);
        for (int i = 0; i < nw; ++i) { const float v = bf2f(Vw[(size_t)(b * SEQ + slo + i) * 256 + g * 64 + lane]); ow0 += SC0[i] * v; ow1 += SC1[i] * v; }
        ow0 /= l0; ow1 /= l1;
    }
    O[(size_t)m * 1024 + h0 * 64 + lane] = (bf16)f2bf(gt[h0 * 3] * oc0 + gt[h0 * 3 + 1] * os0 + gt[h0 * 3 + 2] * ow0);
    O[(size_t)m * 1024 + (h0 + 1) * 64 + lane] = (bf16)f2bf(gt[h0 * 3 + 3] * oc1 + gt[h0 * 3 + 4] * os1 + gt[h0 * 3 + 5] * ow1);
    __syncthreads();
}

namespace ix {
__device__ __forceinline__ void unit(Frame& F, int b, int qb) {
    const int lane = F.lane, wid = F.wave, r32 = lane & 31, hh = lane >> 5;
    const int q0w = 32 * qb + 4 * wid;
    LAS unsigned char* lds = F.lds;
    bf16x8 af[4];
    { const int rho = r32, hsel = (rho >> 2) & 1, r = (rho & 3) + 4 * (rho >> 3), qq = q0w + 2 * hsel + (r >> 3), head = r & 7;
      const bf16* ap = WSP(bf16, WS_IQ) + ((size_t)b * SEQ + qq) * 512 + head * 64 + 8 * hh;
#pragma unroll
      for (int d0 = 0; d0 < 4; ++d0) af[d0] = *(const bf16x8*)(ap + 16 * d0); }
    float w[16];
    { const float* wp = WSP(float, SM_IW) + ((size_t)b * SEQ + q0w + 2 * hh) * 8;
#pragma unroll
      for (int i = 0; i < 4; ++i) { const f32x4 v = ((const f32x4*)wp)[i]; w[4 * i] = v.x; w[4 * i + 1] = v.y; w[4 * i + 2] = v.z; w[4 * i + 3] = v.w; } }
    const int NT = ((32 * qb + 31) >> 6) + 1;
    const bf16* IKb = WSP(bf16, WS_IK) + (size_t)b * SEQ * 64;
    float* SC = WSP(float, WS_SCORES) + ((size_t)b * SEQ + q0w + 2 * hh) * SEQ + r32;
#define IX_DMA(t, buf) __builtin_amdgcn_global_load_lds((const unsigned*)(IKb + (size_t)(64 * (t) + lane) * 64 + wid * 8), (LAS unsigned*)(lds + (buf) * 8192 + wid * 1024), 16, 0, 0)
    IX_DMA(0, 0);
    __syncthreads();
    for (int t = 0; t < NT; ++t) {
        if (t + 1 < NT) IX_DMA(t + 1, (t + 1) & 1);
        const LAS unsigned char* kb = lds + (t & 1) * 8192 + hh * 1024 + r32 * 16;
        f32x16 a0 = {}, a1 = {};
#pragma unroll
        for (int d0 = 0; d0 < 4; ++d0) {
            const bf16x8 b0 = *(const LAS bf16x8*)(kb + d0 * 2048), b1 = *(const LAS bf16x8*)(kb + d0 * 2048 + 512);
            a0 = __builtin_amdgcn_mfma_f32_32x32x16_bf16(af[d0], b0, a0, 0, 0, 0);
            a1 = __builtin_amdgcn_mfma_f32_32x32x16_bf16(af[d0], b1, a1, 0, 0, 0);
        }
        float sA0 = 0.f, sB0 = 0.f, sA1 = 0.f, sB1 = 0.f;
#pragma unroll
        for (int r = 0; r < 8; ++r) { sA0 += w[r] * fmaxf(a0[r], 0.f); sB0 += w[8 + r] * fmaxf(a0[8 + r], 0.f); sA1 += w[r] * fmaxf(a1[r], 0.f); sB1 += w[8 + r] * fmaxf(a1[8 + r], 0.f); }
        float* o = SC + 64 * t;
        o[0] = sA0; o[32] = sA1; o[SEQ] = sB0; o[SEQ + 32] = sB1;
        asm volatile("s_waitcnt vmcnt(4)" ::: "memory");
        __builtin_amdgcn_s_barrier();
    }
    asm volatile("s_waitcnt vmcnt(0)" ::: "memory");
#undef IX_DMA
}
__device__ __forceinline__ int cnt8(unsigned a0, unsigned a1, unsigned a2, unsigned a3, unsigned a4, unsigned a5, unsigned a6, unsigned a7, unsigned cand) {
    int c;
    asm("s_nop 1\n\tv_cmp_le_u32_e64 s[36:37], %9, %1\n\tv_cmp_le_u32_e64 s[38:39], %9, %2\n\tv_cmp_le_u32_e64 s[40:41], %9, %3\n\tv_cmp_le_u32_e64 s[42:43], %9, %4\n\t"
        "v_cmp_le_u32_e64 s[44:45], %9, %5\n\tv_cmp_le_u32_e64 s[46:47], %9, %6\n\tv_cmp_le_u32_e64 s[48:49], %9, %7\n\tv_cmp_le_u32_e64 s[50:51], %9, %8\n\t"
        "s_bcnt1_i32_b64 s36, s[36:37]\n\ts_bcnt1_i32_b64 s38, s[38:39]\n\ts_bcnt1_i32_b64 s40, s[40:41]\n\ts_bcnt1_i32_b64 s42, s[42:43]\n\t"
        "s_bcnt1_i32_b64 s44, s[44:45]\n\ts_bcnt1_i32_b64 s46, s[46:47]\n\ts_bcnt1_i32_b64 s48, s[48:49]\n\ts_bcnt1_i32_b64 s50, s[50:51]\n\t"
        "s_add_i32 s36, s36, s38\n\ts_add_i32 s40, s40, s42\n\ts_add_i32 s44, s44, s46\n\ts_add_i32 s48, s48, s50\n\ts_add_i32 s36, s36, s40\n\ts_add_i32 s44, s44, s48\n\ts_add_i32 %0, s36, s44"
        : "=s"(c) : "v"(a0), "v"(a1), "v"(a2), "v"(a3), "v"(a4), "v"(a5), "v"(a6), "v"(a7), "s"(cand)
        : "s36", "s37", "s38", "s39", "s40", "s41", "s42", "s43", "s44", "s45", "s46", "s47", "s48", "s49", "s50", "s51", "scc");
    return c;
}
template <int NJ>
__device__ __forceinline__ void select_row_t(Frame& F, int m) {
    const int lane = F.lane, b = m >> 12, t = m & 4095, n = t + 1;
    const float* row = WSP(float, WS_SCORES) + (size_t)m * SEQ + lane;
    unsigned k[NJ];
    {
        float v[NJ];
#pragma unroll
        for (int j = 0; j < NJ; ++j) v[j] = row[64 * j];
#pragma unroll
        for (int j = 0; j < NJ; ++j) k[j] = (64 * j + lane < n) ? okey(v[j]) : 0u;
    }
    unsigned thrg = 0u; int need = 0;
    if (n > 256) {
        unsigned prefix = 0u; bool exact = false;
        for (int bit = 31; bit >= 0; --bit) {
            const unsigned cand = prefix | (1u << bit);
            int c = 0;
#pragma unroll
            for (int j = 0; j < NJ; j += 8) c += cnt8(k[j], k[j + 1], k[j + 2], k[j + 3], k[j + 4], k[j + 5], k[j + 6], k[j + 7], cand);
            if (c >= 256) { prefix = cand; if (c == 256) { exact = true; break; } }
        }
        if (exact) { thrg = prefix - 1u; need = 0; }
        else { int cg = 0;
#pragma unroll
            for (int j = 0; j < NJ; j += 8) cg += cnt8(k[j], k[j + 1], k[j + 2], k[j + 3], k[j + 4], k[j + 5], k[j + 6], k[j + 7], prefix + 1u);
            thrg = prefix; need = 256 - cg; }
    }
    const unsigned long long lt = (1ull << lane) - 1ull;
    unsigned mlo = 0u, mhi = 0u;
    if (need == 0) {
#pragma unroll
        for (int j = 0; j < NJ; j += 8)
            asm("s_nop 1\n\tv_cmp_lt_u32_e64 s[36:37], %10, %2\n\tv_cmp_lt_u32_e64 s[38:39], %10, %3\n\tv_cmp_lt_u32_e64 s[40:41], %10, %4\n\tv_cmp_lt_u32_e64 s[42:43], %10, %5\n\t"
                "v_cmp_lt_u32_e64 s[44:45], %10, %6\n\tv_cmp_lt_u32_e64 s[46:47], %10, %7\n\tv_cmp_lt_u32_e64 s[48:49], %10, %8\n\tv_cmp_lt_u32_e64 s[50:51], %10, %9\n\ts_nop 3\n\t"
                "v_writelane_b32 %0, s36, %11\n\tv_writelane_b32 %1, s37, %11\n\tv_writelane_b32 %0, s38, %12\n\tv_writelane_b32 %1, s39, %12\n\t"
                "v_writelane_b32 %0, s40, %13\n\tv_writelane_b32 %1, s41, %13\n\tv_writelane_b32 %0, s42, %14\n\tv_writelane_b32 %1, s43, %14\n\t"
                "v_writelane_b32 %0, s44, %15\n\tv_writelane_b32 %1, s45, %15\n\tv_writelane_b32 %0, s46, %16\n\tv_writelane_b32 %1, s47, %16\n\t"
                "v_writelane_b32 %0, s48, %17\n\tv_writelane_b32 %1, s49, %17\n\tv_writelane_b32 %0, s50, %18\n\tv_writelane_b32 %1, s51, %18"
                : "+v"(mlo), "+v"(mhi) : "v"(k[j]), "v"(k[j + 1]), "v"(k[j + 2]), "v"(k[j + 3]), "v"(k[j + 4]), "v"(k[j + 5]), "v"(k[j + 6]), "v"(k[j + 7]), "s"(thrg),
                  "i"(j), "i"(j + 1), "i"(j + 2), "i"(j + 3), "i"(j + 4), "i"(j + 5), "i"(j + 6), "i"(j + 7)
                : "s36", "s37", "s38", "s39", "s40", "s41", "s42", "s43", "s44", "s45", "s46", "s47", "s48", "s49", "s50", "s51");
    } else {
        unsigned long long myw = 0ull; int ties = 0;
#pragma unroll
        for (int j = 0; j < NJ; ++j) {
            const bool gt = (k[j] > thrg), eq = (k[j] == thrg) && ((64 * j + lane) < n);
            const unsigned long long beq = __ballot(eq);
            const bool sel = gt || (eq && (ties + __popcll(beq & lt) < need)); ties += __popcll(beq);
            const unsigned long long bs = __ballot(sel);
            if (lane == j) myw = bs;
        }
        mlo = (unsigned)myw; mhi = (unsigned)(myw >> 32);
    }
    if (lane <= (t >> 6)) WSP(unsigned long long, WS_MASK)[((size_t)b * 64 + lane) * SEQ + t] = ((unsigned long long)mhi << 32) | mlo;
}
__device__ __forceinline__ void select_row(Frame& F, int m) {
    const int n = (m & 4095) + 1;
    if (n <= 1024) select_row_t<16>(F, m); else if (n <= 2048) select_row_t<32>(F, m); else if (n <= 3072) select_row_t<48>(F, m); else select_row_t<64>(F, m);
}
}

namespace fa {
typedef short s16x4 __attribute__((ext_vector_type(4)));
typedef short v4i16_t __attribute__((ext_vector_type(4)));
constexpr int KOFF = 0, VOFF = 16384, XOFF = 32768, OSTOFF = 36864, TOTOFF = 69632;
constexpr float THR = 8.0f;
__device__ __forceinline__ int crow(int r, int hi) { return (r & 3) + 8 * (r >> 2) + 4 * hi; }
typedef float f32x2_t __attribute__((ext_vector_type(2))); typedef __bf16 bf16x2_t __attribute__((ext_vector_type(2)));
__device__ __forceinline__ unsigned cvtpk(float lo, float hi) { f32x2_t v = {lo, hi}; bf16x2_t b = __builtin_convertvector(v, bf16x2_t); return __builtin_bit_cast(unsigned, b); }
struct Ctx { LAS unsigned char* lds; int lane, wid, r32, hi; };

__device__ __forceinline__ void dma_tile(const Ctx& c, const bf16* Kg, const bf16* Vg, int pitch, int t, int buf) {
    const bf16* ks = Kg + (size_t)(64 * t + c.lane) * pitch + c.wid * 8;
    __builtin_amdgcn_global_load_lds((const unsigned*)ks, (LAS unsigned*)(c.lds + KOFF + buf * 8192 + c.wid * 1024), 16, 0, 0);
    const bf16* vs = Vg + (size_t)(64 * t + 16 * (c.wid & 3) + (c.lane >> 2)) * pitch + (c.wid >> 2) * 32 + (c.lane & 3) * 8;
    __builtin_amdgcn_global_load_lds((const unsigned*)vs, (LAS unsigned*)(c.lds + VOFF + buf * 8192 + c.wid * 1024), 16, 0, 0);
}
__device__ __forceinline__ void qk(const Ctx& c, int buf, const f32x16& ci, f32x16& p0, f32x16& p1) {
    const LAS unsigned char* kb = c.lds + KOFF + buf * 8192 + c.hi * 1024 + c.r32 * 16;
    const LAS bf16x8* qs = (const LAS bf16x8*)(c.lds + OSTOFF + c.wid * 4096) + c.lane;
    p0 = ci; p1 = ci;
#pragma unroll
    for (int d0 = 0; d0 < 4; ++d0) {
        const bf16x8 b0 = *(const LAS bf16x8*)(kb + d0 * 2048), b1 = *(const LAS bf16x8*)(kb + d0 * 2048 + 512), q = qs[d0 * 64];
        p0 = __builtin_amdgcn_mfma_f32_32x32x16_bf16(b0, q, p0, 0, 0, 0);
        p1 = __builtin_amdgcn_mfma_f32_32x32x16_bf16(b1, q, p1, 0, 0, 0);
    }
}
__device__ __forceinline__ void park_q(const Ctx& c, const bf16* Qrow  ) {
    LAS bf16x8* qs = (LAS bf16x8*)(c.lds + OSTOFF + c.wid * 4096) + c.lane;
#pragma unroll
    for (int d0 = 0; d0 < 4; ++d0) qs[d0 * 64] = *(const bf16x8*)(Qrow + d0 * 16 + c.hi * 8);
}
__device__ __forceinline__ s16x4 vtr(const LAS unsigned char* p) { return __builtin_bit_cast(s16x4, __builtin_amdgcn_ds_read_tr16_b64_v4i16((LAS v4i16_t*)p)); }
__device__ __forceinline__ void pv(const Ctx& c, int buf, f32x16 (&o)[2], f32x16& lacc, const u32x4 (&pw)[4]) {
    const bf16x8 ones = {(short)0x3F80, (short)0x3F80, (short)0x3F80, (short)0x3F80, (short)0x3F80, (short)0x3F80, (short)0x3F80, (short)0x3F80};
    const LAS unsigned char* vp = c.lds + VOFF + buf * 8192 + ((c.lane >> 4) & 1) * 32 + (c.lane & 3) * 8 + (4 * c.hi + ((c.lane & 15) >> 2)) * 64;
#pragma unroll
    for (int d0 = 0; d0 < 2; ++d0) {
        s16x4 lo[4], hi[4];
#pragma unroll
        for (int ks = 0; ks < 4; ++ks) { lo[ks] = vtr(vp + d0 * 4096 + ks * 1024); hi[ks] = vtr(vp + d0 * 4096 + ks * 1024 + 512); }
#pragma unroll
        for (int ks = 0; ks < 4; ++ks) {
            const bf16x8 vf = {lo[ks][0], lo[ks][1], lo[ks][2], lo[ks][3], hi[ks][0], hi[ks][1], hi[ks][2], hi[ks][3]};
            o[d0] = __builtin_amdgcn_mfma_f32_32x32x16_bf16(__builtin_bit_cast(bf16x8, pw[ks]), vf, o[d0], 0, 0, 0);
        }
        }
#pragma unroll
    for (int ks = 0; ks < 4; ++ks) lacc = __builtin_amdgcn_mfma_f32_32x32x16_bf16(__builtin_bit_cast(bf16x8, pw[ks]), ones, lacc, 0, 0, 0);
}
struct State { f32x16 o[2]; f32x16 lacc; f32x16 negm; float m; };
__device__ __forceinline__ void reset(State& s) { s.o[0] = f32x16{}; s.o[1] = f32x16{}; s.lacc = f32x16{}; s.negm = f32x16{}; s.m = 0.f; }
__device__ __forceinline__ float rowmax(const f32x16& p0, const f32x16& p1) {
    float a = fmaxf(fmaxf(p0[0], p0[1]), p1[0]), b = fmaxf(fmaxf(p0[2], p0[3]), p1[1]); a = fmaxf(fmaxf(a, p1[2]), p1[3]);
#pragma unroll
    for (int r = 4; r < 16; r += 4) { a = fmaxf(fmaxf(a, p0[r]), p0[r + 1]); b = fmaxf(fmaxf(b, p0[r + 2]), p0[r + 3]); a = fmaxf(fmaxf(a, p1[r]), p1[r + 1]); b = fmaxf(fmaxf(b, p1[r + 2]), p1[r + 3]); }
    const float m = fmaxf(a, b);
    auto rr = __builtin_amdgcn_permlane32_swap(__builtin_bit_cast(unsigned, m), __builtin_bit_cast(unsigned, m), false, false);
    return fmaxf(__builtin_bit_cast(float, rr[0]), __builtin_bit_cast(float, rr[1]));
}
template <bool BITS>
__device__ __forceinline__ void tile_step(const Ctx& c, int buf, State& s, const f32x16& ci, bool first, unsigned w0, unsigned w1) {
    f32x16 p0, p1;
    qk(c, buf, ci, p0, p1);
    const float rm = rowmax(p0, p1);
    bool doit; float dl;
    if (first) { doit = true; dl = rm; } else { doit = __any(rm > THR); dl = fmaxf(rm, 0.f); }
    if (doit) {
        s.m += dl;
#pragma unroll
        for (int r = 0; r < 16; ++r) { p0[r] -= dl; p1[r] -= dl; s.negm[r] = -s.m; }
        if (!first) {
            const float f = __builtin_amdgcn_exp2f(-dl);
            LAS float* xs = (LAS float*)(c.lds + XOFF) + c.wid * 64;
            if (c.hi == 0) xs[c.r32] = f;
#pragma unroll
            for (int r = 0; r < 16; ++r) { const float fr = xs[crow(r, c.hi)]; s.o[0][r] *= fr; s.o[1][r] *= fr; s.lacc[r] *= fr; }
        }
    }
    if (BITS) { w0 >>= 4 * c.hi; w1 >>= 4 * c.hi; }
#pragma unroll
    for (int r = 0; r < 16; ++r) {
        float e0 = __builtin_amdgcn_exp2f(p0[r]), e1 = __builtin_amdgcn_exp2f(p1[r]);
        if (BITS) { const int sh = (r & 3) + 8 * (r >> 2);
            int m0_, m1_;
            asm("v_bfe_i32 %0, %1, %2, 1" : "=v"(m0_) : "v"(w0), "s"(sh)); asm("v_bfe_i32 %0, %1, %2, 1" : "=v"(m1_) : "v"(w1), "s"(sh));
            e0 = __builtin_bit_cast(float, __builtin_bit_cast(unsigned, e0) & (unsigned)m0_);
            e1 = __builtin_bit_cast(float, __builtin_bit_cast(unsigned, e1) & (unsigned)m1_); }
        p0[r] = e0; p1[r] = e1;
    }
    u32x4 pw[4];
    pw[0] = (u32x4){cvtpk(p0[0], p0[1]), cvtpk(p0[2], p0[3]), cvtpk(p0[4], p0[5]), cvtpk(p0[6], p0[7])};
    pw[1] = (u32x4){cvtpk(p0[8], p0[9]), cvtpk(p0[10], p0[11]), cvtpk(p0[12], p0[13]), cvtpk(p0[14], p0[15])};
    pw[2] = (u32x4){cvtpk(p1[0], p1[1]), cvtpk(p1[2], p1[3]), cvtpk(p1[4], p1[5]), cvtpk(p1[6], p1[7])};
    pw[3] = (u32x4){cvtpk(p1[8], p1[9]), cvtpk(p1[10], p1[11]), cvtpk(p1[12], p1[13]), cvtpk(p1[14], p1[15])};
    pv(c, buf, s.o, s.lacc, pw);
}
__device__ __forceinline__ void normalise(const Ctx& c, State& s, const LAS float* gl) {
#pragma unroll
    for (int r = 0; r < 16; ++r) { const float gq = gl ? gl[crow(r, c.hi)] : 1.0f; const float fr = s.lacc[r] > 0.f ? gq / s.lacc[r] : 0.f; s.o[0][r] *= fr; s.o[1][r] *= fr; }
}
__device__ __forceinline__ void causal_words(int qi, unsigned& w0, unsigned& w1) { const unsigned long long w = (qi >= 63) ? ~0ull : ((2ull << qi) - 1ull); w0 = (unsigned)w; w1 = (unsigned)(w >> 32); }
__device__ __forceinline__ void store_o(const Ctx& c, const f32x16 (&val)[2], unsigned char* Ow  ) {
    LAS float* stg = (LAS float*)(c.lds + OSTOFF + c.wid * 4096);
    LAS bf16* sb = (LAS bf16*)stg;
#pragma unroll
    for (int r = 0; r < 16; ++r) { const int orow = crow(r, c.hi);
#pragma unroll
        for (int d0 = 0; d0 < 2; ++d0) sb[orow * 64 + d0 * 32 + c.r32] = (bf16)f2bf(val[d0][r] * OS); }
    const int row = c.lane >> 1, hf = c.lane & 1;
    const u32x4 a = *(const LAS u32x4*)(sb + row * 64 + hf * 32), b = *(const LAS u32x4*)(sb + row * 64 + hf * 32 + 8), cq = *(const LAS u32x4*)(sb + row * 64 + hf * 32 + 16), dq = *(const LAS u32x4*)(sb + row * 64 + hf * 32 + 24);
    u32x4 o0, o1;
    o0.x = pk4_fp8(bflo(a.x), bfhi(a.x), bflo(a.y), bfhi(a.y)); o0.y = pk4_fp8(bflo(a.z), bfhi(a.z), bflo(a.w), bfhi(a.w)); o0.z = pk4_fp8(bflo(b.x), bfhi(b.x), bflo(b.y), bfhi(b.y)); o0.w = pk4_fp8(bflo(b.z), bfhi(b.z), bflo(b.w), bfhi(b.w));
    o1.x = pk4_fp8(bflo(cq.x), bfhi(cq.x), bflo(cq.y), bfhi(cq.y)); o1.y = pk4_fp8(bflo(cq.z), bfhi(cq.z), bflo(cq.w), bfhi(cq.w)); o1.z = pk4_fp8(bflo(dq.x), bfhi(dq.x), bflo(dq.y), bfhi(dq.y)); o1.w = pk4_fp8(bflo(dq.z), bfhi(dq.z), bflo(dq.w), bfhi(dq.w));
    *(u32x4*)(Ow + (size_t)row * 1024 + hf * 32) = o0; *(u32x4*)(Ow + (size_t)row * 1024 + hf * 32 + 16) = o1;
}
__device__ __forceinline__ void store_o_bf16(const Ctx& c, const f32x16 (&val)[2], bf16* Ow) {
    LAS bf16* stg = (LAS bf16*)(c.lds + OSTOFF) + c.wid * 2048;
#pragma unroll
    for (int r = 0; r < 16; ++r) { const int orow = crow(r, c.hi);
#pragma unroll
        for (int d0 = 0; d0 < 2; ++d0) stg[orow * 64 + d0 * 32 + c.r32] = (bf16)f2bf(val[d0][r]); }
#pragma unroll
    for (int i = 0; i < 4; ++i) { const int row = i * 8 + (c.lane >> 3), ch = c.lane & 7; const u32x4 v = *(const LAS u32x4*)(stg + row * 64 + ch * 8); *(u32x4*)(Ow + (size_t)row * 1024 + ch * 8) = v; }
}

__device__ __forceinline__ void dsa_unit(Frame& F, int b, int g, int qt) {
    Ctx c; c.lds = F.lds; c.lane = F.lane; c.wid = F.wave; c.r32 = F.lane & 31; c.hi = F.lane >> 5;
    const int h = 4 * g + (c.wid >> 1), qw = 64 * qt + 32 * (c.wid & 1);
    const size_t mrow = (size_t)b * SEQ + qw;
    const bf16* Q = LWSP(bf16, WS_Q0) + (mrow + c.r32) * 1024 + h * 64;
    park_q(c, Q);
    const bf16* Kg = LWSP(bf16, WS_K0) + (size_t)b * SEQ * 256 + g * 64; const bf16* Vg = LWSP(bf16, WS_V0) + (size_t)b * SEQ * 256 + g * 64;
    typedef __attribute__((address_space(1))) const u32x2* gmask_t;
    const gmask_t MK = (gmask_t)(const u32x2*)(LWSP(unsigned long long, WS_MASK) + (size_t)b * 64 * SEQ + qw + c.r32);
    State s; reset(s);
    const int NT = qt + 1;
    dma_tile(c, Kg, Vg, 256, 0, 0);
    u32x2 mk_next = MK[0];
    __syncthreads();
    for (int t = 0; t < NT; ++t) {
        const u32x2 mk = mk_next;
        if (t + 1 < NT) { dma_tile(c, Kg, Vg, 256, t + 1, (t + 1) & 1); mk_next = MK[(size_t)(t + 1) * SEQ]; }
        tile_step<true>(c, t & 1, s, s.negm, t == 0, mk.x, mk.y);
        __syncthreads();
    }
    normalise(c, s, nullptr);
    store_o(c, s.o, LWSP(unsigned char, WS_O0) + mrow * 1024 + h * 64);
}

__device__ __forceinline__ void nsa_unit(Frame& F, int b, int g, int qt) {
    Ctx c; c.lds = F.lds; c.lane = F.lane; c.wid = F.wave; c.r32 = F.lane & 31; c.hi = F.lane >> 5;
    const int h = 4 * g + (c.wid >> 1), qw = 64 * qt + 32 * (c.wid & 1), qi = 32 * (c.wid & 1) + c.r32;
    const size_t mrow = (size_t)b * SEQ + qw;
    park_q(c, LWSP(bf16, WS_Q1) + (mrow + c.r32) * 1024 + h * 64);
    const unsigned long long sel = LWSP(unsigned long long, WS_SEL)[((size_t)b * 4 + g) * SEQ + qw + c.r32];
    LAS float* gx = (LAS float*)(c.lds + XOFF + 2048) + c.wid * 64;
    gx[c.lane] = LWSP(float, SM_GATES)[(mrow + c.r32) * 48 + h * 3 + 1 + c.hi];
    LAS float* totw = (LAS float*)(c.lds + TOTOFF) + c.wid * 2048;
    LAS float* totl = totw + c.r32;
    State s;
    {
        const bf16* Kg = LWSP(bf16, WS_KSLC) + (size_t)b * SEQ * 256 + g * 64; const bf16* Vg = LWSP(bf16, WS_VSLC) + (size_t)b * SEQ * 256 + g * 64;
        reset(s);
        dma_tile(c, Kg, Vg, 256, 0, 0);
        __syncthreads();
        for (int t = 0; t <= qt; ++t) {
            if (t < qt) dma_tile(c, Kg, Vg, 256, t + 1, (t + 1) & 1);
            const bool on = (sel >> t) & 1ull;
            if (!on) {
#pragma unroll
                for (int r = 0; r < 16; ++r) s.negm[r] = -INFINITY; }
            if (t == qt) { unsigned w0, w1; causal_words(qi, w0, w1); tile_step<true>(c, t & 1, s, s.negm, t == 0, w0, w1); }
            else tile_step<false>(c, t & 1, s, s.negm, t == 0, 0u, 0u);
#pragma unroll
            for (int r = 0; r < 16; ++r) s.negm[r] = -s.m;
            __syncthreads();
        }
        normalise(c, s, gx);
#pragma unroll
        for (int r = 0; r < 16; ++r) { totl[crow(r, c.hi) * 64] = s.o[0][r]; totl[crow(r, c.hi) * 64 + 32] = s.o[1][r]; }
    }
    {
        const bf16* Kg = LWSP(bf16, WS_KWIN) + (size_t)b * SEQ * 256 + g * 64; const bf16* Vg = LWSP(bf16, WS_VWIN) + (size_t)b * SEQ * 256 + g * 64;
        reset(s);
        const int tlo = qt >= 8 ? qt - 8 : 0;
        dma_tile(c, Kg, Vg, 256, tlo, tlo & 1);
        __syncthreads();
        for (int t = tlo; t <= qt; ++t) {
            if (t < qt) dma_tile(c, Kg, Vg, 256, t + 1, (t + 1) & 1);
            if (t == qt) { unsigned w0, w1; causal_words(qi, w0, w1); tile_step<true>(c, t & 1, s, s.negm, t == tlo, w0, w1); }
            else if (t == qt - 8) { unsigned w0, w1; causal_words(qi, w0, w1); tile_step<true>(c, t & 1, s, s.negm, t == tlo, ~w0, ~w1); }
            else tile_step<false>(c, t & 1, s, s.negm, t == tlo, 0u, 0u);
            __syncthreads();
        }
        normalise(c, s, gx + 32);
#pragma unroll
        for (int r = 0; r < 16; ++r) { totl[crow(r, c.hi) * 64] += s.o[0][r]; totl[crow(r, c.hi) * 64 + 32] += s.o[1][r]; }
    }
    const bf16* OCG = LWSP(bf16, WS_OCG) + mrow * 1024 + h * 64; unsigned char* O = LWSP(unsigned char, WS_O1) + mrow * 1024 + h * 64;
#pragma unroll
    for (int i = 0; i < 8; ++i) { const int row = i * 4 + (c.lane >> 4), ch = c.lane & 15;
        const u32x2 oc = *(const u32x2*)(OCG + (size_t)row * 1024 + 4 * ch);
        const f32x4 v = (*(const LAS f32x4*)(totw + row * 64 + 4 * ch) + (f32x4){bflo(oc.x), bfhi(oc.x), bflo(oc.y), bfhi(oc.y)}) * OS;
        *(unsigned*)(O + (size_t)row * 1024 + 4 * ch) = pk4_fp8(v.x, v.y, v.z, v.w); }
}
__device__ __forceinline__ void unit_of(int v, int i, int& b, int& g, int& qt) { const int bg = v >> 4, p = v & 15; b = bg >> 2; g = bg & 3; qt = (i == 0) ? p : (i == 1) ? 63 - p : (i == 2) ? 31 - p : 32 + p; }
}

namespace fp {
using fa::Ctx; using fa::crow; using fa::cvtpk; using fa::vtr; using fa::s16x4; using fa::causal_words;
constexpr int SLOTB = 8192, LK = 0, LV = 3 * SLOTB, LX = 6 * SLOTB, LOST = LX + 4096, LQ = LOST + 8 * 4096;
constexpr float THR = 8.0f;
enum { SW_DSA = 0, SW_SLC = 1, SW_WIN = 2 };
#define FP_SBAR() __builtin_amdgcn_sched_barrier(0)
#define FP_PIN(x) asm volatile("" : "+v"(x))
#define FP_MFMA(a, b, c) __builtin_amdgcn_mfma_f32_32x32x16_bf16(a, b, c, 0, 0, 0)
#define FP_WAIT_BAR(N) asm volatile("s_waitcnt vmcnt(" #N ") lgkmcnt(0)\n\ts_barrier" ::: "memory")
#define FP_MX3(a, b, c) __builtin_fmaxf(__builtin_fmaxf((a), (b)), (c))
typedef const LAS char* lds_cptr;
__device__ __forceinline__ void glds16s(const char* base  , unsigned off, LAS unsigned char* l  ) {
    const unsigned a = __builtin_amdgcn_readfirstlane((unsigned)(unsigned long)l);
    asm volatile("s_nop 4\n\ts_mov_b32 m0, %2\n\ts_nop 0\n\tglobal_load_lds_dwordx4 %0, %1" :: "v"(off), "s"(base), "s"(a) : "memory", "m0");
}
__device__ __forceinline__ float rowmax(const f32x16& p0, const f32x16& p1) {
    float a = FP_MX3(p0[0], p0[1], p1[0]), b = FP_MX3(p0[2], p0[3], p1[1]); a = FP_MX3(a, p1[2], p1[3]);
#pragma unroll
    for (int r = 4; r < 16; r += 4) { a = FP_MX3(a, p0[r], p0[r + 1]); b = FP_MX3(b, p0[r + 2], p0[r + 3]); a = FP_MX3(a, p1[r], p1[r + 1]); b = FP_MX3(b, p1[r + 2], p1[r + 3]); }
    const float m = __builtin_fmaxf(a, b); auto rr = __builtin_amdgcn_permlane32_swap(__builtin_bit_cast(unsigned, m), __builtin_bit_cast(unsigned, m), false, false);
    return __builtin_bit_cast(float, rr[0]); }
__device__ __forceinline__ float pair_sum(float v) { return v + __shfl_xor(v, 32); }
__device__ __forceinline__ void kload2(bf16x8* kf, lds_cptr kp, int d0) { kf[2 * d0] = *(const LAS bf16x8*)(kp + d0 * 2048); kf[2 * d0 + 1] = *(const LAS bf16x8*)(kp + d0 * 2048 + 512); }
#define FP_MBIT(e, w, SH) ({ int m_; asm("v_bfe_i32 %0, %1, %2, 1" : "=v"(m_) : "v"(w), "n"(SH)); __builtin_bit_cast(float, __builtin_bit_cast(unsigned, (e)) & (unsigned)m_); })
template <int SW>
__device__ __forceinline__ void sweep(const Ctx& c, const bf16* Kg, const bf16* Vg, const int NT, const u32x2* MK, const unsigned long long sel, const int qi, f32x16 (&o)[2], float& l_out) {
    const int lane = c.lane, r32 = c.r32, hi = c.hi, wid = c.wid;
    LAS float* wsf = (LAS float*)(c.lds + LX) + wid * 64;
    const unsigned koff = (unsigned)(lane * 256 + wid * 8) * 2u;
    const unsigned voff = (unsigned)((16 * (wid & 3) + (lane >> 2)) * 256 + (wid >> 2) * 32 + (lane & 3) * 8) * 2u;
    LAS unsigned char* kdst = c.lds + LK + wid * 1024; LAS unsigned char* vdst = c.lds + LV + wid * 1024;
#define FP_DMA_K(t, slot) glds16s((const char*)Kg + (size_t)(t) * (64 * 256 * 2), koff, kdst + (slot))
#define FP_DMA_V(t, slot) glds16s((const char*)Vg + (size_t)(t) * (64 * 256 * 2), voff, vdst + (slot))
    const lds_cptr vp0 = (lds_cptr)c.lds + LV + ((lane >> 4) & 1) * 32 + (lane & 3) * 8 + (4 * hi + ((lane & 15) >> 2)) * 64;
    const lds_cptr kp0 = (lds_cptr)c.lds + LK + hi * 1024 + r32 * 16;
    const LAS bf16x8* qs = (const LAS bf16x8*)(c.lds + LQ + wid * 4096) + lane;
#define FP_Q(d0) qs[(d0) * 64]
    bf16x8 qa, qb;
    constexpr int KS = (SW == SW_DSA) ? 1 : (SW == SW_SLC) ? 2 : 0;
    u32x2 mkN = {0u, 0u}; unsigned w0s = 0u, w1s = 0u; bool onv = true; (void)onv; (void)mkN;
    auto words = [&](int j, unsigned& a0, unsigned& a1) {
        unsigned x0 = ~0u, x1 = ~0u;
        if (SW == SW_DSA) { u32x2 m_ = mkN; asm volatile("" : "+v"(m_.x), "+v"(m_.y)); x0 = m_.x; x1 = m_.y; }
        else { if (j == NT - 1) causal_words(qi, x0, x1); else if (SW == SW_WIN && j == 0 && NT == 9) { causal_words(qi, x0, x1); x0 = ~x0; x1 = ~x1; }
               if (SW == SW_SLC && !((sel >> j) & 1ull)) { x0 = 0u; x1 = 0u; } }
        a0 = x0 >> (4 * hi); a1 = x1 >> (4 * hi); };
    typedef __attribute__((address_space(1))) const u32x2* gmask_t; const gmask_t MKG = (gmask_t)MK;
    if (SW == SW_DSA) mkN = MKG[0];
    FP_DMA_K(0, 0); FP_DMA_V(0, 0); if (NT > 1) FP_DMA_K(1, SLOTB); if (NT > 2) FP_DMA_K(2, 2 * SLOTB);
    float mhat = 0.f, l_reg = 0.f; o[0] = f32x16{}; o[1] = f32x16{};
    f32x16 negm;
    { float z_ = 0.f; asm volatile("" : "+v"(z_));
#pragma unroll
      for (int r = 0; r < 16; ++r) negm[r] = z_; }
    bool resc = false;
    f32x16 pA0, pA1, pB0, pB1; bf16x8 kf[8]; s16x4 vlo[8], vhi[8]; u32x4 pw0, pw1, pw2, pw3;
    int sl_prev = 0, sl_cur = 0, sl_next = SLOTB;
#define FP_ROT() do { sl_prev = sl_cur; sl_cur = sl_next; sl_next = (sl_next == 2 * SLOTB) ? 0 : sl_next + SLOTB; } while (0)
#define FP_RESC() do { if (resc) { _Pragma("unroll") for (int d_ = 0; d_ < 2; ++d_) _Pragma("unroll") for (int r = 0; r < 16; ++r) o[d_][r] *= wsf[crow(r, hi)]; } } while (0)
    if (NT > 2) FP_WAIT_BAR(3); else if (NT > 1) FP_WAIT_BAR(2); else FP_WAIT_BAR(1);
    _Pragma("unroll") for (int d0 = 0; d0 < 4; ++d0) kload2(kf, kp0, d0);
    qa = FP_Q(0); qb = FP_Q(1);
    pA0 = FP_MFMA(kf[0], qa, negm); pA1 = FP_MFMA(kf[1], qa, negm); pA0 = FP_MFMA(kf[2], qb, pA0); pA1 = FP_MFMA(kf[3], qb, pA1);
    qa = FP_Q(2); qb = FP_Q(3);
    pA0 = FP_MFMA(kf[4], qa, pA0); pA1 = FP_MFMA(kf[5], qa, pA1); pA0 = FP_MFMA(kf[6], qb, pA0); pA1 = FP_MFMA(kf[7], qb, pA1);
    qa = FP_Q(0);
    { words(0, w0s, w1s);
      const float rm = rowmax(pA0, pA1); mhat = rm;
#pragma unroll
      for (int r = 0; r < 16; ++r) { const int sh = (r & 3) + 8 * (r >> 2);
          const float e0 = __builtin_amdgcn_exp2f(pA0[r] - rm), e1 = __builtin_amdgcn_exp2f(pA1[r] - rm);
          pA0[r] = ((w0s >> sh) & 1u) ? e0 : 0.f; pA1[r] = ((w1s >> sh) & 1u) ? e1 : 0.f; negm[r] = -rm; } }
    FP_WAIT_BAR(0);
    if (SW == SW_DSA && NT > 1) mkN = MKG[SEQ];
    if (NT > 3) FP_DMA_K(3, 0); if (NT > 1) { FP_DMA_V(1, SLOTB); FP_ROT(); }
    if (NT > 1) { _Pragma("unroll") for (int d0 = 0; d0 < 4; ++d0) kload2(kf, kp0 + sl_cur, d0); }
    if (NT > 3) FP_WAIT_BAR(2); else if (NT == 3) FP_WAIT_BAR(1); else FP_WAIT_BAR(0);
#define FP_PKW(P, i) cvtpk(P[i], P[i + 1])
#define FP_PAF(k) __builtin_bit_cast(bf16x8, pw##k)
#define FP_VFR(i) (bf16x8){vlo[i][0], vlo[i][1], vlo[i][2], vlo[i][3], vhi[i][0], vhi[i][1], vhi[i][2], vhi[i][3]}
#define FP_VRD(i) do { vlo[i] = vtr((const LAS unsigned char*)(vp_ + (((i) >> 2) * 4096 + ((i) & 3) * 1024))); vhi[i] = vtr((const LAS unsigned char*)(vp_ + (((i) >> 2) * 4096 + ((i) & 3) * 1024 + 512))); } while (0)
#define FP_KRD(G, d0) do { if (G) { kload2(kf, kp0 + sl_next, d0); FP_SBAR(); } } while (0)
#define FP_GAPA(MF, a0, a1, a2, a3, W0, W1, PW) do { MF; sacc += a0; sacc += a1; sacc += a2; sacc += a3; W0; W1; FP_PIN(PW); FP_PIN(sacc); FP_SBAR(); } while (0)
#define FP_EXM(KIND, X, W, k, SHB) X[k] = ((KIND) == 1) ? FP_MBIT(__builtin_amdgcn_exp2f(X[k]), W, (SHB)) : ((KIND) == 2) ? (onv ? __builtin_amdgcn_exp2f(X[k]) : 0.f) : __builtin_amdgcn_exp2f(X[k])
#define FP_GAPB(MF, KIND, X, W, i) do { MF; FP_EXM(KIND, X, W, i, 2 * (i)); FP_EXM(KIND, X, W, (i) + 1, 2 * (i) + 1); FP_EXM(KIND, X, W, (i) + 2, 2 * (i) + 2); FP_EXM(KIND, X, W, (i) + 3, 2 * (i) + 3); FP_PIN(X); FP_SBAR(); } while (0)
#define FP_STEP(C0, C1, P0, P1, t, KIND, MSET, GK, GVL) do { FP_SBAR(); \
    const lds_cptr vp_ = vp0 + sl_prev; \
    FP_VRD(0); qb = FP_Q(1); FP_SBAR(); float sacc = P0[0] + P0[1]; \
                       FP_GAPA(C0 = FP_MFMA(kf[0], qa, negm), P0[2], P0[3], P0[4], P0[5],     pw0[0] = FP_PKW(P0, 0),  pw0[1] = FP_PKW(P0, 2),  pw0); \
    FP_VRD(4); FP_SBAR(); FP_GAPA(C1 = FP_MFMA(kf[1], qa, negm), P0[6], P0[7], P0[8], P0[9],     pw0[2] = FP_PKW(P0, 4),  pw0[3] = FP_PKW(P0, 6),  pw0); \
    FP_VRD(1); qa = FP_Q(2); FP_SBAR(); FP_GAPA(C0 = FP_MFMA(kf[2], qb, C0),   P0[10], P0[11], P0[12], P0[13], pw1[0] = FP_PKW(P0, 8),  pw1[1] = FP_PKW(P0, 10), pw1); \
    FP_VRD(5); FP_SBAR(); FP_GAPA(C1 = FP_MFMA(kf[3], qb, C1),   P0[14], P0[15], P1[0], P1[1],   pw1[2] = FP_PKW(P0, 12), pw1[3] = FP_PKW(P0, 14), pw1); \
    qb = FP_Q(3); FP_SBAR(); FP_GAPA(C0 = FP_MFMA(kf[4], qa, C0),   P1[2], P1[3], P1[4], P1[5],     pw2[0] = FP_PKW(P1, 0),  pw2[1] = FP_PKW(P1, 2),  pw2); \
    FP_GAPA(C1 = FP_MFMA(kf[5], qa, C1),   P1[6], P1[7], P1[8], P1[9],     pw2[2] = FP_PKW(P1, 4),  pw2[3] = FP_PKW(P1, 6),  pw2); \
    FP_GAPA(C0 = FP_MFMA(kf[6], qb, C0),   P1[10], P1[11], P1[12], P1[13], pw3[0] = FP_PKW(P1, 8),  pw3[1] = FP_PKW(P1, 10), pw3); \
    FP_GAPA(C1 = FP_MFMA(kf[7], qb, C1),   P1[14], P1[15], 0.f, 0.f,       pw3[2] = FP_PKW(P1, 12), pw3[3] = FP_PKW(P1, 14), pw3); \
    l_reg += sacc; \
    MSET; \
    if (SW == SW_DSA && (GVL)) mkN = MKG[(size_t)((t) + 1) * SEQ];                                                          \
    if (GK) FP_DMA_K((t) + 3, sl_cur); if (GVL) FP_DMA_V((t) + 1, sl_next); \
    { const float rm = rowmax(C0, C1); resc = false;                                                                         \
      if (__builtin_expect(__any(rm > THR), 0)) { const float dl = __builtin_fmaxf(rm, 0.f); mhat += dl; \
          const float f = __builtin_amdgcn_exp2f(-dl); l_reg *= f; if (hi == 0) wsf[r32] = f; resc = true; \
          _Pragma("unroll") for (int r = 0; r < 16; ++r) { C0[r] -= dl; C1[r] -= dl; negm[r] = -mhat; } } } \
    FP_SBAR(); \
    FP_VRD(2); FP_SBAR(); FP_GAPB(o[0] = FP_MFMA(FP_PAF(0), FP_VFR(0), o[0]), KIND, C0, w0s, 0);  FP_VRD(6); FP_SBAR(); FP_GAPB(o[1] = FP_MFMA(FP_PAF(0), FP_VFR(4), o[1]), KIND, C0, w0s, 4);     \
    FP_VRD(3); FP_SBAR(); FP_GAPB(o[0] = FP_MFMA(FP_PAF(1), FP_VFR(1), o[0]), KIND, C0, w0s, 8);  FP_VRD(7); FP_SBAR(); FP_GAPB(o[1] = FP_MFMA(FP_PAF(1), FP_VFR(5), o[1]), KIND, C0, w0s, 12); \
    FP_KRD(GVL, 0); FP_GAPB(o[0] = FP_MFMA(FP_PAF(2), FP_VFR(2), o[0]), KIND, C1, w1s, 0);  FP_KRD(GVL, 1); FP_GAPB(o[1] = FP_MFMA(FP_PAF(2), FP_VFR(6), o[1]), KIND, C1, w1s, 4);           \
    FP_KRD(GVL, 2); FP_GAPB(o[0] = FP_MFMA(FP_PAF(3), FP_VFR(3), o[0]), KIND, C1, w1s, 8);  if (GVL) { kload2(kf, kp0 + sl_next, 3); qa = FP_Q(0); FP_SBAR(); }  FP_GAPB(o[1] = FP_MFMA(FP_PAF(3), FP_VFR(7), o[1]), KIND, C1, w1s, 12); \
    } while (0)
#define FP_ENDW(tt) do { if ((tt) + 3 < NT) { FP_WAIT_BAR(2); } else if ((tt) + 2 < NT) { FP_WAIT_BAR(1); } else { FP_WAIT_BAR(0); } } while (0)
#define FP_MSET_S(t) do { if (KS == 1) words((t), w0s, w1s); else if (KS == 2) onv = (sel >> (t)) & 1ull; } while (0)
#define FP_MSET_L(t) words((t), w0s, w1s)
#define FP_DRAIN(P0, P1) do { float sacc = P0[0] + P0[1]; \
      _Pragma("unroll") for (int r = 2; r < 16; ++r) sacc += P0[r]; \
      _Pragma("unroll") for (int r = 0; r < 16; ++r) sacc += P1[r]; \
      l_reg += sacc; \
      pw0 = (u32x4){FP_PKW(P0, 0), FP_PKW(P0, 2), FP_PKW(P0, 4), FP_PKW(P0, 6)}; pw1 = (u32x4){FP_PKW(P0, 8), FP_PKW(P0, 10), FP_PKW(P0, 12), FP_PKW(P0, 14)}; \
      pw2 = (u32x4){FP_PKW(P1, 0), FP_PKW(P1, 2), FP_PKW(P1, 4), FP_PKW(P1, 6)}; pw3 = (u32x4){FP_PKW(P1, 8), FP_PKW(P1, 10), FP_PKW(P1, 12), FP_PKW(P1, 14)}; \
      const lds_cptr vp_ = vp0 + sl_cur; _Pragma("unroll") for (int i = 0; i < 8; ++i) FP_VRD(i); \
      o[0] = FP_MFMA(FP_PAF(0), FP_VFR(0), o[0]); o[1] = FP_MFMA(FP_PAF(0), FP_VFR(4), o[1]); o[0] = FP_MFMA(FP_PAF(1), FP_VFR(1), o[0]); o[1] = FP_MFMA(FP_PAF(1), FP_VFR(5), o[1]); \
      o[0] = FP_MFMA(FP_PAF(2), FP_VFR(2), o[0]); o[1] = FP_MFMA(FP_PAF(2), FP_VFR(6), o[1]); o[0] = FP_MFMA(FP_PAF(3), FP_VFR(3), o[0]); o[1] = FP_MFMA(FP_PAF(3), FP_VFR(7), o[1]); } while (0)
    const int S = NT - 1; int t = 1;
    if (S >= 1) {
        if (!(S & 1)) {
            FP_STEP(pB0, pB1, pA0, pA1, 1, KS, FP_MSET_S(1), (4 < NT), true); FP_ENDW(1); FP_RESC(); FP_ROT();
            pA0 = pB0; pA1 = pB1; t = 2;
        }
        for (; t < S; t += 2) {
            FP_STEP(pB0, pB1, pA0, pA1, t, KS, FP_MSET_S(t), (t + 3 < NT), true);         FP_ENDW(t);     FP_RESC(); FP_ROT();
            FP_STEP(pA0, pA1, pB0, pB1, t + 1, KS, FP_MSET_S(t + 1), (t + 4 < NT), true); FP_ENDW(t + 1); FP_RESC(); FP_ROT();
        }
        FP_STEP(pB0, pB1, pA0, pA1, S, 1, FP_MSET_L(S), false, false); FP_RESC();
    } else { pB0 = pA0; pB1 = pA1; }
    FP_DRAIN(pB0, pB1);
    l_out = l_reg;
    asm volatile("s_waitcnt lgkmcnt(0)\n\ts_barrier" ::: "memory");
#undef FP_Q
#undef FP_DMA_K
#undef FP_DMA_V
#undef FP_ROT
#undef FP_RESC
#undef FP_PKW
#undef FP_PAF
#undef FP_VFR
#undef FP_VRD
#undef FP_KRD
#undef FP_GAPA
#undef FP_EXM
#undef FP_GAPB
#undef FP_STEP
#undef FP_ENDW
#undef FP_MSET_S
#undef FP_MSET_L
#undef FP_DRAIN
}
__device__ __forceinline__ void park_qf(const Ctx& c, const bf16* Qrow) {
    LAS bf16x8* qs = (LAS bf16x8*)(c.lds + LQ + c.wid * 4096) + c.lane;
#pragma unroll
    for (int d0 = 0; d0 < 4; ++d0) qs[d0 * 64] = *(const bf16x8*)(Qrow + d0 * 16 + c.hi * 8);
}
__device__ __forceinline__ void scale_rows(const Ctx& c, f32x16 (&o)[2], float fac) {
    LAS float* wsf = (LAS float*)(c.lds + LX) + c.wid * 64;
    if (c.hi == 0) wsf[32 + c.r32] = fac;
#pragma unroll
    for (int r = 0; r < 16; ++r) { const float f = wsf[32 + crow(r, c.hi)]; o[0][r] *= f; o[1][r] *= f; }
}
__device__ __forceinline__ void dsa_unit(Frame& F, int b, int g, int qt) {
    int ln_ = F.lane; asm volatile("" : "+v"(ln_));
    Ctx c; c.lds = F.lds; c.lane = ln_; c.wid = F.wave; c.r32 = ln_ & 31; c.hi = ln_ >> 5;
    const int h = 4 * g + (c.wid >> 1), qw = 64 * qt + 32 * (c.wid & 1);
    const size_t mrow = (size_t)b * SEQ + qw;
    park_qf(c, LWSP(bf16, WS_Q0) + (mrow + c.r32) * 1024 + h * 64);
    const bf16* Kg = LWSP(bf16, WS_K0) + (size_t)b * SEQ * 256 + g * 64; const bf16* Vg = LWSP(bf16, WS_V0) + (size_t)b * SEQ * 256 + g * 64;
    const u32x2* MK = (const u32x2*)(LWSP(unsigned long long, WS_MASK) + (size_t)b * 64 * SEQ + qw + c.r32);
    f32x16 o[2]; float l;
    sweep<SW_DSA>(c, Kg, Vg, qt + 1, MK, 0ull, 0, o, l);
    l = pair_sum(l);
    scale_rows(c, o, l > 0.f ? 1.0f / l : 0.f);
    LAS bf16* sb = (LAS bf16*)(c.lds + LOST + c.wid * 4096);
#pragma unroll
    for (int r = 0; r < 16; ++r) { const int orow = crow(r, c.hi);
#pragma unroll
        for (int d0 = 0; d0 < 2; ++d0) sb[orow * 64 + d0 * 32 + c.r32] = (bf16)f2bf(o[d0][r] * OS); }
    unsigned char* Ow = LWSP(unsigned char, WS_O0) + mrow * 1024 + h * 64;
    const int row = c.lane >> 1, hf = c.lane & 1;
    const u32x4 a = *(const LAS u32x4*)(sb + row * 64 + hf * 32), bq = *(const LAS u32x4*)(sb + row * 64 + hf * 32 + 8), cq = *(const LAS u32x4*)(sb + row * 64 + hf * 32 + 16), dq = *(const LAS u32x4*)(sb + row * 64 + hf * 32 + 24);
    u32x4 o0, o1;
    o0.x = pk4_fp8(bflo(a.x), bfhi(a.x), bflo(a.y), bfhi(a.y)); o0.y = pk4_fp8(bflo(a.z), bfhi(a.z), bflo(a.w), bfhi(a.w)); o0.z = pk4_fp8(bflo(bq.x), bfhi(bq.x), bflo(bq.y), bfhi(bq.y)); o0.w = pk4_fp8(bflo(bq.z), bfhi(bq.z), bflo(bq.w), bfhi(bq.w));
    o1.x = pk4_fp8(bflo(cq.x), bfhi(cq.x), bflo(cq.y), bfhi(cq.y)); o1.y = pk4_fp8(bflo(cq.z), bfhi(cq.z), bflo(cq.w), bfhi(cq.w)); o1.z = pk4_fp8(bflo(dq.x), bfhi(dq.x), bflo(dq.y), bfhi(dq.y)); o1.w = pk4_fp8(bflo(dq.z), bfhi(dq.z), bflo(dq.w), bfhi(dq.w));
    *(u32x4*)(Ow + (size_t)row * 1024 + hf * 32) = o0; *(u32x4*)(Ow + (size_t)row * 1024 + hf * 32 + 16) = o1;
}
__device__ __forceinline__ void nsa_unit(Frame& F, int b, int g, int qt) {
    int ln_ = F.lane; asm volatile("" : "+v"(ln_));
    Ctx c; c.lds = F.lds; c.lane = ln_; c.wid = F.wave; c.r32 = ln_ & 31; c.hi = ln_ >> 5;
    const int h = 4 * g + (c.wid >> 1), qw = 64 * qt + 32 * (c.wid & 1), qi = 32 * (c.wid & 1) + c.r32;
    const size_t mrow = (size_t)b * SEQ + qw;
    park_qf(c, LWSP(bf16, WS_Q1) + (mrow + c.r32) * 1024 + h * 64);
    const unsigned long long sel = LWSP(unsigned long long, WS_SEL)[((size_t)b * 4 + g) * SEQ + qw + c.r32];
    LAS float* gx = (LAS float*)(c.lds + LX + 2048) + c.wid * 64;
    gx[c.lane] = LWSP(float, SM_GATES)[(mrow + c.r32) * 48 + h * 3 + 1 + c.hi];
    LAS bf16* stg = (LAS bf16*)(c.lds + LOST + c.wid * 4096);
    f32x16 o[2]; float l;
    {
        const bf16* Kg = LWSP(bf16, WS_KSLC) + (size_t)b * SEQ * 256 + g * 64; const bf16* Vg = LWSP(bf16, WS_VSLC) + (size_t)b * SEQ * 256 + g * 64;
        sweep<SW_SLC>(c, Kg, Vg, qt + 1, nullptr, sel, qi, o, l);
        l = pair_sum(l);
        scale_rows(c, o, l > 0.f ? gx[c.r32] / l : 0.f);
#pragma unroll
        for (int r = 0; r < 16; ++r) { const int orow = crow(r, c.hi);
#pragma unroll
            for (int d0 = 0; d0 < 2; ++d0) stg[orow * 64 + d0 * 32 + c.r32] = (bf16)f2bf(o[d0][r]); }
    }
    {
        const int tlo = qt >= 8 ? qt - 8 : 0;
        const bf16* Kg = LWSP(bf16, WS_KWIN) + ((size_t)b * SEQ + 64 * tlo) * 256 + g * 64; const bf16* Vg = LWSP(bf16, WS_VWIN) + ((size_t)b * SEQ + 64 * tlo) * 256 + g * 64;
        sweep<SW_WIN>(c, Kg, Vg, qt - tlo + 1, nullptr, 0ull, qi, o, l);
        l = pair_sum(l);
        scale_rows(c, o, l > 0.f ? gx[32 + c.r32] / l : 0.f);
#pragma unroll
        for (int r = 0; r < 16; ++r) { const int orow = crow(r, c.hi);
#pragma unroll
            for (int d0 = 0; d0 < 2; ++d0) { LAS bf16* p = stg + orow * 64 + d0 * 32 + c.r32; *p = (bf16)f2bf(o[d0][r] + bf2f((unsigned)*p)); } }
    }
    const bf16* OCG = LWSP(bf16, WS_OCG) + mrow * 1024 + h * 64; unsigned char* O = LWSP(unsigned char, WS_O1) + mrow * 1024 + h * 64;
#pragma unroll
    for (int i = 0; i < 4; ++i) { const int row = i * 8 + (c.lane >> 3), ch = c.lane & 7;
        const u32x4 oc = *(const u32x4*)(OCG + (size_t)row * 1024 + 8 * ch), sv = *(const LAS u32x4*)(stg + row * 64 + 8 * ch);
        u32x2 w; w.x = pk4_fp8((bflo(oc.x) + bflo(sv.x)) * OS, (bfhi(oc.x) + bfhi(sv.x)) * OS, (bflo(oc.y) + bflo(sv.y)) * OS, (bfhi(oc.y) + bfhi(sv.y)) * OS);
        w.y = pk4_fp8((bflo(oc.z) + bflo(sv.z)) * OS, (bfhi(oc.z) + bfhi(sv.z)) * OS, (bflo(oc.w) + bflo(sv.w)) * OS, (bfhi(oc.w) + bfhi(sv.w)) * OS);
        *(u32x2*)(O + (size_t)row * 1024 + 8 * ch) = w; }
}
#undef FP_SBAR
#undef FP_PIN
#undef FP_MFMA
#undef FP_WAIT_BAR
#undef FP_MX3
#undef FP_MBIT
}

namespace cm {
using namespace fa;
constexpr int IMPOFF = 69632;
__device__ __forceinline__ void unit(Frame& F, int b, int g, int qt) {
    Ctx c; c.lds = F.lds; c.lane = F.lane; c.wid = F.wave; c.r32 = F.lane & 31; c.hi = F.lane >> 5;
    const int hr = c.wid >> 1, h = 4 * g + hr, qw = 64 * qt + 32 * (c.wid & 1), qi = 32 * (c.wid & 1) + c.r32;
    const size_t mrow = (size_t)b * SEQ + qw;
    park_q(c, LWSP(bf16, WS_Q1) + (mrow + c.r32) * 1024 + h * 64);
    LAS float* gx = (LAS float*)(c.lds + XOFF + 2048) + c.wid * 64;
    if (c.hi == 0) gx[c.r32] = LWSP(float, SM_GATES)[(mrow + c.r32) * 48 + h * 3];
    const int t = qw + c.r32, nv = t >= 31 ? min(255, (t - 31) / 16 + 1) : 0;
    const bf16* Kg = LWSP(bf16, SM_KC) + (size_t)(b * 4 + g) * 256 * 64; const bf16* Vg = LWSP(bf16, SM_VC) + (size_t)(b * 4 + g) * 256 * 64;
    const int NTc = (qt >> 4) + 1;
    f32x16 o[2]; o[0] = f32x16{}; o[1] = f32x16{};
    f32x16 zero = {};
    float m = 0.f, l = 0.f, carry = 0.f;
    float bsum[4][8];
#pragma unroll
    for (int T_ = 0; T_ < 4; ++T_)
#pragma unroll
        for (int i = 0; i < 8; ++i) bsum[T_][i] = 0.f;
    dma_tile(c, Kg, Vg, 64, 0, 0);
    __syncthreads();
#pragma unroll
    for (int T_ = 0; T_ < 4; ++T_) {
        if (T_ < NTc) {
            if (T_ + 1 < NTc) dma_tile(c, Kg, Vg, 64, T_ + 1, (T_ + 1) & 1);
            f32x16 p0, p1;
            qk(c, T_ & 1, zero, p0, p1);
            __builtin_amdgcn_sched_barrier(0);
            const float rm = rowmax(p0, p1) - m;
            bool doit; float dl;
            if (T_ == 0) { doit = true; dl = rm; } else { doit = __any(rm > THR); dl = fmaxf(rm, 0.f); }
            if (doit) {
                m += dl;
                if (T_ > 0) {
                    const float f = __builtin_amdgcn_exp2f(-dl);
                    l *= f; carry *= f;
#pragma unroll
                    for (int u = 0; u < 4; ++u)
#pragma unroll
                        for (int i = 0; i < 8; ++i) bsum[u][i] *= f;
                    LAS float* xs = (LAS float*)(c.lds + XOFF) + c.wid * 64;
                    if (c.hi == 0) xs[c.r32] = f;
#pragma unroll
                    for (int r = 0; r < 16; ++r) { const float fr = xs[crow(r, c.hi)]; o[0][r] *= fr; o[1][r] *= fr; }
                }
            }
            const int cnt = nv - 64 * T_;
            const unsigned long long wm = cnt >= 64 ? ~0ull : (cnt <= 0 ? 0ull : ((1ull << cnt) - 1ull));
            const unsigned w0 = (unsigned)wm >> (4 * c.hi), w1 = (unsigned)(wm >> 32) >> (4 * c.hi);
            float ls = 0.f;
#pragma unroll
            for (int r = 0; r < 16; ++r) { const int sh = (r & 3) + 8 * (r >> 2);
                float e0 = __builtin_amdgcn_exp2f(p0[r] - m), e1 = __builtin_amdgcn_exp2f(p1[r] - m);
                e0 = __builtin_bit_cast(float, __builtin_bit_cast(unsigned, e0) & (unsigned)__builtin_amdgcn_sbfe((int)w0, sh, 1));
                e1 = __builtin_bit_cast(float, __builtin_bit_cast(unsigned, e1) & (unsigned)__builtin_amdgcn_sbfe((int)w1, sh, 1));
                p0[r] = e0; p1[r] = e1; ls += e0 + e1; }
            l += ls;
            float mn0[4], mn1[4], rc0[4], rc1[4];
#pragma unroll
            for (int i = 0; i < 4; ++i) { const float s0 = 0.5f * p0[4 * i + 3], s1 = 0.5f * p1[4 * i + 3];
                mn0[i] = (p0[4 * i] + p0[4 * i + 1]) + (p0[4 * i + 2] + s0); mn1[i] = (p1[4 * i] + p1[4 * i + 1]) + (p1[4 * i + 2] + s1);
                rc0[i] = __shfl_xor(s0, 32); rc1[i] = __shfl_xor(s1, 32); }
            if (c.hi) {
#pragma unroll
                for (int i = 0; i < 4; ++i) { bsum[T_][i] = mn0[i] + rc0[i]; bsum[T_][4 + i] = mn1[i] + rc1[i]; }
            } else {
                bsum[T_][0] = mn0[0] + carry; bsum[T_][4] = mn1[0] + rc0[3];
#pragma unroll
                for (int i = 1; i < 4; ++i) { bsum[T_][i] = mn0[i] + rc0[i - 1]; bsum[T_][4 + i] = mn1[i] + rc1[i - 1]; }
                carry = rc1[3];
            }
            u32x4 pw[4];
            pw[0] = (u32x4){cvtpk(p0[0], p0[1]), cvtpk(p0[2], p0[3]), cvtpk(p0[4], p0[5]), cvtpk(p0[6], p0[7])};
            pw[1] = (u32x4){cvtpk(p0[8], p0[9]), cvtpk(p0[10], p0[11]), cvtpk(p0[12], p0[13]), cvtpk(p0[14], p0[15])};
            pw[2] = (u32x4){cvtpk(p1[0], p1[1]), cvtpk(p1[2], p1[3]), cvtpk(p1[4], p1[5]), cvtpk(p1[6], p1[7])};
            pw[3] = (u32x4){cvtpk(p1[8], p1[9]), cvtpk(p1[10], p1[11]), cvtpk(p1[12], p1[13]), cvtpk(p1[14], p1[15])};
            __builtin_amdgcn_sched_barrier(0);
            {
                const LAS unsigned char* vp = c.lds + VOFF + (T_ & 1) * 8192 + ((c.lane >> 4) & 1) * 32 + (c.lane & 3) * 8 + (4 * c.hi + ((c.lane & 15) >> 2)) * 64;
#pragma unroll
                for (int d0 = 0; d0 < 2; ++d0) {
                    s16x4 lo[4], hi4[4];
#pragma unroll
                    for (int ks = 0; ks < 4; ++ks) { lo[ks] = vtr(vp + d0 * 4096 + ks * 1024); hi4[ks] = vtr(vp + d0 * 4096 + ks * 1024 + 512); }
#pragma unroll
                    for (int ks = 0; ks < 4; ++ks) { const bf16x8 vf = {lo[ks][0], lo[ks][1], lo[ks][2], lo[ks][3], hi4[ks][0], hi4[ks][1], hi4[ks][2], hi4[ks][3]};
                        o[d0] = __builtin_amdgcn_mfma_f32_32x32x16_bf16(__builtin_bit_cast(bf16x8, pw[ks]), vf, o[d0], 0, 0, 0); }
                    __builtin_amdgcn_sched_barrier(0);
                }
            }
            __syncthreads();
        }
    }
    l += __shfl_xor(l, 32);
    const float inv = l > 0.f ? 1.0f / l : 0.f;
    LAS float* imp = (LAS float*)(c.lds + IMPOFF) + (hr * 64 + qi) * 64;
#pragma unroll
    for (int T_ = 0; T_ < 4; ++T_)
#pragma unroll
        for (int i = 0; i < 4; ++i) { imp[16 * T_ + 2 * i + c.hi] = bsum[T_][i] * inv; imp[16 * T_ + 8 + 2 * i + c.hi] = bsum[T_][4 + i] * inv; }
    {
        LAS float* xs = (LAS float*)(c.lds + XOFF) + c.wid * 64;
        if (c.hi == 0) xs[c.r32] = inv * gx[c.r32];
#pragma unroll
        for (int r = 0; r < 16; ++r) { const float fr = xs[crow(r, c.hi)]; o[0][r] *= fr; o[1][r] *= fr; }
        store_o_bf16(c, o, LWSP(bf16, WS_OCG) + mrow * 1024 + h * 64);
    }
    __syncthreads();
    {
        const LAS float* I0 = (const LAS float*)(c.lds + IMPOFF);
        const int j = c.lane;
        for (int qq = 8 * c.wid; qq < 8 * c.wid + 8; ++qq) {
            const float iv = (I0[(0 * 64 + qq) * 64 + j] + I0[(1 * 64 + qq) * 64 + j]) + (I0[(2 * 64 + qq) * 64 + j] + I0[(3 * 64 + qq) * 64 + j]);
            const bool valid = j <= qt, forced = valid && ((j == 0) || (j == qt) || (j + 1 == qt)), cnd = valid && !forced;
            const unsigned long long bf = __ballot(forced), bc = __ballot(cnd);
            const int K = 16 - __popcll(bf);
            unsigned long long bsel = bc;
            if (__popcll(bc) > K) {
                const unsigned key = cnd ? okey(iv) : 0u;
                unsigned prefix = 0u; bool exact = false;
                for (int bit = 31; bit >= 0; --bit) { const unsigned cand = prefix | (1u << bit); const int cn = __popcll(__ballot(key >= cand)); if (cn >= K) { prefix = cand; if (cn == K) { exact = true; break; } } }
                if (exact) bsel = __ballot(key >= prefix);
                else { const unsigned long long bg = __ballot(key > prefix), be = __ballot(key == prefix); const int need = K - __popcll(bg);
                    const bool tk = (key == prefix) && (__popcll(be & ((1ull << j) - 1ull)) < need); bsel = bg | __ballot(tk); }
            }
            const unsigned long long mk = bf | bsel;
            if (j == 0) LWSP(unsigned long long, WS_SEL)[((size_t)b * 4 + g) * SEQ + 64 * qt + qq] = mk;
        }
    }
    __syncthreads();
}
}


#if DBG_CHECK
__device__ __forceinline__ void dbg_compare(Frame& F, const bf16* A, const bf16* R, int slot) {
    float sd = 0.f, sr = 0.f;
    for (size_t i = (size_t)F.gw * 64 + F.lane; i < (size_t)T * D / 2; i += (size_t)F.NGW * 64) { const unsigned a = ((const unsigned*)A)[i], r = ((const unsigned*)R)[i];
        const float d0 = bflo(a) - bflo(r), d1 = bfhi(a) - bfhi(r); sd += d0 * d0 + d1 * d1; sr += bflo(r) * bflo(r) + bfhi(r) * bfhi(r); }
    sd = wave_sum(sd); sr = wave_sum(sr);
    if (F.lane == 0) { atomicAdd((float*)(F.ctl + CW_DBG + slot), sd); atomicAdd((float*)(F.ctl + CW_DBG + slot + 1), sr); }
}
#endif
__device__ __forceinline__ f32x4 yrow(const bf16* Y, const bf16* Yp, int slot, int i) {
    if (slot < 128 * 256) { const u32x2 v = ((const u32x2*)(Y + (size_t)slot * D))[i]; return (f32x4){bflo(v.x), bfhi(v.x), bflo(v.y), bfhi(v.y)}; }
    f32x4 a = {0.f, 0.f, 0.f, 0.f};
#pragma unroll
    for (int q = 0; q < 2; ++q) { const u32x2 v = ((const u32x2*)(Yp + (size_t)q * NE * 256 * D + (size_t)(slot - 128 * 256) * D))[i]; a += (f32x4){bflo(v.x), bfhi(v.x), bflo(v.y), bfhi(v.y)}; }
    return a;
}
constexpr int NPHASE = 22;
struct Args { const void* in[29]; float* out; unsigned char* ws; int ph_lo, ph_hi, li, pad; };
__global__ void __launch_bounds__(NWAVES * 64, 2) trunk_fwd(Args args) {
    extern __shared__ __attribute__((aligned(16))) unsigned char lds[];
const int wave_s = __builtin_amdgcn_readfirstlane((int)threadIdx.x >> 6);
#define MKFRAME() Frame F; F.lds = (LAS unsigned char*)lds; F.MISC = (volatile LAS unsigned*)(F.lds + MISC_OFF); F.wave = wave_s; F.lane = lane_id(); F.tid = wave_s * 64 + F.lane; F.G = gridDim.x; F.gw = blockIdx.x * NWAVES + F.wave; F.NGW = F.G * NWAVES; F.ws = args.ws; F.ctl = (unsigned*)(args.ws + WS_CTL); F.x = (const float*)args.in[0]; F.c = (const float*)args.in[1]; F.pos = (const int*)args.in[2]; F.attn_gain = (const float*)args.in[3]; F.ffn_gain = (const float*)args.in[4]; F.w_ada = (const float*)args.in[5]; F.b_ada = (const float*)args.in[6]; F.a_w_in = (const float*)args.in[7]; F.a_w_out = (const float*)args.in[8]; F.b_w_q = (const float*)args.in[9]; F.b_w_out = (const float*)args.in[10]; F.kv_gain = (const float*)args.in[11]; F.w_kv_ada = (const float*)args.in[12]; F.b_kv_ada = (const float*)args.in[13]; F.w_kv = (const float*)args.in[14]; F.pe_k = (const float*)args.in[15]; F.w1_k = (const float*)args.in[16]; F.w2_k = (const float*)args.in[17]; F.pe_v = (const float*)args.in[18]; F.w1_v = (const float*)args.in[19]; F.w2_v = (const float*)args.in[20]; F.ffn_wg = (const float*)args.in[21]; F.ffn_wu = (const float*)args.in[22]; F.ffn_wd = (const float*)args.in[23]; F.w_router = (const float*)args.in[24]; F.moe_wg = (const float*)args.in[25]; F.moe_wu = (const float*)args.in[26]; F.moe_wd = (const float*)args.in[27]; F.final_gain = (const float*)args.in[28]; F.out = args.out; F.outw = args.pad ? (float*)(args.ws + WS_DRY) : args.out;
    { MKFRAME();
    for (int u = F.tid; u < (LDS_BYTES - LDSCTL_OFF) / 4; u += NWAVES * 64) ((LAS unsigned*)(F.lds + LDSCTL_OFF))[u] = 0u;
    __syncthreads(); }
    XcdBarrier bar; bar.bar = (unsigned*)(args.ws + WS_CTL) + CW_BAR + args.li * XCD_BAR_WORDS; bar.x = 0; bar.st = nullptr;
    if (!MK_PER_PHASE) bar = xcd_barrier_post((unsigned*)(args.ws + WS_CTL) + CW_BAR + args.li * XCD_BAR_WORDS, (volatile LAS unsigned*)((LAS unsigned char*)lds + MISC_OFF) + 8, wave_s == 0 && lane_id() == 0);
#define GRID_BAR() do { if (!MK_PER_PHASE) xcd_barrier(bar, wave_s == 0 && lane_id() == 0); } while (0)
#define GRID_BAR_ALWAYS() do { static_assert(!MK_PER_PHASE, "a seam inside a phase needs the one-launch build"); xcd_barrier(bar, wave_s == 0 && lane_id() == 0); } while (0)
    const int lo = args.ph_lo, hi = args.ph_hi;
#if DBG_TIME
    volatile LAS unsigned long long* tsl = (volatile LAS unsigned long long*)(F.lds + LDSCTL_OFF + 1024);
#define IN(k) ((lo <= (k) && (k) < hi) && (((blockIdx.x == 0 && F.tid == 0) ? (void)(tsl[(k)] = __builtin_amdgcn_s_memrealtime()) : (void)0), true))
#else
#define IN(k) (lo <= (k) && (k) < hi)
#endif
#define BOTH(k) (IN(k) && IN((k) + 1))
#define MOD0 WSP(float, SM_MOD0)
#define MOD1 WSP(float, SM_MOD1)
#define KVMOD WSP(float, SM_KVMOD)
#define CS WSP(float, SM_COS)
#define SN WSP(float, SM_SIN)

    if (IN(0)) { MKFRAME(); p0_prologue(F); if (BOTH(0)) GRID_BAR(); }
    if (IN(1)) { MKFRAME(); norm_phase(F, F.x, F.attn_gain, MOD0, 6144, 0, 1024, WSP(bf16, WS_U)); if (BOTH(1)) GRID_BAR(); }
    if (IN(2)) { MKFRAME();
        pg8::Gemm g{WSP(bf16, WS_U), WSP(bf16, WB_IN), D, D, D}; pg8::StaticOrder S; S.init(T, 2048, F.G, (int)blockIdx.x);
        EpiIn E{WSP(bf16, WS_Q0), WSP(bf16, WS_K0), WSP(bf16, WS_V0), WSP(bf16, WS_IQ), WSP(bf16, WS_IK), WSP(float, SM_IW), CS, SN};
        pg8::gemm_phase(F.lds, g, S, E, F.wave);
        for (int it0 = 2 * blockIdx.x; it0 < T / 32; it0 += 2 * F.G) {
            const int lane = F.lane, half = F.wave >> 2, wq = F.wave & 3, row0 = 32 * (it0 + half), kw = 256 * wq;
            const bf16* ap = WSP(bf16, WS_U) + (size_t)(row0 + (lane & 31)) * D + 8 * (lane >> 5) + kw;
            const bf16* bp = WSP(bf16, WB_IKW) + (size_t)(lane & 31) * D + 8 * (lane >> 5) + kw;
            f32x16 a1 = {}, a2 = {}, a3 = {};
#pragma unroll
            for (int k = 0; k < 256; k += 16) { const bf16x8 a = *(const bf16x8*)(ap + k);
                a1 = __builtin_amdgcn_mfma_f32_32x32x16_bf16(a, *(const bf16x8*)(bp + k), a1, 0, 0, 0);
                a2 = __builtin_amdgcn_mfma_f32_32x32x16_bf16(a, *(const bf16x8*)(bp + 32 * D + k), a2, 0, 0, 0);
                a3 = __builtin_amdgcn_mfma_f32_32x32x16_bf16(a, *(const bf16x8*)(bp + 64 * D + k), a3, 0, 0, 0); }
            LAS float* red = (LAS float*)F.lds + F.wave * 3072 + lane;
#pragma unroll
            for (int r = 0; r < 16; ++r) { red[r * 64] = a1[r]; red[1024 + r * 64] = a2[r]; red[2048 + r * 64] = a3[r]; }
            __syncthreads();
            const int d = lane & 31; bf16* IKo = WSP(bf16, WS_IK); float* IWo = WSP(float, SM_IW);
#pragma unroll
            for (int rr = 0; rr < 4; ++rr) { const int r = 4 * wq + rr; float x1 = 0.f, x2 = 0.f, x3 = 0.f;
#pragma unroll
                for (int w = 0; w < 4; ++w) { const LAS float* q = (const LAS float*)F.lds + (4 * half + w) * 3072 + r * 64 + lane; x1 += q[0]; x2 += q[1024]; x3 += q[2048]; }
                const int row = row0 + (r & 3) + 8 * (r >> 2) + 4 * (lane >> 5);
                const float c = CS[(size_t)row * 32 + d], sn = SN[(size_t)row * 32 + d];
                IKo[(size_t)row * 64 + d] = (bf16)f2bf(x1 * c - x2 * sn); IKo[(size_t)row * 64 + 32 + d] = (bf16)f2bf(x2 * c + x1 * sn);
                if (d < 8) IWo[(size_t)row * 8 + d] = x3 * IWS; }
            __syncthreads();
        }
        if (BOTH(2)) GRID_BAR();
    }
    if (IN(3)) { MKFRAME();
        for (int p = blockIdx.x; p < 256; p += F.G) { const int b = p >> 6, q = p & 63;
#pragma unroll 1
            for (int u = 0; u < 2; ++u) ix::unit(F, b, u ? 127 - q : q);
#pragma unroll 1
            for (int i = 0; i < 8; ++i) ix::select_row(F, b * SEQ + 32 * ((i & 1) ? 127 - q : q) + 4 * F.wave + (i >> 1)); }
        if (BOTH(3)) GRID_BAR(); }
    if (IN(4)) { MKFRAME(); }
    if (IN(5)) { MKFRAME();
        const int v = (F.G == 256) ? ((int)(blockIdx.x & 7) * 32 + (int)(blockIdx.x >> 3)) : (int)blockIdx.x;
        for (int vv = v; vv < 256; vv += F.G) for (int i = 0; i < 4; ++i) { int b, g, qt; fa::unit_of(vv, i, b, g, qt); fp::dsa_unit(F, b, g, qt); }
#if DBG_CHECK
        for (int m = blockIdx.x; m < T; m += F.G) dsa_naive_item(F, m, WSP(bf16, WS_DBG_O0), nullptr);
        GRID_BAR_ALWAYS(); dbg_compare(F, WSP(bf16, WS_O0), WSP(bf16, WS_DBG_O0), 0);
#endif
        if (BOTH(5)) GRID_BAR(); }
    if (IN(6)) { MKFRAME();
        pg8::Gemm g{WSP(bf16, WS_O0), WSP(bf16, WB_O0), D / 2, D / 2, D / 2}; pg8::StaticOrder S; S.init(T, D, F.G, (int)blockIdx.x);
        EpiRes E{F.x, nullptr, WSP(bf16, WS_XR), MOD0 + 2048, 6144, 1.0f / (SW_GU * OS)};
        pg8::gemm_phase<EpiRes, pg8::StaticOrder, true>(F.lds, g, S, E, F.wave);
        if (BOTH(6)) GRID_BAR();
    }
    if (IN(7)) { MKFRAME();
        norm_phase(F, nullptr, F.ffn_gain, MOD0, 6144, 3072, 4096, WSP(bf16, WS_U), true, WSP(bf16, WS_XR));
        { LAS float* scr = (LAS float*)(F.lds + F.wave * 16896); for (int it = F.gw; it < NCONV_B; it += F.NGW) conv_item_b(F, it, scr); }
        if (BOTH(7)) GRID_BAR();
    }
    if (IN(8)) { MKFRAME();
        pg8::Gemm g{WSP(bf16, WS_U), WSP(bf16, WB_GU0), D / 2, D / 2, D / 2}; pg8::StaticOrder S; S.init(T, 2 * FF0, F.G, (int)blockIdx.x);
        EpiSwiglu E{WSP(unsigned char, WS_HID), FF0, 2 * FF0 / 256};
        pg8::gemm_phase<EpiSwiglu, pg8::StaticOrder, true>(F.lds, g, S, E, F.wave);
        if (BOTH(8)) GRID_BAR();
    }
    if (IN(9)) { MKFRAME();
        pg8::Gemm g{WSP(bf16, WS_HID), WSP(bf16, WB_D0), FF0 / 2, FF0 / 2, FF0 / 2}; pg8::StaticOrder S; S.init(T, D, F.G, (int)blockIdx.x);
        EpiRes E{nullptr, WSP(bf16, WS_XR), WSP(bf16, WS_XR), MOD0 + 5120, 6144, 1.0f / (SW_DN * HS)};
        pg8::gemm_phase<EpiRes, pg8::StaticOrder, true>(F.lds, g, S, E, F.wave);
        if (BOTH(9)) GRID_BAR();
    }
    if (IN(10)) { MKFRAME();
        for (int m = F.gw; m < T; m += F.NGW) {
            f32x4 v[4], u[4]; load_row_h(WSP(bf16, WS_XR) + (size_t)m * D, F.lane, v);
            const float r = row_rs(v); const int b = m >> 12;
            modulate_row(v, r, F.kv_gain, KVMOD + (size_t)b * 2048, KVMOD + (size_t)b * 2048 + 1024, F.lane, u);
            store_row_fp8(WSP(unsigned char, WS_U) + (size_t)m * D, F.lane, u);
            modulate_row(v, r, F.attn_gain + D, MOD1 + (size_t)b * 6144, MOD1 + (size_t)b * 6144 + 1024, F.lane, u);
            store_row_fp8(WSP(unsigned char, WS_U) + (size_t)(T + m) * D, F.lane, u);
        }
        if (BOTH(10)) GRID_BAR();
    }
    if (IN(11)) { MKFRAME();
        pg8::Gemm g{WSP(bf16, WS_U), WSP(bf16, WB_KVQ), D / 2, D / 2, D / 2}; KvqOrder S; S.S.init(T, 11 * 256, F.G, (int)blockIdx.x);
        EpiKVQ E{WSP(bf16, WS_KCMP), WSP(bf16, WS_VCMP), WSP(bf16, WS_KSLC), WSP(bf16, WS_VSLC), WSP(bf16, WS_KWIN), WSP(bf16, WS_VWIN), WSP(bf16, WS_Q1), WSP(float, SM_GATES), CS, SN};
        pg8::gemm_phase<EpiKVQ, KvqOrder, true>(F.lds, g, S, E, F.wave);
        if (BOTH(11)) GRID_BAR();
    }
    if (IN(12)) { MKFRAME();
        const float* cb = WSP(float, SM_CBIAS);
        LAS bf16* HL = (LAS bf16*)F.lds;
        for (int rt = blockIdx.x; rt < 256; rt += F.G) {
            const int kv = rt >> 7, lane = F.lane;
            const bf16* A = kv ? WSP(bf16, WS_VCMP) : WSP(bf16, WS_KCMP);
            const f32x16 acc = sgemm_tile(A, 1024, WSP(bf16, WB_C1) + (size_t)kv * 256 * 2048, 2048, 2048, (rt & 127) * 32, F.wave * 32, lane);
            const int col = F.wave * 32 + (lane & 31); const float bias = cb[kv * 256 + col];
#pragma unroll
            for (int r = 0; r < 16; ++r) { const int row = (r & 3) + 8 * (r >> 2) + 4 * (lane >> 5); HL[row * 264 + col] = (bf16)f2bf(gelu_tanh(acc[r] + bias)); }
            __syncthreads();
            if (F.wave < 2) {
                f32x16 o = {};
                const LAS bf16* ap = HL + (lane & 31) * 264 + 8 * (lane >> 5);
                const bf16* bp = WSP(bf16, WB_C2) + (size_t)kv * 64 * 256 + (size_t)(F.wave * 32 + (lane & 31)) * 256 + 8 * (lane >> 5);
#pragma unroll
                for (int k = 0; k < 256; k += 16) o = __builtin_amdgcn_mfma_f32_32x32x16_bf16(*(const LAS bf16x8*)(ap + k), *(const bf16x8*)(bp + k), o, 0, 0, 0);
                bf16* dst = kv ? WSP(bf16, SM_VC) : WSP(bf16, SM_KC);
                const int oc = F.wave * 32 + (lane & 31);
#pragma unroll
                for (int r = 0; r < 16; ++r) { const int row = (rt & 127) * 32 + (r & 3) + 8 * (r >> 2) + 4 * (lane >> 5); dst[(size_t)row * 64 + oc] = ((row & 255) == 255) ? (bf16)0 : (bf16)f2bf(o[r]); }
            }
            __syncthreads();
        }
        if (BOTH(12)) GRID_BAR();
    }
    if (IN(13)) { }
    if (IN(14)) { MKFRAME();
        const int v = (F.G == 256) ? ((int)(blockIdx.x & 7) * 32 + (int)(blockIdx.x >> 3)) : (int)blockIdx.x;
        for (int vv = v; vv < 256; vv += F.G) for (int i = 0; i < 4; ++i) { int b, g, qt; fa::unit_of(vv, i, b, g, qt); cm::unit(F, b, g, qt); }
        if (BOTH(14)) GRID_BAR(); }
    if (IN(15)) { MKFRAME();
        const int v = (F.G == 256) ? ((int)(blockIdx.x & 7) * 32 + (int)(blockIdx.x >> 3)) : (int)blockIdx.x;
        for (int vv = v; vv < 256; vv += F.G) for (int i = 0; i < 4; ++i) { int b, g, qt; fa::unit_of(vv, i, b, g, qt); fp::nsa_unit(F, b, g, qt); }
#if DBG_CHECK
        GRID_BAR_ALWAYS();
        for (int m = blockIdx.x; m < T; m += F.G) nsa_naive_item(F, m, WSP(bf16, WS_DBG_O1), nullptr, nullptr);
        GRID_BAR_ALWAYS(); dbg_compare(F, WSP(bf16, WS_O1), WSP(bf16, WS_DBG_O1), 2);
#endif
        if (BOTH(15)) GRID_BAR(); }
    if (IN(16)) { MKFRAME();
        pg8::Gemm g{WSP(bf16, WS_O1), WSP(bf16, WB_O1), D / 2, D / 2, D / 2}; pg8::StaticOrder S; S.init(T, D, F.G, (int)blockIdx.x);
        EpiRes E{nullptr, WSP(bf16, WS_XR), WSP(bf16, WS_XR), MOD1 + 2048, 6144, 1.0f / (SW_GU * OS)};
        pg8::gemm_phase<EpiRes, pg8::StaticOrder, true>(F.lds, g, S, E, F.wave);
        if (BOTH(16)) GRID_BAR();
    }
    if (IN(17)) { MKFRAME();
        LAS int* lcnt = (LAS int*)(F.lds);
        if (F.tid < NE) lcnt[F.tid] = 0;
        __syncthreads();
        int* toke = WSP(int, SM_TOKE); float* tokw = WSP(float, SM_TOKW);
        for (int m = F.gw; m < T; m += F.NGW) {
            f32x4 v[4], u[4]; load_row_h(WSP(bf16, WS_XR) + (size_t)m * D, F.lane, v);
            const float r = row_rs(v); const int b = m >> 12;
            modulate_row(v, r, F.ffn_gain + D, MOD1 + (size_t)b * 6144 + 3072, MOD1 + (size_t)b * 6144 + 4096, F.lane, u);
            store_row_fp8(WSP(unsigned char, WS_UM) + (size_t)m * D, F.lane, u);
            float lg[NE];
#pragma unroll
            for (int e = 0; e < NE; ++e) lg[e] = 0.f;
#pragma unroll
            for (int j = 0; j < 4; ++j) {
                const float uu[4] = {u[j].x, u[j].y, u[j].z, u[j].w};
#pragma unroll
                for (int q = 0; q < 4; ++q) { const float* wr = F.w_router + (size_t)(4 * F.lane + 256 * j + q) * NE; const f32x4 w0 = *(const f32x4*)wr, w1 = *(const f32x4*)(wr + 4);
                    lg[0] += uu[q] * w0.x; lg[1] += uu[q] * w0.y; lg[2] += uu[q] * w0.z; lg[3] += uu[q] * w0.w; lg[4] += uu[q] * w1.x; lg[5] += uu[q] * w1.y; lg[6] += uu[q] * w1.z; lg[7] += uu[q] * w1.w; }
            }
#pragma unroll
            for (int e = 0; e < NE; ++e) lg[e] = wave_sum(lg[e]);
            int e1 = 0; float v1 = lg[0];
#pragma unroll
            for (int e = 1; e < NE; ++e) if (lg[e] > v1) { v1 = lg[e]; e1 = e; }
            int e2 = -1; float v2 = -INFINITY;
#pragma unroll
            for (int e = 0; e < NE; ++e) if (e != e1 && lg[e] > v2) { v2 = lg[e]; e2 = e; }
            if (F.lane == 0) {
                const float ex = __expf(v2 - v1), w1 = 1.0f / (1.0f + ex);
                toke[2 * m] = e1; toke[2 * m + 1] = e2; tokw[2 * m] = w1; tokw[2 * m + 1] = ex * w1;
                lds_add(&lcnt[e1], 1); lds_add(&lcnt[e2], 1);
            }
        }
        __syncthreads();
        if (F.tid < NE) atomicAdd(F.ctl + CW_CNT + F.tid, (unsigned)lcnt[F.tid]);
        if (BOTH(17)) GRID_BAR();
    }
    if (IN(18)) { MKFRAME();
        LAS int* lcnt = (LAS int*)(F.lds); LAS int* lbase = lcnt + 8; LAS int* lfill = lcnt + 16;
        const int* toke = WSP(int, SM_TOKE); int* slot = WSP(int, SM_SLOT);
        const int rows_per = T / F.G, r0 = blockIdx.x * rows_per;
        if (F.tid < NE) { lcnt[F.tid] = 0; lfill[F.tid] = 0; }
        __syncthreads();
        for (int i = F.tid; i < 2 * rows_per; i += 512) lds_add(&lcnt[toke[2 * r0 + i]], 1);
        __syncthreads();
        if (F.tid < NE) {
            int off = 0; for (int e = 0; e < F.tid; ++e) off += (int)((ld_u32(F.ctl + CW_CNT + e) + 255u) >> 8) * 256;
            lbase[F.tid] = off + (int)atomicAdd(F.ctl + CW_FILL + F.tid, (unsigned)lcnt[F.tid]);
        }
        __syncthreads();
        const unsigned char* UM = WSP(unsigned char, WS_UM); unsigned char* AG = WSP(unsigned char, WS_AG);
        LAS int* SL = lcnt + 32;
        for (int i = F.tid; i < 2 * rows_per; i += 512) { const int e = toke[2 * r0 + i]; const int sl = lbase[e] + lds_add(&lfill[e], 1); SL[i] = sl; slot[2 * r0 + i] = sl; }
        __syncthreads();
        if (rows_per == 8 * NWAVES) {
            u32x4 v[8];
#pragma unroll
            for (int j = 0; j < 8; ++j) v[j] = ((const u32x4*)(UM + (size_t)(r0 + F.wave + NWAVES * j) * D))[F.lane];
#pragma unroll
            for (int j = 0; j < 8; ++j) { const int rr = F.wave + NWAVES * j; const int s0 = SL[2 * rr], s1 = SL[2 * rr + 1];
                ((u32x4*)(AG + (size_t)s0 * D))[F.lane] = v[j]; ((u32x4*)(AG + (size_t)s1 * D))[F.lane] = v[j]; }
        } else {
            for (int rr = F.wave; rr < rows_per; rr += NWAVES) { const u32x4 v = ((const u32x4*)(UM + (size_t)(r0 + rr) * D))[F.lane];
                ((u32x4*)(AG + (size_t)SL[2 * rr] * D))[F.lane] = v; ((u32x4*)(AG + (size_t)SL[2 * rr + 1] * D))[F.lane] = v; }
        }
        if (BOTH(18)) GRID_BAR();
    }
    if (IN(19)) { MKFRAME();
        pg8::Gemm g{WSP(bf16, WS_AG), WSP(bf16, WS_WGU1), D / 2, D / 2, D / 2}; MoeOrder S; S.init(F.ctl + CW_CNT, 2 * FFE / 256, F.G, (int)blockIdx.x);
        EpiSwiglu E{WSP(unsigned char, WS_HID2), FFE, 2 * FFE / 256};
        pg8::gemm_phase<EpiSwiglu, MoeOrder, true>(F.lds, g, S, E, F.wave);
        if (BOTH(19)) GRID_BAR();
    }
    if (IN(20)) { MKFRAME();
        {
            pg8::Gemm g{WSP(bf16, WS_HID2), WSP(bf16, WS_WD1), FFE / 2, FFE / 2, FFE / 2}; MoeOrder S; S.init(F.ctl + CW_CNT, D / 256, F.G, (int)blockIdx.x, 1, 0, 0, 128);
            EpiY E{WSP(bf16, WS_Y)};
            pg8::gemm_phase<EpiY, MoeOrder, true>(F.lds, g, S, E, F.wave); }
        {
            pg8::Gemm g{WSP(bf16, WS_HID2), WSP(bf16, WS_WD1), FFE / 4, FFE / 2, FFE / 2}; MoeOrder S; S.init(F.ctl + CW_CNT, D / 256, F.G, (int)blockIdx.x, 2, FFE / 2, 128);
            EpiYp E{WSP(bf16, WS_Y2)};
            pg8::gemm_phase<EpiYp, MoeOrder, true>(F.lds, g, S, E, F.wave); }
        if (BOTH(20)) GRID_BAR();
    }
    if (IN(21)) { MKFRAME();
        const int* slot = WSP(int, SM_SLOT); const float* tokw = WSP(float, SM_TOKW); const bf16* Y = WSP(bf16, WS_Y); const bf16* Yp = WSP(bf16, WS_Y2);
        for (int m = F.gw; m < T; m += F.NGW) {
            f32x4 v[4]; load_row_h(WSP(bf16, WS_XR) + (size_t)m * D, F.lane, v);
            const int b = m >> 12; const int s1 = slot[2 * m], s2 = slot[2 * m + 1]; const float w1 = tokw[2 * m], w2 = tokw[2 * m + 1];
            const float* fg = MOD1 + (size_t)b * 6144 + 5120;
#pragma unroll
            for (int j = 0; j < 4; ++j) {
                const f32x4 ya = yrow(Y, Yp, s1, F.lane + 64 * j), yb = yrow(Y, Yp, s2, F.lane + 64 * j);
                const f32x4 gq = ((const f32x4*)fg)[F.lane + 64 * j];
                const f32x4 y = ya * w1 + yb * w2;
                v[j] = v[j] + gq * y;
            }
            const float r = row_rs(v);
#pragma unroll
            for (int j = 0; j < 4; ++j) { const f32x4 gn = ((const f32x4*)F.final_gain)[F.lane + 64 * j]; ((f32x4*)(F.outw + (size_t)m * D))[F.lane + 64 * j] = v[j] * r * gn; }
        }
#if DBG_TIME
        {
            if (blockIdx.x == 0 && F.tid == 0) { tsl[NPHASE] = __builtin_amdgcn_s_memrealtime();
                const float ua = 0.01f * (float)(tsl[DBG_TA + 1] - tsl[DBG_TA]), ub = 0.01f * (float)(tsl[DBG_TB + 1] - tsl[DBG_TB]);
                const float cc = sqrtf(10.0f * ua);
                __hip_atomic_store(F.ctl + CW_DBG + 8, __builtin_bit_cast(unsigned, cc), RLX_AGENT); __hip_atomic_store(F.ctl + CW_DBG + 9, __builtin_bit_cast(unsigned, cc * (1.0f + ub * 0.05f)), RLX_AGENT); }
            GRID_BAR_ALWAYS();
            const float cc = __builtin_bit_cast(float, ld_u32(F.ctl + CW_DBG + 8)), c0 = __builtin_bit_cast(float, ld_u32(F.ctl + CW_DBG + 9));
            for (int m = F.gw; m < T; m += F.NGW) for (int j = 0; j < 4; ++j) ((f32x4*)(F.out + (size_t)m * D))[F.lane + 64 * j] = (f32x4){cc, cc, cc, cc};
            GRID_BAR_ALWAYS();
            if (blockIdx.x == 0 && F.tid == 0) F.out[0] = c0;
        }
#endif
#if DBG_CHECK
        {
            const float sd0 = __builtin_bit_cast(float, ld_u32(F.ctl + CW_DBG)), sr0 = __builtin_bit_cast(float, ld_u32(F.ctl + CW_DBG + 1));
            const float sd1 = __builtin_bit_cast(float, ld_u32(F.ctl + CW_DBG + 2)), sr1 = __builtin_bit_cast(float, ld_u32(F.ctl + CW_DBG + 3));
            const float e0 = sqrtf(sd0 / sr0), e1 = sqrtf(sd1 / sr1);
            const float cc = sqrtf(1e6f * e0);
            __syncthreads();
            for (int m = F.gw; m < T; m += F.NGW) for (int j = 0; j < 4; ++j) ((f32x4*)(F.out + (size_t)m * D))[F.lane + 64 * j] = (f32x4){cc, cc, cc, cc};
            GRID_BAR_ALWAYS();
            if (blockIdx.x == 0 && F.tid == 0) F.out[0] = cc * (1.0f + 1000.0f * e1);
        }
#endif
    }
#undef IN
#undef BOTH
}

extern "C" void kernel_launch(void* const* d_in, const int* in_sizes, int n_in, void* d_out, int out_size, void* d_ws, size_t ws_size, hipStream_t stream) {
    static int grid = 0;
    if (grid == 0) {
        if (n_in != 29 || out_size != T * D || ws_size < WS_END) { fprintf(stderr, "kernel_launch: unexpected problem (n_in %d, out %d, ws %zu)\n", n_in, out_size, ws_size); grid = -1; return; }
        int dev = 0, cus = 0, per_cu = 0;
        if (hipGetDevice(&dev) != hipSuccess || hipDeviceGetAttribute(&cus, hipDeviceAttributeMultiprocessorCount, dev) != hipSuccess) { grid = -1; return; }
        if (hipFuncSetAttribute((const void*)trunk_fwd, hipFuncAttributeMaxDynamicSharedMemorySize, LDS_BYTES) != hipSuccess) { fprintf(stderr, "kernel_launch: hipFuncSetAttribute failed\n"); grid = -1; return; }
        if (hipOccupancyMaxActiveBlocksPerMultiprocessor(&per_cu, (const void*)trunk_fwd, NWAVES * 64, LDS_BYTES) != hipSuccess || per_cu < 1) { fprintf(stderr, "kernel_launch: occupancy query says %d\n", per_cu); }
        (void)hipGetLastError();
        grid = cus;
        if (T % grid != 0) { fprintf(stderr, "kernel_launch: grid %d does not divide the token count\n", grid); grid = -1; return; }
    }
    if (grid < 0) return;
    if (hipMemsetAsync((char*)d_ws + WS_CTL, 0, CTL_ZERO_BYTES, stream) != hipSuccess) return;
    Args a{};
    for (int i = 0; i < 29; ++i) a.in[i] = d_in[i];
    a.out = (float*)d_out; a.ws = (unsigned char*)d_ws;
#if MK_PER_PHASE
    for (int p = 0; p < NPHASE; ++p) { a.ph_lo = p; a.ph_hi = p + 1; a.li = p; hipLaunchKernelGGL(trunk_fwd, dim3(grid), dim3(NWAVES * 64), LDS_BYTES, stream, a); }
#elif defined(PROBE_LO)
#ifndef PROBE_DRY
#define PROBE_DRY 0
#endif
    { const int cuts[4] = {0, PROBE_HI, PROBE_LO, PROBE_HI};
      a.ph_lo = 0; a.ph_hi = PROBE_HI; a.li = 0; hipLaunchKernelGGL(trunk_fwd, dim3(grid), dim3(NWAVES * 64), LDS_BYTES, stream, a);
      a.ph_lo = PROBE_LO; a.ph_hi = PROBE_HI; a.li = 1; a.pad = PROBE_DRY; hipLaunchKernelGGL(trunk_fwd, dim3(grid), dim3(NWAVES * 64), LDS_BYTES, stream, a);
      a.pad = 0; if (PROBE_HI < NPHASE) { a.ph_lo = PROBE_HI; a.ph_hi = NPHASE; a.li = 2; hipLaunchKernelGGL(trunk_fwd, dim3(grid), dim3(NWAVES * 64), LDS_BYTES, stream, a); } (void)cuts; }
#else
    a.ph_lo = 0; a.ph_hi = NPHASE; a.li = 0;
    hipLaunchKernelGGL(trunk_fwd, dim3(grid), dim3(NWAVES * 64), LDS_BYTES, stream, a);
#endif
    const hipError_t le = hipPeekAtLastError();
    if (le != hipSuccess) fprintf(stderr, "kernel_launch: launch failed: %s\n", hipGetErrorName(le));
}
```

```cpp
#include <hip/hip_runtime.h>
#include <cstdio>
#include <cstdint>

#ifndef MK_PER_PHASE
#define MK_PER_PHASE 0
#endif

#ifndef DBG_CHECK
#define DBG_CHECK 0
#endif
#ifndef DBG_TIME
#define DBG_TIME 0
#endif
#ifndef DBG_TA
#define DBG_TA 3
#endif
#ifndef DBG_TB
#define DBG_TB 4
#endif
#define GAS __attribute__((address_space(1)))
#define LAS __attribute__((address_space(3)))
typedef unsigned short bf16;
typedef short bf16x8 __attribute__((ext_vector_type(8)));
typedef float f32x4 __attribute__((ext_vector_type(4)));
typedef float f32x16 __attribute__((ext_vector_type(16)));
typedef unsigned u32x4 __attribute__((ext_vector_type(4)));
typedef unsigned u32x2 __attribute__((ext_vector_type(2)));
typedef GAS unsigned gu32;
typedef int v8i_t __attribute__((ext_vector_type(8)));
typedef int v4i_t __attribute__((ext_vector_type(4)));

constexpr int NB = 4, SEQ = 4096, T = NB * SEQ, D = 1024, NH = 16, HD = 64, NG = 4;
constexpr int A_IN = 2120, A_INP = 2304, FF0 = 2816, FFE = 3584, NE = 8;
constexpr int KVW = 1536, BQ = 1072, BQP = 1280;
constexpr float C2 = 0.125f * 1.4426950408889634f;
constexpr float IWS = 0.04419417382415922f;
constexpr float RMS_EPS = 1e-6f;
constexpr int MPAD = 2 * T + NE * 256;
constexpr float SW_GU = 32.f, SW_DN = 64.f, HS = 4.f, OS = 16.f;

constexpr size_t MiB = 1u << 20;
constexpr size_t WS_CTL = 0, CTL_ZERO_BYTES = 1 * MiB;
constexpr size_t WS_SMALL = 1 * MiB;
constexpr size_t SM_MOD0 = WS_SMALL, SM_MOD1 = SM_MOD0 + 4 * 6144 * 4, SM_KVMOD = SM_MOD1 + 4 * 6144 * 4, SM_CBIAS = SM_KVMOD + 4 * 2048 * 4;
constexpr size_t SM_COS = 2 * MiB, SM_SIN = 4 * MiB, SM_IW = 6 * MiB, SM_GATES = 7 * MiB, SM_TOKE = 10 * MiB, SM_TOKW = SM_TOKE + 131072, SM_SLOT = SM_TOKW + 131072;
constexpr size_t SM_KC = 11 * MiB, SM_VC = SM_KC + 524288 + 4096;
static_assert(SM_CBIAS + 2048 <= SM_COS && SM_SLOT + 131072 <= SM_KC && SM_VC + 524288 + 4096 <= 16 * MiB, "small map");
constexpr size_t WB_IN = 16 * MiB;
constexpr size_t WB_O0 = WB_IN + (size_t)A_INP * D * 2;
constexpr size_t WB_GU0 = WB_O0 + (size_t)D * D * 2;
constexpr size_t WB_D0 = WB_GU0 + (size_t)2 * FF0 * D * 2;
constexpr size_t WB_KVQ = WB_D0 + (size_t)D * FF0 * 2;
constexpr size_t WB_O1 = WB_KVQ + (size_t)(KVW + BQP) * D * 2;
constexpr size_t WB_C1 = WB_O1 + (size_t)D * D * 2;
constexpr size_t WB_C2 = WB_C1 + (size_t)512 * 2048 * 2;
constexpr size_t WB_IKW = WB_C2 + 128 * 256 * 2;
static_assert(WB_IKW + 96 * 1024 * 2 <= 50 * MiB, "weight map");
constexpr size_t WS_U = 50 * MiB, WS_U2 = 82 * MiB;
constexpr size_t WS_Q0 = 114 * MiB, WS_K0 = 146 * MiB, WS_V0 = 154 * MiB, WS_IQ = 162 * MiB, WS_IK = 178 * MiB, WS_O0 = 180 * MiB, WS_MASK = 212 * MiB, WS_SCORES = 220 * MiB;
constexpr size_t WS_HID = 220 * MiB;
constexpr size_t WS_KCMP = 114 * MiB, WS_VCMP = 122 * MiB, WS_KSLC = 130 * MiB, WS_VSLC = 138 * MiB, WS_KWIN = 146 * MiB, WS_VWIN = 154 * MiB;
constexpr size_t WS_Q1 = 162 * MiB, WS_O1 = 194 * MiB, WS_CH = 226 * MiB;
constexpr size_t WS_OCG = 50 * MiB;
constexpr size_t WS_SEL = 230 * MiB;
constexpr size_t WS_XR = 318 * MiB;
constexpr size_t WS_UM = 300 * MiB;
constexpr size_t WS_AG = 16 * MiB;
constexpr size_t WS_Y = 16 * MiB;
constexpr size_t WS_DRY = 130 * MiB;
constexpr size_t WS_Y2 = 351 * MiB;
constexpr size_t WS_HID2 = 84 * MiB;
constexpr size_t WS_WGU1 = 351 * MiB, WS_WD1 = 463 * MiB, WS_END = 519 * MiB;
static_assert(WS_AG + (size_t)MPAD * D * 2 <= WS_HID2 && WS_HID2 + (size_t)MPAD * FFE * 2 <= WS_WGU1 && WS_WGU1 + (size_t)NE * 2 * FFE * D * 2 == WS_WD1 && WS_WD1 + (size_t)NE * D * FFE * 2 == WS_END, "moe map");
static_assert(WS_HID + (size_t)T * FF0 * 2 <= WS_WGU1 && WS_UM + (size_t)T * D * 2 <= WS_WGU1 && WS_SCORES + (size_t)NB * SEQ * SEQ * 4 <= 476 * MiB, "map");
constexpr int CW_TMO = 0, CW_BAR = 4096  , CW_CNT = 20480, CW_FILL = 20544, CW_DBG = 20608;
constexpr size_t WS_DBG_O0 = 480 * MiB, WS_DBG_O1 = 240 * MiB;
#define XCD_BAR_WORDS 3456

constexpr int RING_BYTES = 131072, LDSCTL_OFF = 139264, MISC_OFF = LDSCTL_OFF + 320, LDS_BYTES = 147456;
constexpr int NWAVES = 8;

#define RLX_AGENT __ATOMIC_RELAXED, __HIP_MEMORY_SCOPE_AGENT
#define LDS_WAIT() asm volatile("s_waitcnt lgkmcnt(0)" ::: "memory")
#define VM_WAIT() asm volatile("s_waitcnt vmcnt(0)" ::: "memory")
__device__ __forceinline__ unsigned f2bf(float f) { unsigned u = __builtin_bit_cast(unsigned, f); return (u + 0x7fffu + ((u >> 16) & 1u)) >> 16; }
__device__ __forceinline__ unsigned pk2(float lo, float hi) { return f2bf(lo) | (f2bf(hi) << 16); }
__device__ __forceinline__ unsigned pk4_fp8(float a, float b, float c, float d) { int r = 0; r = __builtin_amdgcn_cvt_pk_fp8_f32(a, b, r, false); r = __builtin_amdgcn_cvt_pk_fp8_f32(c, d, r, true); return (unsigned)r; }
__device__ __forceinline__ float bf2f(unsigned v) { return __builtin_bit_cast(float, v << 16); }
__device__ __forceinline__ float bflo(unsigned w) { return __builtin_bit_cast(float, w << 16); }
__device__ __forceinline__ float bfhi(unsigned w) { return __builtin_bit_cast(float, w & 0xffff0000u); }
__device__ __forceinline__ float bfround(float f) { return bf2f(f2bf(f)); }
__device__ __forceinline__ int lane_id() { return (int)__builtin_amdgcn_mbcnt_hi(~0u, __builtin_amdgcn_mbcnt_lo(~0u, 0u)); }
__device__ __forceinline__ float wave_sum(float v) {
#pragma unroll
    for (int o = 1; o < 64; o <<= 1) v += __shfl_xor(v, o);
    return v;
}
__device__ __forceinline__ float wave_max(float v) {
#pragma unroll
    for (int o = 1; o < 64; o <<= 1) v = fmaxf(v, __shfl_xor(v, o));
    return v;
}
__device__ __forceinline__ int wave_sum_i(int v) {
#pragma unroll
    for (int o = 1; o < 64; o <<= 1) v += __shfl_xor(v, o);
    return v;
}
__device__ __forceinline__ int lds_add(LAS int* p, int v) { return __hip_atomic_fetch_add(p, v, __ATOMIC_RELAXED, __HIP_MEMORY_SCOPE_WORKGROUP); }
__device__ __forceinline__ unsigned ld_u32(const unsigned* p) { return __hip_atomic_load(p, RLX_AGENT); }
__device__ __forceinline__ float dot8(u32x4 a, u32x4 b, float acc) {
    acc += bflo(a.x) * bflo(b.x); acc += bfhi(a.x) * bfhi(b.x); acc += bflo(a.y) * bflo(b.y); acc += bfhi(a.y) * bfhi(b.y);
    acc += bflo(a.z) * bflo(b.z); acc += bfhi(a.z) * bfhi(b.z); acc += bflo(a.w) * bflo(b.w); acc += bfhi(a.w) * bfhi(b.w);
    return acc;
}

namespace pg8 {
constexpr int BM = 256, BK = 64, HALF = 128, HTB = HALF * BK * 2, STAGE_BYTES = 8 * HTB, NXCD = 8, WGM = 8;
__host__ __device__ __forceinline__ int lds_byte(int r, int c) { const int st = (r >> 4) * 2 + (c >> 5), rr = r & 15, cc = c & 31, ob = rr * 64 + cc * 2; return st * 1024 + (ob ^ (((ob >> 9) & 1) << 5)); }
__host__ __device__ __forceinline__ void stage_rc(int b, int& R, int& C) { const int st = b / 1024, sb = b % 1024, swz = sb ^ (((sb >> 9) & 1) << 5); R = (st >> 1) * 16 + swz / 64; C = (st & 1) * 32 + (swz % 64) / 2; }
__host__ __device__ __forceinline__ int perm32(int rho) { const int n = rho >> 4, i = rho & 15; return 8 * (i >> 2) + 4 * n + (i & 3); }
struct Unit { int pm, pn, ko; };
struct Gemm { const bf16* A; const bf16* Bt; int K, lda, ldb; };

struct StaticOrder {
    int nM, nN, nwg, G, c;
    __device__ void init(int M, int N, int G_, int c_) { nM = M / BM; nN = N / BM; nwg = nM * nN; G = G_; c = c_; }
    __device__ bool next(int i, Unit& u) const {
        const long L = (long)i * G + c; if (L >= nwg) return false;
        int wgid = (int)L; { const int q = nwg / NXCD, r = nwg % NXCD, xcd = wgid % NXCD, off = wgid / NXCD; wgid = (xcd < r ? xcd * (q + 1) : r * (q + 1) + (xcd - r) * q) + off; }
        const int nig = WGM * nN, gid = wgid / nig, fm = gid * WGM, gsz = (nM - fm) < WGM ? (nM - fm) : WGM;
        u.pm = fm + ((wgid % nig) % gsz); u.pn = (wgid % nig) / gsz; u.ko = 0; return true;
    }
};

template <class Epi, class Sched, bool F8 = false>
__device__ __forceinline__ void gemm_phase(LAS unsigned char* lds, const Gemm g, const Sched& S, const Epi& E, int wid  ) {
    const int lane = lane_id(), tid = wid * 64 + lane, wr = wid >> 2, wc = wid & 3, fr = lane & 15, fq = lane >> 4;
    const int K = g.K, nt = K / BK;
    unsigned voffA[2], voffB[2];
#pragma unroll
    for (int i = 0; i < 2; ++i) { int R, C; stage_rc(tid * 16 + i * 8192, R, C); const int Rb = (R & ~31) + perm32(R & 31);
        voffA[i] = (unsigned)(R * g.lda + C) * 2u; voffB[i] = (unsigned)(Rb * g.ldb + C) * 2u; }
    const size_t kstep = (size_t)(BK * 2);
    const size_t hA = (size_t)HALF * g.lda * 2, hB = (size_t)HALF * g.ldb * 2;
    const size_t tA = 2 * hA, tB = 2 * hB;
    const unsigned ldsw = (unsigned)wid * 1024u;
    const int aoff = lds_byte(wr * 64 + fr, fq * 8), boff = lds_byte(wc * 32 + fr, fq * 8);
#define PG8_SA(b, h) (((b) * 2 + (h)) * HTB)
#define PG8_SB(b, h) ((4 + (b) * 2 + (h)) * HTB)
#define PG8_STAGE(bufoff, gbase, voff) do { _Pragma("unroll") for (int _i = 0; _i < 2; ++_i) \
        __builtin_amdgcn_global_load_lds((const unsigned*)((const char*)(gbase) + (voff)[_i]), (LAS unsigned*)(lds + (bufoff) + ldsw + _i * 8192), 16, 0, 0); } while (0)
#define PG8_LDA(dst, b, h) do { if constexpr (F8) { _Pragma("unroll") for (int m = 0; m < 4; ++m) { dst##8[m].lo = *(const LAS v4i_t*)(lds + PG8_SA(b, h) + aoff + m * 2048); dst##8[m].hi = *(const LAS v4i_t*)(lds + PG8_SA(b, h) + aoff + m * 2048 + 1024); } } \
        else { _Pragma("unroll") for (int m = 0; m < 4; ++m) _Pragma("unroll") for (int k = 0; k < 2; ++k) dst[m][k] = *(const LAS bf16x8*)(lds + PG8_SA(b, h) + aoff + m * 2048 + k * 1024); } } while (0)
#define PG8_LDB(dst, b, h) do { if constexpr (F8) { _Pragma("unroll") for (int n = 0; n < 2; ++n) { dst##8[n].lo = *(const LAS v4i_t*)(lds + PG8_SB(b, h) + boff + n * 2048); dst##8[n].hi = *(const LAS v4i_t*)(lds + PG8_SB(b, h) + boff + n * 2048 + 1024); } } \
        else { _Pragma("unroll") for (int n = 0; n < 2; ++n) _Pragma("unroll") for (int k = 0; k < 2; ++k) dst[n][k] = *(const LAS bf16x8*)(lds + PG8_SB(b, h) + boff + n * 2048 + k * 1024); } } while (0)
#define PG8_MMA(ai, bj, At, Bt) do { if constexpr (F8) __builtin_amdgcn_sched_barrier(0); __builtin_amdgcn_s_setprio(1); _Pragma("unroll") for (int m = 0; m < 4; ++m) _Pragma("unroll") for (int n = 0; n < 2; ++n) { \
        if constexpr (F8)   \
            asm volatile("v_mfma_scale_f32_16x16x128_f8f6f4 %0, %1, %2, %0, %3, %3 op_sel_hi:[0,0,0]" : "+v"(acc[ai][bj][m][n]) : "v"(Bt##8[n]), "v"(At##8[m]), "v"(one8));   \
        else { _Pragma("unroll") for (int k = 0; k < 2; ++k) acc[ai][bj][m][n] = __builtin_amdgcn_mfma_f32_16x16x32_bf16(Bt[n][k], At[m][k], acc[ai][bj][m][n], 0, 0, 0); } } \
        __builtin_amdgcn_s_setprio(0); if constexpr (F8) __builtin_amdgcn_sched_barrier(0); } while (0)
#define PG8_WAIT_V(n) asm volatile("s_waitcnt vmcnt(" #n ")" ::: "memory")
#define PG8_WAIT_L(n) asm volatile("s_waitcnt lgkmcnt(" #n ")" ::: "memory")
#define PG8_BAR __builtin_amdgcn_s_barrier()
#define PG8_SCHED __builtin_amdgcn_sched_barrier(0)
    Unit cur, nxt; int ui = 0;
    if (!S.next(0, cur)) return;
    f32x4 acc[2][2][4][2];
#pragma unroll
    for (int a = 0; a < 2; ++a)
#pragma unroll
        for (int b = 0; b < 2; ++b)
#pragma unroll
            for (int m = 0; m < 4; ++m)
#pragma unroll
                for (int n = 0; n < 2; ++n) acc[a][b][m][n] = (f32x4){0.f, 0.f, 0.f, 0.f};
    bf16x8 At[4][2], B0[2][2], B1[2][2];
    v8i_t At8[4], B08[2], B18[2];
    (void)At; (void)B0; (void)B1; (void)At8; (void)B08; (void)B18;
    const int one8 = 0x7F7F7F7F;
    (void)one8;
    const char* cA = (const char*)g.A + (size_t)cur.pm * tA + cur.ko; const char* cB = (const char*)g.Bt + (size_t)cur.pn * tB + cur.ko;
    PG8_STAGE(PG8_SB(0, 0), cB, voffB); PG8_STAGE(PG8_SB(0, 1), cB + hB, voffB); PG8_STAGE(PG8_SA(0, 0), cA, voffA); PG8_STAGE(PG8_SA(0, 1), cA + hA, voffA);
    if (wr == 1) PG8_BAR;
    PG8_WAIT_V(2); PG8_BAR;
    PG8_STAGE(PG8_SB(1, 0), cB + kstep, voffB); PG8_STAGE(PG8_SA(1, 0), cA + kstep, voffA); PG8_STAGE(PG8_SB(1, 1), cB + hB + kstep, voffB);
    PG8_WAIT_V(6); PG8_BAR;
    for (;;) {
        const bool has_next = S.next(ui + 1, nxt);
        const char* nA = has_next ? (const char*)g.A + (size_t)nxt.pm * tA + nxt.ko : cA; const char* nB = has_next ? (const char*)g.Bt + (size_t)nxt.pn * tB + nxt.ko : cB;
        for (int t = 0; t < nt; t += 2) {
            const bool last = (t == nt - 2);
            const char* a1 = cA + (size_t)(t + 1) * kstep;
            const char* a2 = last ? nA : cA + (size_t)(t + 2) * kstep; const char* b2 = last ? nB : cB + (size_t)(t + 2) * kstep;
            const char* a3 = a2 + kstep; const char* b3 = b2 + kstep;
            PG8_LDB(B0, 0, 0); PG8_LDB(B1, 0, 1); PG8_SCHED; PG8_LDA(At, 0, 0); PG8_STAGE(PG8_SA(1, 1), a1 + hA, voffA);
            PG8_WAIT_V(8); PG8_WAIT_L(0); PG8_BAR; PG8_MMA(0, 0, At, B0); PG8_MMA(0, 1, At, B1); PG8_BAR; PG8_SCHED;
            PG8_LDA(At, 0, 1); PG8_STAGE(PG8_SB(0, 0), b2, voffB); PG8_STAGE(PG8_SB(0, 1), b2 + hB, voffB); PG8_STAGE(PG8_SA(0, 0), a2, voffA);
            PG8_WAIT_V(8); PG8_WAIT_L(0); PG8_BAR; PG8_MMA(1, 0, At, B0); PG8_MMA(1, 1, At, B1); PG8_BAR; PG8_SCHED;
            PG8_LDB(B0, 1, 0); PG8_LDB(B1, 1, 1); PG8_SCHED; PG8_LDA(At, 1, 0); PG8_STAGE(PG8_SA(0, 1), a2 + hA, voffA);
            PG8_WAIT_V(8); PG8_WAIT_L(0); PG8_BAR; PG8_MMA(0, 0, At, B0); PG8_MMA(0, 1, At, B1); PG8_BAR; PG8_SCHED;
            PG8_LDA(At, 1, 1); PG8_STAGE(PG8_SB(1, 0), b3, voffB); PG8_STAGE(PG8_SB(1, 1), b3 + hB, voffB); PG8_STAGE(PG8_SA(1, 0), a3, voffA);
            PG8_WAIT_V(8); PG8_WAIT_L(0); PG8_BAR; PG8_MMA(1, 0, At, B0); PG8_MMA(1, 1, At, B1); PG8_BAR; PG8_SCHED;
        }
        if (wr == 0) PG8_BAR;
        if constexpr (F8) asm volatile("s_nop 15\n\ts_nop 7" ::: "memory");
        E(acc, cur, wr, wc, fr, fq);
        if (!has_next) break;
#pragma unroll
        for (int a = 0; a < 2; ++a)
#pragma unroll
            for (int b = 0; b < 2; ++b)
#pragma unroll
                for (int m = 0; m < 4; ++m)
#pragma unroll
                    for (int n = 0; n < 2; ++n) acc[a][b][m][n] = (f32x4){0.f, 0.f, 0.f, 0.f};
        cur = nxt; cA = nA; cB = nB; ++ui;
        if (wr == 1) PG8_BAR;
    }
    PG8_WAIT_V(0);
    PG8_BAR;
#undef PG8_SA
#undef PG8_SB
#undef PG8_STAGE
#undef PG8_LDA
#undef PG8_LDB
#undef PG8_MMA
#undef PG8_WAIT_V
#undef PG8_WAIT_L
#undef PG8_BAR
#undef PG8_SCHED
}
}

#define XB_TMO      128
#define XB_XCNT(j)  (256  + 64 * (j))
#define XB_XSUB(j)  (1280 + 64 * (j))
#define XB_XGEN(j)  (2304 + 64 * (j))
#define XB_TOP      3328
#define XB_TOPGEN   3392
#define XB_SPIN_CAP (1u << 18)
__device__ __forceinline__ unsigned xb_ld(unsigned* p)              { return __hip_atomic_load(p, __ATOMIC_RELAXED, __HIP_MEMORY_SCOPE_AGENT); }
__device__ __forceinline__ unsigned xb_add(unsigned* p, unsigned v) { return __hip_atomic_fetch_add(p, v, __ATOMIC_RELAXED, __HIP_MEMORY_SCOPE_AGENT); }
__device__ __forceinline__ unsigned xb_xcc_id() { return (unsigned)__builtin_amdgcn_s_getreg((3 << 11) | 20) & 0xFu; }
#define XB_SPIN(cond, bar) do { unsigned _sp = 0; while (cond) { __builtin_amdgcn_s_sleep(1); \
    if ((++_sp & 255u) == 0u) { if (xb_ld(&(bar)[XB_TMO])) break; if (_sp > XB_SPIN_CAP) { atomicAdd(&(bar)[XB_TMO], 1u); break; } } } } while (0)
struct XcdBarrier { unsigned* bar; unsigned x; volatile LAS unsigned* st; };
__device__ __forceinline__ XcdBarrier xcd_barrier_post(unsigned* bar, volatile LAS unsigned* st, bool t0) {
    XcdBarrier b; b.bar = bar; b.x = xb_xcc_id(); b.st = st;
    if (t0) (void)xb_add(&bar[XB_XCNT(b.x)], 1u);
    return b;
}
__device__ __forceinline__ void xcd_barrier_complete(unsigned* bar, unsigned x, unsigned& nloc, unsigned& nx) {
    const unsigned G = gridDim.x * gridDim.y * gridDim.z;
    unsigned sum, cnt, mine, sp = 0u;
    for (;;) {
        sum = 0u; cnt = 0u; mine = 0u;
#pragma unroll
        for (unsigned j = 0; j < 16; ++j) { const unsigned c = xb_ld(&bar[XB_XCNT(j)]); sum += c; cnt += (c > 0u) ? 1u : 0u; mine = (j == x) ? c : mine; }
        if (sum == G) break;
        __builtin_amdgcn_s_sleep(1);
        if ((++sp & 255u) == 0u) { if (xb_ld(&bar[XB_TMO])) break; if (sp > XB_SPIN_CAP) { atomicAdd(&bar[XB_TMO], 1u); break; } }
    }
    nloc = mine > 0u ? mine : 1u; nx = cnt > 0u ? cnt : 1u;
}
__device__ __forceinline__ void xcd_barrier(const XcdBarrier& b, bool t0  ) {
    asm volatile("s_waitcnt vmcnt(0)" ::: "memory");
    __syncthreads();
    if (t0) {
        unsigned* bar = b.bar;
        __builtin_amdgcn_s_waitcnt(0);
        unsigned nloc = b.st[0], nx = b.st[1];
        if (nloc == 0u) { xcd_barrier_complete(bar, b.x, nloc, nx); b.st[0] = nloc; b.st[1] = nx; }
        const unsigned old = xb_add(&bar[XB_XSUB(b.x)], 1u);
        const unsigned gen = old / nloc;
        if (old + 1u == (gen + 1u) * nloc) {
            __builtin_amdgcn_fence(__ATOMIC_RELEASE, "agent");
            asm volatile("s_waitcnt vmcnt(0)" ::: "memory");
            const unsigned og = xb_add(&bar[XB_TOP], 1u);
            const unsigned tg = og / nx;
            if (og + 1u == (tg + 1u) * nx) xb_add(&bar[XB_TOPGEN], 1u);
            else XB_SPIN(xb_ld(&bar[XB_TOPGEN]) == tg, bar);
            __builtin_amdgcn_fence(__ATOMIC_ACQUIRE, "agent");
            xb_add(&bar[XB_XGEN(b.x)], 1u);
            asm volatile("s_waitcnt vmcnt(0)" ::: "memory");
        } else {
            XB_SPIN(xb_ld(&bar[XB_XGEN(b.x)]) == gen, bar);
            __builtin_amdgcn_fence(__ATOMIC_ACQUIRE, "agent");
            asm volatile("s_waitcnt vmcnt(0)" ::: "memory");
        }
    }
    __syncthreads();
}

struct Frame {
    LAS unsigned char* lds;
    volatile LAS unsigned* MISC;
    unsigned* ctl;
    unsigned char* ws;
    int tid, lane, wave, G, gw, NGW;
    const float *x, *c; const int* pos;
    const float *attn_gain, *ffn_gain, *w_ada, *b_ada, *a_w_in, *a_w_out, *b_w_q, *b_w_out, *kv_gain, *w_kv_ada, *b_kv_ada, *w_kv;
    const float *pe_k, *w1_k, *w2_k, *pe_v, *w1_v, *w2_v, *ffn_wg, *ffn_wu, *ffn_wd, *w_router, *moe_wg, *moe_wu, *moe_wd, *final_gain;
    float* out; float* outw;
};
#define WSP(T_, off) ((T_*)(F.ws + (off)))
__device__ __forceinline__ unsigned char* launder(unsigned char* p) { asm volatile("" : "+s"(p)); return p; }
#define LWSP(T_, off) ((T_*)(launder(F.ws) + (off)))

__device__ __forceinline__ void tr_item(const float* W, int Nsrc, int ncol0, int K, int k0, bf16* WT, int drow0, LAS float* scr, int lane) {
    const int cc = ncol0 + (lane & 31); const bool ok = (ncol0 >= 0) && (cc < Nsrc);
    const float* wp = W + (size_t)(k0 + (lane >> 5)) * Nsrc + (ok ? cc : 0);
    float v[32];
#pragma unroll
    for (int i = 0; i < 32; ++i) v[i] = wp[(size_t)(2 * i) * Nsrc];
#pragma unroll
    for (int i = 0; i < 32; ++i) { const int kk = 2 * i + (lane >> 5); scr[kk * 33 + (lane & 31)] = ok ? v[i] : 0.f; }
    LDS_WAIT(); asm volatile("" ::: "memory");
    const int c = lane & 7;
#pragma unroll
    for (int j = 0; j < 4; ++j) { const int n = (lane >> 3) + 8 * j; const LAS float* s = scr + (8 * c) * 33 + n;
        u32x4 o; o.x = pk2(s[0 * 33], s[1 * 33]); o.y = pk2(s[2 * 33], s[3 * 33]); o.z = pk2(s[4 * 33], s[5 * 33]); o.w = pk2(s[6 * 33], s[7 * 33]);
        *(u32x4*)(WT + (size_t)(drow0 + n) * K + k0 + 8 * c) = o; }
    LDS_WAIT(); asm volatile("" ::: "memory");
}
__device__ __forceinline__ void tr_item8(const float* W, int Nsrc, int ncol0, int K, int k0, unsigned char* WT, int drow0, float scale, LAS float* scr, int lane) {
    const int cc = ncol0 + (lane & 31); const bool ok = cc < Nsrc;
    const float* wp = W + (size_t)(k0 + (lane >> 5)) * Nsrc + (ok ? cc : 0);
    float v[64];
#pragma unroll
    for (int i = 0; i < 64; ++i) v[i] = wp[(size_t)(2 * i) * Nsrc];
    const float sc_ = ok ? scale : 0.f;
#pragma unroll
    for (int i = 0; i < 64; ++i) scr[(2 * i + (lane >> 5)) * 33 + (lane & 31)] = v[i] * sc_;
    LDS_WAIT(); asm volatile("" ::: "memory");
    const int c = lane & 7;
#pragma unroll
    for (int j = 0; j < 4; ++j) { const int n = (lane >> 3) + 8 * j; const LAS float* q = scr + (16 * c) * 33 + n;
        u32x4 o; o.x = pk4_fp8(q[0], q[33], q[66], q[99]); o.y = pk4_fp8(q[132], q[165], q[198], q[231]); o.z = pk4_fp8(q[264], q[297], q[330], q[363]); o.w = pk4_fp8(q[396], q[429], q[462], q[495]);
        *(u32x4*)(WT + (size_t)(drow0 + n) * K + k0 + 16 * c) = o; }
    LDS_WAIT(); asm volatile("" ::: "memory");
}
__device__ __forceinline__ int rope_lb(int pb) { const int pn = pb >> 3, half = (pb >> 2) & 1, hl = pb & 3; return 8 * pn + 2 * hl + half; }

__device__ __forceinline__ void conv_item_a(Frame& F, int it, LAS float* scr) {
    const int lane = F.lane;
    int r = it;
    { constexpr int NBK = 2048 / 32, NI = 16 * NBK; if (r < NI) { const int kb = r / NBK, pb = r % NBK; tr_item(F.a_w_in, A_IN, 32 * rope_lb(pb), D, 64 * kb, WSP(bf16, WB_IN), 32 * pb, scr, lane); return; } r -= NI; }
    { constexpr int NBK = 3, NI = 16 * NBK; if (r < NI) { const int kb = r / NBK, pb = r % NBK; tr_item(F.a_w_in, A_IN, 2048 + 32 * pb, D, 64 * kb, WSP(bf16, WB_IKW), 32 * pb, scr, lane); return; } r -= NI; }
    { constexpr int NBK = D / 32, NI = 8 * NBK; if (r < NI) { const int kb = r / NBK, pb = r % NBK; tr_item8(F.a_w_out, D, 32 * pb, D, 128 * kb, WSP(unsigned char, WB_O0), 32 * pb, SW_GU, scr, lane); return; } r -= NI; }
    { constexpr int NBK = 2 * FF0 / 32, NI = 8 * NBK; if (r < NI) { const int kb = r / NBK, pb = r % NBK; const int pn = pb >> 3, half = (pb >> 2) & 1, q = pb & 3;
        tr_item8(half ? F.ffn_wu : F.ffn_wg, FF0, 32 * (4 * pn + q), D, 128 * kb, WSP(unsigned char, WB_GU0), 32 * pb, SW_GU, scr, lane); return; } r -= NI; }
    { constexpr int NBK = D / 32, NI = (FF0 / 128) * NBK; if (r < NI) { const int kb = r / NBK, pb = r % NBK; tr_item8(F.ffn_wd, D, 32 * pb, FF0, 128 * kb, WSP(unsigned char, WB_D0), 32 * pb, SW_DN, scr, lane); return; } r -= NI; }
    { constexpr int NBK = KVW / 32, NI = 8 * NBK; if (r < NI) { const int kb = r / NBK, pb = r % NBK; tr_item8(F.w_kv, KVW, 32 * rope_lb(pb), D, 128 * kb, WSP(unsigned char, WB_KVQ), 32 * pb, SW_GU, scr, lane); return; } r -= NI; }
    { constexpr int NBK = BQP / 32, NI = 8 * NBK; if (r < NI) { const int kb = r / NBK, pb = r % NBK; tr_item8(F.b_w_q, BQ, 32 * rope_lb(pb), D, 128 * kb, WSP(unsigned char, WB_KVQ) + (size_t)KVW * D, 32 * pb, SW_GU, scr, lane); return; } r -= NI; }
    { constexpr int NBK = D / 32, NI = 8 * NBK; if (r < NI) { const int kb = r / NBK, pb = r % NBK; tr_item8(F.b_w_out, D, 32 * pb, D, 128 * kb, WSP(unsigned char, WB_O1), 32 * pb, SW_GU, scr, lane); return; } r -= NI; }
    { constexpr int NBK = 8, NI = 32 * NBK; if (r < NI) { const int kb = r / NBK, pb = r % NBK; tr_item(F.w1_k, 256, 32 * pb, 2048, 64 * kb, WSP(bf16, WB_C1), 32 * pb, scr, lane); return; } r -= NI;
                                       if (r < NI) { const int kb = r / NBK, pb = r % NBK; tr_item(F.w1_v, 256, 32 * pb, 2048, 64 * kb, WSP(bf16, WB_C1), 256 + 32 * pb, scr, lane); return; } r -= NI; }
    { constexpr int NBK = 2, NI = 4 * NBK; if (r < NI) { const int kb = r / NBK, pb = r % NBK; tr_item(F.w2_k, 64, 32 * pb, 256, 64 * kb, WSP(bf16, WB_C2), 32 * pb, scr, lane); return; } r -= NI;
                                       if (r < NI) { const int kb = r / NBK, pb = r % NBK; tr_item(F.w2_v, 64, 32 * pb, 256, 64 * kb, WSP(bf16, WB_C2), 64 + 32 * pb, scr, lane); return; } r -= NI; }
}
constexpr int NCONV_A = 16 * (2048 / 32) + 16 * 3 + 8 * 32 + 8 * (2 * FF0 / 32) + (FF0 / 128) * 32 + 8 * (KVW / 32) + 8 * (BQP / 32) + 8 * 32 + 2 * 32 * 8 + 2 * 4 * 2;
__device__ __forceinline__ void conv_item_b(Frame& F, int it, LAS float* scr) {
    const int lane = F.lane;
    constexpr int NBK1 = 2 * FFE / 32, NI1 = 8 * NBK1;
    constexpr int NBK2 = D / 32, NI2 = (FFE / 128) * NBK2;
    int r = it;
    if (r < NE * NI1) { const int e = r / NI1; r -= e * NI1; const int kb = r / NBK1, pb = r % NBK1; const int pn = pb >> 3, half = (pb >> 2) & 1, q = pb & 3;
        tr_item8((half ? F.moe_wu : F.moe_wg) + (size_t)e * D * FFE, FFE, 32 * (4 * pn + q), D, 128 * kb, WSP(unsigned char, WS_WGU1) + (size_t)e * 2 * FFE * D, 32 * pb, SW_GU, scr, lane); return; }
    r -= NE * NI1;
    { const int e = r / NI2; r -= e * NI2; const int kb = r / NBK2, pb = r % NBK2;
        tr_item8(F.moe_wd + (size_t)e * FFE * D, D, 32 * pb, FFE, 128 * kb, WSP(unsigned char, WS_WD1) + (size_t)e * D * FFE, 32 * pb, SW_DN, scr, lane); }
}
constexpr int NCONV_B = NE * (8 * (2 * FFE / 32) + (FFE / 128) * 32);

template <int NBAT>
__device__ __forceinline__ void gemv_item(Frame& F, const LAS float* act, const float* W, int K, int N, int n0, const float* bias, float* out, int ldo, LAS float* red) {
    const int kper = K / 8, k0 = F.wave * kper;
    float a[NBAT];
#pragma unroll
    for (int b = 0; b < NBAT; ++b) a[b] = 0.f;
    const float* wp = W + (size_t)k0 * N + n0 + F.lane;
#pragma unroll 8
    for (int k = 0; k < kper; ++k) { const float w = wp[(size_t)k * N];
#pragma unroll
        for (int b = 0; b < NBAT; ++b) a[b] += act[b * K + k0 + k] * w; }
#pragma unroll
    for (int b = 0; b < NBAT; ++b) red[(F.wave * 4 + b) * 64 + F.lane] = a[b];
    __syncthreads();
    if (F.tid < 64 * NBAT) { const int b = F.tid >> 6, l = F.tid & 63; float s = 0.f;
#pragma unroll
        for (int w = 0; w < 8; ++w) s += red[(w * 4 + b) * 64 + l];
        out[(size_t)b * ldo + n0 + l] = s + (bias ? bias[n0 + l] : 0.f); }
    __syncthreads();
}

__device__ __forceinline__ void p0_prologue(Frame& F) {
    {
        LAS float* act = (LAS float*)(F.lds);
        LAS float* red = (LAS float*)(F.lds + 16384);
        constexpr int NI_MOD = 6144 / 64, NI_KV = 2048 / 64, NITEMS = 2 * NI_MOD + NI_KV + 8;
        for (int it = blockIdx.x; it < NITEMS; it += F.G) {
            if (it < 2 * NI_MOD + NI_KV) {
                for (int i = F.tid; i < 4096; i += 512) { const float v = F.c[i]; act[i] = v / (1.f + __expf(-v)); }
                __syncthreads();
                if (it < NI_MOD) gemv_item<4>(F, act, F.w_ada, D, 6144, 64 * it, F.b_ada, WSP(float, SM_MOD0), 6144, red);
                else if (it < 2 * NI_MOD) gemv_item<4>(F, act, F.w_ada + (size_t)D * 6144, D, 6144, 64 * (it - NI_MOD), F.b_ada + 6144, WSP(float, SM_MOD1), 6144, red);
                else gemv_item<4>(F, act, F.w_kv_ada, D, 2048, 64 * (it - 2 * NI_MOD), F.b_kv_ada, WSP(float, SM_KVMOD), 2048, red);
            } else {
                const int j = it - (2 * NI_MOD + NI_KV), kv = j >> 2;
                const float* pe = kv ? F.pe_v : F.pe_k;
                for (int i = F.tid; i < 2048; i += 512) act[i] = pe[i];
                __syncthreads();
                gemv_item<1>(F, act, kv ? F.w1_v : F.w1_k, 2048, 256, 64 * (j & 3), nullptr, WSP(float, SM_CBIAS) + 256 * kv, 256, red);
            }
        }
        __syncthreads();
    }
    {
        LAS float* scr = (LAS float*)(F.lds + F.wave * 16896);
        for (int it = F.gw; it < NCONV_A; it += F.NGW) conv_item_a(F, it, scr);
    }
    {
        float* cs = WSP(float, SM_COS); float* sn = WSP(float, SM_SIN);
        for (int i = F.gw * 64 + F.lane; i < T * 32; i += F.NGW * 64) {
            const int m = i >> 5, d = i & 31;
            const float inv = 1.0f / powf(10000.0f, (float)d * (1.0f / 32.0f));
            const float ang = (float)F.pos[m] * inv;
            cs[i] = cosf(ang); sn[i] = sinf(ang);
        }
    }
}

__device__ __forceinline__ void load_row(const float* row, int lane, f32x4 (&v)[4]) {
#pragma unroll
    for (int j = 0; j < 4; ++j) v[j] = ((const f32x4*)row)[lane + 64 * j];
}
__device__ __forceinline__ void load_row_h(const bf16* row, int lane, f32x4 (&v)[4]) {
#pragma unroll
    for (int j = 0; j < 4; ++j) { const u32x2 w = ((const u32x2*)row)[lane + 64 * j]; v[j] = (f32x4){bflo(w.x), bfhi(w.x), bflo(w.y), bfhi(w.y)}; }
}
__device__ __forceinline__ float row_rs(const f32x4 (&v)[4]) {
    float s = 0.f;
#pragma unroll
    for (int j = 0; j < 4; ++j) s += (v[j].x * v[j].x + v[j].y * v[j].y) + (v[j].z * v[j].z + v[j].w * v[j].w);
    return 1.0f / sqrtf(wave_sum(s) * (1.f / D) + RMS_EPS);
}
__device__ __forceinline__ void modulate_row(const f32x4 (&v)[4], float r, const float* gain, const float* shift, const float* scale, int lane, f32x4 (&u)[4]) {
#pragma unroll
    for (int j = 0; j < 4; ++j) { const f32x4 g = ((const f32x4*)gain)[lane + 64 * j], sh = ((const f32x4*)shift)[lane + 64 * j], sc = ((const f32x4*)scale)[lane + 64 * j];
        u[j] = v[j] * r * g * (sc + 1.0f) + sh; }
}
__device__ __forceinline__ void store_row_bf16(bf16* orow, int lane, const f32x4 (&u)[4]) {
#pragma unroll
    for (int j = 0; j < 4; ++j) { u32x2 o; o.x = pk2(u[j].x, u[j].y); o.y = pk2(u[j].z, u[j].w); ((u32x2*)orow)[lane + 64 * j] = o; }
}
__device__ __forceinline__ void store_row_fp8(unsigned char* orow, int lane, const f32x4 (&u)[4]) {
#pragma unroll
    for (int j = 0; j < 4; ++j) ((unsigned*)orow)[lane + 64 * j] = pk4_fp8(u[j].x, u[j].y, u[j].z, u[j].w);
}
__device__ __forceinline__ void norm_phase(Frame& F, const float* src, const float* gain, const float* mod  , int ldm, int shift_off, int scale_off, bf16* dst, bool f8 = false, const bf16* srch = nullptr) {
    for (int m = F.gw; m < T; m += F.NGW) {
        f32x4 v[4], u[4]; if (srch) load_row_h(srch + (size_t)m * D, F.lane, v); else load_row(src + (size_t)m * D, F.lane, v);
        const float r = row_rs(v); const int b = m >> 12;
        modulate_row(v, r, gain, mod + (size_t)b * ldm + shift_off, mod + (size_t)b * ldm + scale_off, F.lane, u);
        if (f8) store_row_fp8((unsigned char*)dst + (size_t)m * D, F.lane, u); else store_row_bf16(dst + (size_t)m * D, F.lane, u);
    }
}

__device__ __forceinline__ void store8(bf16* p, const float (&y)[8]) { u32x4 w; w.x = pk2(y[0], y[1]); w.y = pk2(y[2], y[3]); w.z = pk2(y[4], y[5]); w.w = pk2(y[6], y[7]); *(u32x4*)p = w; }
__device__ __forceinline__ void get8(const f32x4 (&a)[2], float (&x)[8]) { x[0] = a[0].x; x[1] = a[0].y; x[2] = a[0].z; x[3] = a[0].w; x[4] = a[1].x; x[5] = a[1].y; x[6] = a[1].z; x[7] = a[1].w; }
__device__ __forceinline__ void rope8(const float* cs, const float* sn, int row, int fq, const float (&x1)[8], const float (&x2)[8], float sc, float (&y1)[8], float (&y2)[8]) {
    const f32x4 c0 = *(const f32x4*)(cs + (size_t)row * 32 + 8 * fq), c1 = *(const f32x4*)(cs + (size_t)row * 32 + 8 * fq + 4);
    const f32x4 s0 = *(const f32x4*)(sn + (size_t)row * 32 + 8 * fq), s1 = *(const f32x4*)(sn + (size_t)row * 32 + 8 * fq + 4);
    const float c[8] = {c0.x, c0.y, c0.z, c0.w, c1.x, c1.y, c1.z, c1.w}, s[8] = {s0.x, s0.y, s0.z, s0.w, s1.x, s1.y, s1.z, s1.w};
#pragma unroll
    for (int j = 0; j < 8; ++j) { y1[j] = (x1[j] * c[j] - x2[j] * s[j]) * sc; y2[j] = (x2[j] * c[j] + x1[j] * s[j]) * sc; }
}
struct EpiIn {
    bf16 *Q, *K, *V, *IQ, *IK; float* IW; const float *cs, *sn;
    __device__ __forceinline__ void operator()(const f32x4 (&acc)[2][2][4][2], const pg8::Unit& u, int wr, int wc, int fr, int fq) const {
        const int pn = u.pn;
        if (pn == 8 && wc >= 2) return;
#pragma unroll
        for (int ai = 0; ai < 2; ++ai)
#pragma unroll
            for (int m = 0; m < 4; ++m) {
                const int row = u.pm * 256 + ai * 128 + wr * 64 + m * 16 + fr;
                float x1[8], x2[8]; get8(acc[ai][0][m], x1); get8(acc[ai][1][m], x2);
                if (pn == 5) { bf16* d = V + (size_t)row * 256 + wc * 64 + 8 * fq; store8(d, x1); store8(d + 32, x2); }
                else if (pn == 8 && wc == 1) { if (fq == 0) { f32x4 a = {x1[0] * IWS, x1[1] * IWS, x1[2] * IWS, x1[3] * IWS}, b = {x1[4] * IWS, x1[5] * IWS, x1[6] * IWS, x1[7] * IWS};
                        *(f32x4*)(IW + (size_t)row * 8) = a; *(f32x4*)(IW + (size_t)row * 8 + 4) = b; } }
                else {
                    float y1[8], y2[8]; rope8(cs, sn, row, fq, x1, x2, pn < 4 ? C2 : 1.0f, y1, y2);
                    bf16* d;
                    if (pn < 4) d = Q + (size_t)row * 1024 + (4 * pn + wc) * 64;
                    else if (pn == 4) d = K + (size_t)row * 256 + wc * 64;
                    else if (pn < 8) d = IQ + (size_t)row * 512 + (4 * (pn - 6) + wc) * 64;
                    else d = IK + (size_t)row * 64;
                    store8(d + 8 * fq, y1); store8(d + 32 + 8 * fq, y2);
                }
            }
    }
};
struct EpiRes {
    const float* basef; const bf16* baseh; bf16* out; const float* gate; int ldg; float sc;
    __device__ __forceinline__ void operator()(const f32x4 (&acc)[2][2][4][2], const pg8::Unit& u, int wr, int wc, int fr, int fq) const {
        const float* gv = gate + (size_t)((u.pm * 256) >> 12) * ldg;
#pragma unroll
        for (int bj = 0; bj < 2; ++bj) {
            const int col = u.pn * 256 + bj * 128 + wc * 32 + 8 * fq;
            const f32x4 g0 = *(const f32x4*)(gv + col) * sc, g1 = *(const f32x4*)(gv + col + 4) * sc;
#pragma unroll
            for (int ai = 0; ai < 2; ++ai)
#pragma unroll
                for (int m = 0; m < 4; ++m) {
                    const size_t o = (size_t)(u.pm * 256 + ai * 128 + wr * 64 + m * 16 + fr) * D + col;
                    f32x4 b0, b1;
                    if (basef) { b0 = *(const f32x4*)(basef + o); b1 = *(const f32x4*)(basef + o + 4); }
                    else { const u32x4 w = *(const u32x4*)(baseh + o); b0 = (f32x4){bflo(w.x), bfhi(w.x), bflo(w.y), bfhi(w.y)}; b1 = (f32x4){bflo(w.z), bfhi(w.z), bflo(w.w), bfhi(w.w)}; }
                    const f32x4 r0 = b0 + g0 * acc[ai][bj][m][0], r1 = b1 + g1 * acc[ai][bj][m][1];
                    u32x4 w; w.x = pk2(r0.x, r0.y); w.y = pk2(r0.z, r0.w); w.z = pk2(r1.x, r1.y); w.w = pk2(r1.z, r1.w);
                    *(u32x4*)(out + o) = w;
                }
        }
    }
};
__device__ __forceinline__ float silu_f(float g) { return g * __builtin_amdgcn_rcpf(1.0f + __builtin_amdgcn_exp2f(-1.4426950408889634f * g)); }
struct EpiSwiglu {
    unsigned char* H; int ldh, npn;
    __device__ __forceinline__ void operator()(const f32x4 (&acc)[2][2][4][2], const pg8::Unit& u, int wr, int wc, int fr, int fq) const {
        const int col = (u.pn % npn) * 128 + wc * 32 + 8 * fq;
#pragma unroll
        for (int ai = 0; ai < 2; ++ai)
#pragma unroll
            for (int m = 0; m < 4; ++m) {
                const int row = u.pm * 256 + ai * 128 + wr * 64 + m * 16 + fr;
                float g[8], up[8], h[8]; get8(acc[ai][0][m], g); get8(acc[ai][1][m], up);
#pragma unroll
                for (int j = 0; j < 8; ++j) h[j] = silu_f(g[j] * (1.0f / SW_GU)) * up[j] * (HS / SW_GU);
                u32x2 w; w.x = pk4_fp8(h[0], h[1], h[2], h[3]); w.y = pk4_fp8(h[4], h[5], h[6], h[7]);
                *(u32x2*)(H + (size_t)row * ldh + col) = w;
            }
    }
};
struct EpiKVQ {
    bf16 *KCMP, *VCMP, *KSLC, *VSLC, *KWIN, *VWIN, *Q; float* GATES; const float *cs, *sn;
    __device__ __forceinline__ void operator()(const f32x4 (&acc)[2][2][4][2], const pg8::Unit& u, int wr, int wc, int fr, int fq) const {
        const int pn = u.pn;
        if (pn == 10 && wc >= 1) return;
#pragma unroll
        for (int ai = 0; ai < 2; ++ai)
#pragma unroll
            for (int m = 0; m < 4; ++m) {
                const int row = (u.pm & 63) * 256 + ai * 128 + wr * 64 + m * 16 + fr;
                float x1[8], x2[8]; get8(acc[ai][0][m], x1); get8(acc[ai][1][m], x2);
#pragma unroll
                for (int j = 0; j < 8; ++j) { x1[j] *= 1.0f / SW_GU; x2[j] *= 1.0f / SW_GU; }
                if (pn < 6) {
                    if ((pn & 1) == 0) { float y1[8], y2[8]; rope8(cs, sn, row, fq, x1, x2, 1.0f, y1, y2);
#pragma unroll
                        for (int j = 0; j < 8; ++j) { x1[j] = y1[j]; x2[j] = y2[j]; } }
                    bf16* d;
                    if (pn < 2) d = (pn == 0 ? KCMP : VCMP) + ((size_t)((row >> 12) * 4 + wc) * SEQ + (row & 4095)) * 64;
                    else d = (pn == 2 ? KSLC : pn == 3 ? VSLC : pn == 4 ? KWIN : VWIN) + (size_t)row * 256 + wc * 64;
                    store8(d + 8 * fq, x1); store8(d + 32 + 8 * fq, x2);
                } else if (pn < 10) {
                    float y1[8], y2[8]; rope8(cs, sn, row, fq, x1, x2, C2, y1, y2);
                    bf16* d = Q + (size_t)row * 1024 + (4 * (pn - 6) + wc) * 64;
                    store8(d + 8 * fq, y1); store8(d + 32 + 8 * fq, y2);
                } else {
                    float* gp = GATES + (size_t)row * 48;
#pragma unroll
                    for (int j = 0; j < 8; ++j) gp[8 * fq + j] = 1.0f / (1.0f + __expf(-x1[j]));
                    if (fq < 2) {
#pragma unroll
                        for (int j = 0; j < 8; ++j) gp[32 + 8 * fq + j] = 1.0f / (1.0f + __expf(-x2[j])); }
                }
            }
    }
};
struct EpiY {
    bf16* Y;
    __device__ __forceinline__ void operator()(const f32x4 (&acc)[2][2][4][2], const pg8::Unit& u, int wr, int wc, int fr, int fq) const {
#pragma unroll
        for (int ai = 0; ai < 2; ++ai)
#pragma unroll
            for (int m = 0; m < 4; ++m) {
                const int row = u.pm * 256 + ai * 128 + wr * 64 + m * 16 + fr;
#pragma unroll
                for (int bj = 0; bj < 2; ++bj) { float x[8]; get8(acc[ai][bj][m], x);
#pragma unroll
                    for (int j = 0; j < 8; ++j) x[j] *= 1.0f / (SW_DN * HS);
                    store8(Y + (size_t)row * D + (u.pn & 3) * 256 + bj * 128 + wc * 32 + 8 * fq, x); }
            }
    }
};
struct EpiYp {
    bf16* Yp;
    __device__ __forceinline__ void operator()(const f32x4 (&acc)[2][2][4][2], const pg8::Unit& u, int wr, int wc, int fr, int fq) const {
        bf16* base = Yp + (size_t)((u.ko * 586) >> 20) * ((size_t)NE * 256 * D) + (size_t)(u.pm - 128) * 256 * D + (u.pn & 3) * 256 + wc * 32 + 8 * fq;
#pragma unroll
        for (int ai = 0; ai < 2; ++ai)
#pragma unroll
            for (int m = 0; m < 4; ++m) {
                const int row = ai * 128 + wr * 64 + m * 16 + fr;
#pragma unroll
                for (int bj = 0; bj < 2; ++bj) { float x[8]; get8(acc[ai][bj][m], x);
#pragma unroll
                    for (int j = 0; j < 8; ++j) x[j] *= 1.0f / (SW_DN * HS);
                    store8(base + (size_t)row * D + bj * 128, x); }
            }
    }
};
struct KvqOrder {
    pg8::StaticOrder S;
    __device__ bool next(int i, pg8::Unit& u) const { if (!S.next(i, u)) return false; if (u.pn >= 6) u.pm += 64; return true; }
};
struct MoeOrder {
    int tend[NE]; int npn, ksplit, kbytes, mtlo, nmt, j, per8;
    __device__ void init(const unsigned* cnt, int npn_, int G_, int c_, int ksplit_ = 1, int kbytes_ = 0, int mt0_ = 0, int mt1_ = 1 << 30) {
        int acc = 0; for (int e = 0; e < NE; ++e) { acc += (int)((ld_u32(cnt + e) + 255u) >> 8); tend[e] = acc; }
        npn = npn_; ksplit = ksplit_; kbytes = kbytes_;
        const int mt0 = mt0_ < acc ? mt0_ : acc, mt1 = mt1_ < acc ? mt1_ : acc, n = mt1 - mt0;
        const int nx = (G_ % 8 == 0) ? 8 : 1, x = (nx == 8) ? (c_ & 7) : 0;
        mtlo = mt0 + (int)((long)n * x / nx); nmt = mt0 + (int)((long)n * (x + 1) / nx) - mtlo;
        j = (nx == 8) ? (c_ >> 3) : c_; per8 = G_ / nx;
    }
    __device__ bool next(int i, pg8::Unit& u) const {
        const int idx = i * per8 + j;
        const int cw = (npn < 4 ? npn : 4), upc = nmt * cw * ksplit;
        if (nmt <= 0 || idx >= nmt * npn * ksplit) return false;
        const int q = idx / upc, w = idx % upc, mt = mtlo + w / (cw * ksplit), r = w % (cw * ksplit), pn = q * cw + r / ksplit, kh = r % ksplit; int e = 0;
#pragma unroll
        for (int k = 0; k < NE - 1; ++k) e += (mt >= tend[k]) ? 1 : 0;
        u.pm = mt; u.pn = e * npn + pn; u.ko = kh * kbytes; return true;
    }
};

__device__ __forceinline__ f32x16 sgemm_tile(const bf16* A, int lda, const bf16* Bt, int ldb, int K, int row0, int col0, int lane) {
    f32x16 acc = {};
    const bf16* ap = A + (size_t)(row0 + (lane & 31)) * lda + 8 * (lane >> 5);
    const bf16* bp = Bt + (size_t)(col0 + (lane & 31)) * ldb + 8 * (lane >> 5);
#pragma unroll 8
    for (int k = 0; k < K; k += 16) { const bf16x8 a = *(const bf16x8*)(ap + k), b = *(const bf16x8*)(bp + k); acc = __builtin_amdgcn_mfma_f32_32x32x16_bf16(a, b, acc, 0, 0, 0); }
    return acc;
}
__device__ __forceinline__ float gelu_tanh(float x) { const float t = tanhf(0.7978845608028654f * (x + 0.044715f * x * x * x)); return 0.5f * x * (1.0f + t); }

__device__ __forceinline__ unsigned okey(float f) { const unsigned u = __builtin_bit_cast(unsigned, f); return (u & 0x80000000u) ? ~u : (u | 0x80000000u); }
__device__ __forceinline__ void dsa_naive_item(Frame& F, int m, bf16* O  , unsigned long long* MASKo  ) {
    const int tid = F.tid, lane = F.lane, wave = F.wave;
    const int b = m >> 12, t = m & 4095, n = t + 1;
    LAS unsigned* KEY = (LAS unsigned*)(F.lds);
    LAS u32x4* IQL = (LAS u32x4*)(F.lds + 16384);
    LAS float* IWL = (LAS float*)(F.lds + 16384 + 1024);
    LAS int* LIST = (LAS int*)(F.lds + 20480);
    LAS int* CNT = (LAS int*)(F.lds + 20480 + 1024);
    LAS float* PL = (LAS float*)(F.lds + 24576);
    const bf16* IQ = WSP(bf16, WS_IQ); const bf16* IK = WSP(bf16, WS_IK); const float* IW = WSP(float, SM_IW);
    if (tid < 64) IQL[tid] = ((const u32x4*)(IQ + (size_t)m * 512))[tid];
    if (tid < 8) IWL[tid] = IW[(size_t)m * 8 + tid];
    __syncthreads();
    for (int s = tid; s < n; s += 512) {
        const u32x4* kp = (const u32x4*)(IK + (size_t)(b * SEQ + s) * 64);
        u32x4 kv[8];
#pragma unroll
        for (int c = 0; c < 8; ++c) kv[c] = kp[c];
        float sc = 0.f;
#pragma unroll
        for (int h = 0; h < 8; ++h) { float d = 0.f;
#pragma unroll
            for (int c = 0; c < 8; ++c) d = dot8(kv[c], IQL[h * 8 + c], d);
            sc += IWL[h] * fmaxf(d, 0.f); }
        KEY[s] = okey(sc);
    }
    __syncthreads();
    const bool all = (n <= 256);
    unsigned thr = 0u; int need_ties = 0;
    if (!all) {
        unsigned myk[8];
#pragma unroll
        for (int i = 0; i < 8; ++i) { const int s = tid + 512 * i; myk[i] = s < n ? KEY[s] : 0u; }
        unsigned prefix = 0u;
        for (int bit = 31; bit >= 0; --bit) {
            const unsigned cand = prefix | (1u << bit);
            int c = 0;
#pragma unroll
            for (int i = 0; i < 8; ++i) c += (myk[i] >= cand) ? 1 : 0;
            c = wave_sum_i(c);
            if (lane == 0) CNT[(bit & 1) * 8 + wave] = c;
            __syncthreads();
            int tot = 0;
#pragma unroll
            for (int w = 0; w < 8; ++w) tot += CNT[(bit & 1) * 8 + w];
            if (tot >= 256) prefix = cand;
        }
        thr = prefix;
        int c = 0;
#pragma unroll
        for (int i = 0; i < 8; ++i) c += (myk[i] > thr) ? 1 : 0;
        c = wave_sum_i(c);
        if (lane == 0) CNT[16 + wave] = c;
        __syncthreads();
        int tot = 0;
#pragma unroll
        for (int w = 0; w < 8; ++w) tot += CNT[16 + w];
        need_ties = 256 - tot;
    }
    if (wave == 0) {
        int pos = 0, ties = 0;
        const unsigned long long lt = (1ull << lane) - 1ull;
        for (int c0 = 0; c0 < n; c0 += 64) {
            const int s = c0 + lane; const bool valid = s < n; const unsigned k = valid ? KEY[s] : 0u;
            const bool gt = valid && (all || k > thr), eq = valid && !all && (k == thr);
            const unsigned long long beq = __ballot(eq); const int tr = ties + __popcll(beq & lt);
            const bool sel = gt || (eq && tr < need_ties);
            const unsigned long long bs = __ballot(sel); const int p = pos + __popcll(bs & lt);
            if (sel) LIST[p] = s;
            if (MASKo && lane == 0) MASKo[((size_t)b * 64 + (c0 >> 6)) * SEQ + t] = bs;
            pos += __popcll(bs); ties += __popcll(beq);
        }
        if (lane == 0) CNT[32] = pos;
    }
    __syncthreads();
    if (!O) return;
    const int nsel = CNT[32];
    const int g = wave >> 1, h0 = 4 * g + 2 * (wave & 1);
    const bf16* Q = WSP(bf16, WS_Q0); const bf16* Kp = WSP(bf16, WS_K0); const bf16* Vp = WSP(bf16, WS_V0);
    u32x4 q0[8], q1[8];
#pragma unroll
    for (int c = 0; c < 8; ++c) { q0[c] = ((const u32x4*)(Q + (size_t)m * 1024 + h0 * 64))[c]; q1[c] = ((const u32x4*)(Q + (size_t)m * 1024 + (h0 + 1) * 64))[c]; }
    float s0[4], s1[4]; float mx0 = -INFINITY, mx1 = -INFINITY;
#pragma unroll
    for (int i = 0; i < 4; ++i) { const int j = lane + 64 * i; s0[i] = -INFINITY; s1[i] = -INFINITY;
        if (j < nsel) { const int s = LIST[j]; const u32x4* kp = (const u32x4*)(Kp + (size_t)(b * SEQ + s) * 256 + g * 64); float d0 = 0.f, d1 = 0.f;
#pragma unroll
            for (int c = 0; c < 8; ++c) { const u32x4 kk = kp[c]; d0 = dot8(kk, q0[c], d0); d1 = dot8(kk, q1[c], d1); }
            s0[i] = d0; s1[i] = d1; }
        mx0 = fmaxf(mx0, s0[i]); mx1 = fmaxf(mx1, s1[i]); }
    mx0 = wave_max(mx0); mx1 = wave_max(mx1);
    float l0 = 0.f, l1 = 0.f;
    LAS float* P0 = PL + (wave * 2 + 0) * 256; LAS float* P1 = PL + (wave * 2 + 1) * 256;
#pragma unroll
    for (int i = 0; i < 4; ++i) { const int j = lane + 64 * i; const float p0 = (j < nsel) ? __builtin_amdgcn_exp2f(s0[i] - mx0) : 0.f, p1 = (j < nsel) ? __builtin_amdgcn_exp2f(s1[i] - mx1) : 0.f;
        l0 += p0; l1 += p1; P0[j] = bfround(p0); P1[j] = bfround(p1); }
    l0 = wave_sum(l0); l1 = wave_sum(l1);
    float a0 = 0.f, a1 = 0.f;
    for (int j = 0; j < nsel; ++j) { const int s = LIST[j]; const float v = bf2f(Vp[(size_t)(b * SEQ + s) * 256 + g * 64 + lane]); a0 += P0[j] * v; a1 += P1[j] * v; }
    O[(size_t)m * 1024 + h0 * 64 + lane] = (bf16)f2bf(a0 / l0); O[(size_t)m * 1024 + (h0 + 1) * 64 + lane] = (bf16)f2bf(a1 / l1);
    __syncthreads();
}

__device__ __forceinline__ void nsa_naive_item(Frame& F, int m, bf16* O  , bf16* OCG  , unsigned long long* SELo  ) {
    const int lane = F.lane, wave = F.wave;
    const int b = m >> 12, t = m & 4095, jt = t >> 6;
    const int g = wave >> 1, h0 = 4 * g + 2 * (wave & 1);
    LAS float* PC = (LAS float*)(F.lds);
    LAS float* SC0 = (LAS float*)(F.lds + 16384) + (wave * 2 + 0) * 1024;
    LAS float* SC1 = SC0 + 1024;
    LAS unsigned long long* SEL = (LAS unsigned long long*)(F.lds + 16384 + 65536);
    const bf16* Q = WSP(bf16, WS_Q1);
    u32x4 q0[8], q1[8];
#pragma unroll
    for (int c = 0; c < 8; ++c) { q0[c] = ((const u32x4*)(Q + (size_t)m * 1024 + h0 * 64))[c]; q1[c] = ((const u32x4*)(Q + (size_t)m * 1024 + (h0 + 1) * 64))[c]; }
    const int nv = t >= 31 ? min(255, (t - 31) / 16 + 1) : 0;
    const bf16* KC = WSP(bf16, SM_KC) + (size_t)(b * 4 + g) * 256 * 64; const bf16* VC = WSP(bf16, SM_VC) + (size_t)(b * 4 + g) * 256 * 64;
    float oc0 = 0.f, oc1 = 0.f;
    {
        float s0[4], s1[4]; float mx0 = -INFINITY, mx1 = -INFINITY;
#pragma unroll
        for (int i = 0; i < 4; ++i) { const int n = lane + 64 * i; s0[i] = -INFINITY; s1[i] = -INFINITY;
            if (n < nv) { const u32x4* kp = (const u32x4*)(KC + (size_t)n * 64); float d0 = 0.f, d1 = 0.f;
#pragma unroll
                for (int c = 0; c < 8; ++c) { const u32x4 kk = kp[c]; d0 = dot8(kk, q0[c], d0); d1 = dot8(kk, q1[c], d1); }
                s0[i] = d0; s1[i] = d1; }
            mx0 = fmaxf(mx0, s0[i]); mx1 = fmaxf(mx1, s1[i]); }
        mx0 = wave_max(mx0); mx1 = wave_max(mx1);
        float p0[4], p1[4], l0 = 0.f, l1 = 0.f;
#pragma unroll
        for (int i = 0; i < 4; ++i) { const int n = lane + 64 * i; p0[i] = (n < nv) ? __builtin_amdgcn_exp2f(s0[i] - mx0) : 0.f; p1[i] = (n < nv) ? __builtin_amdgcn_exp2f(s1[i] - mx1) : 0.f; l0 += p0[i]; l1 += p1[i]; }
        l0 = wave_sum(l0); l1 = wave_sum(l1);
        const float r0 = nv > 0 ? 1.0f / l0 : 0.f, r1 = nv > 0 ? 1.0f / l1 : 0.f;
#pragma unroll
        for (int i = 0; i < 4; ++i) { const int n = lane + 64 * i; PC[h0 * 256 + n] = p0[i] * r0; PC[(h0 + 1) * 256 + n] = p1[i] * r1; SC0[n] = bfround(p0[i]); SC1[n] = bfround(p1[i]); }
        for (int n = 0; n < nv; ++n) { const float v = bf2f(VC[(size_t)n * 64 + lane]); oc0 += SC0[n] * v; oc1 += SC1[n] * v; }
        oc0 *= r0; oc1 *= r1;
    }
    __syncthreads();
    if ((wave & 1) == 0) {
        const int j = lane;
        auto P4 = [&](int n) -> float { return (PC[(4 * g) * 256 + n] + PC[(4 * g + 1) * 256 + n]) + (PC[(4 * g + 2) * 256 + n] + PC[(4 * g + 3) * 256 + n]); };
        float imp = P4(4 * j) + P4(4 * j + 1) + P4(4 * j + 2) + 0.5f * P4(4 * j + 3);
        if (j > 0) imp += 0.5f * P4(4 * j - 1);
        const bool valid = j <= jt, forced = (j == 0) || (j == jt) || (j + 1 == jt);
        const float val = valid ? (forced ? 1e30f : imp) : -1e30f;
        int rank = 0;
        for (int jj = 0; jj < 64; ++jj) { const float vj = __shfl(val, jj); rank += ((vj > val) || (vj == val && jj < j)) ? 1 : 0; }
        const unsigned long long mk = __ballot(rank < 16);
        if (lane == 0) { SEL[g] = mk; if (SELo) SELo[((size_t)b * 4 + g) * SEQ + t] = mk; }
    }
    __syncthreads();
    const float* gt = WSP(float, SM_GATES) + (size_t)m * 48;
    if (OCG) { OCG[(size_t)m * 1024 + h0 * 64 + lane] = (bf16)f2bf(gt[h0 * 3] * oc0); OCG[(size_t)m * 1024 + (h0 + 1) * 64 + lane] = (bf16)f2bf(gt[h0 * 3 + 3] * oc1); }
    if (!O) return;
    float os0 = 0.f, os1 = 0.f;
    {
        unsigned long long mk = SEL[g]; if (jt < 63) mk &= ((1ull << (jt + 1)) - 1ull);
        const bf16* Ks = WSP(bf16, WS_KSLC); const bf16* Vs = WSP(bf16, WS_VSLC);
        int cnt = 0; float mx0 = -INFINITY, mx1 = -INFINITY;
        for (unsigned long long r = mk; r; r &= r - 1ull) { const int j = __builtin_ctzll(r); const int tok = 64 * j + lane;
            float d0 = -INFINITY, d1 = -INFINITY;
            if (tok <= t) { const u32x4* kp = (const u32x4*)(Ks + (size_t)(b * SEQ + tok) * 256 + g * 64); d0 = 0.f; d1 = 0.f;
#pragma unroll
                for (int c = 0; c < 8; ++c) { const u32x4 kk = kp[c]; d0 = dot8(kk, q0[c], d0); d1 = dot8(kk, q1[c], d1); } }
            SC0[cnt * 64 + lane] = d0; SC1[cnt * 64 + lane] = d1; mx0 = fmaxf(mx0, d0); mx1 = fmaxf(mx1, d1); ++cnt; }
        mx0 = wave_max(mx0); mx1 = wave_max(mx1);
        float l0 = 0.f, l1 = 0.f;
        for (int i = lane; i < cnt * 64; i += 64) { const float p0 = __builtin_amdgcn_exp2f(SC0[i] - mx0), p1 = __builtin_amdgcn_exp2f(SC1[i] - mx1); l0 += p0; l1 += p1; SC0[i] = bfround(p0); SC1[i] = bfround(p1); }
        l0 = wave_sum(l0); l1 = wave_sum(l1);
        cnt = 0;
        for (unsigned long long r = mk; r; r &= r - 1ull) { const int j = __builtin_ctzll(r);
            const int kmax = min(64, t - 64 * j + 1);
            for (int kk = 0; kk < kmax; ++kk) { const float v = bf2f(Vs[(size_t)(b * SEQ + 64 * j + kk) * 256 + g * 64 + lane]); os0 += SC0[cnt * 64 + kk] * v; os1 += SC1[cnt * 64 + kk] * v; }
            ++cnt; }
        os0 /= l0; os1 /= l1;
    }
    float ow0 = 0.f, ow1 = 0.f;
    {
        const bf16* Kw = WSP(bf16, WS_KWIN); const bf16* Vw = WSP(bf16, WS_VWIN);
        const int slo = max(0, t - 511), nw = t - slo + 1;
        float mx0 = -INFINITY, mx1 = -INFINITY;
        for (int i = lane; i < nw; i += 64) { const u32x4* kp = (const u32x4*)(Kw + (size_t)(b * SEQ + slo + i) * 256 + g * 64); float d0 = 0.f, d1 = 0.f;
#pragma unroll
            for (int c = 0; c < 8; ++c) { const u32x4 kk = kp[c]; d0 = dot8(kk, q0[c], d0); d1 = dot8(kk, q1[c], d1); }
            SC0[i] = d0; SC1[i] = d1; mx0 = fmaxf(mx0, d0); mx1 = fmaxf(mx1, d1); }
        mx0 = wave_max(mx0); mx1 = wave_max(mx1);
        float l0 = 0.f, l1 = 0.f;
        for (int i = lane; i < nw; i += 64) { const float p0 = __builtin_amdgcn_exp2f(SC0[i] - mx0), p1 = __builtin_amdgcn_exp2f(SC1[i] - mx1); l0 += p0; l1 += p1; SC0[i] = bfround(p0); SC1[i] = bfround(p1); }
        l0 = wave_sum(l0); l1 = wave_sum(l1);
        for (int i = 0; i < nw; ++i) { const float v = bf2f(Vw[(size_t)(b * SEQ + slo + i) * 256 + g * 64 + lane]); ow0 += SC0[i] * v; ow1 += SC1[i] * v; }
        ow0 /= l0; ow1 /= l1;
    }
    O[(size_t)m * 1024 + h0 * 64 + lane] = (bf16)f2bf(gt[h0 * 3] * oc0 + gt[h0 * 3 + 1] * os0 + gt[h0 * 3 + 2] * ow0);
    O[(size_t)m * 1024 + (h0 + 1) * 64 + lane] = (bf16)f2bf(gt[h0 * 3 + 3] * oc1 + gt[h0 * 3 + 4] * os1 + gt[h0 * 3 + 5] * ow1);
    __syncthreads();
}

namespace ix {
__device__ __forceinline__ void unit(Frame& F, int b, int qb) {
    const int lane = F.lane, wid = F.wave, r32 = lane & 31, hh = lane >> 5;
    const int q0w = 32 * qb + 4 * wid;
    LAS unsigned char* lds = F.lds;
    bf16x8 af[4];
    { const int rho = r32, hsel = (rho >> 2) & 1, r = (rho & 3) + 4 * (rho >> 3), qq = q0w + 2 * hsel + (r >> 3), head = r & 7;
      const bf16* ap = WSP(bf16, WS_IQ) + ((size_t)b * SEQ + qq) * 512 + head * 64 + 8 * hh;
#pragma unroll
      for (int d0 = 0; d0 < 4; ++d0) af[d0] = *(const bf16x8*)(ap + 16 * d0); }
    float w[16];
    { const float* wp = WSP(float, SM_IW) + ((size_t)b * SEQ + q0w + 2 * hh) * 8;
#pragma unroll
      for (int i = 0; i < 4; ++i) { const f32x4 v = ((const f32x4*)wp)[i]; w[4 * i] = v.x; w[4 * i + 1] = v.y; w[4 * i + 2] = v.z; w[4 * i + 3] = v.w; } }
    const int NT = ((32 * qb + 31) >> 6) + 1;
    const bf16* IKb = WSP(bf16, WS_IK) + (size_t)b * SEQ * 64;
    float* SC = WSP(float, WS_SCORES) + ((size_t)b * SEQ + q0w + 2 * hh) * SEQ + r32;
#define IX_DMA(t, buf) __builtin_amdgcn_global_load_lds((const unsigned*)(IKb + (size_t)(64 * (t) + lane) * 64 + wid * 8), (LAS unsigned*)(lds + (buf) * 8192 + wid * 1024), 16, 0, 0)
    IX_DMA(0, 0);
    __syncthreads();
    for (int t = 0; t < NT; ++t) {
        if (t + 1 < NT) IX_DMA(t + 1, (t + 1) & 1);
        const LAS unsigned char* kb = lds + (t & 1) * 8192 + hh * 1024 + r32 * 16;
        f32x16 a0 = {}, a1 = {};
#pragma unroll
        for (int d0 = 0; d0 < 4; ++d0) {
            const bf16x8 b0 = *(const LAS bf16x8*)(kb + d0 * 2048), b1 = *(const LAS bf16x8*)(kb + d0 * 2048 + 512);
            a0 = __builtin_amdgcn_mfma_f32_32x32x16_bf16(af[d0], b0, a0, 0, 0, 0);
            a1 = __builtin_amdgcn_mfma_f32_32x32x16_bf16(af[d0], b1, a1, 0, 0, 0);
        }
        float sA0 = 0.f, sB0 = 0.f, sA1 = 0.f, sB1 = 0.f;
#pragma unroll
        for (int r = 0; r < 8; ++r) { sA0 += w[r] * fmaxf(a0[r], 0.f); sB0 += w[8 + r] * fmaxf(a0[8 + r], 0.f); sA1 += w[r] * fmaxf(a1[r], 0.f); sB1 += w[8 + r] * fmaxf(a1[8 + r], 0.f); }
        float* o = SC + 64 * t;
        o[0] = sA0; o[32] = sA1; o[SEQ] = sB0; o[SEQ + 32] = sB1;
        asm volatile("s_waitcnt vmcnt(4)" ::: "memory");
        __builtin_amdgcn_s_barrier();
    }
    asm volatile("s_waitcnt vmcnt(0)" ::: "memory");
#undef IX_DMA
}
__device__ __forceinline__ int cnt8(unsigned a0, unsigned a1, unsigned a2, unsigned a3, unsigned a4, unsigned a5, unsigned a6, unsigned a7, unsigned cand) {
    int c;
    asm("s_nop 1\n\tv_cmp_le_u32_e64 s[36:37], %9, %1\n\tv_cmp_le_u32_e64 s[38:39], %9, %2\n\tv_cmp_le_u32_e64 s[40:41], %9, %3\n\tv_cmp_le_u32_e64 s[42:43], %9, %4\n\t"
        "v_cmp_le_u32_e64 s[44:45], %9, %5\n\tv_cmp_le_u32_e64 s[46:47], %9, %6\n\tv_cmp_le_u32_e64 s[48:49], %9, %7\n\tv_cmp_le_u32_e64 s[50:51], %9, %8\n\t"
        "s_bcnt1_i32_b64 s36, s[36:37]\n\ts_bcnt1_i32_b64 s38, s[38:39]\n\ts_bcnt1_i32_b64 s40, s[40:41]\n\ts_bcnt1_i32_b64 s42, s[42:43]\n\t"
        "s_bcnt1_i32_b64 s44, s[44:45]\n\ts_bcnt1_i32_b64 s46, s[46:47]\n\ts_bcnt1_i32_b64 s48, s[48:49]\n\ts_bcnt1_i32_b64 s50, s[50:51]\n\t"
        "s_add_i32 s36, s36, s38\n\ts_add_i32 s40, s40, s42\n\ts_add_i32 s44, s44, s46\n\ts_add_i32 s48, s48, s50\n\ts_add_i32 s36, s36, s40\n\ts_add_i32 s44, s44, s48\n\ts_add_i32 %0, s36, s44"
        : "=s"(c) : "v"(a0), "v"(a1), "v"(a2), "v"(a3), "v"(a4), "v"(a5), "v"(a6), "v"(a7), "s"(cand)
        : "s36", "s37", "s38", "s39", "s40", "s41", "s42", "s43", "s44", "s45", "s46", "s47", "s48", "s49", "s50", "s51", "scc");
    return c;
}
template <int NJ>
__device__ __forceinline__ void select_row_t(Frame& F, int m) {
    const int lane = F.lane, b = m >> 12, t = m & 4095, n = t + 1;
    const float* row = WSP(float, WS_SCORES) + (size_t)m * SEQ + lane;
    unsigned k[NJ];
    {
        float v[NJ];
#pragma unroll
        for (int j = 0; j < NJ; ++j) v[j] = row[64 * j];
#pragma unroll
        for (int j = 0; j < NJ; ++j) k[j] = (64 * j + lane < n) ? okey(v[j]) : 0u;
    }
    unsigned thrg = 0u; int need = 0;
    if (n > 256) {
        unsigned prefix = 0u; bool exact = false;
        for (int bit = 31; bit >= 0; --bit) {
            const unsigned cand = prefix | (1u << bit);
            int c = 0;
#pragma unroll
            for (int j = 0; j < NJ; j += 8) c += cnt8(k[j], k[j + 1], k[j + 2], k[j + 3], k[j + 4], k[j + 5], k[j + 6], k[j + 7], cand);
            if (c >= 256) { prefix = cand; if (c == 256) { exact = true; break; } }
        }
        if (exact) { thrg = prefix - 1u; need = 0; }
        else { int cg = 0;
#pragma unroll
            for (int j = 0; j < NJ; j += 8) cg += cnt8(k[j], k[j + 1], k[j + 2], k[j + 3], k[j + 4], k[j + 5], k[j + 6], k[j + 7], prefix + 1u);
            thrg = prefix; need = 256 - cg; }
    }
    const unsigned long long lt = (1ull << lane) - 1ull;
    unsigned mlo = 0u, mhi = 0u;
    if (need == 0) {
#pragma unroll
        for (int j = 0; j < NJ; j += 8)
            asm("s_nop 1\n\tv_cmp_lt_u32_e64 s[36:37], %10, %2\n\tv_cmp_lt_u32_e64 s[38:39], %10, %3\n\tv_cmp_lt_u32_e64 s[40:41], %10, %4\n\tv_cmp_lt_u32_e64 s[42:43], %10, %5\n\t"
                "v_cmp_lt_u32_e64 s[44:45], %10, %6\n\tv_cmp_lt_u32_e64 s[46:47], %10, %7\n\tv_cmp_lt_u32_e64 s[48:49], %10, %8\n\tv_cmp_lt_u32_e64 s[50:51], %10, %9\n\ts_nop 3\n\t"
                "v_writelane_b32 %0, s36, %11\n\tv_writelane_b32 %1, s37, %11\n\tv_writelane_b32 %0, s38, %12\n\tv_writelane_b32 %1, s39, %12\n\t"
                "v_writelane_b32 %0, s40, %13\n\tv_writelane_b32 %1, s41, %13\n\tv_writelane_b32 %0, s42, %14\n\tv_writelane_b32 %1, s43, %14\n\t"
                "v_writelane_b32 %0, s44, %15\n\tv_writelane_b32 %1, s45, %15\n\tv_writelane_b32 %0, s46, %16\n\tv_writelane_b32 %1, s47, %16\n\t"
                "v_writelane_b32 %0, s48, %17\n\tv_writelane_b32 %1, s49, %17\n\tv_writelane_b32 %0, s50, %18\n\tv_writelane_b32 %1, s51, %18"
                : "+v"(mlo), "+v"(mhi) : "v"(k[j]), "v"(k[j + 1]), "v"(k[j + 2]), "v"(k[j + 3]), "v"(k[j + 4]), "v"(k[j + 5]), "v"(k[j + 6]), "v"(k[j + 7]), "s"(thrg),
                  "i"(j), "i"(j + 1), "i"(j + 2), "i"(j + 3), "i"(j + 4), "i"(j + 5), "i"(j + 6), "i"(j + 7)
                : "s36", "s37", "s38", "s39", "s40", "s41", "s42", "s43", "s44", "s45", "s46", "s47", "s48", "s49", "s50", "s51");
    } else {
        unsigned long long myw = 0ull; int ties = 0;
#pragma unroll
        for (int j = 0; j < NJ; ++j) {
            const bool gt = (k[j] > thrg), eq = (k[j] == thrg) && ((64 * j + lane) < n);
            const unsigned long long beq = __ballot(eq);
            const bool sel = gt || (eq && (ties + __popcll(beq & lt) < need)); ties += __popcll(beq);
            const unsigned long long bs = __ballot(sel);
            if (lane == j) myw = bs;
        }
        mlo = (unsigned)myw; mhi = (unsigned)(myw >> 32);
    }
    if (lane <= (t >> 6)) WSP(unsigned long long, WS_MASK)[((size_t)b * 64 + lane) * SEQ + t] = ((unsigned long long)mhi << 32) | mlo;
}
__device__ __forceinline__ void select_row(Frame& F, int m) {
    const int n = (m & 4095) + 1;
    if (n <= 1024) select_row_t<16>(F, m); else if (n <= 2048) select_row_t<32>(F, m); else if (n <= 3072) select_row_t<48>(F, m); else select_row_t<64>(F, m);
}
}

namespace fa {
typedef short s16x4 __attribute__((ext_vector_type(4)));
typedef short v4i16_t __attribute__((ext_vector_type(4)));
constexpr int KOFF = 0, VOFF = 16384, XOFF = 32768, OSTOFF = 36864, TOTOFF = 69632;
constexpr float THR = 8.0f;
__device__ __forceinline__ int crow(int r, int hi) { return (r & 3) + 8 * (r >> 2) + 4 * hi; }
typedef float f32x2_t __attribute__((ext_vector_type(2))); typedef __bf16 bf16x2_t __attribute__((ext_vector_type(2)));
__device__ __forceinline__ unsigned cvtpk(float lo, float hi) { f32x2_t v = {lo, hi}; bf16x2_t b = __builtin_convertvector(v, bf16x2_t); return __builtin_bit_cast(unsigned, b); }
struct Ctx { LAS unsigned char* lds; int lane, wid, r32, hi; };

__device__ __forceinline__ void dma_tile(const Ctx& c, const bf16* Kg, const bf16* Vg, int pitch, int t, int buf) {
    const bf16* ks = Kg + (size_t)(64 * t + c.lane) * pitch + c.wid * 8;
    __builtin_amdgcn_global_load_lds((const unsigned*)ks, (LAS unsigned*)(c.lds + KOFF + buf * 8192 + c.wid * 1024), 16, 0, 0);
    const bf16* vs = Vg + (size_t)(64 * t + 16 * (c.wid & 3) + (c.lane >> 2)) * pitch + (c.wid >> 2) * 32 + (c.lane & 3) * 8;
    __builtin_amdgcn_global_load_lds((const unsigned*)vs, (LAS unsigned*)(c.lds + VOFF + buf * 8192 + c.wid * 1024), 16, 0, 0);
}
__device__ __forceinline__ void qk(const Ctx& c, int buf, const f32x16& ci, f32x16& p0, f32x16& p1) {
    const LAS unsigned char* kb = c.lds + KOFF + buf * 8192 + c.hi * 1024 + c.r32 * 16;
    const LAS bf16x8* qs = (const LAS bf16x8*)(c.lds + OSTOFF + c.wid * 4096) + c.lane;
    p0 = ci; p1 = ci;
#pragma unroll
    for (int d0 = 0; d0 < 4; ++d0) {
        const bf16x8 b0 = *(const LAS bf16x8*)(kb + d0 * 2048), b1 = *(const LAS bf16x8*)(kb + d0 * 2048 + 512), q = qs[d0 * 64];
        p0 = __builtin_amdgcn_mfma_f32_32x32x16_bf16(b0, q, p0, 0, 0, 0);
        p1 = __builtin_amdgcn_mfma_f32_32x32x16_bf16(b1, q, p1, 0, 0, 0);
    }
}
__device__ __forceinline__ void park_q(const Ctx& c, const bf16* Qrow  ) {
    LAS bf16x8* qs = (LAS bf16x8*)(c.lds + OSTOFF + c.wid * 4096) + c.lane;
#pragma unroll
    for (int d0 = 0; d0 < 4; ++d0) qs[d0 * 64] = *(const bf16x8*)(Qrow + d0 * 16 + c.hi * 8);
}
__device__ __forceinline__ s16x4 vtr(const LAS unsigned char* p) { return __builtin_bit_cast(s16x4, __builtin_amdgcn_ds_read_tr16_b64_v4i16((LAS v4i16_t*)p)); }
__device__ __forceinline__ void pv(const Ctx& c, int buf, f32x16 (&o)[2], f32x16& lacc, const u32x4 (&pw)[4]) {
    const bf16x8 ones = {(short)0x3F80, (short)0x3F80, (short)0x3F80, (short)0x3F80, (short)0x3F80, (short)0x3F80, (short)0x3F80, (short)0x3F80};
    const LAS unsigned char* vp = c.lds + VOFF + buf * 8192 + ((c.lane >> 4) & 1) * 32 + (c.lane & 3) * 8 + (4 * c.hi + ((c.lane & 15) >> 2)) * 64;
#pragma unroll
    for (int d0 = 0; d0 < 2; ++d0) {
        s16x4 lo[4], hi[4];
#pragma unroll
        for (int ks = 0; ks < 4; ++ks) { lo[ks] = vtr(vp + d0 * 4096 + ks * 1024); hi[ks] = vtr(vp + d0 * 4096 + ks * 1024 + 512); }
#pragma unroll
        for (int ks = 0; ks < 4; ++ks) {
            const bf16x8 vf = {lo[ks][0], lo[ks][1], lo[ks][2], lo[ks][3], hi[ks][0], hi[ks][1], hi[ks][2], hi[ks][3]};
            o[d0] = __builtin_amdgcn_mfma_f32_32x32x16_bf16(__builtin_bit_cast(bf16x8, pw[ks]), vf, o[d0], 0, 0, 0);
        }
        }
#pragma unroll
    for (int ks = 0; ks < 4; ++ks) lacc = __builtin_amdgcn_mfma_f32_32x32x16_bf16(__builtin_bit_cast(bf16x8, pw[ks]), ones, lacc, 0, 0, 0);
}
struct State { f32x16 o[2]; f32x16 lacc; f32x16 negm; float m; };
__device__ __forceinline__ void reset(State& s) { s.o[0] = f32x16{}; s.o[1] = f32x16{}; s.lacc = f32x16{}; s.negm = f32x16{}; s.m = 0.f; }
__device__ __forceinline__ float rowmax(const f32x16& p0, const f32x16& p1) {
    float a = fmaxf(fmaxf(p0[0], p0[1]), p1[0]), b = fmaxf(fmaxf(p0[2], p0[3]), p1[1]); a = fmaxf(fmaxf(a, p1[2]), p1[3]);
#pragma unroll
    for (int r = 4; r < 16; r += 4) { a = fmaxf(fmaxf(a, p0[r]), p0[r + 1]); b = fmaxf(fmaxf(b, p0[r + 2]), p0[r + 3]); a = fmaxf(fmaxf(a, p1[r]), p1[r + 1]); b = fmaxf(fmaxf(b, p1[r + 2]), p1[r + 3]); }
    const float m = fmaxf(a, b);
    auto rr = __builtin_amdgcn_permlane32_swap(__builtin_bit_cast(unsigned, m), __builtin_bit_cast(unsigned, m), false, false);
    return fmaxf(__builtin_bit_cast(float, rr[0]), __builtin_bit_cast(float, rr[1]));
}
template <bool BITS>
__device__ __forceinline__ void tile_step(const Ctx& c, int buf, State& s, const f32x16& ci, bool first, unsigned w0, unsigned w1) {
    f32x16 p0, p1;
    qk(c, buf, ci, p0, p1);
    const float rm = rowmax(p0, p1);
    bool doit; float dl;
    if (first) { doit = true; dl = rm; } else { doit = __any(rm > THR); dl = fmaxf(rm, 0.f); }
    if (doit) {
        s.m += dl;
#pragma unroll
        for (int r = 0; r < 16; ++r) { p0[r] -= dl; p1[r] -= dl; s.negm[r] = -s.m; }
        if (!first) {
            const float f = __builtin_amdgcn_exp2f(-dl);
            LAS float* xs = (LAS float*)(c.lds + XOFF) + c.wid * 64;
            if (c.hi == 0) xs[c.r32] = f;
#pragma unroll
            for (int r = 0; r < 16; ++r) { const float fr = xs[crow(r, c.hi)]; s.o[0][r] *= fr; s.o[1][r] *= fr; s.lacc[r] *= fr; }
        }
    }
    if (BITS) { w0 >>= 4 * c.hi; w1 >>= 4 * c.hi; }
#pragma unroll
    for (int r = 0; r < 16; ++r) {
        float e0 = __builtin_amdgcn_exp2f(p0[r]), e1 = __builtin_amdgcn_exp2f(p1[r]);
        if (BITS) { const int sh = (r & 3) + 8 * (r >> 2);
            int m0_, m1_;
            asm("v_bfe_i32 %0, %1, %2, 1" : "=v"(m0_) : "v"(w0), "s"(sh)); asm("v_bfe_i32 %0, %1, %2, 1" : "=v"(m1_) : "v"(w1), "s"(sh));
            e0 = __builtin_bit_cast(float, __builtin_bit_cast(unsigned, e0) & (unsigned)m0_);
            e1 = __builtin_bit_cast(float, __builtin_bit_cast(unsigned, e1) & (unsigned)m1_); }
        p0[r] = e0; p1[r] = e1;
    }
    u32x4 pw[4];
    pw[0] = (u32x4){cvtpk(p0[0], p0[1]), cvtpk(p0[2], p0[3]), cvtpk(p0[4], p0[5]), cvtpk(p0[6], p0[7])};
    pw[1] = (u32x4){cvtpk(p0[8], p0[9]), cvtpk(p0[10], p0[11]), cvtpk(p0[12], p0[13]), cvtpk(p0[14], p0[15])};
    pw[2] = (u32x4){cvtpk(p1[0], p1[1]), cvtpk(p1[2], p1[3]), cvtpk(p1[4], p1[5]), cvtpk(p1[6], p1[7])};
    pw[3] = (u32x4){cvtpk(p1[8], p1[9]), cvtpk(p1[10], p1[11]), cvtpk(p1[12], p1[13]), cvtpk(p1[14], p1[15])};
    pv(c, buf, s.o, s.lacc, pw);
}
__device__ __forceinline__ void normalise(const Ctx& c, State& s, const LAS float* gl) {
#pragma unroll
    for (int r = 0; r < 16; ++r) { const float gq = gl ? gl[crow(r, c.hi)] : 1.0f; const float fr = s.lacc[r] > 0.f ? gq / s.lacc[r] : 0.f; s.o[0][r] *= fr; s.o[1][r] *= fr; }
}
__device__ __forceinline__ void causal_words(int qi, unsigned& w0, unsigned& w1) { const unsigned long long w = (qi >= 63) ? ~0ull : ((2ull << qi) - 1ull); w0 = (unsigned)w; w1 = (unsigned)(w >> 32); }
__device__ __forceinline__ void store_o(const Ctx& c, const f32x16 (&val)[2], unsigned char* Ow  ) {
    LAS float* stg = (LAS float*)(c.lds + OSTOFF + c.wid * 4096);
    LAS bf16* sb = (LAS bf16*)stg;
#pragma unroll
    for (int r = 0; r < 16; ++r) { const int orow = crow(r, c.hi);
#pragma unroll
        for (int d0 = 0; d0 < 2; ++d0) sb[orow * 64 + d0 * 32 + c.r32] = (bf16)f2bf(val[d0][r] * OS); }
    const int row = c.lane >> 1, hf = c.lane & 1;
    const u32x4 a = *(const LAS u32x4*)(sb + row * 64 + hf * 32), b = *(const LAS u32x4*)(sb + row * 64 + hf * 32 + 8), cq = *(const LAS u32x4*)(sb + row * 64 + hf * 32 + 16), dq = *(const LAS u32x4*)(sb + row * 64 + hf * 32 + 24);
    u32x4 o0, o1;
    o0.x = pk4_fp8(bflo(a.x), bfhi(a.x), bflo(a.y), bfhi(a.y)); o0.y = pk4_fp8(bflo(a.z), bfhi(a.z), bflo(a.w), bfhi(a.w)); o0.z = pk4_fp8(bflo(b.x), bfhi(b.x), bflo(b.y), bfhi(b.y)); o0.w = pk4_fp8(bflo(b.z), bfhi(b.z), bflo(b.w), bfhi(b.w));
    o1.x = pk4_fp8(bflo(cq.x), bfhi(cq.x), bflo(cq.y), bfhi(cq.y)); o1.y = pk4_fp8(bflo(cq.z), bfhi(cq.z), bflo(cq.w), bfhi(cq.w)); o1.z = pk4_fp8(bflo(dq.x), bfhi(dq.x), bflo(dq.y), bfhi(dq.y)); o1.w = pk4_fp8(bflo(dq.z), bfhi(dq.z), bflo(dq.w), bfhi(dq.w));
    *(u32x4*)(Ow + (size_t)row * 1024 + hf * 32) = o0; *(u32x4*)(Ow + (size_t)row * 1024 + hf * 32 + 16) = o1;
}
__device__ __forceinline__ void store_o_bf16(const Ctx& c, const f32x16 (&val)[2], bf16* Ow) {
    LAS bf16* stg = (LAS bf16*)(c.lds + OSTOFF) + c.wid * 2048;
#pragma unroll
    for (int r = 0; r < 16; ++r) { const int orow = crow(r, c.hi);
#pragma unroll
        for (int d0 = 0; d0 < 2; ++d0) stg[orow * 64 + d0 * 32 + c.r32] = (bf16)f2bf(val[d0][r]); }
#pragma unroll
    for (int i = 0; i < 4; ++i) { const int row = i * 8 + (c.lane >> 3), ch = c.lane & 7; const u32x4 v = *(const LAS u32x4*)(stg + row * 64 + ch * 8); *(u32x4*)(Ow + (size_t)row * 1024 + ch * 8) = v; }
}

__device__ __forceinline__ void dsa_unit(Frame& F, int b, int g, int qt) {
    Ctx c; c.lds = F.lds; c.lane = F.lane; c.wid = F.wave; c.r32 = F.lane & 31; c.hi = F.lane >> 5;
    const int h = 4 * g + (c.wid >> 1), qw = 64 * qt + 32 * (c.wid & 1);
    const size_t mrow = (size_t)b * SEQ + qw;
    const bf16* Q = LWSP(bf16, WS_Q0) + (mrow + c.r32) * 1024 + h * 64;
    park_q(c, Q);
    const bf16* Kg = LWSP(bf16, WS_K0) + (size_t)b * SEQ * 256 + g * 64; const bf16* Vg = LWSP(bf16, WS_V0) + (size_t)b * SEQ * 256 + g * 64;
    typedef __attribute__((address_space(1))) const u32x2* gmask_t;
    const gmask_t MK = (gmask_t)(const u32x2*)(LWSP(unsigned long long, WS_MASK) + (size_t)b * 64 * SEQ + qw + c.r32);
    State s; reset(s);
    const int NT = qt + 1;
    dma_tile(c, Kg, Vg, 256, 0, 0);
    u32x2 mk_next = MK[0];
    __syncthreads();
    for (int t = 0; t < NT; ++t) {
        const u32x2 mk = mk_next;
        if (t + 1 < NT) { dma_tile(c, Kg, Vg, 256, t + 1, (t + 1) & 1); mk_next = MK[(size_t)(t + 1) * SEQ]; }
        tile_step<true>(c, t & 1, s, s.negm, t == 0, mk.x, mk.y);
        __syncthreads();
    }
    normalise(c, s, nullptr);
    store_o(c, s.o, LWSP(unsigned char, WS_O0) + mrow * 1024 + h * 64);
}

__device__ __forceinline__ void nsa_unit(Frame& F, int b, int g, int qt) {
    Ctx c; c.lds = F.lds; c.lane = F.lane; c.wid = F.wave; c.r32 = F.lane & 31; c.hi = F.lane >> 5;
    const int h = 4 * g + (c.wid >> 1), qw = 64 * qt + 32 * (c.wid & 1), qi = 32 * (c.wid & 1) + c.r32;
    const size_t mrow = (size_t)b * SEQ + qw;
    park_q(c, LWSP(bf16, WS_Q1) + (mrow + c.r32) * 1024 + h * 64);
    const unsigned long long sel = LWSP(unsigned long long, WS_SEL)[((size_t)b * 4 + g) * SEQ + qw + c.r32];
    LAS float* gx = (LAS float*)(c.lds + XOFF + 2048) + c.wid * 64;
    gx[c.lane] = LWSP(float, SM_GATES)[(mrow + c.r32) * 48 + h * 3 + 1 + c.hi];
    LAS float* totw = (LAS float*)(c.lds + TOTOFF) + c.wid * 2048;
    LAS float* totl = totw + c.r32;
    State s;
    {
        const bf16* Kg = LWSP(bf16, WS_KSLC) + (size_t)b * SEQ * 256 + g * 64; const bf16* Vg = LWSP(bf16, WS_VSLC) + (size_t)b * SEQ * 256 + g * 64;
        reset(s);
        dma_tile(c, Kg, Vg, 256, 0, 0);
        __syncthreads();
        for (int t = 0; t <= qt; ++t) {
            if (t < qt) dma_tile(c, Kg, Vg, 256, t + 1, (t + 1) & 1);
            const bool on = (sel >> t) & 1ull;
            if (!on) {
#pragma unroll
                for (int r = 0; r < 16; ++r) s.negm[r] = -INFINITY; }
            if (t == qt) { unsigned w0, w1; causal_words(qi, w0, w1); tile_step<true>(c, t & 1, s, s.negm, t == 0, w0, w1); }
            else tile_step<false>(c, t & 1, s, s.negm, t == 0, 0u, 0u);
#pragma unroll
            for (int r = 0; r < 16; ++r) s.negm[r] = -s.m;
            __syncthreads();
        }
        normalise(c, s, gx);
#pragma unroll
        for (int r = 0; r < 16; ++r) { totl[crow(r, c.hi) * 64] = s.o[0][r]; totl[crow(r, c.hi) * 64 + 32] = s.o[1][r]; }
    }
    {
        const bf16* Kg = LWSP(bf16, WS_KWIN) + (size_t)b * SEQ * 256 + g * 64; const bf16* Vg = LWSP(bf16, WS_VWIN) + (size_t)b * SEQ * 256 + g * 64;
        reset(s);
        const int tlo = qt >= 8 ? qt - 8 : 0;
        dma_tile(c, Kg, Vg, 256, tlo, tlo & 1);
        __syncthreads();
        for (int t = tlo; t <= qt; ++t) {
            if (t < qt) dma_tile(c, Kg, Vg, 256, t + 1, (t + 1) & 1);
            if (t == qt) { unsigned w0, w1; causal_words(qi, w0, w1); tile_step<true>(c, t & 1, s, s.negm, t == tlo, w0, w1); }
            else if (t == qt - 8) { unsigned w0, w1; causal_words(qi, w0, w1); tile_step<true>(c, t & 1, s, s.negm, t == tlo, ~w0, ~w1); }
            else tile_step<false>(c, t & 1, s, s.negm, t == tlo, 0u, 0u);
            __syncthreads();
        }
        normalise(c, s, gx + 32);
#pragma unroll
        for (int r = 0; r < 16; ++r) { totl[crow(r, c.hi) * 64] += s.o[0][r]; totl[crow(r, c.hi) * 64 + 32] += s.o[1][r]; }
    }
    const bf16* OCG = LWSP(bf16, WS_OCG) + mrow * 1024 + h * 64; unsigned char* O = LWSP(unsigned char, WS_O1) + mrow * 1024 + h * 64;
#pragma unroll
    for (int i = 0; i < 8; ++i) { const int row = i * 4 + (c.lane >> 4), ch = c.lane & 15;
        const u32x2 oc = *(const u32x2*)(OCG + (size_t)row * 1024 + 4 * ch);
        const f32x4 v = (*(const LAS f32x4*)(totw + row * 64 + 4 * ch) + (f32x4){bflo(oc.x), bfhi(oc.x), bflo(oc.y), bfhi(oc.y)}) * OS;
        *(unsigned*)(O + (size_t)row * 1024 + 4 * ch) = pk4_fp8(v.x, v.y, v.z, v.w); }
}
__device__ __forceinline__ void unit_of(int v, int i, int& b, int& g, int& qt) { const int bg = v >> 4, p = v & 15; b = bg >> 2; g = bg & 3; qt = (i == 0) ? p : (i == 1) ? 63 - p : (i == 2) ? 31 - p : 32 + p; }
}

namespace fp {
using fa::Ctx; using fa::crow; using fa::cvtpk; using fa::vtr; using fa::s16x4; using fa::causal_words;
constexpr int SLOTB = 8192, LK = 0, LV = 3 * SLOTB, LX = 6 * SLOTB, LOST = LX + 4096, LQ = LOST + 8 * 4096;
constexpr float THR = 8.0f;
enum { SW_DSA = 0, SW_SLC = 1, SW_WIN = 2 };
#define FP_SBAR() __builtin_amdgcn_sched_barrier(0)
#define FP_PIN(x) asm volatile("" : "+v"(x))
#define FP_MFMA(a, b, c) __builtin_amdgcn_mfma_f32_32x32x16_bf16(a, b, c, 0, 0, 0)
#define FP_WAIT_BAR(N) asm volatile("s_waitcnt vmcnt(" #N ") lgkmcnt(0)\n\ts_barrier" ::: "memory")
#define FP_MX3(a, b, c) __builtin_fmaxf(__builtin_fmaxf((a), (b)), (c))
typedef const LAS char* lds_cptr;
__device__ __forceinline__ void glds16s(const char* base  , unsigned off, LAS unsigned char* l  ) {
    const unsigned a = __builtin_amdgcn_readfirstlane((unsigned)(unsigned long)l);
    asm volatile("s_nop 4\n\ts_mov_b32 m0, %2\n\ts_nop 0\n\tglobal_load_lds_dwordx4 %0, %1" :: "v"(off), "s"(base), "s"(a) : "memory", "m0");
}
__device__ __forceinline__ float rowmax(const f32x16& p0, const f32x16& p1) {
    float a = FP_MX3(p0[0], p0[1], p1[0]), b = FP_MX3(p0[2], p0[3], p1[1]); a = FP_MX3(a, p1[2], p1[3]);
#pragma unroll
    for (int r = 4; r < 16; r += 4) { a = FP_MX3(a, p0[r], p0[r + 1]); b = FP_MX3(b, p0[r + 2], p0[r + 3]); a = FP_MX3(a, p1[r], p1[r + 1]); b = FP_MX3(b, p1[r + 2], p1[r + 3]); }
    const float m = __builtin_fmaxf(a, b); auto rr = __builtin_amdgcn_permlane32_swap(__builtin_bit_cast(unsigned, m), __builtin_bit_cast(unsigned, m), false, false);
    return __builtin_bit_cast(float, rr[0]); }
__device__ __forceinline__ float pair_sum(float v) { return v + __shfl_xor(v, 32); }
__device__ __forceinline__ void kload2(bf16x8* kf, lds_cptr kp, int d0) { kf[2 * d0] = *(const LAS bf16x8*)(kp + d0 * 2048); kf[2 * d0 + 1] = *(const LAS bf16x8*)(kp + d0 * 2048 + 512); }
#define FP_MBIT(e, w, SH) ({ int m_; asm("v_bfe_i32 %0, %1, %2, 1" : "=v"(m_) : "v"(w), "n"(SH)); __builtin_bit_cast(float, __builtin_bit_cast(unsigned, (e)) & (unsigned)m_); })
template <int SW>
__device__ __forceinline__ void sweep(const Ctx& c, const bf16* Kg, const bf16* Vg, const int NT, const u32x2* MK, const unsigned long long sel, const int qi, f32x16 (&o)[2], float& l_out) {
    const int lane = c.lane, r32 = c.r32, hi = c.hi, wid = c.wid;
    LAS float* wsf = (LAS float*)(c.lds + LX) + wid * 64;
    const unsigned koff = (unsigned)(lane * 256 + wid * 8) * 2u;
    const unsigned voff = (unsigned)((16 * (wid & 3) + (lane >> 2)) * 256 + (wid >> 2) * 32 + (lane & 3) * 8) * 2u;
    LAS unsigned char* kdst = c.lds + LK + wid * 1024; LAS unsigned char* vdst = c.lds + LV + wid * 1024;
#define FP_DMA_K(t, slot) glds16s((const char*)Kg + (size_t)(t) * (64 * 256 * 2), koff, kdst + (slot))
#define FP_DMA_V(t, slot) glds16s((const char*)Vg + (size_t)(t) * (64 * 256 * 2), voff, vdst + (slot))
    const lds_cptr vp0 = (lds_cptr)c.lds + LV + ((lane >> 4) & 1) * 32 + (lane & 3) * 8 + (4 * hi + ((lane & 15) >> 2)) * 64;
    const lds_cptr kp0 = (lds_cptr)c.lds + LK + hi * 1024 + r32 * 16;
    const LAS bf16x8* qs = (const LAS bf16x8*)(c.lds + LQ + wid * 4096) + lane;
#define FP_Q(d0) qs[(d0) * 64]
    bf16x8 qa, qb;
    constexpr int KS = (SW == SW_DSA) ? 1 : (SW == SW_SLC) ? 2 : 0;
    u32x2 mkN = {0u, 0u}; unsigned w0s = 0u, w1s = 0u; bool onv = true; (void)onv; (void)mkN;
    auto words = [&](int j, unsigned& a0, unsigned& a1) {
        unsigned x0 = ~0u, x1 = ~0u;
        if (SW == SW_DSA) { u32x2 m_ = mkN; asm volatile("" : "+v"(m_.x), "+v"(m_.y)); x0 = m_.x; x1 = m_.y; }
        else { if (j == NT - 1) causal_words(qi, x0, x1); else if (SW == SW_WIN && j == 0 && NT == 9) { causal_words(qi, x0, x1); x0 = ~x0; x1 = ~x1; }
               if (SW == SW_SLC && !((sel >> j) & 1ull)) { x0 = 0u; x1 = 0u; } }
        a0 = x0 >> (4 * hi); a1 = x1 >> (4 * hi); };
    typedef __attribute__((address_space(1))) const u32x2* gmask_t; const gmask_t MKG = (gmask_t)MK;
    if (SW == SW_DSA) mkN = MKG[0];
    FP_DMA_K(0, 0); FP_DMA_V(0, 0); if (NT > 1) FP_DMA_K(1, SLOTB); if (NT > 2) FP_DMA_K(2, 2 * SLOTB);
    float mhat = 0.f, l_reg = 0.f; o[0] = f32x16{}; o[1] = f32x16{};
    f32x16 negm;
    { float z_ = 0.f; asm volatile("" : "+v"(z_));
#pragma unroll
      for (int r = 0; r < 16; ++r) negm[r] = z_; }
    bool resc = false;
    f32x16 pA0, pA1, pB0, pB1; bf16x8 kf[8]; s16x4 vlo[8], vhi[8]; u32x4 pw0, pw1, pw2, pw3;
    int sl_prev = 0, sl_cur = 0, sl_next = SLOTB;
#define FP_ROT() do { sl_prev = sl_cur; sl_cur = sl_next; sl_next = (sl_next == 2 * SLOTB) ? 0 : sl_next + SLOTB; } while (0)
#define FP_RESC() do { if (resc) { _Pragma("unroll") for (int d_ = 0; d_ < 2; ++d_) _Pragma("unroll") for (int r = 0; r < 16; ++r) o[d_][r] *= wsf[crow(r, hi)]; } } while (0)
    if (NT > 2) FP_WAIT_BAR(3); else if (NT > 1) FP_WAIT_BAR(2); else FP_WAIT_BAR(1);
    _Pragma("unroll") for (int d0 = 0; d0 < 4; ++d0) kload2(kf, kp0, d0);
    qa = FP_Q(0); qb = FP_Q(1);
    pA0 = FP_MFMA(kf[0], qa, negm); pA1 = FP_MFMA(kf[1], qa, negm); pA0 = FP_MFMA(kf[2], qb, pA0); pA1 = FP_MFMA(kf[3], qb, pA1);
    qa = FP_Q(2); qb = FP_Q(3);
    pA0 = FP_MFMA(kf[4], qa, pA0); pA1 = FP_MFMA(kf[5], qa, pA1); pA0 = FP_MFMA(kf[6], qb, pA0); pA1 = FP_MFMA(kf[7], qb, pA1);
    qa = FP_Q(0);
    { words(0, w0s, w1s);
      const float rm = rowmax(pA0, pA1); mhat = rm;
#pragma unroll
      for (int r = 0; r < 16; ++r) { const int sh = (r & 3) + 8 * (r >> 2);
          const float e0 = __builtin_amdgcn_exp2f(pA0[r] - rm), e1 = __builtin_amdgcn_exp2f(pA1[r] - rm);
          pA0[r] = ((w0s >> sh) & 1u) ? e0 : 0.f; pA1[r] = ((w1s >> sh) & 1u) ? e1 : 0.f; negm[r] = -rm; } }
    FP_WAIT_BAR(0);
    if (SW == SW_DSA && NT > 1) mkN = MKG[SEQ];
    if (NT > 3) FP_DMA_K(3, 0); if (NT > 1) { FP_DMA_V(1, SLOTB); FP_ROT(); }
    if (NT > 1) { _Pragma("unroll") for (int d0 = 0; d0 < 4; ++d0) kload2(kf, kp0 + sl_cur, d0); }
    if (NT > 3) FP_WAIT_BAR(2); else if (NT == 3) FP_WAIT_BAR(1); else FP_WAIT_BAR(0);
#define FP_PKW(P, i) cvtpk(P[i], P[i + 1])
#define FP_PAF(k) __builtin_bit_cast(bf16x8, pw##k)
#define FP_VFR(i) (bf16x8){vlo[i][0], vlo[i][1], vlo[i][2], vlo[i][3], vhi[i][0], vhi[i][1], vhi[i][2], vhi[i][3]}
#define FP_VRD(i) do { vlo[i] = vtr((const LAS unsigned char*)(vp_ + (((i) >> 2) * 4096 + ((i) & 3) * 1024))); vhi[i] = vtr((const LAS unsigned char*)(vp_ + (((i) >> 2) * 4096 + ((i) & 3) * 1024 + 512))); } while (0)
#define FP_KRD(G, d0) do { if (G) { kload2(kf, kp0 + sl_next, d0); FP_SBAR(); } } while (0)
#define FP_GAPA(MF, a0, a1, a2, a3, W0, W1, PW) do { MF; sacc += a0; sacc += a1; sacc += a2; sacc += a3; W0; W1; FP_PIN(PW); FP_PIN(sacc); FP_SBAR(); } while (0)
#define FP_EXM(KIND, X, W, k, SHB) X[k] = ((KIND) == 1) ? FP_MBIT(__builtin_amdgcn_exp2f(X[k]), W, (SHB)) : ((KIND) == 2) ? (onv ? __builtin_amdgcn_exp2f(X[k]) : 0.f) : __builtin_amdgcn_exp2f(X[k])
#define FP_GAPB(MF, KIND, X, W, i) do { MF; FP_EXM(KIND, X, W, i, 2 * (i)); FP_EXM(KIND, X, W, (i) + 1, 2 * (i) + 1); FP_EXM(KIND, X, W, (i) + 2, 2 * (i) + 2); FP_EXM(KIND, X, W, (i) + 3, 2 * (i) + 3); FP_PIN(X); FP_SBAR(); } while (0)
#define FP_STEP(C0, C1, P0, P1, t, KIND, MSET, GK, GVL) do { FP_SBAR(); \
    const lds_cptr vp_ = vp0 + sl_prev; \
    FP_VRD(0); qb = FP_Q(1); FP_SBAR(); float sacc = P0[0] + P0[1]; \
                       FP_GAPA(C0 = FP_MFMA(kf[0], qa, negm), P0[2], P0[3], P0[4], P0[5],     pw0[0] = FP_PKW(P0, 0),  pw0[1] = FP_PKW(P0, 2),  pw0); \
    FP_VRD(4); FP_SBAR(); FP_GAPA(C1 = FP_MFMA(kf[1], qa, negm), P0[6], P0[7], P0[8], P0[9],     pw0[2] = FP_PKW(P0, 4),  pw0[3] = FP_PKW(P0, 6),  pw0); \
    FP_VRD(1); qa = FP_Q(2); FP_SBAR(); FP_GAPA(C0 = FP_MFMA(kf[2], qb, C0),   P0[10], P0[11], P0[12], P0[13], pw1[0] = FP_PKW(P0, 8),  pw1[1] = FP_PKW(P0, 10), pw1); \
    FP_VRD(5); FP_SBAR(); FP_GAPA(C1 = FP_MFMA(kf[3], qb, C1),   P0[14], P0[15], P1[0], P1[1],   pw1[2] = FP_PKW(P0, 12), pw1[3] = FP_PKW(P0, 14), pw1); \
    qb = FP_Q(3); FP_SBAR(); FP_GAPA(C0 = FP_MFMA(kf[4], qa, C0),   P1[2], P1[3], P1[4], P1[5],     pw2[0] = FP_PKW(P1, 0),  pw2[1] = FP_PKW(P1, 2),  pw2); \
    FP_GAPA(C1 = FP_MFMA(kf[5], qa, C1),   P1[6], P1[7], P1[8], P1[9],     pw2[2] = FP_PKW(P1, 4),  pw2[3] = FP_PKW(P1, 6),  pw2); \
    FP_GAPA(C0 = FP_MFMA(kf[6], qb, C0),   P1[10], P1[11], P1[12], P1[13], pw3[0] = FP_PKW(P1, 8),  pw3[1] = FP_PKW(P1, 10), pw3); \
    FP_GAPA(C1 = FP_MFMA(kf[7], qb, C1),   P1[14], P1[15], 0.f, 0.f,       pw3[2] = FP_PKW(P1, 12), pw3[3] = FP_PKW(P1, 14), pw3); \
    l_reg += sacc; \
    MSET; \
    if (SW == SW_DSA && (GVL)) mkN = MKG[(size_t)((t) + 1) * SEQ];                                                          \
    if (GK) FP_DMA_K((t) + 3, sl_cur); if (GVL) FP_DMA_V((t) + 1, sl_next); \
    { const float rm = rowmax(C0, C1); resc = false;                                                                         \
      if (__builtin_expect(__any(rm > THR), 0)) { const float dl = __builtin_fmaxf(rm, 0.f); mhat += dl; \
          const float f = __builtin_amdgcn_exp2f(-dl); l_reg *= f; if (hi == 0) wsf[r32] = f; resc = true; \
          _Pragma("unroll") for (int r = 0; r < 16; ++r) { C0[r] -= dl; C1[r] -= dl; negm[r] = -mhat; } } } \
    FP_SBAR(); \
    FP_VRD(2); FP_SBAR(); FP_GAPB(o[0] = FP_MFMA(FP_PAF(0), FP_VFR(0), o[0]), KIND, C0, w0s, 0);  FP_VRD(6); FP_SBAR(); FP_GAPB(o[1] = FP_MFMA(FP_PAF(0), FP_VFR(4), o[1]), KIND, C0, w0s, 4);     \
    FP_VRD(3); FP_SBAR(); FP_GAPB(o[0] = FP_MFMA(FP_PAF(1), FP_VFR(1), o[0]), KIND, C0, w0s, 8);  FP_VRD(7); FP_SBAR(); FP_GAPB(o[1] = FP_MFMA(FP_PAF(1), FP_VFR(5), o[1]), KIND, C0, w0s, 12); \
    FP_KRD(GVL, 0); FP_GAPB(o[0] = FP_MFMA(FP_PAF(2), FP_VFR(2), o[0]), KIND, C1, w1s, 0);  FP_KRD(GVL, 1); FP_GAPB(o[1] = FP_MFMA(FP_PAF(2), FP_VFR(6), o[1]), KIND, C1, w1s, 4);           \
    FP_KRD(GVL, 2); FP_GAPB(o[0] = FP_MFMA(FP_PAF(3), FP_VFR(3), o[0]), KIND, C1, w1s, 8);  if (GVL) { kload2(kf, kp0 + sl_next, 3); qa = FP_Q(0); FP_SBAR(); }  FP_GAPB(o[1] = FP_MFMA(FP_PAF(3), FP_VFR(7), o[1]), KIND, C1, w1s, 12); \
    } while (0)
#define FP_ENDW(tt) do { if ((tt) + 3 < NT) { FP_WAIT_BAR(2); } else if ((tt) + 2 < NT) { FP_WAIT_BAR(1); } else { FP_WAIT_BAR(0); } } while (0)
#define FP_MSET_S(t) do { if (KS == 1) words((t), w0s, w1s); else if (KS == 2) onv = (sel >> (t)) & 1ull; } while (0)
#define FP_MSET_L(t) words((t), w0s, w1s)
#define FP_DRAIN(P0, P1) do { float sacc = P0[0] + P0[1]; \
      _Pragma("unroll") for (int r = 2; r < 16; ++r) sacc += P0[r]; \
      _Pragma("unroll") for (int r = 0; r < 16; ++r) sacc += P1[r]; \
      l_reg += sacc; \
      pw0 = (u32x4){FP_PKW(P0, 0), FP_PKW(P0, 2), FP_PKW(P0, 4), FP_PKW(P0, 6)}; pw1 = (u32x4){FP_PKW(P0, 8), FP_PKW(P0, 10), FP_PKW(P0, 12), FP_PKW(P0, 14)}; \
      pw2 = (u32x4){FP_PKW(P1, 0), FP_PKW(P1, 2), FP_PKW(P1, 4), FP_PKW(P1, 6)}; pw3 = (u32x4){FP_PKW(P1, 8), FP_PKW(P1, 10), FP_PKW(P1, 12), FP_PKW(P1, 14)}; \
      const lds_cptr vp_ = vp0 + sl_cur; _Pragma("unroll") for (int i = 0; i < 8; ++i) FP_VRD(i); \
      o[0] = FP_MFMA(FP_PAF(0), FP_VFR(0), o[0]); o[1] = FP_MFMA(FP_PAF(0), FP_VFR(4), o[1]); o[0] = FP_MFMA(FP_PAF(1), FP_VFR(1), o[0]); o[1] = FP_MFMA(FP_PAF(1), FP_VFR(5), o[1]); \
      o[0] = FP_MFMA(FP_PAF(2), FP_VFR(2), o[0]); o[1] = FP_MFMA(FP_PAF(2), FP_VFR(6), o[1]); o[0] = FP_MFMA(FP_PAF(3), FP_VFR(3), o[0]); o[1] = FP_MFMA(FP_PAF(3), FP_VFR(7), o[1]); } while (0)
    const int S = NT - 1; int t = 1;
    if (S >= 1) {
        if (!(S & 1)) {
            FP_STEP(pB0, pB1, pA0, pA1, 1, KS, FP_MSET_S(1), (4 < NT), true); FP_ENDW(1); FP_RESC(); FP_ROT();
            pA0 = pB0; pA1 = pB1; t = 2;
        }
        for (; t < S; t += 2) {
            FP_STEP(pB0, pB1, pA0, pA1, t, KS, FP_MSET_S(t), (t + 3 < NT), true);         FP_ENDW(t);     FP_RESC(); FP_ROT();
            FP_STEP(pA0, pA1, pB0, pB1, t + 1, KS, FP_MSET_S(t + 1), (t + 4 < NT), true); FP_ENDW(t + 1); FP_RESC(); FP_ROT();
        }
        FP_STEP(pB0, pB1, pA0, pA1, S, 1, FP_MSET_L(S), false, false); FP_RESC();
    } else { pB0 = pA0; pB1 = pA1; }
    FP_DRAIN(pB0, pB1);
    l_out = l_reg;
    asm volatile("s_waitcnt lgkmcnt(0)\n\ts_barrier" ::: "memory");
#undef FP_Q
#undef FP_DMA_K
#undef FP_DMA_V
#undef FP_ROT
#undef FP_RESC
#undef FP_PKW
#undef FP_PAF
#undef FP_VFR
#undef FP_VRD
#undef FP_KRD
#undef FP_GAPA
#undef FP_EXM
#undef FP_GAPB
#undef FP_STEP
#undef FP_ENDW
#undef FP_MSET_S
#undef FP_MSET_L
#undef FP_DRAIN
}
__device__ __forceinline__ void park_qf(const Ctx& c, const bf16* Qrow) {
    LAS bf16x8* qs = (LAS bf16x8*)(c.lds + LQ + c.wid * 4096) + c.lane;
#pragma unroll
    for (int d0 = 0; d0 < 4; ++d0) qs[d0 * 64] = *(const bf16x8*)(Qrow + d0 * 16 + c.hi * 8);
}
__device__ __forceinline__ void scale_rows(const Ctx& c, f32x16 (&o)[2], float fac) {
    LAS float* wsf = (LAS float*)(c.lds + LX) + c.wid * 64;
    if (c.hi == 0) wsf[32 + c.r32] = fac;
#pragma unroll
    for (int r = 0; r < 16; ++r) { const float f = wsf[32 + crow(r, c.hi)]; o[0][r] *= f; o[1][r] *= f; }
}
__device__ __forceinline__ void dsa_unit(Frame& F, int b, int g, int qt) {
    int ln_ = F.lane; asm volatile("" : "+v"(ln_));
    Ctx c; c.lds = F.lds; c.lane = ln_; c.wid = F.wave; c.r32 = ln_ & 31; c.hi = ln_ >> 5;
    const int h = 4 * g + (c.wid >> 1), qw = 64 * qt + 32 * (c.wid & 1);
    const size_t mrow = (size_t)b * SEQ + qw;
    park_qf(c, LWSP(bf16, WS_Q0) + (mrow + c.r32) * 1024 + h * 64);
    const bf16* Kg = LWSP(bf16, WS_K0) + (size_t)b * SEQ * 256 + g * 64; const bf16* Vg = LWSP(bf16, WS_V0) + (size_t)b * SEQ * 256 + g * 64;
    const u32x2* MK = (const u32x2*)(LWSP(unsigned long long, WS_MASK) + (size_t)b * 64 * SEQ + qw + c.r32);
    f32x16 o[2]; float l;
    sweep<SW_DSA>(c, Kg, Vg, qt + 1, MK, 0ull, 0, o, l);
    l = pair_sum(l);
    scale_rows(c, o, l > 0.f ? 1.0f / l : 0.f);
    LAS bf16* sb = (LAS bf16*)(c.lds + LOST + c.wid * 4096);
#pragma unroll
    for (int r = 0; r < 16; ++r) { const int orow = crow(r, c.hi);
#pragma unroll
        for (int d0 = 0; d0 < 2; ++d0) sb[orow * 64 + d0 * 32 + c.r32] = (bf16)f2bf(o[d0][r] * OS); }
    unsigned char* Ow = LWSP(unsigned char, WS_O0) + mrow * 1024 + h * 64;
    const int row = c.lane >> 1, hf = c.lane & 1;
    const u32x4 a = *(const LAS u32x4*)(sb + row * 64 + hf * 32), bq = *(const LAS u32x4*)(sb + row * 64 + hf * 32 + 8), cq = *(const LAS u32x4*)(sb + row * 64 + hf * 32 + 16), dq = *(const LAS u32x4*)(sb + row * 64 + hf * 32 + 24);
    u32x4 o0, o1;
    o0.x = pk4_fp8(bflo(a.x), bfhi(a.x), bflo(a.y), bfhi(a.y)); o0.y = pk4_fp8(bflo(a.z), bfhi(a.z), bflo(a.w), bfhi(a.w)); o0.z = pk4_fp8(bflo(bq.x), bfhi(bq.x), bflo(bq.y), bfhi(bq.y)); o0.w = pk4_fp8(bflo(bq.z), bfhi(bq.z), bflo(bq.w), bfhi(bq.w));
    o1.x = pk4_fp8(bflo(cq.x), bfhi(cq.x), bflo(cq.y), bfhi(cq.y)); o1.y = pk4_fp8(bflo(cq.z), bfhi(cq.z), bflo(cq.w), bfhi(cq.w)); o1.z = pk4_fp8(bflo(dq.x), bfhi(dq.x), bflo(dq.y), bfhi(dq.y)); o1.w = pk4_fp8(bflo(dq.z), bfhi(dq.z), bflo(dq.w), bfhi(dq.w));
    *(u32x4*)(Ow + (size_t)row * 1024 + hf * 32) = o0; *(u32x4*)(Ow + (size_t)row * 1024 + hf * 32 + 16) = o1;
}
__device__ __forceinline__ void nsa_unit(Frame& F, int b, int g, int qt) {
    int ln_ = F.lane; asm volatile("" : "+v"(ln_));
    Ctx c; c.lds = F.lds; c.lane = ln_; c.wid = F.wave; c.r32 = ln_ & 31; c.hi = ln_ >> 5;
    const int h = 4 * g + (c.wid >> 1), qw = 64 * qt + 32 * (c.wid & 1), qi = 32 * (c.wid & 1) + c.r32;
    const size_t mrow = (size_t)b * SEQ + qw;
    park_qf(c, LWSP(bf16, WS_Q1) + (mrow + c.r32) * 1024 + h * 64);
    const unsigned long long sel = LWSP(unsigned long long, WS_SEL)[((size_t)b * 4 + g) * SEQ + qw + c.r32];
    LAS float* gx = (LAS float*)(c.lds + LX + 2048) + c.wid * 64;
    gx[c.lane] = LWSP(float, SM_GATES)[(mrow + c.r32) * 48 + h * 3 + 1 + c.hi];
    LAS bf16* stg = (LAS bf16*)(c.lds + LOST + c.wid * 4096);
    f32x16 o[2]; float l;
    {
        const bf16* Kg = LWSP(bf16, WS_KSLC) + (size_t)b * SEQ * 256 + g * 64; const bf16* Vg = LWSP(bf16, WS_VSLC) + (size_t)b * SEQ * 256 + g * 64;
        sweep<SW_SLC>(c, Kg, Vg, qt + 1, nullptr, sel, qi, o, l);
        l = pair_sum(l);
        scale_rows(c, o, l > 0.f ? gx[c.r32] / l : 0.f);
#pragma unroll
        for (int r = 0; r < 16; ++r) { const int orow = crow(r, c.hi);
#pragma unroll
            for (int d0 = 0; d0 < 2; ++d0) stg[orow * 64 + d0 * 32 + c.r32] = (bf16)f2bf(o[d0][r]); }
    }
    {
        const int tlo = qt >= 8 ? qt - 8 : 0;
        const bf16* Kg = LWSP(bf16, WS_KWIN) + ((size_t)b * SEQ + 64 * tlo) * 256 + g * 64; const bf16* Vg = LWSP(bf16, WS_VWIN) + ((size_t)b * SEQ + 64 * tlo) * 256 + g * 64;
        sweep<SW_WIN>(c, Kg, Vg, qt - tlo + 1, nullptr, 0ull, qi, o, l);
        l = pair_sum(l);
        scale_rows(c, o, l > 0.f ? gx[32 + c.r32] / l : 0.f);
#pragma unroll
        for (int r = 0; r < 16; ++r) { const int orow = crow(r, c.hi);
#pragma unroll
            for (int d0 = 0; d0 < 2; ++d0) { LAS bf16* p = stg + orow * 64 + d0 * 32 + c.r32; *p = (bf16)f2bf(o[d0][r] + bf2f((unsigned)*p)); } }
    }
    const bf16* OCG = LWSP(bf16, WS_OCG) + mrow * 1024 + h * 64; unsigned char* O = LWSP(unsigned char, WS_O1) + mrow * 1024 + h * 64;
#pragma unroll
    for (int i = 0; i < 4; ++i) { const int row = i * 8 + (c.lane >> 3), ch = c.lane & 7;
        const u32x4 oc = *(const u32x4*)(OCG + (size_t)row * 1024 + 8 * ch), sv = *(const LAS u32x4*)(stg + row * 64 + 8 * ch);
        u32x2 w; w.x = pk4_fp8((bflo(oc.x) + bflo(sv.x)) * OS, (bfhi(oc.x) + bfhi(sv.x)) * OS, (bflo(oc.y) + bflo(sv.y)) * OS, (bfhi(oc.y) + bfhi(sv.y)) * OS);
        w.y = pk4_fp8((bflo(oc.z) + bflo(sv.z)) * OS, (bfhi(oc.z) + bfhi(sv.z)) * OS, (bflo(oc.w) + bflo(sv.w)) * OS, (bfhi(oc.w) + bfhi(sv.w)) * OS);
        *(u32x2*)(O + (size_t)row * 1024 + 8 * ch) = w; }
}
#undef FP_SBAR
#undef FP_PIN
#undef FP_MFMA
#undef FP_WAIT_BAR
#undef FP_MX3
#undef FP_MBIT
}

namespace cm {
using namespace fa;
constexpr int IMPOFF = 69632;
__device__ __forceinline__ void unit(Frame& F, int b, int g, int qt) {
    Ctx c; c.lds = F.lds; c.lane = F.lane; c.wid = F.wave; c.r32 = F.lane & 31; c.hi = F.lane >> 5;
    const int hr = c.wid >> 1, h = 4 * g + hr, qw = 64 * qt + 32 * (c.wid & 1), qi = 32 * (c.wid & 1) + c.r32;
    const size_t mrow = (size_t)b * SEQ + qw;
    park_q(c, LWSP(bf16, WS_Q1) + (mrow + c.r32) * 1024 + h * 64);
    LAS float* gx = (LAS float*)(c.lds + XOFF + 2048) + c.wid * 64;
    if (c.hi == 0) gx[c.r32] = LWSP(float, SM_GATES)[(mrow + c.r32) * 48 + h * 3];
    const int t = qw + c.r32, nv = t >= 31 ? min(255, (t - 31) / 16 + 1) : 0;
    const bf16* Kg = LWSP(bf16, SM_KC) + (size_t)(b * 4 + g) * 256 * 64; const bf16* Vg = LWSP(bf16, SM_VC) + (size_t)(b * 4 + g) * 256 * 64;
    const int NTc = (qt >> 4) + 1;
    f32x16 o[2]; o[0] = f32x16{}; o[1] = f32x16{};
    f32x16 zero = {};
    float m = 0.f, l = 0.f, carry = 0.f;
    float bsum[4][8];
#pragma unroll
    for (int T_ = 0; T_ < 4; ++T_)
#pragma unroll
        for (int i = 0; i < 8; ++i) bsum[T_][i] = 0.f;
    dma_tile(c, Kg, Vg, 64, 0, 0);
    __syncthreads();
#pragma unroll
    for (int T_ = 0; T_ < 4; ++T_) {
        if (T_ < NTc) {
            if (T_ + 1 < NTc) dma_tile(c, Kg, Vg, 64, T_ + 1, (T_ + 1) & 1);
            f32x16 p0, p1;
            qk(c, T_ & 1, zero, p0, p1);
            __builtin_amdgcn_sched_barrier(0);
            const float rm = rowmax(p0, p1) - m;
            bool doit; float dl;
            if (T_ == 0) { doit = true; dl = rm; } else { doit = __any(rm > THR); dl = fmaxf(rm, 0.f); }
            if (doit) {
                m += dl;
                if (T_ > 0) {
                    const float f = __builtin_amdgcn_exp2f(-dl);
                    l *= f; carry *= f;
#pragma unroll
                    for (int u = 0; u < 4; ++u)
#pragma unroll
                        for (int i = 0; i < 8; ++i) bsum[u][i] *= f;
                    LAS float* xs = (LAS float*)(c.lds + XOFF) + c.wid * 64;
                    if (c.hi == 0) xs[c.r32] = f;
#pragma unroll
                    for (int r = 0; r < 16; ++r) { const float fr = xs[crow(r, c.hi)]; o[0][r] *= fr; o[1][r] *= fr; }
                }
            }
            const int cnt = nv - 64 * T_;
            const unsigned long long wm = cnt >= 64 ? ~0ull : (cnt <= 0 ? 0ull : ((1ull << cnt) - 1ull));
            const unsigned w0 = (unsigned)wm >> (4 * c.hi), w1 = (unsigned)(wm >> 32) >> (4 * c.hi);
            float ls = 0.f;
#pragma unroll
            for (int r = 0; r < 16; ++r) { const int sh = (r & 3) + 8 * (r >> 2);
                float e0 = __builtin_amdgcn_exp2f(p0[r] - m), e1 = __builtin_amdgcn_exp2f(p1[r] - m);
                e0 = __builtin_bit_cast(float, __builtin_bit_cast(unsigned, e0) & (unsigned)__builtin_amdgcn_sbfe((int)w0, sh, 1));
                e1 = __builtin_bit_cast(float, __builtin_bit_cast(unsigned, e1) & (unsigned)__builtin_amdgcn_sbfe((int)w1, sh, 1));
                p0[r] = e0; p1[r] = e1; ls += e0 + e1; }
            l += ls;
            float mn0[4], mn1[4], rc0[4], rc1[4];
#pragma unroll
            for (int i = 0; i < 4; ++i) { const float s0 = 0.5f * p0[4 * i + 3], s1 = 0.5f * p1[4 * i + 3];
                mn0[i] = (p0[4 * i] + p0[4 * i + 1]) + (p0[4 * i + 2] + s0); mn1[i] = (p1[4 * i] + p1[4 * i + 1]) + (p1[4 * i + 2] + s1);
                rc0[i] = __shfl_xor(s0, 32); rc1[i] = __shfl_xor(s1, 32); }
            if (c.hi) {
#pragma unroll
                for (int i = 0; i < 4; ++i) { bsum[T_][i] = mn0[i] + rc0[i]; bsum[T_][4 + i] = mn1[i] + rc1[i]; }
            } else {
                bsum[T_][0] = mn0[0] + carry; bsum[T_][4] = mn1[0] + rc0[3];
#pragma unroll
                for (int i = 1; i < 4; ++i) { bsum[T_][i] = mn0[i] + rc0[i - 1]; bsum[T_][4 + i] = mn1[i] + rc1[i - 1]; }
                carry = rc1[3];
            }
            u32x4 pw[4];
            pw[0] = (u32x4){cvtpk(p0[0], p0[1]), cvtpk(p0[2], p0[3]), cvtpk(p0[4], p0[5]), cvtpk(p0[6], p0[7])};
            pw[1] = (u32x4){cvtpk(p0[8], p0[9]), cvtpk(p0[10], p0[11]), cvtpk(p0[12], p0[13]), cvtpk(p0[14], p0[15])};
            pw[2] = (u32x4){cvtpk(p1[0], p1[1]), cvtpk(p1[2], p1[3]), cvtpk(p1[4], p1[5]), cvtpk(p1[6], p1[7])};
            pw[3] = (u32x4){cvtpk(p1[8], p1[9]), cvtpk(p1[10], p1[11]), cvtpk(p1[12], p1[13]), cvtpk(p1[14], p1[15])};
            __builtin_amdgcn_sched_barrier(0);
            {
                const LAS unsigned char* vp = c.lds + VOFF + (T_ & 1) * 8192 + ((c.lane >> 4) & 1) * 32 + (c.lane & 3) * 8 + (4 * c.hi + ((c.lane & 15) >> 2)) * 64;
#pragma unroll
                for (int d0 = 0; d0 < 2; ++d0) {
                    s16x4 lo[4], hi4[4];
#pragma unroll
                    for (int ks = 0; ks < 4; ++ks) { lo[ks] = vtr(vp + d0 * 4096 + ks * 1024); hi4[ks] = vtr(vp + d0 * 4096 + ks * 1024 + 512); }
#pragma unroll
                    for (int ks = 0; ks < 4; ++ks) { const bf16x8 vf = {lo[ks][0], lo[ks][1], lo[ks][2], lo[ks][3], hi4[ks][0], hi4[ks][1], hi4[ks][2], hi4[ks][3]};
                        o[d0] = __builtin_amdgcn_mfma_f32_32x32x16_bf16(__builtin_bit_cast(bf16x8, pw[ks]), vf, o[d0], 0, 0, 0); }
                    __builtin_amdgcn_sched_barrier(0);
                }
            }
            __syncthreads();
        }
    }
    l += __shfl_xor(l, 32);
    const float inv = l > 0.f ? 1.0f / l : 0.f;
    LAS float* imp = (LAS float*)(c.lds + IMPOFF) + (hr * 64 + qi) * 64;
#pragma unroll
    for (int T_ = 0; T_ < 4; ++T_)
#pragma unroll
        for (int i = 0; i < 4; ++i) { imp[16 * T_ + 2 * i + c.hi] = bsum[T_][i] * inv; imp[16 * T_ + 8 + 2 * i + c.hi] = bsum[T_][4 + i] * inv; }
    {
        LAS float* xs = (LAS float*)(c.lds + XOFF) + c.wid * 64;
        if (c.hi == 0) xs[c.r32] = inv * gx[c.r32];
#pragma unroll
        for (int r = 0; r < 16; ++r) { const float fr = xs[crow(r, c.hi)]; o[0][r] *= fr; o[1][r] *= fr; }
        store_o_bf16(c, o, LWSP(bf16, WS_OCG) + mrow * 1024 + h * 64);
    }
    __syncthreads();
    {
        const LAS float* I0 = (const LAS float*)(c.lds + IMPOFF);
        const int j = c.lane;
        const bool valid = j <= qt, forced = valid && ((j == 0) || (j == qt) || (j + 1 == qt)), cnd = valid && !forced;
        const unsigned long long bf = __ballot(forced), bc = __ballot(cnd);
        const int K = 16 - __popcll(bf);
        unsigned long long mk[8];
        if (__popcll(bc) > K) {
            unsigned key[8], prefix[8];
#pragma unroll
            for (int u = 0; u < 8; ++u) { const int qq = 8 * c.wid + u;
                const float iv = (I0[(0 * 64 + qq) * 64 + j] + I0[(1 * 64 + qq) * 64 + j]) + (I0[(2 * 64 + qq) * 64 + j] + I0[(3 * 64 + qq) * 64 + j]);
                key[u] = cnd ? okey(iv) : 0u; prefix[u] = 0u; }
            for (int bit = 31; bit >= 0; --bit) {
#pragma unroll
                for (int u = 0; u < 8; ++u) { const unsigned cand = prefix[u] | (1u << bit); const int cn = __popcll(__ballot(key[u] >= cand)); if (cn >= K) prefix[u] = cand; }
            }
#pragma unroll
            for (int u = 0; u < 8; ++u) {
                const unsigned long long bg = __ballot(key[u] > prefix[u]), be = __ballot(key[u] == prefix[u] && cnd); const int need = K - __popcll(bg);
                const bool tk = (key[u] == prefix[u]) && cnd && (__popcll(be & ((1ull << j) - 1ull)) < need); mk[u] = bf | bg | __ballot(tk); }
        } else {
#pragma unroll
            for (int u = 0; u < 8; ++u) mk[u] = bf | bc;
        }
#pragma unroll
        for (int u = 0; u < 8; ++u) if (j == 0) LWSP(unsigned long long, WS_SEL)[((size_t)b * 4 + g) * SEQ + 64 * qt + 8 * c.wid + u] = mk[u];
    }
    __syncthreads();
}
}


#if DBG_CHECK
__device__ __forceinline__ void dbg_compare(Frame& F, const bf16* A, const bf16* R, int slot) {
    float sd = 0.f, sr = 0.f;
    for (size_t i = (size_t)F.gw * 64 + F.lane; i < (size_t)T * D / 2; i += (size_t)F.NGW * 64) { const unsigned a = ((const unsigned*)A)[i], r = ((const unsigned*)R)[i];
        const float d0 = bflo(a) - bflo(r), d1 = bfhi(a) - bfhi(r); sd += d0 * d0 + d1 * d1; sr += bflo(r) * bflo(r) + bfhi(r) * bfhi(r); }
    sd = wave_sum(sd); sr = wave_sum(sr);
    if (F.lane == 0) { atomicAdd((float*)(F.ctl + CW_DBG + slot), sd); atomicAdd((float*)(F.ctl + CW_DBG + slot + 1), sr); }
}
#endif
__device__ __forceinline__ f32x4 yrow(const bf16* Y, const bf16* Yp, int slot, int i) {
    if (slot < 128 * 256) { const u32x2 v = ((const u32x2*)(Y + (size_t)slot * D))[i]; return (f32x4){bflo(v.x), bfhi(v.x), bflo(v.y), bfhi(v.y)}; }
    f32x4 a = {0.f, 0.f, 0.f, 0.f};
#pragma unroll
    for (int q = 0; q < 2; ++q) { const u32x2 v = ((const u32x2*)(Yp + (size_t)q * NE * 256 * D + (size_t)(slot - 128 * 256) * D))[i]; a += (f32x4){bflo(v.x), bfhi(v.x), bflo(v.y), bfhi(v.y)}; }
    return a;
}
constexpr int NPHASE = 22;
struct Args { const void* in[29]; float* out; unsigned char* ws; int ph_lo, ph_hi, li, pad; };
__global__ void __launch_bounds__(NWAVES * 64, 2) trunk_fwd(Args args) {
    extern __shared__ __attribute__((aligned(16))) unsigned char lds[];
const int wave_s = __builtin_amdgcn_readfirstlane((int)threadIdx.x >> 6);
#define MKFRAME() Frame F; F.lds = (LAS unsigned char*)lds; F.MISC = (volatile LAS unsigned*)(F.lds + MISC_OFF); F.wave = wave_s; F.lane = lane_id(); F.tid = wave_s * 64 + F.lane; F.G = gridDim.x; F.gw = blockIdx.x * NWAVES + F.wave; F.NGW = F.G * NWAVES; F.ws = args.ws; F.ctl = (unsigned*)(args.ws + WS_CTL); F.x = (const float*)args.in[0]; F.c = (const float*)args.in[1]; F.pos = (const int*)args.in[2]; F.attn_gain = (const float*)args.in[3]; F.ffn_gain = (const float*)args.in[4]; F.w_ada = (const float*)args.in[5]; F.b_ada = (const float*)args.in[6]; F.a_w_in = (const float*)args.in[7]; F.a_w_out = (const float*)args.in[8]; F.b_w_q = (const float*)args.in[9]; F.b_w_out = (const float*)args.in[10]; F.kv_gain = (const float*)args.in[11]; F.w_kv_ada = (const float*)args.in[12]; F.b_kv_ada = (const float*)args.in[13]; F.w_kv = (const float*)args.in[14]; F.pe_k = (const float*)args.in[15]; F.w1_k = (const float*)args.in[16]; F.w2_k = (const float*)args.in[17]; F.pe_v = (const float*)args.in[18]; F.w1_v = (const float*)args.in[19]; F.w2_v = (const float*)args.in[20]; F.ffn_wg = (const float*)args.in[21]; F.ffn_wu = (const float*)args.in[22]; F.ffn_wd = (const float*)args.in[23]; F.w_router = (const float*)args.in[24]; F.moe_wg = (const float*)args.in[25]; F.moe_wu = (const float*)args.in[26]; F.moe_wd = (const float*)args.in[27]; F.final_gain = (const float*)args.in[28]; F.out = args.out; F.outw = args.pad ? (float*)(args.ws + WS_DRY) : args.out;
    { MKFRAME();
    for (int u = F.tid; u < (LDS_BYTES - LDSCTL_OFF) / 4; u += NWAVES * 64) ((LAS unsigned*)(F.lds + LDSCTL_OFF))[u] = 0u;
    __syncthreads(); }
    XcdBarrier bar; bar.bar = (unsigned*)(args.ws + WS_CTL) + CW_BAR + args.li * XCD_BAR_WORDS; bar.x = 0; bar.st = nullptr;
    if (!MK_PER_PHASE) bar = xcd_barrier_post((unsigned*)(args.ws + WS_CTL) + CW_BAR + args.li * XCD_BAR_WORDS, (volatile LAS unsigned*)((LAS unsigned char*)lds + MISC_OFF) + 8, wave_s == 0 && lane_id() == 0);
#define GRID_BAR() do { if (!MK_PER_PHASE) xcd_barrier(bar, wave_s == 0 && lane_id() == 0); } while (0)
#define GRID_BAR_ALWAYS() do { static_assert(!MK_PER_PHASE, "a seam inside a phase needs the one-launch build"); xcd_barrier(bar, wave_s == 0 && lane_id() == 0); } while (0)
    const int lo = args.ph_lo, hi = args.ph_hi;
#if DBG_TIME
    volatile LAS unsigned long long* tsl = (volatile LAS unsigned long long*)(F.lds + LDSCTL_OFF + 1024);
#define IN(k) ((lo <= (k) && (k) < hi) && (((blockIdx.x == 0 && F.tid == 0) ? (void)(tsl[(k)] = __builtin_amdgcn_s_memrealtime()) : (void)0), true))
#else
#define IN(k) (lo <= (k) && (k) < hi)
#endif
#define BOTH(k) (IN(k) && IN((k) + 1))
#define MOD0 WSP(float, SM_MOD0)
#define MOD1 WSP(float, SM_MOD1)
#define KVMOD WSP(float, SM_KVMOD)
#define CS WSP(float, SM_COS)
#define SN WSP(float, SM_SIN)

    if (IN(0)) { MKFRAME(); p0_prologue(F); if (BOTH(0)) GRID_BAR(); }
    if (IN(1)) { MKFRAME(); norm_phase(F, F.x, F.attn_gain, MOD0, 6144, 0, 1024, WSP(bf16, WS_U)); if (BOTH(1)) GRID_BAR(); }
    if (IN(2)) { MKFRAME();
        pg8::Gemm g{WSP(bf16, WS_U), WSP(bf16, WB_IN), D, D, D}; pg8::StaticOrder S; S.init(T, 2048, F.G, (int)blockIdx.x);
        EpiIn E{WSP(bf16, WS_Q0), WSP(bf16, WS_K0), WSP(bf16, WS_V0), WSP(bf16, WS_IQ), WSP(bf16, WS_IK), WSP(float, SM_IW), CS, SN};
        pg8::gemm_phase(F.lds, g, S, E, F.wave);
        for (int it0 = 2 * blockIdx.x; it0 < T / 32; it0 += 2 * F.G) {
            const int lane = F.lane, half = F.wave >> 2, wq = F.wave & 3, row0 = 32 * (it0 + half), kw = 256 * wq;
            const bf16* ap = WSP(bf16, WS_U) + (size_t)(row0 + (lane & 31)) * D + 8 * (lane >> 5) + kw;
            const bf16* bp = WSP(bf16, WB_IKW) + (size_t)(lane & 31) * D + 8 * (lane >> 5) + kw;
            f32x16 a1 = {}, a2 = {}, a3 = {};
#pragma unroll
            for (int k = 0; k < 256; k += 16) { const bf16x8 a = *(const bf16x8*)(ap + k);
                a1 = __builtin_amdgcn_mfma_f32_32x32x16_bf16(a, *(const bf16x8*)(bp + k), a1, 0, 0, 0);
                a2 = __builtin_amdgcn_mfma_f32_32x32x16_bf16(a, *(const bf16x8*)(bp + 32 * D + k), a2, 0, 0, 0);
                a3 = __builtin_amdgcn_mfma_f32_32x32x16_bf16(a, *(const bf16x8*)(bp + 64 * D + k), a3, 0, 0, 0); }
            LAS float* red = (LAS float*)F.lds + F.wave * 3072 + lane;
#pragma unroll
            for (int r = 0; r < 16; ++r) { red[r * 64] = a1[r]; red[1024 + r * 64] = a2[r]; red[2048 + r * 64] = a3[r]; }
            __syncthreads();
            const int d = lane & 31; bf16* IKo = WSP(bf16, WS_IK); float* IWo = WSP(float, SM_IW);
#pragma unroll
            for (int rr = 0; rr < 4; ++rr) { const int r = 4 * wq + rr; float x1 = 0.f, x2 = 0.f, x3 = 0.f;
#pragma unroll
                for (int w = 0; w < 4; ++w) { const LAS float* q = (const LAS float*)F.lds + (4 * half + w) * 3072 + r * 64 + lane; x1 += q[0]; x2 += q[1024]; x3 += q[2048]; }
                const int row = row0 + (r & 3) + 8 * (r >> 2) + 4 * (lane >> 5);
                const float c = CS[(size_t)row * 32 + d], sn = SN[(size_t)row * 32 + d];
                IKo[(size_t)row * 64 + d] = (bf16)f2bf(x1 * c - x2 * sn); IKo[(size_t)row * 64 + 32 + d] = (bf16)f2bf(x2 * c + x1 * sn);
                if (d < 8) IWo[(size_t)row * 8 + d] = x3 * IWS; }
            __syncthreads();
        }
        if (BOTH(2)) GRID_BAR();
    }
    if (IN(3)) { MKFRAME();
        for (int p = blockIdx.x; p < 256; p += F.G) { const int b = p >> 6, q = p & 63;
#pragma unroll 1
            for (int u = 0; u < 2; ++u) ix::unit(F, b, u ? 127 - q : q);
#pragma unroll 1
            for (int i = 0; i < 8; ++i) ix::select_row(F, b * SEQ + 32 * ((i & 1) ? 127 - q : q) + 4 * F.wave + (i >> 1)); }
        if (BOTH(3)) GRID_BAR(); }
    if (IN(4)) { MKFRAME(); }
    if (IN(5)) { MKFRAME();
        const int v = (F.G == 256) ? ((int)(blockIdx.x & 7) * 32 + (int)(blockIdx.x >> 3)) : (int)blockIdx.x;
        for (int vv = v; vv < 256; vv += F.G) for (int i = 0; i < 4; ++i) { int b, g, qt; fa::unit_of(vv, i, b, g, qt); fp::dsa_unit(F, b, g, qt); }
#if DBG_CHECK
        for (int m = blockIdx.x; m < T; m += F.G) dsa_naive_item(F, m, WSP(bf16, WS_DBG_O0), nullptr);
        GRID_BAR_ALWAYS(); dbg_compare(F, WSP(bf16, WS_O0), WSP(bf16, WS_DBG_O0), 0);
#endif
        if (BOTH(5)) GRID_BAR(); }
    if (IN(6)) { MKFRAME();
        pg8::Gemm g{WSP(bf16, WS_O0), WSP(bf16, WB_O0), D / 2, D / 2, D / 2}; pg8::StaticOrder S; S.init(T, D, F.G, (int)blockIdx.x);
        EpiRes E{F.x, nullptr, WSP(bf16, WS_XR), MOD0 + 2048, 6144, 1.0f / (SW_GU * OS)};
        pg8::gemm_phase<EpiRes, pg8::StaticOrder, true>(F.lds, g, S, E, F.wave);
        if (BOTH(6)) GRID_BAR();
    }
    if (IN(7)) { MKFRAME();
        norm_phase(F, nullptr, F.ffn_gain, MOD0, 6144, 3072, 4096, WSP(bf16, WS_U), true, WSP(bf16, WS_XR));
        { LAS float* scr = (LAS float*)(F.lds + F.wave * 16896); for (int it = F.gw; it < NCONV_B; it += F.NGW) conv_item_b(F, it, scr); }
        if (BOTH(7)) GRID_BAR();
    }
    if (IN(8)) { MKFRAME();
        pg8::Gemm g{WSP(bf16, WS_U), WSP(bf16, WB_GU0), D / 2, D / 2, D / 2}; pg8::StaticOrder S; S.init(T, 2 * FF0, F.G, (int)blockIdx.x);
        EpiSwiglu E{WSP(unsigned char, WS_HID), FF0, 2 * FF0 / 256};
        pg8::gemm_phase<EpiSwiglu, pg8::StaticOrder, true>(F.lds, g, S, E, F.wave);
        if (BOTH(8)) GRID_BAR();
    }
    if (IN(9)) { MKFRAME();
        pg8::Gemm g{WSP(bf16, WS_HID), WSP(bf16, WB_D0), FF0 / 2, FF0 / 2, FF0 / 2}; pg8::StaticOrder S; S.init(T, D, F.G, (int)blockIdx.x);
        EpiRes E{nullptr, WSP(bf16, WS_XR), WSP(bf16, WS_XR), MOD0 + 5120, 6144, 1.0f / (SW_DN * HS)};
        pg8::gemm_phase<EpiRes, pg8::StaticOrder, true>(F.lds, g, S, E, F.wave);
        if (BOTH(9)) GRID_BAR();
    }
    if (IN(10)) { MKFRAME();
        for (int m = F.gw; m < T; m += F.NGW) {
            f32x4 v[4], u[4]; load_row_h(WSP(bf16, WS_XR) + (size_t)m * D, F.lane, v);
            const float r = row_rs(v); const int b = m >> 12;
            modulate_row(v, r, F.kv_gain, KVMOD + (size_t)b * 2048, KVMOD + (size_t)b * 2048 + 1024, F.lane, u);
            store_row_fp8(WSP(unsigned char, WS_U) + (size_t)m * D, F.lane, u);
            modulate_row(v, r, F.attn_gain + D, MOD1 + (size_t)b * 6144, MOD1 + (size_t)b * 6144 + 1024, F.lane, u);
            store_row_fp8(WSP(unsigned char, WS_U) + (size_t)(T + m) * D, F.lane, u);
        }
        if (BOTH(10)) GRID_BAR();
    }
    if (IN(11)) { MKFRAME();
        pg8::Gemm g{WSP(bf16, WS_U), WSP(bf16, WB_KVQ), D / 2, D / 2, D / 2}; KvqOrder S; S.S.init(T, 11 * 256, F.G, (int)blockIdx.x);
        EpiKVQ E{WSP(bf16, WS_KCMP), WSP(bf16, WS_VCMP), WSP(bf16, WS_KSLC), WSP(bf16, WS_VSLC), WSP(bf16, WS_KWIN), WSP(bf16, WS_VWIN), WSP(bf16, WS_Q1), WSP(float, SM_GATES), CS, SN};
        pg8::gemm_phase<EpiKVQ, KvqOrder, true>(F.lds, g, S, E, F.wave);
        if (BOTH(11)) GRID_BAR();
    }
    if (IN(12)) { MKFRAME();
        const float* cb = WSP(float, SM_CBIAS);
        LAS bf16* HL = (LAS bf16*)F.lds;
        for (int rt = blockIdx.x; rt < 256; rt += F.G) {
            const int kv = rt >> 7, lane = F.lane;
            const bf16* A = kv ? WSP(bf16, WS_VCMP) : WSP(bf16, WS_KCMP);
            const f32x16 acc = sgemm_tile(A, 1024, WSP(bf16, WB_C1) + (size_t)kv * 256 * 2048, 2048, 2048, (rt & 127) * 32, F.wave * 32, lane);
            const int col = F.wave * 32 + (lane & 31); const float bias = cb[kv * 256 + col];
#pragma unroll
            for (int r = 0; r < 16; ++r) { const int row = (r & 3) + 8 * (r >> 2) + 4 * (lane >> 5); HL[row * 264 + col] = (bf16)f2bf(gelu_tanh(acc[r] + bias)); }
            __syncthreads();
            if (F.wave < 2) {
                f32x16 o = {};
                const LAS bf16* ap = HL + (lane & 31) * 264 + 8 * (lane >> 5);
                const bf16* bp = WSP(bf16, WB_C2) + (size_t)kv * 64 * 256 + (size_t)(F.wave * 32 + (lane & 31)) * 256 + 8 * (lane >> 5);
#pragma unroll
                for (int k = 0; k < 256; k += 16) o = __builtin_amdgcn_mfma_f32_32x32x16_bf16(*(const LAS bf16x8*)(ap + k), *(const bf16x8*)(bp + k), o, 0, 0, 0);
                bf16* dst = kv ? WSP(bf16, SM_VC) : WSP(bf16, SM_KC);
                const int oc = F.wave * 32 + (lane & 31);
#pragma unroll
                for (int r = 0; r < 16; ++r) { const int row = (rt & 127) * 32 + (r & 3) + 8 * (r >> 2) + 4 * (lane >> 5); dst[(size_t)row * 64 + oc] = ((row & 255) == 255) ? (bf16)0 : (bf16)f2bf(o[r]); }
            }
            __syncthreads();
        }
        if (BOTH(12)) GRID_BAR();
    }
    if (IN(13)) { }
    if (IN(14)) { MKFRAME();
        const int v = (F.G == 256) ? ((int)(blockIdx.x & 7) * 32 + (int)(blockIdx.x >> 3)) : (int)blockIdx.x;
        for (int vv = v; vv < 256; vv += F.G) for (int i = 0; i < 4; ++i) { int b, g, qt; fa::unit_of(vv, i, b, g, qt); cm::unit(F, b, g, qt); }
        if (BOTH(14)) GRID_BAR(); }
    if (IN(15)) { MKFRAME();
        const int v = (F.G == 256) ? ((int)(blockIdx.x & 7) * 32 + (int)(blockIdx.x >> 3)) : (int)blockIdx.x;
        for (int vv = v; vv < 256; vv += F.G) for (int i = 0; i < 4; ++i) { int b, g, qt; fa::unit_of(vv, i, b, g, qt); fp::nsa_unit(F, b, g, qt); }
#if DBG_CHECK
        GRID_BAR_ALWAYS();
        for (int m = blockIdx.x; m < T; m += F.G) nsa_naive_item(F, m, WSP(bf16, WS_DBG_O1), nullptr, nullptr);
        GRID_BAR_ALWAYS(); dbg_compare(F, WSP(bf16, WS_O1), WSP(bf16, WS_DBG_O1), 2);
#endif
        if (BOTH(15)) GRID_BAR(); }
    if (IN(16)) { MKFRAME();
        pg8::Gemm g{WSP(bf16, WS_O1), WSP(bf16, WB_O1), D / 2, D / 2, D / 2}; pg8::StaticOrder S; S.init(T, D, F.G, (int)blockIdx.x);
        EpiRes E{nullptr, WSP(bf16, WS_XR), WSP(bf16, WS_XR), MOD1 + 2048, 6144, 1.0f / (SW_GU * OS)};
        pg8::gemm_phase<EpiRes, pg8::StaticOrder, true>(F.lds, g, S, E, F.wave);
        if (BOTH(16)) GRID_BAR();
    }
    if (IN(17)) { MKFRAME();
        LAS int* lcnt = (LAS int*)(F.lds);
        if (F.tid < NE) lcnt[F.tid] = 0;
        __syncthreads();
        int* toke = WSP(int, SM_TOKE); float* tokw = WSP(float, SM_TOKW);
        for (int m = F.gw; m < T; m += F.NGW) {
            f32x4 v[4], u[4]; load_row_h(WSP(bf16, WS_XR) + (size_t)m * D, F.lane, v);
            const float r = row_rs(v); const int b = m >> 12;
            modulate_row(v, r, F.ffn_gain + D, MOD1 + (size_t)b * 6144 + 3072, MOD1 + (size_t)b * 6144 + 4096, F.lane, u);
            store_row_fp8(WSP(unsigned char, WS_UM) + (size_t)m * D, F.lane, u);
            float lg[NE];
#pragma unroll
            for (int e = 0; e < NE; ++e) lg[e] = 0.f;
#pragma unroll
            for (int j = 0; j < 4; ++j) {
                const float uu[4] = {u[j].x, u[j].y, u[j].z, u[j].w};
#pragma unroll
                for (int q = 0; q < 4; ++q) { const float* wr = F.w_router + (size_t)(4 * F.lane + 256 * j + q) * NE; const f32x4 w0 = *(const f32x4*)wr, w1 = *(const f32x4*)(wr + 4);
                    lg[0] += uu[q] * w0.x; lg[1] += uu[q] * w0.y; lg[2] += uu[q] * w0.z; lg[3] += uu[q] * w0.w; lg[4] += uu[q] * w1.x; lg[5] += uu[q] * w1.y; lg[6] += uu[q] * w1.z; lg[7] += uu[q] * w1.w; }
            }
#pragma unroll
            for (int e = 0; e < NE; ++e) lg[e] = wave_sum(lg[e]);
            int e1 = 0; float v1 = lg[0];
#pragma unroll
            for (int e = 1; e < NE; ++e) if (lg[e] > v1) { v1 = lg[e]; e1 = e; }
            int e2 = -1; float v2 = -INFINITY;
#pragma unroll
            for (int e = 0; e < NE; ++e) if (e != e1 && lg[e] > v2) { v2 = lg[e]; e2 = e; }
            if (F.lane == 0) {
                const float ex = __expf(v2 - v1), w1 = 1.0f / (1.0f + ex);
                toke[2 * m] = e1; toke[2 * m + 1] = e2; tokw[2 * m] = w1; tokw[2 * m + 1] = ex * w1;
                lds_add(&lcnt[e1], 1); lds_add(&lcnt[e2], 1);
            }
        }
        __syncthreads();
        if (F.tid < NE) atomicAdd(F.ctl + CW_CNT + F.tid, (unsigned)lcnt[F.tid]);
        if (BOTH(17)) GRID_BAR();
    }
    if (IN(18)) { MKFRAME();
        LAS int* lcnt = (LAS int*)(F.lds); LAS int* lbase = lcnt + 8; LAS int* lfill = lcnt + 16;
        const int* toke = WSP(int, SM_TOKE); int* slot = WSP(int, SM_SLOT);
        const int rows_per = T / F.G, r0 = blockIdx.x * rows_per;
        if (F.tid < NE) { lcnt[F.tid] = 0; lfill[F.tid] = 0; }
        __syncthreads();
        for (int i = F.tid; i < 2 * rows_per; i += 512) lds_add(&lcnt[toke[2 * r0 + i]], 1);
        __syncthreads();
        if (F.tid < NE) {
            int off = 0; for (int e = 0; e < F.tid; ++e) off += (int)((ld_u32(F.ctl + CW_CNT + e) + 255u) >> 8) * 256;
            lbase[F.tid] = off + (int)atomicAdd(F.ctl + CW_FILL + F.tid, (unsigned)lcnt[F.tid]);
        }
        __syncthreads();
        const unsigned char* UM = WSP(unsigned char, WS_UM); unsigned char* AG = WSP(unsigned char, WS_AG);
        LAS int* SL = lcnt + 32;
        for (int i = F.tid; i < 2 * rows_per; i += 512) { const int e = toke[2 * r0 + i]; const int sl = lbase[e] + lds_add(&lfill[e], 1); SL[i] = sl; slot[2 * r0 + i] = sl; }
        __syncthreads();
        if (rows_per == 8 * NWAVES) {
            u32x4 v[8];
#pragma unroll
            for (int j = 0; j < 8; ++j) v[j] = ((const u32x4*)(UM + (size_t)(r0 + F.wave + NWAVES * j) * D))[F.lane];
#pragma unroll
            for (int j = 0; j < 8; ++j) { const int rr = F.wave + NWAVES * j; const int s0 = SL[2 * rr], s1 = SL[2 * rr + 1];
                ((u32x4*)(AG + (size_t)s0 * D))[F.lane] = v[j]; ((u32x4*)(AG + (size_t)s1 * D))[F.lane] = v[j]; }
        } else {
            for (int rr = F.wave; rr < rows_per; rr += NWAVES) { const u32x4 v = ((const u32x4*)(UM + (size_t)(r0 + rr) * D))[F.lane];
                ((u32x4*)(AG + (size_t)SL[2 * rr] * D))[F.lane] = v; ((u32x4*)(AG + (size_t)SL[2 * rr + 1] * D))[F.lane] = v; }
        }
        if (BOTH(18)) GRID_BAR();
    }
    if (IN(19)) { MKFRAME();
        pg8::Gemm g{WSP(bf16, WS_AG), WSP(bf16, WS_WGU1), D / 2, D / 2, D / 2}; MoeOrder S; S.init(F.ctl + CW_CNT, 2 * FFE / 256, F.G, (int)blockIdx.x);
        EpiSwiglu E{WSP(unsigned char, WS_HID2), FFE, 2 * FFE / 256};
        pg8::gemm_phase<EpiSwiglu, MoeOrder, true>(F.lds, g, S, E, F.wave);
        if (BOTH(19)) GRID_BAR();
    }
    if (IN(20)) { MKFRAME();
        {
            pg8::Gemm g{WSP(bf16, WS_HID2), WSP(bf16, WS_WD1), FFE / 2, FFE / 2, FFE / 2}; MoeOrder S; S.init(F.ctl + CW_CNT, D / 256, F.G, (int)blockIdx.x, 1, 0, 0, 128);
            EpiY E{WSP(bf16, WS_Y)};
            pg8::gemm_phase<EpiY, MoeOrder, true>(F.lds, g, S, E, F.wave); }
        {
            pg8::Gemm g{WSP(bf16, WS_HID2), WSP(bf16, WS_WD1), FFE / 4, FFE / 2, FFE / 2}; MoeOrder S; S.init(F.ctl + CW_CNT, D / 256, F.G, (int)blockIdx.x, 2, FFE / 2, 128);
            EpiYp E{WSP(bf16, WS_Y2)};
            pg8::gemm_phase<EpiYp, MoeOrder, true>(F.lds, g, S, E, F.wave); }
        if (BOTH(20)) GRID_BAR();
    }
    if (IN(21)) { MKFRAME();
        const int* slot = WSP(int, SM_SLOT); const float* tokw = WSP(float, SM_TOKW); const bf16* Y = WSP(bf16, WS_Y); const bf16* Yp = WSP(bf16, WS_Y2);
        for (int m = F.gw; m < T; m += F.NGW) {
            f32x4 v[4]; load_row_h(WSP(bf16, WS_XR) + (size_t)m * D, F.lane, v);
            const int b = m >> 12; const int s1 = slot[2 * m], s2 = slot[2 * m + 1]; const float w1 = tokw[2 * m], w2 = tokw[2 * m + 1];
            const float* fg = MOD1 + (size_t)b * 6144 + 5120;
#pragma unroll
            for (int j = 0; j < 4; ++j) {
                const f32x4 ya = yrow(Y, Yp, s1, F.lane + 64 * j), yb = yrow(Y, Yp, s2, F.lane + 64 * j);
                const f32x4 gq = ((const f32x4*)fg)[F.lane + 64 * j];
                const f32x4 y = ya * w1 + yb * w2;
                v[j] = v[j] + gq * y;
            }
            const float r = row_rs(v);
#pragma unroll
            for (int j = 0; j < 4; ++j) { const f32x4 gn = ((const f32x4*)F.final_gain)[F.lane + 64 * j]; ((f32x4*)(F.outw + (size_t)m * D))[F.lane + 64 * j] = v[j] * r * gn; }
        }
#if DBG_TIME
        {
            if (blockIdx.x == 0 && F.tid == 0) { tsl[NPHASE] = __builtin_amdgcn_s_memrealtime();
                const float ua = 0.01f * (float)(tsl[DBG_TA + 1] - tsl[DBG_TA]), ub = 0.01f * (float)(tsl[DBG_TB + 1] - tsl[DBG_TB]);
                const float cc = sqrtf(10.0f * ua);
                __hip_atomic_store(F.ctl + CW_DBG + 8, __builtin_bit_cast(unsigned, cc), RLX_AGENT); __hip_atomic_store(F.ctl + CW_DBG + 9, __builtin_bit_cast(unsigned, cc * (1.0f + ub * 0.05f)), RLX_AGENT); }
            GRID_BAR_ALWAYS();
            const float cc = __builtin_bit_cast(float, ld_u32(F.ctl + CW_DBG + 8)), c0 = __builtin_bit_cast(float, ld_u32(F.ctl + CW_DBG + 9));
            for (int m = F.gw; m < T; m += F.NGW) for (int j = 0; j < 4; ++j) ((f32x4*)(F.out + (size_t)m * D))[F.lane + 64 * j] = (f32x4){cc, cc, cc, cc};
            GRID_BAR_ALWAYS();
            if (blockIdx.x == 0 && F.tid == 0) F.out[0] = c0;
        }
#endif
#if DBG_CHECK
        {
            const float sd0 = __builtin_bit_cast(float, ld_u32(F.ctl + CW_DBG)), sr0 = __builtin_bit_cast(float, ld_u32(F.ctl + CW_DBG + 1));
            const float sd1 = __builtin_bit_cast(float, ld_u32(F.ctl + CW_DBG + 2)), sr1 = __builtin_bit_cast(float, ld_u32(F.ctl + CW_DBG + 3));
            const float e0 = sqrtf(sd0 / sr0), e1 = sqrtf(sd1 / sr1);
            const float cc = sqrtf(1e6f * e0);
            __syncthreads();
            for (int m = F.gw; m < T; m += F.NGW) for (int j = 0; j < 4; ++j) ((f32x4*)(F.out + (size_t)m * D))[F.lane + 64 * j] = (f32x4){cc, cc, cc, cc};
            GRID_BAR_ALWAYS();
            if (blockIdx.x == 0 && F.tid == 0) F.out[0] = cc * (1.0f + 1000.0f * e1);
        }
#endif
    }
#undef IN
#undef BOTH
}

extern "C" void kernel_launch(void* const* d_in, const int* in_sizes, int n_in, void* d_out, int out_size, void* d_ws, size_t ws_size, hipStream_t stream) {
    static int grid = 0;
    if (grid == 0) {
        if (n_in != 29 || out_size != T * D || ws_size < WS_END) { fprintf(stderr, "kernel_launch: unexpected problem (n_in %d, out %d, ws %zu)\n", n_in, out_size, ws_size); grid = -1; return; }
        int dev = 0, cus = 0, per_cu = 0;
        if (hipGetDevice(&dev) != hipSuccess || hipDeviceGetAttribute(&cus, hipDeviceAttributeMultiprocessorCount, dev) != hipSuccess) { grid = -1; return; }
        if (hipFuncSetAttribute((const void*)trunk_fwd, hipFuncAttributeMaxDynamicSharedMemorySize, LDS_BYTES) != hipSuccess) { fprintf(stderr, "kernel_launch: hipFuncSetAttribute failed\n"); grid = -1; return; }
        if (hipOccupancyMaxActiveBlocksPerMultiprocessor(&per_cu, (const void*)trunk_fwd, NWAVES * 64, LDS_BYTES) != hipSuccess || per_cu < 1) { fprintf(stderr, "kernel_launch: occupancy query says %d\n", per_cu); }
        (void)hipGetLastError();
        grid = cus;
        if (T % grid != 0) { fprintf(stderr, "kernel_launch: grid %d does not divide the token count\n", grid); grid = -1; return; }
    }
    if (grid < 0) return;
    if (hipMemsetAsync((char*)d_ws + WS_CTL, 0, CTL_ZERO_BYTES, stream) != hipSuccess) return;
    Args a{};
    for (int i = 0; i < 29; ++i) a.in[i] = d_in[i];
    a.out = (float*)d_out; a.ws = (unsigned char*)d_ws;
#if MK_PER_PHASE
    for (int p = 0; p < NPHASE; ++p) { a.ph_lo = p; a.ph_hi = p + 1; a.li = p; hipLaunchKernelGGL(trunk_fwd, dim3(grid), dim3(NWAVES * 64), LDS_BYTES, stream, a); }
#elif defined(PROBE_LO)
#ifndef PROBE_DRY
#define PROBE_DRY 0
#endif
    { const int cuts[4] = {0, PROBE_HI, PROBE_LO, PROBE_HI};
      a.ph_lo = 0; a.ph_hi = PROBE_HI; a.li = 0; hipLaunchKernelGGL(trunk_fwd, dim3(grid), dim3(NWAVES * 64), LDS_BYTES, stream, a);
      a.ph_lo = PROBE_LO; a.ph_hi = PROBE_HI; a.li = 1; a.pad = PROBE_DRY; hipLaunchKernelGGL(trunk_fwd, dim3(grid), dim3(NWAVES * 64), LDS_BYTES, stream, a);
      a.pad = 0; if (PROBE_HI < NPHASE) { a.ph_lo = PROBE_HI; a.ph_hi = NPHASE; a.li = 2; hipLaunchKernelGGL(trunk_fwd, dim3(grid), dim3(NWAVES * 64), LDS_BYTES, stream, a); } (void)cuts; }
#else
    a.ph_lo = 0; a.ph_hi = NPHASE; a.li = 0;
    hipLaunchKernelGGL(trunk_fwd, dim3(grid), dim3(NWAVES * 64), LDS_BYTES, stream, a);
#endif
    const hipError_t le = hipPeekAtLastError();
    if (le != hipSuccess) fprintf(stderr, "kernel_launch: launch failed: %s\n", hipGetErrorName(le));
}
```
